# Optimizing an MI355X kernel written in HIP

```python
import math
import jax
import jax.numpy as jnp
from jax import lax
import numpy as np

D_MODEL = 1024
BATCH = 1
SEQ = 16384
DEPTH = 4

HEAD_DIM = 64
CHUNK = 64
FOX_HEADS = 4
FOX_BLOCK = 128
GLA_HEADS = 4
GLA_LOWRANK = 16
GLA_TAU = 16.0
RET_HEADS = 4
ROPE_THETA = 10000.0
SSD_HEADS = 8
SSD_GROUPS = 2
SSD_STATE = 64
SSD_CONV = 4
SSD_INNER = SSD_HEADS * HEAD_DIM
SSD_CONV_CH = SSD_INNER + 2 * SSD_GROUPS * SSD_STATE
FOX_W = FOX_HEADS * HEAD_DIM
GLA_W = GLA_HEADS * HEAD_DIM
RET_W = RET_HEADS * HEAD_DIM
N_BRANCH = 4
FFN_HIDDEN = ((8 * D_MODEL + 3 * 256 - 1) // (3 * 256)) * 256
NORM_EPS = 1e-6
IN_SPLITS = (FOX_W, FOX_W, FOX_W, FOX_HEADS,
             GLA_W, GLA_W, GLA_W, GLA_LOWRANK, GLA_W,
             RET_W, RET_W, RET_W, RET_W,
             SSD_INNER, SSD_CONV_CH, SSD_HEADS,
             N_BRANCH * D_MODEL)
N_IN = sum(IN_SPLITS)

kernel_name = 'hybrid_fox_gla_ret_ssd_trunk'


def rms_norm(x, g):
    xf = x.astype(jnp.float32)
    y = xf * lax.rsqrt(jnp.mean(xf * xf, axis=-1, keepdims=True) + NORM_EPS)
    return (y * g.astype(jnp.float32)).astype(x.dtype)


def split_cols(u, sizes):
    return jnp.split(u, np.cumsum(sizes)[:-1].tolist(), axis=-1)


def rotary_tables(positions):
    half = HEAD_DIM // 2
    inv = ROPE_THETA ** (-jnp.arange(half, dtype=jnp.float32) / half)
    ang = positions.astype(jnp.float32)[..., None] * inv
    return jnp.cos(ang)[:, :, None, :], jnp.sin(ang)[:, :, None, :]


def apply_rotary(x, cos, sin):
    half = x.shape[-1] // 2
    xf = x.astype(jnp.float32)
    x1, x2 = xf[..., :half], xf[..., half:]
    return jnp.concatenate([x1 * cos - x2 * sin, x1 * sin + x2 * cos], axis=-1).astype(x.dtype)


def causal_depthwise_conv(x, w, b):
    k_w, ch = w.shape
    y = lax.conv_general_dilated(x, w[:, None, :], window_strides=(1,), padding=[(k_w - 1, 0)],
                                 dimension_numbers=('NWC', 'WIO', 'NWC'), feature_group_count=ch)
    return y + b


def forgetting_attention(q, k, v, f_logit, q_gain, k_gain):
    bsz, seq, nh, dh = q.shape
    nb = seq // FOX_BLOCK
    qf = rms_norm(q, q_gain).astype(jnp.float32) * (dh ** -0.5)
    kf = rms_norm(k, k_gain).astype(jnp.float32)
    vf = v.astype(jnp.float32)
    c = jnp.cumsum(jax.nn.log_sigmoid(f_logit.astype(jnp.float32)), axis=1)
    qb = qf.reshape(bsz, nb, FOX_BLOCK, nh, dh).transpose(1, 0, 3, 2, 4)
    cb = c.reshape(bsz, nb, FOX_BLOCK, nh).transpose(1, 0, 3, 2)
    ck = c.transpose(0, 2, 1)
    kpos = jnp.arange(seq)

    def block(args):
        q_blk, c_blk, i = args
        s = jnp.einsum('bhqd,bkhd->bhqk', q_blk, kf) + c_blk[..., :, None] - ck[..., None, :]
        qpos = i * FOX_BLOCK + jnp.arange(FOX_BLOCK)
        s = jnp.where(kpos[None, :] <= qpos[:, None], s, -jnp.inf)
        p = jax.nn.softmax(s, axis=-1)
        return jnp.einsum('bhqk,bkhd->bqhd', p, vf)

    o = lax.map(block, (qb, cb, jnp.arange(nb)))
    return o.transpose(1, 0, 2, 3, 4).reshape(bsz, seq, nh * dh).astype(v.dtype)


def gla_chunked(q, k, v, log_a):
    bsz, seq, nh, dk = q.shape
    dv = v.shape[-1]
    nc = seq // CHUNK
    qf = (q.astype(jnp.float32) * (dk ** -0.5)).reshape(bsz, nc, CHUNK, nh, dk)
    kf = k.astype(jnp.float32).reshape(bsz, nc, CHUNK, nh, dk)
    vf = v.astype(jnp.float32).reshape(bsz, nc, CHUNK, nh, dv)
    b = jnp.cumsum(log_a.astype(jnp.float32).reshape(bsz, nc, CHUNK, nh, dk), axis=2)
    b_last = b[:, :, -1]
    q_dec = qf * jnp.exp(b)
    k_inv = kf * jnp.exp(-b)
    k_end = kf * jnp.exp(b_last[:, :, None] - b)
    mask = jnp.tril(jnp.ones((CHUNK, CHUNK), dtype=bool))
    attn = jnp.where(mask, jnp.einsum('bcthd,bcshd->bchts', q_dec, k_inv), 0.0)
    o_intra = jnp.einsum('bchts,bcshv->bcthv', attn, vf)
    kv = jnp.einsum('bcshd,bcshv->bchdv', k_end, vf)

    def step(state, inp):
        kv_c, dec_c = inp
        return state * dec_c[..., None] + kv_c, state

    s0 = jnp.zeros((bsz, nh, dk, dv), jnp.float32)
    _, s_in = lax.scan(step, s0, (jnp.moveaxis(kv, 1, 0), jnp.moveaxis(jnp.exp(b_last), 1, 0)))
    s_in = jnp.moveaxis(s_in, 0, 1)
    o_inter = jnp.einsum('bcthd,bchdv->bcthv', q_dec, s_in)
    return (o_intra + o_inter).reshape(bsz, seq, nh, dv).astype(v.dtype)


def retention_chunked(q, k, v, log_gamma):
    bsz, seq, nh, dk = q.shape
    dv = v.shape[-1]
    nc = seq // CHUNK
    qf = q.astype(jnp.float32).reshape(bsz, nc, CHUNK, nh, dk)
    kf = (k.astype(jnp.float32) * (dk ** -0.5)).reshape(bsz, nc, CHUNK, nh, dk)
    vf = v.astype(jnp.float32).reshape(bsz, nc, CHUNK, nh, dv)
    idx = jnp.arange(CHUNK, dtype=jnp.float32)
    rel = idx[:, None] - idx[None, :]
    decay = jnp.where(rel >= 0, jnp.exp(jnp.maximum(rel, 0.0)[None] * log_gamma[:, None, None]), 0.0)
    scores = jnp.einsum('bcthd,bcshd->bchts', qf, kf) * decay
    o_intra = jnp.einsum('bchts,bcshv->bcthv', scores, vf)
    q_w = jnp.exp((idx + 1.0)[:, None] * log_gamma)
    k_w = jnp.exp((CHUNK - 1.0 - idx)[:, None] * log_gamma)
    kv = jnp.einsum('bcshd,sh,bcshv->bchdv', kf, k_w, vf)
    chunk_decay = jnp.exp(CHUNK * log_gamma)

    def step(state, kv_c):
        return state * chunk_decay[:, None, None] + kv_c, state

    s0 = jnp.zeros((bsz, nh, dk, dv), jnp.float32)
    _, s_in = lax.scan(step, s0, jnp.moveaxis(kv, 1, 0))
    s_in = jnp.moveaxis(s_in, 0, 1)
    o_inter = jnp.einsum('bcthd,th,bchdv->bcthv', qf, q_w, s_in)
    return (o_intra + o_inter).reshape(bsz, seq, nh, dv).astype(v.dtype)


def ssd_chunked(x, dt, a, bmat, cmat):
    bsz, seq, nh, hp = x.shape
    ng, ns = bmat.shape[2], bmat.shape[3]
    r = nh // ng
    nc = seq // CHUNK
    xf = x.astype(jnp.float32).reshape(bsz, nc, CHUNK, ng, r, hp)
    dtf = dt.astype(jnp.float32).reshape(bsz, nc, CHUNK, ng, r)
    bf = bmat.astype(jnp.float32).reshape(bsz, nc, CHUNK, ng, ns)
    cf = cmat.astype(jnp.float32).reshape(bsz, nc, CHUNK, ng, ns)
    xdt = xf * dtf[..., None]
    cs = jnp.cumsum(dtf * a.astype(jnp.float32).reshape(ng, r), axis=2)
    cs_h = jnp.moveaxis(cs, 2, -1)
    mask = jnp.tril(jnp.ones((CHUNK, CHUNK), dtype=bool))
    seg = cs_h[..., :, None] - cs_h[..., None, :]
    decay = jnp.exp(jnp.where(mask, seg, -jnp.inf))
    cb = jnp.einsum('bctgn,bcsgn->bcgts', cf, bf)
    y_intra = jnp.einsum('bcgts,bcgrts,bcsgrp->bctgrp', cb, decay, xdt)
    cs_last = cs[:, :, -1]
    w_end = jnp.exp(cs_last[:, :, None] - cs)
    contrib = jnp.einsum('bcsgn,bcsgr,bcsgrp->bcgrpn', bf, w_end, xdt)

    def step(h, inp):
        c_c, d_c = inp
        return h * d_c[..., None, None] + c_c, h

    h0 = jnp.zeros((bsz, ng, r, hp, ns), jnp.float32)
    _, h_in = lax.scan(step, h0, (jnp.moveaxis(contrib, 1, 0), jnp.moveaxis(jnp.exp(cs_last), 1, 0)))
    h_in = jnp.moveaxis(h_in, 0, 1)
    y_inter = jnp.einsum('bctgn,bcgrpn,bctgr->bctgrp', cf, h_in, jnp.exp(cs))
    return (y_intra + y_inter).reshape(bsz, seq, nh, hp).astype(x.dtype)


def mixer_block(h, cos, sin, w_in, fox_bf, fox_qn, fox_kn, gla_w2, gla_b, gla_norm, ret_norm,
                conv_w, conv_b, dt_bias, a_log, d_skip, ssd_norm, w_up_a, w_up_b, w_up_c, w_up_d, w_out):
    bsz, seq, _ = h.shape
    u = h @ w_in
    (fq, fk, fv, ff, gq, gk, gv, glr, gr, rq, rk, rv, rg, z, xbc, dt, gates) = split_cols(u, IN_SPLITS)
    heads = lambda t: t.reshape(bsz, seq, -1, HEAD_DIM)
    y_a = forgetting_attention(heads(fq), heads(fk), heads(fv), ff + fox_bf, fox_qn, fox_kn)
    log_a = jax.nn.log_sigmoid((glr @ gla_w2 + gla_b).astype(jnp.float32)) / GLA_TAU
    o_b = gla_chunked(heads(gq), heads(gk), heads(gv), heads(log_a))
    y_b = (rms_norm(o_b, gla_norm) * jax.nn.silu(heads(gr))).reshape(bsz, seq, GLA_W)
    log_gamma = jnp.log(1.0 - 2.0 ** (-5.0 - jnp.arange(RET_HEADS, dtype=jnp.float32)))
    o_c = retention_chunked(apply_rotary(heads(rq), cos, sin), apply_rotary(heads(rk), cos, sin), heads(rv), log_gamma)
    y_c = (rms_norm(o_c, ret_norm) * jax.nn.silu(heads(rg))).reshape(bsz, seq, RET_W)
    xbc = jax.nn.silu(causal_depthwise_conv(xbc, conv_w, conv_b))
    xs, bm, cm = jnp.split(xbc, [SSD_INNER, SSD_INNER + SSD_GROUPS * SSD_STATE], axis=-1)
    dt = jax.nn.softplus((dt + dt_bias).astype(jnp.float32))
    a = -jnp.exp(a_log.astype(jnp.float32))
    xs_h = heads(xs)
    o_d = ssd_chunked(xs_h, dt, a, bm.reshape(bsz, seq, SSD_GROUPS, SSD_STATE), cm.reshape(bsz, seq, SSD_GROUPS, SSD_STATE))
    o_d = o_d + d_skip[:, None] * xs_h
    y_d = (o_d.reshape(bsz, seq, SSD_INNER) * jax.nn.silu(z)).reshape(bsz, seq, SSD_GROUPS, -1)
    y_d = rms_norm(y_d, ssd_norm.reshape(SSD_GROUPS, -1)).reshape(bsz, seq, SSD_INNER)
    g = jax.nn.sigmoid(gates.reshape(bsz, seq, N_BRANCH, D_MODEL))
    merged = (g[:, :, 0] * (y_a @ w_up_a) + g[:, :, 1] * (y_b @ w_up_b)
              + g[:, :, 2] * (y_c @ w_up_c) + g[:, :, 3] * (y_d @ w_up_d))
    return merged @ w_out


def swiglu(h, w_in, w_out):
    gate, up = jnp.split(h @ w_in, 2, axis=-1)
    return (jax.nn.silu(gate) * up) @ w_out


def setup_inputs(seed: int = 0) -> dict:
    key = jax.random.key(seed)
    ks = jax.random.split(key, 26)
    f32 = jnp.float32
    L = DEPTH

    def normal(k, shape, fan_in):
        return jax.random.normal(k, shape, f32) * (fan_in ** -0.5)

    def gain(k, shape):
        return 1.0 + 0.02 * jax.random.normal(k, shape, f32)

    x = jax.random.normal(ks[0], (BATCH, SEQ, D_MODEL), f32)
    start = jax.random.randint(ks[1], (BATCH, 1), 0, 1024, dtype=jnp.int32)
    positions = start + jnp.arange(SEQ, dtype=jnp.int32)[None, :]
    dt0 = jnp.exp(jax.random.uniform(ks[14], (L, SSD_HEADS), f32, math.log(1e-3), math.log(1e-1)))
    return {
        'x': x,
        'positions': positions,
        'ln1': gain(ks[2], (L, D_MODEL)),
        'ln2': gain(ks[3], (L, D_MODEL)),
        'w_in': normal(ks[4], (L, D_MODEL, N_IN), D_MODEL),
        'fox_bf': jax.random.uniform(ks[5], (L, FOX_HEADS), f32, 1.0, 5.0),
        'fox_qn': gain(ks[6], (L, HEAD_DIM)),
        'fox_kn': gain(ks[7], (L, HEAD_DIM)),
        'gla_w2': normal(ks[8], (L, GLA_LOWRANK, GLA_W), GLA_LOWRANK),
        'gla_b': 0.1 * jax.random.normal(ks[9], (L, GLA_W), f32),
        'gla_norm': gain(ks[10], (L, HEAD_DIM)),
        'ret_norm': gain(ks[11], (L, HEAD_DIM)),
        'ssd_conv_w': normal(ks[12], (L, SSD_CONV, SSD_CONV_CH), SSD_CONV),
        'ssd_conv_b': 0.01 * jax.random.normal(ks[13], (L, SSD_CONV_CH), f32),
        'ssd_dt_bias': dt0 + jnp.log(-jnp.expm1(-dt0)),
        'ssd_a_log': jnp.log(jax.random.uniform(ks[15], (L, SSD_HEADS), f32, 1.0, 16.0)),
        'ssd_d': 1.0 + 0.1 * jax.random.normal(ks[16], (L, SSD_HEADS), f32),
        'ssd_norm': gain(ks[17], (L, SSD_INNER)),
        'w_up_a': normal(ks[18], (L, FOX_W, D_MODEL), FOX_W),
        'w_up_b': normal(ks[19], (L, GLA_W, D_MODEL), GLA_W),
        'w_up_c': normal(ks[20], (L, RET_W, D_MODEL), RET_W),
        'w_up_d': normal(ks[21], (L, SSD_INNER, D_MODEL), SSD_INNER),
        'w_out': normal(ks[22], (L, D_MODEL, D_MODEL), D_MODEL),
        'w_ffn_in': normal(ks[23], (L, D_MODEL, 2 * FFN_HIDDEN), D_MODEL),
        'w_ffn_out': normal(ks[24], (L, FFN_HIDDEN, D_MODEL), FFN_HIDDEN),
    }


def reference(x, positions, ln1, ln2, w_in, fox_bf, fox_qn, fox_kn, gla_w2, gla_b, gla_norm, ret_norm,
              ssd_conv_w, ssd_conv_b, ssd_dt_bias, ssd_a_log, ssd_d, ssd_norm,
              w_up_a, w_up_b, w_up_c, w_up_d, w_out, w_ffn_in, w_ffn_out):
    cos, sin = rotary_tables(positions)
    for l in range(DEPTH):
        h = rms_norm(x, ln1[l])
        x = x + mixer_block(h, cos, sin, w_in[l], fox_bf[l], fox_qn[l], fox_kn[l], gla_w2[l], gla_b[l],
                            gla_norm[l], ret_norm[l], ssd_conv_w[l], ssd_conv_b[l], ssd_dt_bias[l],
                            ssd_a_log[l], ssd_d[l], ssd_norm[l], w_up_a[l], w_up_b[l], w_up_c[l],
                            w_up_d[l], w_out[l])
        h = rms_norm(x, ln2[l])
        x = x + swiglu(h, w_ffn_in[l], w_ffn_out[l])
    return x
```

```cpp
#include <hip/hip_runtime.h>
#include <hip/hip_bf16.h>
#include <hip/hip_cooperative_groups.h>
#include <cstdio>
namespace cg = cooperative_groups;

typedef __attribute__((ext_vector_type(8))) short bf16x8;
typedef __attribute__((ext_vector_type(4))) float f32x4;
typedef unsigned short bfu;

#define S_LEN 16384
#define DM 1024
#define NU 8192
#define NINP 8448
#define NSRC 8220
#define FH 2816
#define NCH 256
#define LDP 72
#define YW 1280
#define EPS 1e-6f
#define SMEM_HALF 73728
#define SMEM_BYTES 147456
#define NTHREADS 512
#define PH_PER_LAYER 10
#ifndef PROBE_DUP
#define PROBE_DUP -1
#endif

struct Params {
  const float* in[25];
  float* out;
  unsigned char* ws;
};
typedef const __attribute__((address_space(4))) Params CParams;
constexpr size_t OFF_WinT = 0;
constexpr size_t OFF_WupT = OFF_WinT + (((size_t)NINP*DM*2 + 255) & ~(size_t)255);
constexpr size_t OFF_WoutT = OFF_WupT + (((size_t)DM*YW*2 + 255) & ~(size_t)255);
constexpr size_t OFF_WfiT = OFF_WoutT + (((size_t)DM*DM*2 + 255) & ~(size_t)255);
constexpr size_t OFF_WfoT = OFF_WfiT + (((size_t)2*FH*DM*2 + 255) & ~(size_t)255);
constexpr size_t OFF_u = OFF_WfoT + (((size_t)DM*FH*2 + 255) & ~(size_t)255);
constexpr size_t OFF_small = OFF_u + (((size_t)S_LEN*NU*2 + 255) & ~(size_t)255);
constexpr size_t OFF_h = OFF_small + (((size_t)S_LEN*32*4 + 255) & ~(size_t)255);
constexpr size_t OFF_y = OFF_h + (((size_t)S_LEN*DM*2 + 255) & ~(size_t)255);
constexpr size_t OFF_ssq = OFF_y + (((size_t)S_LEN*YW*2 + 255) & ~(size_t)255);
constexpr size_t OFF_foxq = OFF_ssq + (((size_t)S_LEN*8*4 + 255) & ~(size_t)255);
constexpr size_t OFF_foxk = OFF_foxq + (((size_t)4*S_LEN*64*2 + 255) & ~(size_t)255);
constexpr size_t OFF_foxvT = OFF_foxk + (((size_t)4*S_LEN*64*2 + 255) & ~(size_t)255);
constexpr size_t OFF_foxc = OFF_foxvT + (((size_t)4*S_LEN*64*2 + 255) & ~(size_t)255);
constexpr size_t OFF_foxtot = OFF_foxc + (((size_t)4*S_LEN*4 + 255) & ~(size_t)255);
constexpr size_t OFF_VT = OFF_foxtot + (((size_t)4*NCH*4 + 255) & ~(size_t)255);
constexpr size_t OFF_ST = OFF_VT + (((size_t)16*NCH*4096*2 + 255) & ~(size_t)255);
constexpr size_t OFF_dec = OFF_ST + (((size_t)16*NCH*4096*2 + 255) & ~(size_t)255);
constexpr size_t OFF_csb = OFF_dec + (((size_t)16*NCH*64*4 + 255) & ~(size_t)255);
constexpr size_t OFF_ssdX = OFF_csb + (((size_t)16*S_LEN*4 + 255) & ~(size_t)255);
constexpr size_t OFF_ssdB = OFF_ssdX + (((size_t)S_LEN*512*2 + 255) & ~(size_t)255);
constexpr size_t OFF_ssdC = OFF_ssdB + (((size_t)2*S_LEN*64*2 + 255) & ~(size_t)255);
constexpr size_t OFF_rcos = OFF_ssdC + (((size_t)2*S_LEN*64*2 + 255) & ~(size_t)255);
constexpr size_t OFF_rsin = OFF_rcos + (((size_t)S_LEN*32*4 + 255) & ~(size_t)255);
constexpr size_t OFF_ctr = OFF_rsin + (((size_t)S_LEN*32*4 + 255) & ~(size_t)255);
constexpr size_t OFF_bar = OFF_ctr + (((size_t)256 + 255) & ~(size_t)255);
constexpr size_t WS_NEED = OFF_bar + 256;

__device__ __forceinline__ bfu f2bf(float f) {
  unsigned u = __float_as_uint(f);
  u += 0x7fffu + ((u >> 16) & 1u);
  return (bfu)(u >> 16);
}
__device__ __forceinline__ float bf2f(bfu b) { return __uint_as_float(((unsigned)b) << 16); }
__device__ __forceinline__ float sigmoidf_(float x) { return 1.f / (1.f + __expf(-x)); }
__device__ __forceinline__ float siluf_(float x) { return x / (1.f + __expf(-x)); }
__device__ __forceinline__ float logsigmoidf_(float z) { return fminf(z, 0.f) - log1pf(expf(-fabsf(z))); }
__device__ __forceinline__ float logsigmoid_fast(float z) { return fminf(z, 0.f) - __logf(1.f + __expf(-fabsf(z))); }
__device__ __forceinline__ float softplus_fast(float z) { return fmaxf(z, 0.f) + __logf(1.f + __expf(-fabsf(z))); }
__device__ __forceinline__ float softplusf_(float z) { return fmaxf(z, 0.f) + log1pf(expf(-fabsf(z))); }

namespace pg8 { __device__ __forceinline__ unsigned cvt_pk_bf16(float lo, float hi); }
__device__ __forceinline__ bf16x8 lds_frag(const bfu* base, int row, int kofs, int stride) {
  return *reinterpret_cast<const bf16x8*>(base + row * stride + kofs);
}

__device__ __forceinline__ void mma16x64(f32x4 (&acc)[4], const bfu* sA, int arow0, const bfu* sB, int lane) {
  const int r = lane & 15, q = (lane >> 4) * 8;
#pragma unroll
  for (int ks = 0; ks < 2; ++ks) {
    bf16x8 a = lds_frag(sA, arow0 + r, ks * 32 + q, LDP);
#pragma unroll
    for (int n = 0; n < 4; ++n) {
      bf16x8 b = lds_frag(sB, n * 16 + r, ks * 32 + q, LDP);
      acc[n] = __builtin_amdgcn_mfma_f32_16x16x32_bf16(a, b, acc[n], 0, 0, 0);
    }
  }
}

__device__ __forceinline__ void load_tile64(bfu* s, const bfu* g, int gs, int tid) {
#pragma unroll
  for (int i = 0; i < 2; ++i) {
    int id = tid + i * 256;
    int r = id >> 3, c = (id & 7) * 8;
    *reinterpret_cast<uint4*>(s + r * LDP + c) = *reinterpret_cast<const uint4*>(g + (size_t)r * gs + c);
  }
}

template <int NI>
__device__ __forceinline__ void gemm_main(f32x4 (&acc)[4][NI], const bfu* __restrict__ A, int lda,
                                          const bfu* __restrict__ Bt, int ldb, int K, bfu* smem, int tid) {
  bfu* sA = smem;
  bfu* sB = smem + 2 * 128 * LDP;
  const int lane = tid & 63, w = tid >> 6, wm = w >> 1, wn = w & 1;
  const int lr = lane & 15, lq = (lane >> 4) * 8;
  const int crow = tid >> 3, ccol = (tid & 7) * 8;
  const bfu* Ap = A + (size_t)crow * lda + ccol;
  const bfu* Bp = Bt + (size_t)crow * ldb + ccol;
  uint4 ra[4], rb[NI];
#pragma unroll
  for (int i = 0; i < 4; ++i) ra[i] = *reinterpret_cast<const uint4*>(Ap + (size_t)i * 32 * lda);
#pragma unroll
  for (int i = 0; i < NI; ++i) rb[i] = *reinterpret_cast<const uint4*>(Bp + (size_t)i * 32 * ldb);
#pragma unroll
  for (int i = 0; i < 4; ++i) *reinterpret_cast<uint4*>(sA + (crow + i * 32) * LDP + ccol) = ra[i];
#pragma unroll
  for (int i = 0; i < NI; ++i) *reinterpret_cast<uint4*>(sB + (crow + i * 32) * LDP + ccol) = rb[i];
  __syncthreads();
  const int nk = K >> 6;
  for (int kt = 0; kt < nk; ++kt) {
    const int cur = kt & 1;
    if (kt + 1 < nk) {
      const int ko = (kt + 1) * 64;
#pragma unroll
      for (int i = 0; i < 4; ++i) ra[i] = *reinterpret_cast<const uint4*>(Ap + (size_t)i * 32 * lda + ko);
#pragma unroll
      for (int i = 0; i < NI; ++i) rb[i] = *reinterpret_cast<const uint4*>(Bp + (size_t)i * 32 * ldb + ko);
    }
    const bfu* a_s = sA + cur * 128 * LDP + (wm * 64) * LDP;
    const bfu* b_s = sB + cur * 128 * LDP + (wn * NI * 16) * LDP;
#pragma unroll
    for (int ks = 0; ks < 2; ++ks) {
      bf16x8 af[4], bfr[NI];
#pragma unroll
      for (int mi = 0; mi < 4; ++mi) af[mi] = lds_frag(a_s, mi * 16 + lr, ks * 32 + lq, LDP);
#pragma unroll
      for (int ni = 0; ni < NI; ++ni) bfr[ni] = lds_frag(b_s, ni * 16 + lr, ks * 32 + lq, LDP);
#pragma unroll
      for (int mi = 0; mi < 4; ++mi)
#pragma unroll
        for (int ni = 0; ni < NI; ++ni)
          acc[mi][ni] = __builtin_amdgcn_mfma_f32_16x16x32_bf16(af[mi], bfr[ni], acc[mi][ni], 0, 0, 0);
    }
    if (kt + 1 < nk) {
      bfu* sAn = sA + (cur ^ 1) * 128 * LDP;
      bfu* sBn = sB + (cur ^ 1) * 128 * LDP;
#pragma unroll
      for (int i = 0; i < 4; ++i) *reinterpret_cast<uint4*>(sAn + (crow + i * 32) * LDP + ccol) = ra[i];
#pragma unroll
      for (int i = 0; i < NI; ++i) *reinterpret_cast<uint4*>(sBn + (crow + i * 32) * LDP + ccol) = rb[i];
    }
    __syncthreads();
  }
}

template <int NI>
__device__ __forceinline__ void zero_acc(f32x4 (&acc)[4][NI]) {
#pragma unroll
  for (int i = 0; i < 4; ++i)
#pragma unroll
    for (int j = 0; j < NI; ++j) acc[i][j] = (f32x4){0.f, 0.f, 0.f, 0.f};
}

__device__ __forceinline__ int win_src(int dc) {
  if (dc < 768) return dc;
  if (dc < 1536) return dc + 4;
  if (dc < 4096) return dc + 20;
  if (dc < 8192) return dc + 28;
  int s = dc - 8192;
  if (s < 4) return 768 + s;
  if (s < 20) return 1540 + (s - 4);
  if (s < 28) return 4116 + (s - 20);
  return -1;
}
__device__ __forceinline__ int ffi_src(int dc) {
  const int G = dc >> 5, w = dc & 31, f = w >> 3, r = w & 7;
  return (r < 4) ? (G * 16 + f * 4 + r) : (FH + G * 16 + f * 4 + (r - 4));
}

__device__ __forceinline__ void convert_tile(const float* __restrict__ W, int ldw, int kt, int ntd, bfu* __restrict__ Wt,
                                             int ldt, int kofs, int mode, const float* __restrict__ rowgain,
                                             bfu* sT, int tid) {
  const int c4 = (tid & 15) * 4, r0 = tid >> 4;
  const int dc = ntd * 64 + c4;
  int sc = dc;
  if (mode == 1) sc = win_src(dc);
  else if (mode == 2) sc = ffi_src(dc);
#pragma unroll
  for (int ps = 0; ps < 4; ++ps) {
    int kk = r0 + ps * 16;
    int k = kt * 64 + kk;
    float4 v = make_float4(0.f, 0.f, 0.f, 0.f);
    if (sc >= 0) v = *reinterpret_cast<const float4*>(W + (size_t)k * ldw + sc);
    if (rowgain) { float g = rowgain[k]; v.x *= g; v.y *= g; v.z *= g; v.w *= g; }
    sT[(c4 + 0) * LDP + kk] = f2bf(v.x);
    sT[(c4 + 1) * LDP + kk] = f2bf(v.y);
    sT[(c4 + 2) * LDP + kk] = f2bf(v.z);
    sT[(c4 + 3) * LDP + kk] = f2bf(v.w);
  }
  __syncthreads();
#pragma unroll
  for (int i = 0; i < 2; ++i) {
    int id = tid + i * 256;
    int nn = id >> 3, kc = (id & 7) * 8;
    *reinterpret_cast<uint4*>(Wt + (size_t)(ntd * 64 + nn) * ldt + kofs + kt * 64 + kc) =
        *reinterpret_cast<const uint4*>(sT + nn * LDP + kc);
  }
  __syncthreads();
}

__device__ void phase_convert_norm(CParams& p_o, int l, bfu* smem, int tid, int vb, int vg) {
  const int nconv = 4800, nnorm = 4096;
  const int nrot = (l == 0) ? 64 : 0;
  const int total = nconv + nnorm + nrot;
  if (l == 0 && vb == 0 && tid < 64) ((unsigned*)(p_o.ws + OFF_ctr))[tid] = 0u;
  for (int it = vb; it < total; it += vg) {
    CParams* pp_ = &p_o;
    asm volatile("" : "+s"(pp_));
    CParams& p = *pp_;
    if (it < nconv) {
      if (it < 2112) {
        int kt = it & 15, nt = it >> 4;
        convert_tile(p.in[4] + (size_t)l * DM * NSRC, NSRC, kt, nt, ((bfu*)(p.ws + OFF_WinT)), DM, 0, 1, nullptr, smem, tid);
      } else if (it < 2304) {
        int j = it - 2112; int br = j >> 6; j &= 63;
        int kt = j & 3, nt = j >> 2;
        const float* W = (br == 0 ? p.in[18] : (br == 1 ? p.in[19] : p.in[20])) + (size_t)l * 256 * DM;
        convert_tile(W, DM, kt, nt, ((bfu*)(p.ws + OFF_WupT)), YW, br * 256, 0, nullptr, smem, tid);
      } else if (it < 2432) {
        int j = it - 2304; int kt = j & 7, nt = j >> 3;
        convert_tile(p.in[21] + (size_t)l * 512 * DM, DM, kt, nt, ((bfu*)(p.ws + OFF_WupT)), YW, 768, 0, p.in[17] + l * 512, smem, tid);
      } else if (it < 2688) {
        int j = it - 2432; int kt = j & 15, nt = j >> 4;
        convert_tile(p.in[22] + (size_t)l * DM * DM, DM, kt, nt, ((bfu*)(p.ws + OFF_WoutT)), DM, 0, 0, nullptr, smem, tid);
      } else if (it < 4096) {
        int j = it - 2688; int kt = j & 15, nt = j >> 4;
        convert_tile(p.in[23] + (size_t)l * DM * 2 * FH, 2 * FH, kt, nt, ((bfu*)(p.ws + OFF_WfiT)), DM, 0, 2, nullptr, smem, tid);
      } else {
        int j = it - 4096; int kt = j % 44, nt = j / 44;
        convert_tile(p.in[24] + (size_t)l * FH * DM, DM, kt, nt, ((bfu*)(p.ws + OFF_WfoT)), FH, 0, 0, nullptr, smem, tid);
      }
    } else if (it < nconv + nnorm) {
      int row = (it - nconv) * 4 + (tid >> 6);
      int lane = tid & 63;
      const float* xr = (l == 0 ? p.in[0] : p.out) + (size_t)row * DM;
      const float* g = p.in[2] + l * DM;
      float4 v[4];
      float ss = 0.f;
#pragma unroll
      for (int i = 0; i < 4; ++i) {
        v[i] = *reinterpret_cast<const float4*>(xr + i * 256 + lane * 4);
        ss += v[i].x * v[i].x + v[i].y * v[i].y + v[i].z * v[i].z + v[i].w * v[i].w;
      }
#pragma unroll
      for (int m = 1; m < 64; m <<= 1) ss += __shfl_xor(ss, m, 64);
      float rstd = rsqrtf(ss * (1.f / DM) + EPS);
#pragma unroll
      for (int i = 0; i < 4; ++i) {
        float4 gg = *reinterpret_cast<const float4*>(g + i * 256 + lane * 4);
        ushort4 o;
        o.x = f2bf(v[i].x * rstd * gg.x); o.y = f2bf(v[i].y * rstd * gg.y);
        o.z = f2bf(v[i].z * rstd * gg.z); o.w = f2bf(v[i].w * rstd * gg.w);
        *reinterpret_cast<ushort4*>(((bfu*)(p.ws + OFF_h)) + (size_t)row * DM + i * 256 + lane * 4) = o;
      }
    } else {
      int base = (it - nconv - nnorm) * 256;
      for (int e = tid; e < 256 * 32; e += 256) {
        int tok = base + (e >> 5), i = e & 31;
        float inv = powf(10000.f, -(float)i / 32.f);
        float ang = (float)((const int*)p.in[1])[tok] * inv;
        double a = (double)ang;
        double kq = rint(a * 0.15915494309189535);
        float r = (float)(a - kq * 6.283185307179586);
        ((float*)(p.ws + OFF_rcos))[tok * 32 + i] = cosf(r);
        ((float*)(p.ws + OFF_rsin))[tok * 32 + i] = sinf(r);
      }
    }
  }
}

__device__ void phase_norm2(CParams& p, int l, int tid, int vb, int vg) {
  for (int it = vb; it < 4096; it += vg) {
    int row = it * 4 + (tid >> 6);
    int lane = tid & 63;
    const float* xr = p.out + (size_t)row * DM;
    const float* g = p.in[3] + l * DM;
    float4 v[4];
    float ss = 0.f;
#pragma unroll
    for (int i = 0; i < 4; ++i) {
      v[i] = *reinterpret_cast<const float4*>(xr + i * 256 + lane * 4);
      ss += v[i].x * v[i].x + v[i].y * v[i].y + v[i].z * v[i].z + v[i].w * v[i].w;
    }
#pragma unroll
    for (int m = 1; m < 64; m <<= 1) ss += __shfl_xor(ss, m, 64);
    float rstd = rsqrtf(ss * (1.f / DM) + EPS);
#pragma unroll
    for (int i = 0; i < 4; ++i) {
      float4 gg = *reinterpret_cast<const float4*>(g + i * 256 + lane * 4);
      ushort4 o;
      o.x = f2bf(v[i].x * rstd * gg.x); o.y = f2bf(v[i].y * rstd * gg.y);
      o.z = f2bf(v[i].z * rstd * gg.z); o.w = f2bf(v[i].w * rstd * gg.w);
      *reinterpret_cast<ushort4*>(((bfu*)(p.ws + OFF_h)) + (size_t)row * DM + i * 256 + lane * 4) = o;
    }
  }
}

__device__ __forceinline__ float wave_incl_scan(float v, int lane) {
#pragma unroll
  for (int d = 1; d < 64; d <<= 1) {
    float o = __shfl_up(v, d, 64);
    if (lane >= d) v += o;
  }
  return v;
}

__device__ void phase_prep(CParams& p_o, int l, bfu* smem, int tid, int wr, int vb, int vg) {
  bfu* sK = smem;
  bfu* sV = smem + 64 * LDP;
  float* sF = reinterpret_cast<float*>(smem + 2 * 64 * LDP);
  float* s_glr = sF;
  float* s_seg = sF + 1024;
  float* s_ps = sF + 1280;
  float* s_cs = sF + 1344;
  float* s_dt = sF + 1408;
  const int lane = tid & 63, seg = tid >> 6, col = lane;
  const int total = NCH * 20;
  for (int it = vb; it < total; it += vg) {
    CParams* pp_ = &p_o;
    asm volatile("" : "+s"(pp_));
    CParams& p = *pp_;
    const int c = it / 20, hs = it - c * 20;
    const int tok0 = c * 64;
    bfu kreg[16], vreg[16];
    if (hs < 4) {
      const int h = hs;
      for (int i = tid; i < 1024; i += 256) s_glr[i] = ((float*)(p.ws + OFF_small))[(tok0 + (i >> 4)) * 32 + 4 + (i & 15)];
      float wv[16];
#pragma unroll
      for (int r = 0; r < 16; ++r) wv[r] = p.in[8][(l * 16 + r) * 256 + h * 64 + col];
      const float bias = p.in[9][l * 256 + h * 64 + col];
      __syncthreads();
      float lb[16];
      float run = 0.f;
#pragma unroll
      for (int i = 0; i < 16; ++i) {
        int t = seg * 16 + i;
        float z = bias;
#pragma unroll
        for (int r = 0; r < 16; ++r) z += s_glr[t * 16 + r] * wv[r];
        run += logsigmoid_fast(z) * (1.f / 16.f);
        lb[i] = run;
      }
      s_seg[seg * 64 + col] = run;
      __syncthreads();
      float pre = 0.f, blast = 0.f;
#pragma unroll
      for (int s2 = 0; s2 < 4; ++s2) {
        float v = s_seg[s2 * 64 + col];
        if (s2 < seg) pre += v;
        blast += v;
      }
      if (seg == 0) {
        float e = __expf(blast);
        s_ps[col] = e;
        ((float*)(p.ws + OFF_dec))[(hs * NCH + c) * 64 + col] = e;
        ((float*)(p.ws + OFF_csb))[hs * S_LEN + tok0 + col] = 0.f;
      }
#pragma unroll
      for (int i = 0; i < 16; ++i) {
        int tok = tok0 + seg * 16 + i;
        float b = lb[i] + pre;
        bfu* ur = ((bfu*)(p.ws + OFF_u)) + (size_t)tok * NU + h * 64 + col;
        float q = bf2f(ur[768]), k = bf2f(ur[1024]);
        vreg[i] = ur[1280];
        bfu qd = f2bf(q * 0.125f * __expf(b));
        bfu ki = f2bf(k * __expf(-b));
        if (wr) { ur[768] = qd; ur[1024] = ki; }
        kreg[i] = ki;
      }
    } else if (hs < 8) {
      const int h = hs - 4;
      const float lg = log1pf(-exp2f(-5.f - (float)h));
      if (seg == 0) {
        s_ps[col] = 1.f;
        ((float*)(p.ws + OFF_dec))[(hs * NCH + c) * 64 + col] = __expf(64.f * lg);
        ((float*)(p.ws + OFF_csb))[hs * S_LEN + tok0 + col] = (float)(col + 1) * lg;
      }
#pragma unroll
      for (int i = 0; i < 16; ++i) {
        int t = seg * 16 + i, tok = tok0 + t;
        float cs = ((float*)(p.ws + OFF_rcos))[tok * 32 + (col & 31)], sn = ((float*)(p.ws + OFF_rsin))[tok * 32 + (col & 31)];
        bfu* ur = ((bfu*)(p.ws + OFF_u)) + (size_t)tok * NU + h * 64;
        float qo = bf2f(ur[1792 + col]), qx = bf2f(ur[1792 + (col ^ 32)]);
        float ko = bf2f(ur[2048 + col]), kx = bf2f(ur[2048 + (col ^ 32)]);
        vreg[i] = ur[2304 + col];
        float qr, kr;
        if (col < 32) { qr = qo * cs - qx * sn; kr = ko * cs - kx * sn; }
        else          { qr = qx * sn + qo * cs; kr = kx * sn + ko * cs; }
        kr *= 0.125f;
        bfu kb = f2bf(kr);
        if (wr) { ur[1792 + col] = f2bf(qr); ur[2048 + col] = kb; }
        kreg[i] = f2bf(bf2f(kb) * __expf(lg * (float)(63 - t)));
      }
    } else if (hs < 16) {
      const int h = hs - 8, g = h >> 2;
      if (seg == 0) {
        float dtv = softplus_fast(((float*)(p.ws + OFF_small))[(tok0 + lane) * 32 + 20 + h] + p.in[14][l * 8 + h]);
        float a = -__expf(p.in[15][l * 8 + h]);
        float cs = wave_incl_scan(dtv * a, lane);
        s_cs[lane] = cs;
        s_dt[lane] = dtv;
        ((float*)(p.ws + OFF_csb))[hs * S_LEN + tok0 + lane] = cs;
        s_ps[lane] = 1.f;
      }
      __syncthreads();
      const float cs_last = s_cs[63];
      if (seg == 0) ((float*)(p.ws + OFF_dec))[(hs * NCH + c) * 64 + col] = __expf(cs_last);
      const int chx = h * 64 + col, chb = 512 + g * 64 + col, chc = 640 + g * 64 + col;
      float wx[4], wb[4], wc[4];
#pragma unroll
      for (int j = 0; j < 4; ++j) {
        wx[j] = p.in[12][(l * 4 + j) * 768 + chx];
        wb[j] = p.in[12][(l * 4 + j) * 768 + chb];
        wc[j] = p.in[12][(l * 4 + j) * 768 + chc];
      }
      const float bx = p.in[13][l * 768 + chx], bb = p.in[13][l * 768 + chb], bc = p.in[13][l * 768 + chc];
      float x0, x1, x2, b0, b1, b2, c0, c1, c2;
      {
        int tb = tok0 + seg * 16;
        const bfu* ub = ((bfu*)(p.ws + OFF_u)) + 3328;
        x0 = (tb - 3 >= 0) ? bf2f(ub[(size_t)(tb - 3) * NU + chx]) : 0.f;
        x1 = (tb - 2 >= 0) ? bf2f(ub[(size_t)(tb - 2) * NU + chx]) : 0.f;
        x2 = (tb - 1 >= 0) ? bf2f(ub[(size_t)(tb - 1) * NU + chx]) : 0.f;
        b0 = (tb - 3 >= 0) ? bf2f(ub[(size_t)(tb - 3) * NU + chb]) : 0.f;
        b1 = (tb - 2 >= 0) ? bf2f(ub[(size_t)(tb - 2) * NU + chb]) : 0.f;
        b2 = (tb - 1 >= 0) ? bf2f(ub[(size_t)(tb - 1) * NU + chb]) : 0.f;
        c0 = (tb - 3 >= 0) ? bf2f(ub[(size_t)(tb - 3) * NU + chc]) : 0.f;
        c1 = (tb - 2 >= 0) ? bf2f(ub[(size_t)(tb - 2) * NU + chc]) : 0.f;
        c2 = (tb - 1 >= 0) ? bf2f(ub[(size_t)(tb - 1) * NU + chc]) : 0.f;
      }
#pragma unroll
      for (int i = 0; i < 16; ++i) {
        int t = seg * 16 + i, tok = tok0 + t;
        const bfu* ur = ((bfu*)(p.ws + OFF_u)) + (size_t)tok * NU + 3328;
        float x3 = bf2f(ur[chx]), b3 = bf2f(ur[chb]), c3 = bf2f(ur[chc]);
        float xs = siluf_(bx + wx[0] * x0 + wx[1] * x1 + wx[2] * x2 + wx[3] * x3);
        float bs = siluf_(bb + wb[0] * b0 + wb[1] * b1 + wb[2] * b2 + wb[3] * b3);
        float cv = siluf_(bc + wc[0] * c0 + wc[1] * c1 + wc[2] * c2 + wc[3] * c3);
        x0 = x1; x1 = x2; x2 = x3; b0 = b1; b1 = b2; b2 = b3; c0 = c1; c1 = c2; c2 = c3;
        bfu xb = f2bf(xs);
        ((bfu*)(p.ws + OFF_ssdX))[(size_t)tok * 512 + chx] = xb;
        if ((h & 3) == 0) {
          ((bfu*)(p.ws + OFF_ssdB))[((size_t)g * S_LEN + tok) * 64 + col] = f2bf(bs);
          ((bfu*)(p.ws + OFF_ssdC))[((size_t)g * S_LEN + tok) * 64 + col] = f2bf(cv);
        }
        vreg[i] = f2bf(xs * s_dt[t]);
        kreg[i] = f2bf(bs * __expf(cs_last - s_cs[t]));
      }
    } else {
      const int h = hs - 16;
      if (seg == 0) {
        float lf = logsigmoid_fast(((float*)(p.ws + OFF_small))[(tok0 + lane) * 32 + h] + p.in[5][l * 4 + h]);
        float cs = wave_incl_scan(lf, lane);
        ((float*)(p.ws + OFF_foxc))[h * S_LEN + tok0 + lane] = cs;
        if (lane == 63) ((float*)(p.ws + OFF_foxtot))[h * NCH + c] = cs;
      }
      const float qg = p.in[6][l * 64 + col], kg = p.in[7][l * 64 + col];
#pragma unroll
      for (int i = 0; i < 16; ++i) {
        int tok = tok0 + seg * 16 + i;
        const bfu* ur = ((bfu*)(p.ws + OFF_u)) + (size_t)tok * NU + h * 64 + col;
        float q = bf2f(ur[0]), k = bf2f(ur[256]);
        vreg[i] = ur[512];
        float sq = q * q, sk = k * k;
#pragma unroll
        for (int m = 1; m < 64; m <<= 1) { sq += __shfl_xor(sq, m, 64); sk += __shfl_xor(sk, m, 64); }
        ((bfu*)(p.ws + OFF_foxq))[((size_t)h * S_LEN + tok) * 64 + col] = f2bf(q * rsqrtf(sq * (1.f / 64.f) + EPS) * qg * (0.125f * 1.44269504088896f));
        ((bfu*)(p.ws + OFF_foxk))[((size_t)h * S_LEN + tok) * 64 + col] = f2bf(k * rsqrtf(sk * (1.f / 64.f) + EPS) * kg);
      }
      uint4 v0, v1;
      v0.x = vreg[0] | ((unsigned)vreg[1] << 16); v0.y = vreg[2] | ((unsigned)vreg[3] << 16);
      v0.z = vreg[4] | ((unsigned)vreg[5] << 16); v0.w = vreg[6] | ((unsigned)vreg[7] << 16);
      v1.x = vreg[8] | ((unsigned)vreg[9] << 16); v1.y = vreg[10] | ((unsigned)vreg[11] << 16);
      v1.z = vreg[12] | ((unsigned)vreg[13] << 16); v1.w = vreg[14] | ((unsigned)vreg[15] << 16);
      bfu* dst = ((bfu*)(p.ws + OFF_foxvT)) + ((size_t)h * 64 + col) * S_LEN + tok0 + seg * 16;
      *reinterpret_cast<uint4*>(dst) = v0;
      *reinterpret_cast<uint4*>(dst + 8) = v1;
      continue;
    }
    {
      uint4 k0, k1, v0, v1;
      k0.x = kreg[0] | ((unsigned)kreg[1] << 16); k0.y = kreg[2] | ((unsigned)kreg[3] << 16);
      k0.z = kreg[4] | ((unsigned)kreg[5] << 16); k0.w = kreg[6] | ((unsigned)kreg[7] << 16);
      k1.x = kreg[8] | ((unsigned)kreg[9] << 16); k1.y = kreg[10] | ((unsigned)kreg[11] << 16);
      k1.z = kreg[12] | ((unsigned)kreg[13] << 16); k1.w = kreg[14] | ((unsigned)kreg[15] << 16);
      v0.x = vreg[0] | ((unsigned)vreg[1] << 16); v0.y = vreg[2] | ((unsigned)vreg[3] << 16);
      v0.z = vreg[4] | ((unsigned)vreg[5] << 16); v0.w = vreg[6] | ((unsigned)vreg[7] << 16);
      v1.x = vreg[8] | ((unsigned)vreg[9] << 16); v1.y = vreg[10] | ((unsigned)vreg[11] << 16);
      v1.z = vreg[12] | ((unsigned)vreg[13] << 16); v1.w = vreg[14] | ((unsigned)vreg[15] << 16);
      *reinterpret_cast<uint4*>(sK + col * LDP + seg * 16) = k0;
      *reinterpret_cast<uint4*>(sK + col * LDP + seg * 16 + 8) = k1;
      *reinterpret_cast<uint4*>(sV + col * LDP + seg * 16) = v0;
      *reinterpret_cast<uint4*>(sV + col * LDP + seg * 16 + 8) = v1;
      bfu* dst = ((bfu*)(p.ws + OFF_VT)) + (((size_t)hs * NCH + c) * 64 + col) * 64 + seg * 16;
      *reinterpret_cast<uint4*>(dst) = v0;
      *reinterpret_cast<uint4*>(dst + 8) = v1;
    }
    __syncthreads();
    {
      f32x4 acc[4];
#pragma unroll
      for (int n = 0; n < 4; ++n) acc[n] = (f32x4){0.f, 0.f, 0.f, 0.f};
      mma16x64(acc, sV, seg * 16, sK, lane);
      bfu* st = ((bfu*)(p.ws + OFF_ST)) + ((size_t)hs * NCH + c) * 4096;
#pragma unroll
      for (int n = 0; n < 4; ++n) {
        int d = n * 16 + (lane & 15);
        float ps = s_ps[d];
#pragma unroll
        for (int j = 0; j < 4; ++j) {
          int e = seg * 16 + (lane >> 4) * 4 + j;
          st[e * 64 + d] = f2bf(acc[n][j] * ps);
        }
      }
    }
    __syncthreads();
  }
}

__device__ void phase_scan(CParams& p, int tid, int wr, int vb, int vg) {
  for (int it = vb; it < 128; it += vg) {
    int gidx = it * 256 + tid;
    int hs = gidx >> 11, rem = gidx & 2047, e = rem >> 5, dp = rem & 31;
    unsigned* stp = reinterpret_cast<unsigned*>(((bfu*)(p.ws + OFF_ST)) + (size_t)hs * NCH * 4096 + e * 64 + dp * 2);
    const float2* dcp = reinterpret_cast<const float2*>(((float*)(p.ws + OFF_dec)) + (size_t)hs * NCH * 64 + dp * 2);
    float s0 = 0.f, s1 = 0.f;
    for (int c0 = 0; c0 < NCH; c0 += 8) {
      unsigned kv[8];
      float2 dc[8];
#pragma unroll
      for (int i = 0; i < 8; ++i) {
        kv[i] = stp[(size_t)(c0 + i) * 2048];
        dc[i] = dcp[(c0 + i) * 32];
      }
#pragma unroll
      for (int i = 0; i < 8; ++i) {
        unsigned o = (unsigned)f2bf(s0) | ((unsigned)f2bf(s1) << 16);
        stp[(size_t)(c0 + i) * 2048] = o;
        s0 = s0 * dc[i].x + bf2f((bfu)(kv[i] & 0xffffu));
        s1 = s1 * dc[i].y + bf2f((bfu)(kv[i] >> 16));
      }
    }
  }
}

__device__ __forceinline__ void att_compute(const bfu* kS, const bfu* vS, const float* cS, const bfu* sQw,
                                            const float (&ct)[2], float (&l_run)[2], f32x4 (&O)[2][4],
                                            int kt, int qb, int r0, int w, int lr, int lq, int lg4) {
    f32x4 sc[2][4];
#pragma unroll
    for (int mi = 0; mi < 2; ++mi)
#pragma unroll
      for (int n = 0; n < 4; ++n) sc[mi][n] = (f32x4){0.f, 0.f, 0.f, 0.f};
#pragma unroll
    for (int ks = 0; ks < 2; ++ks) {
      bf16x8 aq0 = lds_frag(sQw, lr, ks * 32 + lq, LDP);
      bf16x8 aq1 = lds_frag(sQw, 16 + lr, ks * 32 + lq, LDP);
#pragma unroll
      for (int n = 0; n < 4; ++n) {
        bf16x8 kf = lds_frag(kS, n * 16 + lr, ks * 32 + lq, LDP);
        sc[0][n] = __builtin_amdgcn_mfma_f32_16x16x32_bf16(kf, aq0, sc[0][n], 0, 0, 0);
        sc[1][n] = __builtin_amdgcn_mfma_f32_16x16x32_bf16(kf, aq1, sc[1][n], 0, 0, 0);
      }
    }
    f32x4 csv[4];
#pragma unroll
    for (int n = 0; n < 4; ++n) csv[n] = *reinterpret_cast<const f32x4*>(cS + n * 16 + lg4);
    const bool diag = (kt >= 2 * qb);
    bf16x8 pf[2][2];
#pragma unroll
    for (int mi = 0; mi < 2; ++mi) {
      const int qrow = r0 + w * 32 + mi * 16 + lr;
      float ps = 0.f;
#pragma unroll
      for (int n = 0; n < 4; ++n)
#pragma unroll
        for (int j = 0; j < 4; ++j) {
          float v = (sc[mi][n][j] + ct[mi]) - csv[n][j];
          if (diag && (kt * 64 + n * 16 + lg4 + j > qrow)) v = -INFINITY;
          const float pv = __builtin_amdgcn_exp2f(v);
          sc[mi][n][j] = pv;
          ps += pv;
        }
      l_run[mi] += ps;
#pragma unroll
      for (int ks = 0; ks < 2; ++ks) {
        union { bf16x8 v; unsigned u[4]; } pk;
        pk.u[0] = pg8::cvt_pk_bf16(sc[mi][2 * ks][0], sc[mi][2 * ks][1]);
        pk.u[1] = pg8::cvt_pk_bf16(sc[mi][2 * ks][2], sc[mi][2 * ks][3]);
        pk.u[2] = pg8::cvt_pk_bf16(sc[mi][2 * ks + 1][0], sc[mi][2 * ks + 1][1]);
        pk.u[3] = pg8::cvt_pk_bf16(sc[mi][2 * ks + 1][2], sc[mi][2 * ks + 1][3]);
        pf[mi][ks] = pk.v;
      }
    }
#pragma unroll
    for (int ks = 0; ks < 2; ++ks) {
#pragma unroll
      for (int ef = 0; ef < 4; ++ef) {
        union { bf16x8 v; uint2 h2[2]; } vf;
        vf.h2[0] = *reinterpret_cast<const uint2*>(vS + (ef * 16 + lr) * LDP + ks * 32 + lg4);
        vf.h2[1] = *reinterpret_cast<const uint2*>(vS + (ef * 16 + lr) * LDP + ks * 32 + 16 + lg4);
#pragma unroll
        for (int mi = 0; mi < 2; ++mi)
          O[mi][ef] = __builtin_amdgcn_mfma_f32_16x16x32_bf16(vf.v, pf[mi][ks], O[mi][ef], 0, 0, 0);
      }
    }
}

__device__ void attn_item(CParams& p, int l, int qb, int h, bfu* smem, int tid, int half, unsigned char* smem_raw) {
  bfu* sK = smem;
  bfu* sV = smem + 2 * 64 * LDP;
  float* s_c = reinterpret_cast<float*>(smem + 4 * 64 * LDP);
  float* s_off = s_c + 128;
  const int lane = tid & 63, w = tid >> 6;
  const int lr = lane & 15, lq = (lane >> 4) * 8, lg4 = (lane >> 4) * 4;
  const int r0 = qb * 128;
  const float L2E = 1.44269504088896f;
  s_off[tid] = ((float*)(p.ws + OFF_foxtot))[h * NCH + tid];
  __syncthreads();
  float myoff = 0.f;
  for (int i = 0; i < tid; ++i) myoff += s_off[i];
  __syncthreads();
  s_off[tid] = myoff;
  float* s_misc = reinterpret_cast<float*>(smem + 28416);
  if (tid < 64) {
    float gq = fabsf(p.in[6][l * 64 + tid]), gk = fabsf(p.in[7][l * 64 + tid]);
#pragma unroll
    for (int m = 1; m < 64; m <<= 1) { gq = fmaxf(gq, __shfl_xor(gq, m, 64)); gk = fmaxf(gk, __shfl_xor(gk, m, 64)); }
    if (tid == 0) { s_misc[0] = 40.f + 2.f * 8.f * gq * gk * 1.01f; reinterpret_cast<int*>(s_misc)[1] = 2 * qb; s_misc[2] = 8.f * gq * gk * 1.01f * 1.44269504088896f; }
  }
  __syncthreads();
  {
    const float thr = s_misc[0];
    const float cref = s_off[2 * qb];
    if (tid < 2 * qb && s_off[tid + 1] <= cref + thr) atomicMin(reinterpret_cast<int*>(s_misc) + 1, tid);
  }
  __syncthreads();
  int kt_min = reinterpret_cast<int*>(s_misc)[1];
  const int nkt = 2 * qb + 2;
  if ((nkt - kt_min) & 1) kt_min -= 1;
  const bfu* Qg = ((bfu*)(p.ws + OFF_foxq)) + (size_t)h * S_LEN * 64;
  const bfu* Kg = ((bfu*)(p.ws + OFF_foxk)) + (size_t)h * S_LEN * 64;
  const bfu* Vg = ((bfu*)(p.ws + OFF_foxvT)) + (size_t)h * 64 * S_LEN;
  const float* Cg = ((float*)(p.ws + OFF_foxc)) + (size_t)h * S_LEN;
  bfu* sQ = smem + 4 * 64 * LDP + 768;
  {
#pragma unroll
    for (int i = 0; i < 4; ++i) {
      int id = tid + i * 256;
      int r = id >> 3, c = (id & 7) * 8;
      *reinterpret_cast<uint4*>(sQ + r * LDP + c) = *reinterpret_cast<const uint4*>(Qg + (size_t)(r0 + r) * 64 + c);
    }
  }
  const bfu* sQw = sQ + (w * 32) * LDP;
  float ct[2], l_run[2];
  const float lbound = s_misc[2];
  f32x4 O[2][4];
#pragma unroll
  for (int mi = 0; mi < 2; ++mi) {
    const int qrow = r0 + w * 32 + mi * 16 + lr;
    ct[mi] = (Cg[qrow] + s_off[qrow >> 6]) * L2E - lbound;
    l_run[mi] = 0.f;
#pragma unroll
    for (int n = 0; n < 4; ++n) O[mi][n] = (f32x4){0.f, 0.f, 0.f, 0.f};
  }
  const int nkh = (nkt - kt_min) >> 1;
  const int kt0 = kt_min + half * nkh;
  const int crow0 = tid >> 3, ccol = (tid & 7) * 8;
  uint4 rk0A, rk1A, rv0A, rv1A, rk0B, rk1B, rv0B, rv1B;
  float rcA = 0.f, rcB = 0.f;
  {
    const int k0 = kt0 * 64;
    rk0A = *reinterpret_cast<const uint4*>(Kg + (size_t)(k0 + crow0) * 64 + ccol);
    rk1A = *reinterpret_cast<const uint4*>(Kg + (size_t)(k0 + crow0 + 32) * 64 + ccol);
    rv0A = *reinterpret_cast<const uint4*>(Vg + (size_t)(crow0) * S_LEN + k0 + ccol);
    rv1A = *reinterpret_cast<const uint4*>(Vg + (size_t)(crow0 + 32) * S_LEN + k0 + ccol);
    if (tid < 64) rcA = (Cg[k0 + tid] + s_off[kt0]) * L2E;
  }
  *reinterpret_cast<uint4*>(sK + (crow0) * LDP + ccol) = rk0A;
  *reinterpret_cast<uint4*>(sK + (crow0 + 32) * LDP + ccol) = rk1A;
  *reinterpret_cast<uint4*>(sV + (crow0) * LDP + ccol) = rv0A;
  *reinterpret_cast<uint4*>(sV + (crow0 + 32) * LDP + ccol) = rv1A;
  if (tid < 64) s_c[tid] = rcA;
  rk0B = rk1B = rv0B = rv1B = rk0A;
  __syncthreads();
#define ATT_LOAD(S, KT)                                                                              \
  {                                                                                                  \
    const int k0_ = (KT) * 64;                                                                       \
    rk0##S = *reinterpret_cast<const uint4*>(Kg + (size_t)(k0_ + crow0) * 64 + ccol);                \
    rk1##S = *reinterpret_cast<const uint4*>(Kg + (size_t)(k0_ + crow0 + 32) * 64 + ccol);           \
    rv0##S = *reinterpret_cast<const uint4*>(Vg + (size_t)(crow0) * S_LEN + k0_ + ccol);             \
    rv1##S = *reinterpret_cast<const uint4*>(Vg + (size_t)(crow0 + 32) * S_LEN + k0_ + ccol);        \
    if (tid < 64) rc##S = (Cg[k0_ + tid] + s_off[(KT)]) * L2E;                                       \
  }
#define ATT_STORE(S, BUF)                                                                            \
  {                                                                                                  \
    bfu* kN_ = sK + (BUF) * 64 * LDP;                                                                \
    bfu* vN_ = sV + (BUF) * 64 * LDP;                                                                \
    *reinterpret_cast<uint4*>(kN_ + (crow0) * LDP + ccol) = rk0##S;                                  \
    *reinterpret_cast<uint4*>(kN_ + (crow0 + 32) * LDP + ccol) = rk1##S;                             \
    *reinterpret_cast<uint4*>(vN_ + (crow0) * LDP + ccol) = rv0##S;                                  \
    *reinterpret_cast<uint4*>(vN_ + (crow0 + 32) * LDP + ccol) = rv1##S;                             \
    if (tid < 64) s_c[(BUF) * 64 + tid] = rc##S;                                                     \
  }
  if (nkh > 1) ATT_LOAD(B, kt0 + 1);
  for (int it = 0; it < nkh; it += 2) {
    if (it + 2 < nkh) ATT_LOAD(A, kt0 + it + 2);
    att_compute(sK, sV, s_c, sQw, ct, l_run, O, kt0 + it, qb, r0, w, lr, lq, lg4);
    if (it + 1 < nkh) ATT_STORE(B, 1);
    __syncthreads();
    if (it + 1 >= nkh) break;
    if (it + 3 < nkh) ATT_LOAD(B, kt0 + it + 3);
    att_compute(sK + 64 * LDP, sV + 64 * LDP, s_c + 64, sQw, ct, l_run, O, kt0 + it + 1, qb, r0, w, lr, lq, lg4);
    if (it + 2 < nkh) ATT_STORE(A, 0);
    __syncthreads();
  }
#undef ATT_LOAD
#undef ATT_STORE
  float* xch = reinterpret_cast<float*>(smem_raw + SMEM_HALF);
  if (half == 1) {
#pragma unroll
    for (int mi = 0; mi < 2; ++mi) {
#pragma unroll
      for (int n = 0; n < 4; ++n)
#pragma unroll
        for (int j = 0; j < 4; ++j) xch[((mi * 4 + n) * 4 + j) * 256 + tid] = O[mi][n][j];
      xch[(32 + mi) * 256 + tid] = l_run[mi];
    }
  }
  __syncthreads();
  if (half == 0) {
#pragma unroll
    for (int mi = 0; mi < 2; ++mi) {
      float lsum = l_run[mi] + xch[(32 + mi) * 256 + tid];
      lsum += __shfl_xor(lsum, 16, 64);
      lsum += __shfl_xor(lsum, 32, 64);
      const float inv = 1.f / lsum;
      const int qrow = r0 + w * 32 + mi * 16 + lr;
      bfu* yp = ((bfu*)(p.ws + OFF_y)) + (size_t)qrow * YW + h * 64 + lg4;
#pragma unroll
      for (int n = 0; n < 4; ++n) {
        float o0 = (O[mi][n][0] + xch[((mi * 4 + n) * 4 + 0) * 256 + tid]) * inv;
        float o1 = (O[mi][n][1] + xch[((mi * 4 + n) * 4 + 1) * 256 + tid]) * inv;
        float o2 = (O[mi][n][2] + xch[((mi * 4 + n) * 4 + 2) * 256 + tid]) * inv;
        float o3 = (O[mi][n][3] + xch[((mi * 4 + n) * 4 + 3) * 256 + tid]) * inv;
        uint2 wv;
        wv.x = pg8::cvt_pk_bf16(o0, o1);
        wv.y = pg8::cvt_pk_bf16(o2, o3);
        *reinterpret_cast<uint2*>(yp + n * 16) = wv;
      }
    }
  }
  __syncthreads();
}

__device__ void chunk_out_item(CParams& p, int l, int c, int hs, bfu* smem, int tid) {
  bfu* sQ = smem;
  bfu* sKi = smem + 64 * LDP;
  bfu* sV = smem + 2 * 64 * LDP;
  bfu* sS = smem + 3 * 64 * LDP;
  bfu* sP = smem + 4 * 64 * LDP;
  float* s_cs = reinterpret_cast<float*>(smem + 5 * 64 * LDP);
  const int lane = tid & 63, w = tid >> 6;
  const int lr = lane & 15, lg4 = (lane >> 4) * 4;
  const int tok0 = c * 64;
  const bfu *Qp, *Kp;
  int qs;
  if (hs < 4) { Qp = ((bfu*)(p.ws + OFF_u)) + (size_t)tok0 * NU + 768 + hs * 64; Kp = ((bfu*)(p.ws + OFF_u)) + (size_t)tok0 * NU + 1024 + hs * 64; qs = NU; }
  else if (hs < 8) { Qp = ((bfu*)(p.ws + OFF_u)) + (size_t)tok0 * NU + 1792 + (hs - 4) * 64; Kp = ((bfu*)(p.ws + OFF_u)) + (size_t)tok0 * NU + 2048 + (hs - 4) * 64; qs = NU; }
  else { int g = (hs - 8) >> 2; Qp = ((bfu*)(p.ws + OFF_ssdC)) + ((size_t)g * S_LEN + tok0) * 64; Kp = ((bfu*)(p.ws + OFF_ssdB)) + ((size_t)g * S_LEN + tok0) * 64; qs = 64; }
  load_tile64(sQ, Qp, qs, tid);
  load_tile64(sKi, Kp, qs, tid);
  load_tile64(sV, ((bfu*)(p.ws + OFF_VT)) + ((size_t)hs * NCH + c) * 4096, 64, tid);
  load_tile64(sS, ((bfu*)(p.ws + OFF_ST)) + ((size_t)hs * NCH + c) * 4096, 64, tid);
  if (tid < 64) s_cs[tid] = ((float*)(p.ws + OFF_csb))[hs * S_LEN + tok0 + tid];
  __syncthreads();
  f32x4 sc[4];
#pragma unroll
  for (int n = 0; n < 4; ++n) sc[n] = (f32x4){0.f, 0.f, 0.f, 0.f};
  mma16x64(sc, sQ, w * 16, sKi, lane);
  float cst[4];
#pragma unroll
  for (int j = 0; j < 4; ++j) cst[j] = s_cs[w * 16 + lg4 + j];
#pragma unroll
  for (int n = 0; n < 4; ++n) {
    const int s = n * 16 + lr;
    const float css = s_cs[s];
#pragma unroll
    for (int j = 0; j < 4; ++j) {
      const int t = w * 16 + lg4 + j;
      float pv = (s <= t) ? sc[n][j] * __expf(cst[j] - css) : 0.f;
      sP[t * LDP + s] = f2bf(pv);
    }
  }
  f32x4 o[4];
#pragma unroll
  for (int n = 0; n < 4; ++n) o[n] = (f32x4){0.f, 0.f, 0.f, 0.f};
  mma16x64(o, sQ, w * 16, sS, lane);
#pragma unroll
  for (int j = 0; j < 4; ++j) {
    const float rs = __expf(cst[j]);
#pragma unroll
    for (int n = 0; n < 4; ++n) o[n][j] *= rs;
  }
  __syncthreads();
  mma16x64(o, sP, w * 16, sV, lane);
  if (hs < 8) {
    const int h = hs & 3;
    const float* gain = (hs < 4 ? p.in[10] : p.in[11]) + l * 64;
    const int gcol = (hs < 4 ? 1536 : 2560) + h * 64;
    const int ycol = (hs < 4 ? 256 : 512) + h * 64;
#pragma unroll
    for (int j = 0; j < 4; ++j) {
      float ss = 0.f;
#pragma unroll
      for (int n = 0; n < 4; ++n) ss += o[n][j] * o[n][j];
      ss += __shfl_xor(ss, 1, 64); ss += __shfl_xor(ss, 2, 64);
      ss += __shfl_xor(ss, 4, 64); ss += __shfl_xor(ss, 8, 64);
      const float rstd = rsqrtf(ss * (1.f / 64.f) + EPS);
      const int tok = tok0 + w * 16 + lg4 + j;
#pragma unroll
      for (int n = 0; n < 4; ++n) {
        const int e = n * 16 + lr;
        float gt = bf2f(((bfu*)(p.ws + OFF_u))[(size_t)tok * NU + gcol + e]);
        ((bfu*)(p.ws + OFF_y))[(size_t)tok * YW + ycol + e] = f2bf(o[n][j] * rstd * gain[e] * siluf_(gt));
      }
    }
  } else {
    const int h = hs - 8;
    const float dsk = p.in[16][l * 8 + h];
#pragma unroll
    for (int j = 0; j < 4; ++j) {
      const int tok = tok0 + w * 16 + lg4 + j;
      float ss = 0.f;
#pragma unroll
      for (int n = 0; n < 4; ++n) {
        const int e = n * 16 + lr;
        float xs = bf2f(((bfu*)(p.ws + OFF_ssdX))[(size_t)tok * 512 + h * 64 + e]);
        float z = bf2f(((bfu*)(p.ws + OFF_u))[(size_t)tok * NU + 2816 + h * 64 + e]);
        float yd = (o[n][j] + dsk * xs) * siluf_(z);
        ss += yd * yd;
        ((bfu*)(p.ws + OFF_y))[(size_t)tok * YW + 768 + h * 64 + e] = f2bf(yd);
      }
      ss += __shfl_xor(ss, 1, 64); ss += __shfl_xor(ss, 2, 64);
      ss += __shfl_xor(ss, 4, 64); ss += __shfl_xor(ss, 8, 64);
      if (lr == 0) ((float*)(p.ws + OFF_ssq))[tok * 8 + h] = ss;
    }
  }
  __syncthreads();
}

__device__ void phase_mix(CParams& p_o, int l, bfu* smem, int tid, int half, int cidx, unsigned char* smem_raw) {
  __shared__ int s_item;
  const int total = 512 + NCH * 8;
  while (true) {
    __syncthreads();
    if (threadIdx.x == 0) s_item = (int)atomicAdd(&((unsigned*)(p_o.ws + OFF_ctr))[cidx], 1u);
    __syncthreads();
    const int it = s_item;
    if (it >= total) break;
    CParams* pp_ = &p_o;
    asm volatile("" : "+s"(pp_));
    CParams& p = *pp_;
    if (it < 512) {
      int qb = 127 - (it >> 2), h = it & 3;
      attn_item(p, l, qb, h, smem, tid, half, smem_raw);
    } else {
      int j = (it - 512) * 2 + half;
      chunk_out_item(p, l, j >> 4, j & 15, smem, tid);
    }
  }
}

__device__ void phase_upmerge(CParams& p, bfu* smem, int tid, int vb, int vg) {
  bfu* sA = smem;
  bfu* sB = smem + 2 * 128 * LDP;
  float* s_rs = reinterpret_cast<float*>(smem + 2 * 128 * LDP + 2 * 64 * LDP);
  const int lane = tid & 63, w = tid >> 6, wm = w >> 1, wn = w & 1;
  const int lr = lane & 15, lq = (lane >> 4) * 8, lg4 = (lane >> 4) * 4;
  const int crow = tid >> 3, ccol = (tid & 7) * 8;
  for (int it = vb; it < 128 * 16; it += vg) {
    const int mt = it >> 4, nt = it & 15;
    const bfu* Ap = ((bfu*)(p.ws + OFF_y)) + (size_t)(mt * 128 + crow) * YW + ccol;
    const bfu* Bp = ((bfu*)(p.ws + OFF_WupT)) + (size_t)(nt * 64 + crow) * YW + ccol;
    const bfu* Gp = ((bfu*)(p.ws + OFF_u)) + (size_t)(mt * 128 + wm * 64 + lr) * NU + 4096 + nt * 64 + wn * 32 + lg4;
    {
      const int row = tid >> 1, g = tid & 1;
      const float4 q4 = *reinterpret_cast<const float4*>(((float*)(p.ws + OFF_ssq)) + (mt * 128 + row) * 8 + g * 4);
      s_rs[g * 128 + row] = rsqrtf((q4.x + q4.y + q4.z + q4.w) * (1.f / 256.f) + EPS);
    }
    uint4 a0_0, a0_1, a0_2, a0_3, b0_0, b0_1, a1_0, a1_1, a1_2, a1_3, b1_0, b1_1;
#define U_LOAD(S, KT)                                                                \
  {                                                                                  \
    const int ko_ = (KT) * 64;                                                       \
    a##S##_0 = *reinterpret_cast<const uint4*>(Ap + (size_t)0 * 32 * YW + ko_);      \
    a##S##_1 = *reinterpret_cast<const uint4*>(Ap + (size_t)1 * 32 * YW + ko_);      \
    a##S##_2 = *reinterpret_cast<const uint4*>(Ap + (size_t)2 * 32 * YW + ko_);      \
    a##S##_3 = *reinterpret_cast<const uint4*>(Ap + (size_t)3 * 32 * YW + ko_);      \
    b##S##_0 = *reinterpret_cast<const uint4*>(Bp + (size_t)0 * 32 * YW + ko_);      \
    b##S##_1 = *reinterpret_cast<const uint4*>(Bp + (size_t)1 * 32 * YW + ko_);      \
  }
#define U_STORE(S, BUF)                                                              \
  {                                                                                  \
    bfu* sAn_ = sA + (BUF) * 128 * LDP + crow * LDP + ccol;                          \
    bfu* sBn_ = sB + (BUF) * 64 * LDP + crow * LDP + ccol;                           \
    *reinterpret_cast<uint4*>(sAn_ + 0 * 32 * LDP) = a##S##_0;                       \
    *reinterpret_cast<uint4*>(sAn_ + 1 * 32 * LDP) = a##S##_1;                       \
    *reinterpret_cast<uint4*>(sAn_ + 2 * 32 * LDP) = a##S##_2;                       \
    *reinterpret_cast<uint4*>(sAn_ + 3 * 32 * LDP) = a##S##_3;                       \
    *reinterpret_cast<uint4*>(sBn_ + 0 * 32 * LDP) = b##S##_0;                       \
    *reinterpret_cast<uint4*>(sBn_ + 1 * 32 * LDP) = b##S##_1;                       \
  }
#define U_COMPUTE(BUF)                                                               \
  {                                                                                  \
    const bfu* a_s = sA + (BUF) * 128 * LDP + (wm * 64) * LDP;                       \
    const bfu* b_s = sB + (BUF) * 64 * LDP + (wn * 32) * LDP;                        \
    _Pragma("unroll") for (int ks = 0; ks < 2; ++ks) {                               \
      bf16x8 af0 = lds_frag(a_s, 0 * 16 + lr, ks * 32 + lq, LDP);                    \
      bf16x8 af1 = lds_frag(a_s, 1 * 16 + lr, ks * 32 + lq, LDP);                    \
      bf16x8 af2 = lds_frag(a_s, 2 * 16 + lr, ks * 32 + lq, LDP);                    \
      bf16x8 af3 = lds_frag(a_s, 3 * 16 + lr, ks * 32 + lq, LDP);                    \
      _Pragma("unroll") for (int ni = 0; ni < 2; ++ni) {                             \
        bf16x8 bf_ = lds_frag(b_s, ni * 16 + lr, ks * 32 + lq, LDP);                 \
        acc[0][ni] = __builtin_amdgcn_mfma_f32_16x16x32_bf16(bf_, af0, acc[0][ni], 0, 0, 0); \
        acc[1][ni] = __builtin_amdgcn_mfma_f32_16x16x32_bf16(bf_, af1, acc[1][ni], 0, 0, 0); \
        acc[2][ni] = __builtin_amdgcn_mfma_f32_16x16x32_bf16(bf_, af2, acc[2][ni], 0, 0, 0); \
        acc[3][ni] = __builtin_amdgcn_mfma_f32_16x16x32_bf16(bf_, af3, acc[3][ni], 0, 0, 0); \
      }                                                                              \
    }                                                                                \
  }
    f32x4 acc[4][2], tot[4][2];
    zero_acc<2>(acc);
    zero_acc<2>(tot);
    uint2 gt[4][2];
    U_LOAD(0, 0);
    U_LOAD(1, 1);
    U_STORE(0, 0);
    __syncthreads();
#pragma unroll 1
    for (int kt = 0; kt < 20; kt += 2) {
      if ((kt & 3) == 0) {
        const int br = kt >> 2, gb = br < 3 ? br : 3;
#pragma unroll
        for (int mi = 0; mi < 4; ++mi)
#pragma unroll
          for (int ni = 0; ni < 2; ++ni)
            gt[mi][ni] = *reinterpret_cast<const uint2*>(Gp + (size_t)(mi * 16) * NU + gb * 1024 + ni * 16);
      }
      if (kt + 2 < 20) U_LOAD(0, kt + 2);
      U_COMPUTE(0);
      U_STORE(1, 1);
      __syncthreads();
      if (kt + 3 < 20) U_LOAD(1, kt + 3);
      U_COMPUTE(1);
      if (kt + 2 < 20) U_STORE(0, 0);
      if ((kt & 3) == 2) {
        const int br = kt >> 2;
#pragma unroll
        for (int mi = 0; mi < 4; ++mi) {
          float rsc = 1.f;
          if (br >= 3) rsc = s_rs[(br - 3) * 128 + wm * 64 + mi * 16 + lr];
#pragma unroll
          for (int ni = 0; ni < 2; ++ni) {
            const uint2 g2 = gt[mi][ni];
            tot[mi][ni][0] += acc[mi][ni][0] * (__uint_as_float(g2.x << 16) * rsc);
            tot[mi][ni][1] += acc[mi][ni][1] * (__uint_as_float(g2.x & 0xffff0000u) * rsc);
            tot[mi][ni][2] += acc[mi][ni][2] * (__uint_as_float(g2.y << 16) * rsc);
            tot[mi][ni][3] += acc[mi][ni][3] * (__uint_as_float(g2.y & 0xffff0000u) * rsc);
            acc[mi][ni] = (f32x4){0.f, 0.f, 0.f, 0.f};
          }
        }
      }
      __syncthreads();
    }
#undef U_LOAD
#undef U_STORE
#undef U_COMPUTE
    bfu* Hp = ((bfu*)(p.ws + OFF_h)) + (size_t)(mt * 128 + wm * 64 + lr) * DM + nt * 64 + wn * 32 + lg4;
#pragma unroll
    for (int mi = 0; mi < 4; ++mi)
#pragma unroll
      for (int ni = 0; ni < 2; ++ni) {
        uint2 wv;
        wv.x = pg8::cvt_pk_bf16(tot[mi][ni][0], tot[mi][ni][1]);
        wv.y = pg8::cvt_pk_bf16(tot[mi][ni][2], tot[mi][ni][3]);
        *reinterpret_cast<uint2*>(Hp + (size_t)(mi * 16) * DM + ni * 16) = wv;
      }
  }
}

namespace pg8 {
#define PG8_LAS __attribute__((address_space(3)))
typedef unsigned short bf16_t;
typedef short bf16x8 __attribute__((ext_vector_type(8)));
typedef float f32x4 __attribute__((ext_vector_type(4)));
typedef unsigned u32x4 __attribute__((ext_vector_type(4)));
typedef unsigned u32x2 __attribute__((ext_vector_type(2)));
constexpr int BM = 256, BK = 64, HALF = 128, HTB = HALF * BK * 2, STAGE_BYTES = 8 * HTB, NXCD = 8, WGM = 8;
__device__ __forceinline__ int lds_byte(int r, int c) { const int st = (r >> 4) * 2 + (c >> 5), rr = r & 15, cc = c & 31, ob = rr * 64 + cc * 2; return st * 1024 + (ob ^ (((ob >> 9) & 1) << 5)); }
__device__ __forceinline__ void stage_rc(int b, int& R, int& C) { const int st = b / 1024, sb = b % 1024, swz = sb ^ (((sb >> 9) & 1) << 5); R = (st >> 1) * 16 + swz / 64; C = (st & 1) * 32 + (swz % 64) / 2; }
__device__ __forceinline__ int perm32(int rho) { const int n = rho >> 4, i = rho & 15; return 8 * (i >> 2) + 4 * n + (i & 3); }
struct Unit { int pm, pn; };
struct Gemm { const bf16_t* A; const bf16_t* Bt; int M, N, K; };
struct StaticOrder {
    int nM, nN, nwg, G, c;
    __device__ void init(int M, int N, int G_, int c_) { nM = M / BM; nN = N / BM; nwg = nM * nN; G = G_; c = c_; }
    __device__ bool next(int i, Unit& u) const {
        const long L = (long)i * G + c; if (L >= nwg) return false;
        int wgid = (int)L; { const int q = nwg / NXCD, r = nwg % NXCD, xcd = wgid % NXCD, off = wgid / NXCD; wgid = (xcd < r ? xcd * (q + 1) : r * (q + 1) + (xcd - r) * q) + off; }
        const int nig = WGM * nN, gid = wgid / nig, fm = gid * WGM, gsz = (nM - fm) < WGM ? (nM - fm) : WGM;
        u.pm = fm + ((wgid % nig) % gsz); u.pn = (wgid % nig) / gsz; return true;
    }
    __device__ __forceinline__ void a_ready(const Unit&) const {}
    __device__ __forceinline__ void done(const Unit&) const {}
};
__device__ __forceinline__ unsigned cvt_pk_bf16(float lo, float hi) { unsigned r; asm volatile("v_cvt_pk_bf16_f32 %0, %1, %2" : "=v"(r) : "v"(lo), "v"(hi)); return r; }

template <class Epi, class Sched>
__device__ __forceinline__ void gemm_phase(PG8_LAS unsigned char* lds, const Gemm g, const Sched& S, const Epi& E) {
    const int tid = threadIdx.x, wid = __builtin_amdgcn_readfirstlane(tid >> 6), lane = tid & 63, wr = wid >> 2, wc = wid & 3, fr = lane & 15, fq = lane >> 4;
    const int K = g.K, nt = K / BK;
    unsigned voffA[2], voffB[2];
#pragma unroll
    for (int i = 0; i < 2; ++i) { int R, C; stage_rc(tid * 16 + i * 8192, R, C); const int Rb = Epi::PERM ? ((R & ~31) + perm32(R & 31)) : R;
        voffA[i] = (unsigned)(R * K + C) * 2u; voffB[i] = (unsigned)(Rb * K + C) * 2u; }
    const size_t kstep = (size_t)(BK * 2);
    const size_t hstep = (size_t)HALF * K * 2;
    const size_t tstep = 2 * hstep;
    const unsigned ldsw = (unsigned)wid * 1024u;
    const int aoff = lds_byte(wr * 64 + fr, fq * 8), boff = lds_byte(wc * 32 + fr, fq * 8);
#define PG8_SA(b, h) (((b) * 2 + (h)) * HTB)
#define PG8_SB(b, h) ((4 + (b) * 2 + (h)) * HTB)
#define PG8_STAGE(bufoff, gbase, voff) do { _Pragma("unroll") for (int _i = 0; _i < 2; ++_i) \
        __builtin_amdgcn_global_load_lds((const unsigned*)((const char*)(gbase) + (voff)[_i]), (PG8_LAS unsigned*)(lds + (bufoff) + ldsw + _i * 8192), 16, 0, 0); } while (0)
#define PG8_LDA(dst, b, h) do { _Pragma("unroll") for (int m = 0; m < 4; ++m) _Pragma("unroll") for (int k = 0; k < 2; ++k) dst[m][k] = *(const PG8_LAS bf16x8*)(lds + PG8_SA(b, h) + aoff + m * 2048 + k * 1024); } while (0)
#define PG8_LDB(dst, b, h) do { _Pragma("unroll") for (int n = 0; n < 2; ++n) _Pragma("unroll") for (int k = 0; k < 2; ++k) dst[n][k] = *(const PG8_LAS bf16x8*)(lds + PG8_SB(b, h) + boff + n * 2048 + k * 1024); } while (0)
#define PG8_MMA(ai, bj, At, Bt) do { __builtin_amdgcn_s_setprio(1); _Pragma("unroll") for (int m = 0; m < 4; ++m) _Pragma("unroll") for (int n = 0; n < 2; ++n) _Pragma("unroll") for (int k = 0; k < 2; ++k) \
        acc[ai][bj][m][n] = __builtin_amdgcn_mfma_f32_16x16x32_bf16(Bt[n][k], At[m][k], acc[ai][bj][m][n], 0, 0, 0); __builtin_amdgcn_s_setprio(0); } while (0)
#define PG8_WAIT_V(n) asm volatile("s_waitcnt vmcnt(" #n ")" ::: "memory")
#define PG8_WAIT_L(n) asm volatile("s_waitcnt lgkmcnt(" #n ")" ::: "memory")
#define PG8_BAR __builtin_amdgcn_s_barrier()
#define PG8_SCHED __builtin_amdgcn_sched_barrier(0)
    Unit cur, nxt; int ui = 0;
    if (!S.next(0, cur)) return;
    f32x4 acc[2][2][4][2];
#pragma unroll
    for (int a = 0; a < 2; ++a)
#pragma unroll
        for (int b = 0; b < 2; ++b)
#pragma unroll
            for (int m = 0; m < 4; ++m)
#pragma unroll
                for (int n = 0; n < 2; ++n) acc[a][b][m][n] = (f32x4){0.f, 0.f, 0.f, 0.f};
    bf16x8 At[4][2], B0[2][2], B1[2][2];
    const char* cA = (const char*)g.A + (size_t)cur.pm * tstep; const char* cB = (const char*)g.Bt + (size_t)cur.pn * tstep;
    S.a_ready(cur);
    PG8_STAGE(PG8_SB(0, 0), cB, voffB); PG8_STAGE(PG8_SA(0, 0), cA, voffA); PG8_STAGE(PG8_SB(0, 1), cB + hstep, voffB); PG8_STAGE(PG8_SA(0, 1), cA + hstep, voffA);
    if (wr == 1) PG8_BAR;
    PG8_WAIT_V(4); PG8_BAR;
    PG8_STAGE(PG8_SB(1, 0), cB + kstep, voffB); PG8_STAGE(PG8_SA(1, 0), cA + kstep, voffA); PG8_STAGE(PG8_SB(1, 1), cB + hstep + kstep, voffB);
    PG8_WAIT_V(6); PG8_BAR;
    for (;;) {
        const bool has_next = S.next(ui + 1, nxt);
        const char* nA = has_next ? (const char*)g.A + (size_t)nxt.pm * tstep : cA; const char* nB = has_next ? (const char*)g.Bt + (size_t)nxt.pn * tstep : cB;
        for (int t = 0; t < nt; t += 2) {
            const bool last = (t == nt - 2);
            const char* a1 = cA + (size_t)(t + 1) * kstep;
            const char* a2 = last ? nA : cA + (size_t)(t + 2) * kstep; const char* b2 = last ? nB : cB + (size_t)(t + 2) * kstep;
            const char* a3 = a2 + kstep; const char* b3 = b2 + kstep;
            if (last && has_next) S.a_ready(nxt);
            PG8_LDB(B0, 0, 0); PG8_SCHED; PG8_LDA(At, 0, 0); PG8_STAGE(PG8_SA(1, 1), a1 + hstep, voffA);
            PG8_WAIT_L(8); PG8_BAR; PG8_WAIT_L(0); PG8_MMA(0, 0, At, B0); PG8_BAR; PG8_SCHED;
            PG8_LDB(B1, 0, 1); PG8_STAGE(PG8_SB(0, 0), b2, voffB);
            PG8_BAR; PG8_WAIT_L(0); PG8_MMA(0, 1, At, B1); PG8_BAR;
            PG8_LDA(At, 0, 1); PG8_STAGE(PG8_SA(0, 0), a2, voffA);
            PG8_BAR; PG8_WAIT_L(0); PG8_MMA(1, 0, At, B0); PG8_BAR; PG8_SCHED;
            PG8_STAGE(PG8_SB(0, 1), b2 + hstep, voffB);
            PG8_WAIT_V(6); PG8_BAR; PG8_MMA(1, 1, At, B1); PG8_BAR;
            PG8_LDB(B0, 1, 0); PG8_SCHED; PG8_LDA(At, 1, 0); PG8_STAGE(PG8_SA(0, 1), a2 + hstep, voffA);
            PG8_WAIT_L(8); PG8_BAR; PG8_WAIT_L(0); PG8_MMA(0, 0, At, B0); PG8_BAR; PG8_SCHED;
            PG8_LDB(B1, 1, 1); PG8_STAGE(PG8_SB(1, 0), b3, voffB);
            PG8_BAR; PG8_WAIT_L(0); PG8_MMA(0, 1, At, B1); PG8_BAR;
            PG8_LDA(At, 1, 1); PG8_STAGE(PG8_SA(1, 0), a3, voffA);
            PG8_BAR; PG8_WAIT_L(0); PG8_MMA(1, 0, At, B0); PG8_BAR; PG8_SCHED;
            PG8_STAGE(PG8_SB(1, 1), b3 + hstep, voffB);
            PG8_WAIT_V(6); PG8_BAR; PG8_MMA(1, 1, At, B1); PG8_BAR;
        }
            if constexpr (!Epi::AFTER_DRAIN) { E(acc, cur, wr, wc, fr, fq); S.done(cur); }
            if (!has_next) break;
#pragma unroll
        for (int a = 0; a < 2; ++a)
#pragma unroll
            for (int b = 0; b < 2; ++b)
#pragma unroll
                for (int m = 0; m < 4; ++m)
#pragma unroll
                    for (int n = 0; n < 2; ++n) acc[a][b][m][n] = (f32x4){0.f, 0.f, 0.f, 0.f};
        cur = nxt; cA = nA; cB = nB; ++ui;
    }
    PG8_WAIT_V(0);
    if (wr == 0) PG8_BAR;
    PG8_BAR;
    if constexpr (Epi::AFTER_DRAIN) { E.fused(acc, cur, wr, wc, fr, fq, lds, wid, lane); S.done(cur); }
#undef PG8_SA
#undef PG8_SB
#undef PG8_STAGE
#undef PG8_LDA
#undef PG8_LDB
#undef PG8_MMA
#undef PG8_WAIT_V
#undef PG8_WAIT_L
#undef PG8_BAR
#undef PG8_SCHED
}

}

struct EpiInproj {
  static constexpr bool PERM = true, AFTER_DRAIN = false;
  bfu* u; float* small;
  __device__ __forceinline__ void operator()(const pg8::f32x4 (&acc)[2][2][4][2], const pg8::Unit& un, int wr, int wc, int fr, int fq) const {
    const int row0 = un.pm * 256 + wr * 64 + fr;
    if (un.pn < 32) {
      const bool sig = un.pn >= 16;
      const int col0 = un.pn * 256 + wc * 32 + 8 * fq;
#pragma unroll
      for (int ai = 0; ai < 2; ++ai)
#pragma unroll
        for (int m = 0; m < 4; ++m) {
          bfu* rowp = u + (size_t)(row0 + ai * 128 + m * 16) * NU + col0;
#pragma unroll
          for (int bj = 0; bj < 2; ++bj) {
            pg8::f32x4 v0 = acc[ai][bj][m][0], v1 = acc[ai][bj][m][1];
            if (sig) {
#pragma unroll
              for (int j = 0; j < 4; ++j) { v0[j] = sigmoidf_(v0[j]); v1[j] = sigmoidf_(v1[j]); }
            }
            pg8::u32x4 w;
            w.x = pg8::cvt_pk_bf16(v0[0], v0[1]); w.y = pg8::cvt_pk_bf16(v0[2], v0[3]);
            w.z = pg8::cvt_pk_bf16(v1[0], v1[1]); w.w = pg8::cvt_pk_bf16(v1[2], v1[3]);
            *(pg8::u32x4*)(rowp + bj * 128) = w;
          }
        }
    } else if (wc == 0) {
#pragma unroll
      for (int ai = 0; ai < 2; ++ai)
#pragma unroll
        for (int m = 0; m < 4; ++m) {
          float* sp = small + (size_t)(row0 + ai * 128 + m * 16) * 32 + 8 * fq;
          *(pg8::f32x4*)(sp) = acc[ai][0][m][0];
          *(pg8::f32x4*)(sp + 4) = acc[ai][0][m][1];
        }
    }
  }
};
struct EpiResid {
  static constexpr bool PERM = false, AFTER_DRAIN = false;
  const float* xold; float* out;
  __device__ __forceinline__ void operator()(const pg8::f32x4 (&acc)[2][2][4][2], const pg8::Unit& un, int wr, int wc, int fr, int fq) const {
    const int row0 = un.pm * 256 + wr * 64 + fr, col0 = un.pn * 256 + wc * 32 + 4 * fq;
#pragma unroll
    for (int ai = 0; ai < 2; ++ai)
#pragma unroll
      for (int m = 0; m < 4; ++m) {
        const size_t off = (size_t)(row0 + ai * 128 + m * 16) * DM + col0;
#pragma unroll
        for (int bj = 0; bj < 2; ++bj)
#pragma unroll
          for (int n = 0; n < 2; ++n) {
            const pg8::f32x4 b = *(const pg8::f32x4*)(xold + off + bj * 128 + n * 16);
            *(pg8::f32x4*)(out + off + bj * 128 + n * 16) = b + acc[ai][bj][m][n];
          }
        asm volatile("" ::: "memory");
      }
  }
};
struct EpiSwiglu {
  static constexpr bool PERM = true, AFTER_DRAIN = false;
  bfu* hidden;
  __device__ __forceinline__ void operator()(const pg8::f32x4 (&acc)[2][2][4][2], const pg8::Unit& un, int wr, int wc, int fr, int fq) const {
    const int row0 = un.pm * 256 + wr * 64 + fr;
#pragma unroll
    for (int ai = 0; ai < 2; ++ai)
#pragma unroll
      for (int m = 0; m < 4; ++m) {
        bfu* rowp = hidden + (size_t)(row0 + ai * 128 + m * 16) * FH + (un.pn * 8 + wc) * 16 + 4 * fq;
#pragma unroll
        for (int bj = 0; bj < 2; ++bj) {
          const pg8::f32x4 g = acc[ai][bj][m][0], uu = acc[ai][bj][m][1];
          pg8::u32x2 w;
          w.x = pg8::cvt_pk_bf16(siluf_(g[0]) * uu[0], siluf_(g[1]) * uu[1]);
          w.y = pg8::cvt_pk_bf16(siluf_(g[2]) * uu[2], siluf_(g[3]) * uu[3]);
          *(pg8::u32x2*)(rowp + bj * 64) = w;
        }
      }
  }
};

__device__ __forceinline__ void grid_barrier(unsigned* ctr, unsigned target) {
  asm volatile("s_waitcnt vmcnt(0)" ::: "memory");
  __syncthreads();
  if (threadIdx.x == 0) {
    __builtin_amdgcn_fence(__ATOMIC_RELEASE, "agent");
    asm volatile("s_waitcnt vmcnt(0)" ::: "memory");
    __hip_atomic_fetch_add(ctr, 1u, __ATOMIC_RELAXED, __HIP_MEMORY_SCOPE_AGENT);
    while (__hip_atomic_load(ctr, __ATOMIC_RELAXED, __HIP_MEMORY_SCOPE_AGENT) < target) __builtin_amdgcn_s_sleep(1);
    __builtin_amdgcn_fence(__ATOMIC_ACQUIRE, "agent");
    asm volatile("s_waitcnt vmcnt(0)" ::: "memory");
  }
  __syncthreads();
}

__global__ void __launch_bounds__(NTHREADS, 2) mega(Params p_in, int ph_lo, int ph_hi, int use_cg) {
  extern __shared__ __attribute__((aligned(16))) unsigned char smem_raw[];
  unsigned nbar = 0;
  for (int ph = ph_lo; ph < ph_hi; ++ph) {
#if PROBE_DUP >= 0
    const int l = ph / (PH_PER_LAYER + 1);
    const int ks = ph - l * (PH_PER_LAYER + 1);
    const int k = (ks <= PROBE_DUP) ? ks : ks - 1;
    const int wr = (ks == PROBE_DUP) ? 0 : 1;
#else
    const int wr = 1;
    const int l = ph / PH_PER_LAYER, k = ph - l * PH_PER_LAYER;
#endif
    int t512 = threadIdx.x;
    asm volatile("" : "+v"(t512));
    const int tid = t512 & 255;
    const int half = __builtin_amdgcn_readfirstlane(t512 >> 8);
    const int vb = blockIdx.x * 2 + half, vg = gridDim.x * 2;
    bfu* smem = reinterpret_cast<bfu*>(smem_raw + half * SMEM_HALF);
    CParams* pp = (CParams*)__builtin_amdgcn_kernarg_segment_ptr();
    asm volatile("" : "+s"(pp));
    CParams& p = *pp;
    switch (k) {
      case 0: phase_convert_norm(p, l, smem, tid, vb, vg); break;
      case 1: {
        pg8::Gemm g; g.A = (bfu*)(p.ws + OFF_h); g.Bt = (bfu*)(p.ws + OFF_WinT); g.M = S_LEN; g.N = NINP; g.K = DM;
        pg8::StaticOrder so; so.init(S_LEN, NINP, gridDim.x, blockIdx.x);
        EpiInproj e; e.u = (bfu*)(p.ws + OFF_u); e.small = (float*)(p.ws + OFF_small);
        pg8::gemm_phase<EpiInproj, pg8::StaticOrder>((PG8_LAS unsigned char*)smem_raw, g, so, e);
      } break;
      case 2: phase_prep(p, l, smem, tid, wr, vb, vg); break;
      case 3: phase_scan(p, tid, wr, vb, vg); break;
      case 4: phase_mix(p, l, smem, tid, half, ph, smem_raw); break;
      case 5: phase_upmerge(p, smem, tid, vb, vg); break;
      case 6: {
        pg8::Gemm g; g.A = (bfu*)(p.ws + OFF_h); g.Bt = (bfu*)(p.ws + OFF_WoutT); g.M = S_LEN; g.N = DM; g.K = DM;
        pg8::StaticOrder so; so.init(S_LEN, DM, gridDim.x, blockIdx.x);
        EpiResid e; e.xold = (l == 0 ? p.in[0] : p.out); e.out = p.out;
        pg8::gemm_phase<EpiResid, pg8::StaticOrder>((PG8_LAS unsigned char*)smem_raw, g, so, e);
      } break;
      case 7: phase_norm2(p, l, tid, vb, vg); break;
      case 8: {
        pg8::Gemm g; g.A = (bfu*)(p.ws + OFF_h); g.Bt = (bfu*)(p.ws + OFF_WfiT); g.M = S_LEN; g.N = 2 * FH; g.K = DM;
        pg8::StaticOrder so; so.init(S_LEN, 2 * FH, gridDim.x, blockIdx.x);
        EpiSwiglu e; e.hidden = (bfu*)(p.ws + OFF_u);
        pg8::gemm_phase<EpiSwiglu, pg8::StaticOrder>((PG8_LAS unsigned char*)smem_raw, g, so, e);
      } break;
      default: {
        pg8::Gemm g; g.A = (bfu*)(p.ws + OFF_u); g.Bt = (bfu*)(p.ws + OFF_WfoT); g.M = S_LEN; g.N = DM; g.K = FH;
        pg8::StaticOrder so; so.init(S_LEN, DM, gridDim.x, blockIdx.x);
        EpiResid e; e.xold = p.out; e.out = p.out;
        pg8::gemm_phase<EpiResid, pg8::StaticOrder>((PG8_LAS unsigned char*)smem_raw, g, so, e);
      } break;
    }
    if (ph + 1 < ph_hi) {
      if (use_cg) cg::this_grid().sync();
      else { ++nbar; grid_barrier((unsigned*)(p_in.ws + OFF_bar), nbar * gridDim.x); }
    }
  }
}

#ifndef MK_COOP
#define MK_COOP 1
#endif

extern "C" void kernel_launch(void* const* d_in, const int* in_sizes, int n_in, void* d_out, int out_size, void* d_ws,
                              size_t ws_size, hipStream_t stream) {
  Params p{};
  for (int i = 0; i < 25; ++i) p.in[i] = reinterpret_cast<const float*>(d_in[i]);
  p.out = reinterpret_cast<float*>(d_out);
  p.ws = reinterpret_cast<unsigned char*>(d_ws);
  if (WS_NEED > ws_size) { fprintf(stderr, "workspace too small: need %zu have %zu\n", (size_t)WS_NEED, ws_size); return; }

  static int grid_blocks = 0;
  if (!grid_blocks) {
    (void)hipFuncSetAttribute((const void*)mega, hipFuncAttributeMaxDynamicSharedMemorySize, SMEM_BYTES);
    int dev = 0, cus = 0, per_cu = 0;
    (void)hipGetDevice(&dev);
    (void)hipDeviceGetAttribute(&cus, hipDeviceAttributeMultiprocessorCount, dev);
    (void)hipOccupancyMaxActiveBlocksPerMultiprocessor(&per_cu, mega, NTHREADS, SMEM_BYTES);
    per_cu = 1;
    grid_blocks = cus * per_cu;
  }
  const int nph = 4 * (PH_PER_LAYER + (PROBE_DUP >= 0 ? 1 : 0));
#if MK_COOP
  int lo = 0, hi = nph, use_cg = 0;
  void* args[] = {&p, &lo, &hi, &use_cg};
  (void)hipMemsetAsync(p.ws + OFF_bar, 0, 256, stream);
  hipError_t e = hipLaunchCooperativeKernel((const void*)mega, dim3(grid_blocks), dim3(NTHREADS), args, SMEM_BYTES, stream);
  if (e != hipSuccess) fprintf(stderr, "cooperative launch failed: %s (grid %d)\n", hipGetErrorString(e), grid_blocks);
#else
  for (int ph = 0; ph < nph; ++ph)
    hipLaunchKernelGGL(mega, dim3(grid_blocks), dim3(NTHREADS), SMEM_BYTES, stream, p, ph, ph + 1, 0);
#endif
}
```

```cpp
#include <hip/hip_runtime.h>
#include <hip/hip_bf16.h>
#include <hip/hip_cooperative_groups.h>
#include <cstdio>
namespace cg = cooperative_groups;

typedef __attribute__((ext_vector_type(8))) short bf16x8;
typedef __attribute__((ext_vector_type(4))) float f32x4;
typedef unsigned short bfu;

#define S_LEN 16384
#define DM 1024
#define NU 8192
#define NINP 8448
#define NSRC 8220
#define FH 2816
#define NCH 256
#define LDP 72
#define YW 1280
#define EPS 1e-6f
#define SMEM_HALF 73728
#define SMEM_BYTES 147456
#define NTHREADS 512
#define PH_PER_LAYER 10
#ifndef PROBE_DUP
#define PROBE_DUP -1
#endif

struct Params {
  const float* in[25];
  float* out;
  unsigned char* ws;
};
typedef const __attribute__((address_space(4))) Params CParams;
constexpr size_t OFF_WinT = 0;
constexpr size_t OFF_WupT = OFF_WinT + (((size_t)NINP*DM*2 + 255) & ~(size_t)255);
constexpr size_t OFF_WoutT = OFF_WupT + (((size_t)DM*YW*2 + 255) & ~(size_t)255);
constexpr size_t OFF_WfiT = OFF_WoutT + (((size_t)DM*DM*2 + 255) & ~(size_t)255);
constexpr size_t OFF_WfoT = OFF_WfiT + (((size_t)2*FH*DM*2 + 255) & ~(size_t)255);
constexpr size_t OFF_u = OFF_WfoT + (((size_t)DM*FH*2 + 255) & ~(size_t)255);
constexpr size_t OFF_small = OFF_u + (((size_t)S_LEN*NU*2 + 255) & ~(size_t)255);
constexpr size_t OFF_h = OFF_small + (((size_t)S_LEN*32*4 + 255) & ~(size_t)255);
constexpr size_t OFF_y = OFF_h + (((size_t)S_LEN*DM*2 + 255) & ~(size_t)255);
constexpr size_t OFF_ssq = OFF_y + (((size_t)S_LEN*YW*2 + 255) & ~(size_t)255);
constexpr size_t OFF_foxq = OFF_ssq + (((size_t)S_LEN*8*4 + 255) & ~(size_t)255);
constexpr size_t OFF_foxk = OFF_foxq + (((size_t)4*S_LEN*64*2 + 255) & ~(size_t)255);
constexpr size_t OFF_foxvT = OFF_foxk + (((size_t)4*S_LEN*64*2 + 255) & ~(size_t)255);
constexpr size_t OFF_foxc = OFF_foxvT + (((size_t)4*S_LEN*64*2 + 255) & ~(size_t)255);
constexpr size_t OFF_foxtot = OFF_foxc + (((size_t)4*S_LEN*4 + 255) & ~(size_t)255);
constexpr size_t OFF_VT = OFF_foxtot + (((size_t)4*NCH*4 + 255) & ~(size_t)255);
constexpr size_t OFF_ST = OFF_VT + (((size_t)16*NCH*4096*2 + 255) & ~(size_t)255);
constexpr size_t OFF_dec = OFF_ST + (((size_t)16*NCH*4096*2 + 255) & ~(size_t)255);
constexpr size_t OFF_csb = OFF_dec + (((size_t)16*NCH*64*4 + 255) & ~(size_t)255);
constexpr size_t OFF_ssdX = OFF_csb + (((size_t)16*S_LEN*4 + 255) & ~(size_t)255);
constexpr size_t OFF_ssdB = OFF_ssdX + (((size_t)S_LEN*512*2 + 255) & ~(size_t)255);
constexpr size_t OFF_ssdC = OFF_ssdB + (((size_t)2*S_LEN*64*2 + 255) & ~(size_t)255);
constexpr size_t OFF_rcos = OFF_ssdC + (((size_t)2*S_LEN*64*2 + 255) & ~(size_t)255);
constexpr size_t OFF_rsin = OFF_rcos + (((size_t)S_LEN*32*4 + 255) & ~(size_t)255);
constexpr size_t OFF_ctr = OFF_rsin + (((size_t)S_LEN*32*4 + 255) & ~(size_t)255);
constexpr size_t OFF_bar = OFF_ctr + (((size_t)256 + 255) & ~(size_t)255);
constexpr size_t WS_NEED = OFF_bar + 256;

__device__ __forceinline__ bfu f2bf(float f) {
  unsigned u = __float_as_uint(f);
  u += 0x7fffu + ((u >> 16) & 1u);
  return (bfu)(u >> 16);
}
__device__ __forceinline__ float bf2f(bfu b) { return __uint_as_float(((unsigned)b) << 16); }
__device__ __forceinline__ float sigmoidf_(float x) { return 1.f / (1.f + __expf(-x)); }
__device__ __forceinline__ float siluf_(float x) { return x / (1.f + __expf(-x)); }
__device__ __forceinline__ float logsigmoidf_(float z) { return fminf(z, 0.f) - log1pf(expf(-fabsf(z))); }
__device__ __forceinline__ float logsigmoid_fast(float z) { return fminf(z, 0.f) - __logf(1.f + __expf(-fabsf(z))); }
__device__ __forceinline__ float softplus_fast(float z) { return fmaxf(z, 0.f) + __logf(1.f + __expf(-fabsf(z))); }
__device__ __forceinline__ float softplusf_(float z) { return fmaxf(z, 0.f) + log1pf(expf(-fabsf(z))); }

namespace pg8 { __device__ __forceinline__ unsigned cvt_pk_bf16(float lo, float hi); }
__device__ __forceinline__ bf16x8 lds_frag(const bfu* base, int row, int kofs, int stride) {
  return *reinterpret_cast<const bf16x8*>(base + row * stride + kofs);
}

__device__ __forceinline__ void mma16x64(f32x4 (&acc)[4], const bfu* sA, int arow0, const bfu* sB, int lane) {
  const int r = lane & 15, q = (lane >> 4) * 8;
#pragma unroll
  for (int ks = 0; ks < 2; ++ks) {
    bf16x8 a = lds_frag(sA, arow0 + r, ks * 32 + q, LDP);
#pragma unroll
    for (int n = 0; n < 4; ++n) {
      bf16x8 b = lds_frag(sB, n * 16 + r, ks * 32 + q, LDP);
      acc[n] = __builtin_amdgcn_mfma_f32_16x16x32_bf16(a, b, acc[n], 0, 0, 0);
    }
  }
}

__device__ __forceinline__ void load_tile64(bfu* s, const bfu* g, int gs, int tid) {
#pragma unroll
  for (int i = 0; i < 2; ++i) {
    int id = tid + i * 256;
    int r = id >> 3, c = (id & 7) * 8;
    *reinterpret_cast<uint4*>(s + r * LDP + c) = *reinterpret_cast<const uint4*>(g + (size_t)r * gs + c);
  }
}

template <int NI>
__device__ __forceinline__ void gemm_main(f32x4 (&acc)[4][NI], const bfu* __restrict__ A, int lda,
                                          const bfu* __restrict__ Bt, int ldb, int K, bfu* smem, int tid) {
  bfu* sA = smem;
  bfu* sB = smem + 2 * 128 * LDP;
  const int lane = tid & 63, w = tid >> 6, wm = w >> 1, wn = w & 1;
  const int lr = lane & 15, lq = (lane >> 4) * 8;
  const int crow = tid >> 3, ccol = (tid & 7) * 8;
  const bfu* Ap = A + (size_t)crow * lda + ccol;
  const bfu* Bp = Bt + (size_t)crow * ldb + ccol;
  uint4 ra[4], rb[NI];
#pragma unroll
  for (int i = 0; i < 4; ++i) ra[i] = *reinterpret_cast<const uint4*>(Ap + (size_t)i * 32 * lda);
#pragma unroll
  for (int i = 0; i < NI; ++i) rb[i] = *reinterpret_cast<const uint4*>(Bp + (size_t)i * 32 * ldb);
#pragma unroll
  for (int i = 0; i < 4; ++i) *reinterpret_cast<uint4*>(sA + (crow + i * 32) * LDP + ccol) = ra[i];
#pragma unroll
  for (int i = 0; i < NI; ++i) *reinterpret_cast<uint4*>(sB + (crow + i * 32) * LDP + ccol) = rb[i];
  __syncthreads();
  const int nk = K >> 6;
  for (int kt = 0; kt < nk; ++kt) {
    const int cur = kt & 1;
    if (kt + 1 < nk) {
      const int ko = (kt + 1) * 64;
#pragma unroll
      for (int i = 0; i < 4; ++i) ra[i] = *reinterpret_cast<const uint4*>(Ap + (size_t)i * 32 * lda + ko);
#pragma unroll
      for (int i = 0; i < NI; ++i) rb[i] = *reinterpret_cast<const uint4*>(Bp + (size_t)i * 32 * ldb + ko);
    }
    const bfu* a_s = sA + cur * 128 * LDP + (wm * 64) * LDP;
    const bfu* b_s = sB + cur * 128 * LDP + (wn * NI * 16) * LDP;
#pragma unroll
    for (int ks = 0; ks < 2; ++ks) {
      bf16x8 af[4], bfr[NI];
#pragma unroll
      for (int mi = 0; mi < 4; ++mi) af[mi] = lds_frag(a_s, mi * 16 + lr, ks * 32 + lq, LDP);
#pragma unroll
      for (int ni = 0; ni < NI; ++ni) bfr[ni] = lds_frag(b_s, ni * 16 + lr, ks * 32 + lq, LDP);
#pragma unroll
      for (int mi = 0; mi < 4; ++mi)
#pragma unroll
        for (int ni = 0; ni < NI; ++ni)
          acc[mi][ni] = __builtin_amdgcn_mfma_f32_16x16x32_bf16(af[mi], bfr[ni], acc[mi][ni], 0, 0, 0);
    }
    if (kt + 1 < nk) {
      bfu* sAn = sA + (cur ^ 1) * 128 * LDP;
      bfu* sBn = sB + (cur ^ 1) * 128 * LDP;
#pragma unroll
      for (int i = 0; i < 4; ++i) *reinterpret_cast<uint4*>(sAn + (crow + i * 32) * LDP + ccol) = ra[i];
#pragma unroll
      for (int i = 0; i < NI; ++i) *reinterpret_cast<uint4*>(sBn + (crow + i * 32) * LDP + ccol) = rb[i];
    }
    __syncthreads();
  }
}

template <int NI>
__device__ __forceinline__ void zero_acc(f32x4 (&acc)[4][NI]) {
#pragma unroll
  for (int i = 0; i < 4; ++i)
#pragma unroll
    for (int j = 0; j < NI; ++j) acc[i][j] = (f32x4){0.f, 0.f, 0.f, 0.f};
}

__device__ __forceinline__ int win_src(int dc) {
  if (dc < 768) return dc;
  if (dc < 1536) return dc + 4;
  if (dc < 4096) return dc + 20;
  if (dc < 8192) return dc + 28;
  int s = dc - 8192;
  if (s < 4) return 768 + s;
  if (s < 20) return 1540 + (s - 4);
  if (s < 28) return 4116 + (s - 20);
  return -1;
}
__device__ __forceinline__ int ffi_src(int dc) {
  const int G = dc >> 5, w = dc & 31, f = w >> 3, r = w & 7;
  return (r < 4) ? (G * 16 + f * 4 + r) : (FH + G * 16 + f * 4 + (r - 4));
}

__device__ __forceinline__ void convert_tile(const float* __restrict__ W, int ldw, int kt, int ntd, bfu* __restrict__ Wt,
                                             int ldt, int kofs, int mode, const float* __restrict__ rowgain,
                                             bfu* sT, int tid) {
  const int c4 = (tid & 15) * 4, r0 = tid >> 4;
  const int dc = ntd * 64 + c4;
  int sc = dc;
  if (mode == 1) sc = win_src(dc);
  else if (mode == 2) sc = ffi_src(dc);
#pragma unroll
  for (int ps = 0; ps < 4; ++ps) {
    int kk = r0 + ps * 16;
    int k = kt * 64 + kk;
    float4 v = make_float4(0.f, 0.f, 0.f, 0.f);
    if (sc >= 0) v = *reinterpret_cast<const float4*>(W + (size_t)k * ldw + sc);
    if (rowgain) { float g = rowgain[k]; v.x *= g; v.y *= g; v.z *= g; v.w *= g; }
    sT[(c4 + 0) * LDP + kk] = f2bf(v.x);
    sT[(c4 + 1) * LDP + kk] = f2bf(v.y);
    sT[(c4 + 2) * LDP + kk] = f2bf(v.z);
    sT[(c4 + 3) * LDP + kk] = f2bf(v.w);
  }
  __syncthreads();
#pragma unroll
  for (int i = 0; i < 2; ++i) {
    int id = tid + i * 256;
    int nn = id >> 3, kc = (id & 7) * 8;
    *reinterpret_cast<uint4*>(Wt + (size_t)(ntd * 64 + nn) * ldt + kofs + kt * 64 + kc) =
        *reinterpret_cast<const uint4*>(sT + nn * LDP + kc);
  }
  __syncthreads();
}

__device__ void phase_convert_norm(CParams& p_o, int l, bfu* smem, int tid, int vb, int vg) {
  const int nconv = 4800, nnorm = 4096;
  const int nrot = (l == 0) ? 64 : 0;
  const int total = nconv + nnorm + nrot;
  if (l == 0 && vb == 0 && tid < 64) ((unsigned*)(p_o.ws + OFF_ctr))[tid] = 0u;
  for (int it = vb; it < total; it += vg) {
    CParams* pp_ = &p_o;
    asm volatile("" : "+s"(pp_));
    CParams& p = *pp_;
    if (it < nconv) {
      if (it < 2112) {
        int kt = it & 15, nt = it >> 4;
        convert_tile(p.in[4] + (size_t)l * DM * NSRC, NSRC, kt, nt, ((bfu*)(p.ws + OFF_WinT)), DM, 0, 1, nullptr, smem, tid);
      } else if (it < 2304) {
        int j = it - 2112; int br = j >> 6; j &= 63;
        int kt = j & 3, nt = j >> 2;
        const float* W = (br == 0 ? p.in[18] : (br == 1 ? p.in[19] : p.in[20])) + (size_t)l * 256 * DM;
        convert_tile(W, DM, kt, nt, ((bfu*)(p.ws + OFF_WupT)), YW, br * 256, 0, nullptr, smem, tid);
      } else if (it < 2432) {
        int j = it - 2304; int kt = j & 7, nt = j >> 3;
        convert_tile(p.in[21] + (size_t)l * 512 * DM, DM, kt, nt, ((bfu*)(p.ws + OFF_WupT)), YW, 768, 0, p.in[17] + l * 512, smem, tid);
      } else if (it < 2688) {
        int j = it - 2432; int kt = j & 15, nt = j >> 4;
        convert_tile(p.in[22] + (size_t)l * DM * DM, DM, kt, nt, ((bfu*)(p.ws + OFF_WoutT)), DM, 0, 0, nullptr, smem, tid);
      } else if (it < 4096) {
        int j = it - 2688; int kt = j & 15, nt = j >> 4;
        convert_tile(p.in[23] + (size_t)l * DM * 2 * FH, 2 * FH, kt, nt, ((bfu*)(p.ws + OFF_WfiT)), DM, 0, 2, nullptr, smem, tid);
      } else {
        int j = it - 4096; int kt = j % 44, nt = j / 44;
        convert_tile(p.in[24] + (size_t)l * FH * DM, DM, kt, nt, ((bfu*)(p.ws + OFF_WfoT)), FH, 0, 0, nullptr, smem, tid);
      }
    } else if (it < nconv + nnorm) {
      int row = (it - nconv) * 4 + (tid >> 6);
      int lane = tid & 63;
      const float* xr = (l == 0 ? p.in[0] : p.out) + (size_t)row * DM;
      const float* g = p.in[2] + l * DM;
      float4 v[4];
      float ss = 0.f;
#pragma unroll
      for (int i = 0; i < 4; ++i) {
        v[i] = *reinterpret_cast<const float4*>(xr + i * 256 + lane * 4);
        ss += v[i].x * v[i].x + v[i].y * v[i].y + v[i].z * v[i].z + v[i].w * v[i].w;
      }
#pragma unroll
      for (int m = 1; m < 64; m <<= 1) ss += __shfl_xor(ss, m, 64);
      float rstd = rsqrtf(ss * (1.f / DM) + EPS);
#pragma unroll
      for (int i = 0; i < 4; ++i) {
        float4 gg = *reinterpret_cast<const float4*>(g + i * 256 + lane * 4);
        ushort4 o;
        o.x = f2bf(v[i].x * rstd * gg.x); o.y = f2bf(v[i].y * rstd * gg.y);
        o.z = f2bf(v[i].z * rstd * gg.z); o.w = f2bf(v[i].w * rstd * gg.w);
        *reinterpret_cast<ushort4*>(((bfu*)(p.ws + OFF_h)) + (size_t)row * DM + i * 256 + lane * 4) = o;
      }
    } else {
      int base = (it - nconv - nnorm) * 256;
      for (int e = tid; e < 256 * 32; e += 256) {
        int tok = base + (e >> 5), i = e & 31;
        float inv = powf(10000.f, -(float)i / 32.f);
        float ang = (float)((const int*)p.in[1])[tok] * inv;
        double a = (double)ang;
        double kq = rint(a * 0.15915494309189535);
        float r = (float)(a - kq * 6.283185307179586);
        ((float*)(p.ws + OFF_rcos))[tok * 32 + i] = cosf(r);
        ((float*)(p.ws + OFF_rsin))[tok * 32 + i] = sinf(r);
      }
    }
  }
}

__device__ void phase_norm2(CParams& p, int l, int tid, int vb, int vg) {
  for (int it = vb; it < 4096; it += vg) {
    int row = it * 4 + (tid >> 6);
    int lane = tid & 63;
    const float* xr = p.out + (size_t)row * DM;
    const float* g = p.in[3] + l * DM;
    float4 v[4];
    float ss = 0.f;
#pragma unroll
    for (int i = 0; i < 4; ++i) {
      v[i] = *reinterpret_cast<const float4*>(xr + i * 256 + lane * 4);
      ss += v[i].x * v[i].x + v[i].y * v[i].y + v[i].z * v[i].z + v[i].w * v[i].w;
    }
#pragma unroll
    for (int m = 1; m < 64; m <<= 1) ss += __shfl_xor(ss, m, 64);
    float rstd = rsqrtf(ss * (1.f / DM) + EPS);
#pragma unroll
    for (int i = 0; i < 4; ++i) {
      float4 gg = *reinterpret_cast<const float4*>(g + i * 256 + lane * 4);
      ushort4 o;
      o.x = f2bf(v[i].x * rstd * gg.x); o.y = f2bf(v[i].y * rstd * gg.y);
      o.z = f2bf(v[i].z * rstd * gg.z); o.w = f2bf(v[i].w * rstd * gg.w);
      *reinterpret_cast<ushort4*>(((bfu*)(p.ws + OFF_h)) + (size_t)row * DM + i * 256 + lane * 4) = o;
    }
  }
}

__device__ __forceinline__ float wave_incl_scan(float v, int lane) {
#pragma unroll
  for (int d = 1; d < 64; d <<= 1) {
    float o = __shfl_up(v, d, 64);
    if (lane >= d) v += o;
  }
  return v;
}

__device__ void phase_prep(CParams& p_o, int l, bfu* smem, int tid, int wr, int vb, int vg) {
  bfu* sK = smem;
  bfu* sV = smem + 64 * LDP;
  float* sF = reinterpret_cast<float*>(smem + 2 * 64 * LDP);
  float* s_glr = sF;
  float* s_seg = sF + 1024;
  float* s_ps = sF + 1280;
  float* s_cs = sF + 1344;
  float* s_dt = sF + 1408;
  const int lane = tid & 63, seg = tid >> 6, col = lane;
  const int total = NCH * 20;
  for (int it = vb; it < total; it += vg) {
    CParams* pp_ = &p_o;
    asm volatile("" : "+s"(pp_));
    CParams& p = *pp_;
    const int c = it / 20, hs = it - c * 20;
    const int tok0 = c * 64;
    bfu kreg[16], vreg[16];
    if (hs < 4) {
      const int h = hs;
      for (int i = tid; i < 1024; i += 256) s_glr[i] = ((float*)(p.ws + OFF_small))[(tok0 + (i >> 4)) * 32 + 4 + (i & 15)];
      float wv[16];
#pragma unroll
      for (int r = 0; r < 16; ++r) wv[r] = p.in[8][(l * 16 + r) * 256 + h * 64 + col];
      const float bias = p.in[9][l * 256 + h * 64 + col];
      __syncthreads();
      float lb[16];
      float run = 0.f;
#pragma unroll
      for (int i = 0; i < 16; ++i) {
        int t = seg * 16 + i;
        float z = bias;
#pragma unroll
        for (int r = 0; r < 16; ++r) z += s_glr[t * 16 + r] * wv[r];
        run += logsigmoid_fast(z) * (1.f / 16.f);
        lb[i] = run;
      }
      s_seg[seg * 64 + col] = run;
      __syncthreads();
      float pre = 0.f, blast = 0.f;
#pragma unroll
      for (int s2 = 0; s2 < 4; ++s2) {
        float v = s_seg[s2 * 64 + col];
        if (s2 < seg) pre += v;
        blast += v;
      }
      if (seg == 0) {
        float e = __expf(blast);
        s_ps[col] = e;
        ((float*)(p.ws + OFF_dec))[(hs * NCH + c) * 64 + col] = e;
        ((float*)(p.ws + OFF_csb))[hs * S_LEN + tok0 + col] = 0.f;
      }
#pragma unroll
      for (int i = 0; i < 16; ++i) {
        int tok = tok0 + seg * 16 + i;
        float b = lb[i] + pre;
        bfu* ur = ((bfu*)(p.ws + OFF_u)) + (size_t)tok * NU + h * 64 + col;
        float q = bf2f(ur[768]), k = bf2f(ur[1024]);
        vreg[i] = ur[1280];
        bfu qd = f2bf(q * 0.125f * __expf(b));
        bfu ki = f2bf(k * __expf(-b));
        if (wr) { ur[768] = qd; ur[1024] = ki; }
        kreg[i] = ki;
      }
    } else if (hs < 8) {
      const int h = hs - 4;
      const float lg = log1pf(-exp2f(-5.f - (float)h));
      if (seg == 0) {
        s_ps[col] = 1.f;
        ((float*)(p.ws + OFF_dec))[(hs * NCH + c) * 64 + col] = __expf(64.f * lg);
        ((float*)(p.ws + OFF_csb))[hs * S_LEN + tok0 + col] = (float)(col + 1) * lg;
      }
#pragma unroll
      for (int i = 0; i < 16; ++i) {
        int t = seg * 16 + i, tok = tok0 + t;
        float cs = ((float*)(p.ws + OFF_rcos))[tok * 32 + (col & 31)], sn = ((float*)(p.ws + OFF_rsin))[tok * 32 + (col & 31)];
        bfu* ur = ((bfu*)(p.ws + OFF_u)) + (size_t)tok * NU + h * 64;
        float qo = bf2f(ur[1792 + col]), qx = bf2f(ur[1792 + (col ^ 32)]);
        float ko = bf2f(ur[2048 + col]), kx = bf2f(ur[2048 + (col ^ 32)]);
        vreg[i] = ur[2304 + col];
        float qr, kr;
        if (col < 32) { qr = qo * cs - qx * sn; kr = ko * cs - kx * sn; }
        else          { qr = qx * sn + qo * cs; kr = kx * sn + ko * cs; }
        kr *= 0.125f;
        bfu kb = f2bf(kr);
        if (wr) { ur[1792 + col] = f2bf(qr); ur[2048 + col] = kb; }
        kreg[i] = f2bf(bf2f(kb) * __expf(lg * (float)(63 - t)));
      }
    } else if (hs < 16) {
      const int h = hs - 8, g = h >> 2;
      if (seg == 0) {
        float dtv = softplus_fast(((float*)(p.ws + OFF_small))[(tok0 + lane) * 32 + 20 + h] + p.in[14][l * 8 + h]);
        float a = -__expf(p.in[15][l * 8 + h]);
        float cs = wave_incl_scan(dtv * a, lane);
        s_cs[lane] = cs;
        s_dt[lane] = dtv;
        ((float*)(p.ws + OFF_csb))[hs * S_LEN + tok0 + lane] = cs;
        s_ps[lane] = 1.f;
      }
      __syncthreads();
      const float cs_last = s_cs[63];
      if (seg == 0) ((float*)(p.ws + OFF_dec))[(hs * NCH + c) * 64 + col] = __expf(cs_last);
      const int chx = h * 64 + col, chb = 512 + g * 64 + col, chc = 640 + g * 64 + col;
      float wx[4], wb[4], wc[4];
#pragma unroll
      for (int j = 0; j < 4; ++j) {
        wx[j] = p.in[12][(l * 4 + j) * 768 + chx];
        wb[j] = p.in[12][(l * 4 + j) * 768 + chb];
        wc[j] = p.in[12][(l * 4 + j) * 768 + chc];
      }
      const float bx = p.in[13][l * 768 + chx], bb = p.in[13][l * 768 + chb], bc = p.in[13][l * 768 + chc];
      float x0, x1, x2, b0, b1, b2, c0, c1, c2;
      {
        int tb = tok0 + seg * 16;
        const bfu* ub = ((bfu*)(p.ws + OFF_u)) + 3328;
        x0 = (tb - 3 >= 0) ? bf2f(ub[(size_t)(tb - 3) * NU + chx]) : 0.f;
        x1 = (tb - 2 >= 0) ? bf2f(ub[(size_t)(tb - 2) * NU + chx]) : 0.f;
        x2 = (tb - 1 >= 0) ? bf2f(ub[(size_t)(tb - 1) * NU + chx]) : 0.f;
        b0 = (tb - 3 >= 0) ? bf2f(ub[(size_t)(tb - 3) * NU + chb]) : 0.f;
        b1 = (tb - 2 >= 0) ? bf2f(ub[(size_t)(tb - 2) * NU + chb]) : 0.f;
        b2 = (tb - 1 >= 0) ? bf2f(ub[(size_t)(tb - 1) * NU + chb]) : 0.f;
        c0 = (tb - 3 >= 0) ? bf2f(ub[(size_t)(tb - 3) * NU + chc]) : 0.f;
        c1 = (tb - 2 >= 0) ? bf2f(ub[(size_t)(tb - 2) * NU + chc]) : 0.f;
        c2 = (tb - 1 >= 0) ? bf2f(ub[(size_t)(tb - 1) * NU + chc]) : 0.f;
      }
#pragma unroll
      for (int i = 0; i < 16; ++i) {
        int t = seg * 16 + i, tok = tok0 + t;
        const bfu* ur = ((bfu*)(p.ws + OFF_u)) + (size_t)tok * NU + 3328;
        float x3 = bf2f(ur[chx]), b3 = bf2f(ur[chb]), c3 = bf2f(ur[chc]);
        float xs = siluf_(bx + wx[0] * x0 + wx[1] * x1 + wx[2] * x2 + wx[3] * x3);
        float bs = siluf_(bb + wb[0] * b0 + wb[1] * b1 + wb[2] * b2 + wb[3] * b3);
        float cv = siluf_(bc + wc[0] * c0 + wc[1] * c1 + wc[2] * c2 + wc[3] * c3);
        x0 = x1; x1 = x2; x2 = x3; b0 = b1; b1 = b2; b2 = b3; c0 = c1; c1 = c2; c2 = c3;
        bfu xb = f2bf(xs);
        ((bfu*)(p.ws + OFF_ssdX))[(size_t)tok * 512 + chx] = xb;
        if ((h & 3) == 0) {
          ((bfu*)(p.ws + OFF_ssdB))[((size_t)g * S_LEN + tok) * 64 + col] = f2bf(bs);
          ((bfu*)(p.ws + OFF_ssdC))[((size_t)g * S_LEN + tok) * 64 + col] = f2bf(cv);
        }
        vreg[i] = f2bf(xs * s_dt[t]);
        kreg[i] = f2bf(bs * __expf(cs_last - s_cs[t]));
      }
    } else {
      const int h = hs - 16;
      if (seg == 0) {
        float lf = logsigmoid_fast(((float*)(p.ws + OFF_small))[(tok0 + lane) * 32 + h] + p.in[5][l * 4 + h]);
        float cs = wave_incl_scan(lf, lane);
        ((float*)(p.ws + OFF_foxc))[h * S_LEN + tok0 + lane] = cs;
        if (lane == 63) ((float*)(p.ws + OFF_foxtot))[h * NCH + c] = cs;
      }
      const float qg = p.in[6][l * 64 + col], kg = p.in[7][l * 64 + col];
#pragma unroll
      for (int i = 0; i < 16; ++i) {
        int tok = tok0 + seg * 16 + i;
        const bfu* ur = ((bfu*)(p.ws + OFF_u)) + (size_t)tok * NU + h * 64 + col;
        float q = bf2f(ur[0]), k = bf2f(ur[256]);
        vreg[i] = ur[512];
        float sq = q * q, sk = k * k;
#pragma unroll
        for (int m = 1; m < 64; m <<= 1) { sq += __shfl_xor(sq, m, 64); sk += __shfl_xor(sk, m, 64); }
        ((bfu*)(p.ws + OFF_foxq))[((size_t)h * S_LEN + tok) * 64 + col] = f2bf(q * rsqrtf(sq * (1.f / 64.f) + EPS) * qg * (0.125f * 1.44269504088896f));
        ((bfu*)(p.ws + OFF_foxk))[((size_t)h * S_LEN + tok) * 64 + col] = f2bf(k * rsqrtf(sk * (1.f / 64.f) + EPS) * kg);
      }
      uint4 v0, v1;
      v0.x = vreg[0] | ((unsigned)vreg[1] << 16); v0.y = vreg[2] | ((unsigned)vreg[3] << 16);
      v0.z = vreg[4] | ((unsigned)vreg[5] << 16); v0.w = vreg[6] | ((unsigned)vreg[7] << 16);
      v1.x = vreg[8] | ((unsigned)vreg[9] << 16); v1.y = vreg[10] | ((unsigned)vreg[11] << 16);
      v1.z = vreg[12] | ((unsigned)vreg[13] << 16); v1.w = vreg[14] | ((unsigned)vreg[15] << 16);
      bfu* dst = ((bfu*)(p.ws + OFF_foxvT)) + ((size_t)h * 64 + col) * S_LEN + tok0 + seg * 16;
      *reinterpret_cast<uint4*>(dst) = v0;
      *reinterpret_cast<uint4*>(dst + 8) = v1;
      continue;
    }
    {
      uint4 k0, k1, v0, v1;
      k0.x = kreg[0] | ((unsigned)kreg[1] << 16); k0.y = kreg[2] | ((unsigned)kreg[3] << 16);
      k0.z = kreg[4] | ((unsigned)kreg[5] << 16); k0.w = kreg[6] | ((unsigned)kreg[7] << 16);
      k1.x = kreg[8] | ((unsigned)kreg[9] << 16); k1.y = kreg[10] | ((unsigned)kreg[11] << 16);
      k1.z = kreg[12] | ((unsigned)kreg[13] << 16); k1.w = kreg[14] | ((unsigned)kreg[15] << 16);
      v0.x = vreg[0] | ((unsigned)vreg[1] << 16); v0.y = vreg[2] | ((unsigned)vreg[3] << 16);
      v0.z = vreg[4] | ((unsigned)vreg[5] << 16); v0.w = vreg[6] | ((unsigned)vreg[7] << 16);
      v1.x = vreg[8] | ((unsigned)vreg[9] << 16); v1.y = vreg[10] | ((unsigned)vreg[11] << 16);
      v1.z = vreg[12] | ((unsigned)vreg[13] << 16); v1.w = vreg[14] | ((unsigned)vreg[15] << 16);
      *reinterpret_cast<uint4*>(sK + col * LDP + seg * 16) = k0;
      *reinterpret_cast<uint4*>(sK + col * LDP + seg * 16 + 8) = k1;
      *reinterpret_cast<uint4*>(sV + col * LDP + seg * 16) = v0;
      *reinterpret_cast<uint4*>(sV + col * LDP + seg * 16 + 8) = v1;
      bfu* dst = ((bfu*)(p.ws + OFF_VT)) + (((size_t)hs * NCH + c) * 64 + col) * 64 + seg * 16;
      *reinterpret_cast<uint4*>(dst) = v0;
      *reinterpret_cast<uint4*>(dst + 8) = v1;
    }
    __syncthreads();
    {
      f32x4 acc[4];
#pragma unroll
      for (int n = 0; n < 4; ++n) acc[n] = (f32x4){0.f, 0.f, 0.f, 0.f};
      mma16x64(acc, sV, seg * 16, sK, lane);
      bfu* st = ((bfu*)(p.ws + OFF_ST)) + ((size_t)hs * NCH + c) * 4096;
#pragma unroll
      for (int n = 0; n < 4; ++n) {
        int d = n * 16 + (lane & 15);
        float ps = s_ps[d];
#pragma unroll
        for (int j = 0; j < 4; ++j) {
          int e = seg * 16 + (lane >> 4) * 4 + j;
          st[e * 64 + d] = f2bf(acc[n][j] * ps);
        }
      }
    }
    __syncthreads();
  }
}

__device__ void phase_scan(CParams& p, int tid, int wr, int vb, int vg) {
  for (int it = vb; it < 128; it += vg) {
    int gidx = it * 256 + tid;
    int hs = gidx >> 11, rem = gidx & 2047, e = rem >> 5, dp = rem & 31;
    unsigned* stp = reinterpret_cast<unsigned*>(((bfu*)(p.ws + OFF_ST)) + (size_t)hs * NCH * 4096 + e * 64 + dp * 2);
    const float2* dcp = reinterpret_cast<const float2*>(((float*)(p.ws + OFF_dec)) + (size_t)hs * NCH * 64 + dp * 2);
    float s0 = 0.f, s1 = 0.f;
    for (int c0 = 0; c0 < NCH; c0 += 8) {
      unsigned kv[8];
      float2 dc[8];
#pragma unroll
      for (int i = 0; i < 8; ++i) {
        kv[i] = stp[(size_t)(c0 + i) * 2048];
        dc[i] = dcp[(c0 + i) * 32];
      }
#pragma unroll
      for (int i = 0; i < 8; ++i) {
        unsigned o = (unsigned)f2bf(s0) | ((unsigned)f2bf(s1) << 16);
        stp[(size_t)(c0 + i) * 2048] = o;
        s0 = s0 * dc[i].x + bf2f((bfu)(kv[i] & 0xffffu));
        s1 = s1 * dc[i].y + bf2f((bfu)(kv[i] >> 16));
      }
    }
  }
}

__device__ __forceinline__ void att_compute(const bfu* kS, const bfu* vS, const float* cS, const bfu* sQw,
                                            const float (&ct)[2], float (&l_run)[2], f32x4 (&O)[2][4],
                                            int kt, int qb, int r0, int w, int lr, int lq, int lg4) {
    f32x4 sc[2][4];
#pragma unroll
    for (int mi = 0; mi < 2; ++mi)
#pragma unroll
      for (int n = 0; n < 4; ++n) sc[mi][n] = (f32x4){0.f, 0.f, 0.f, 0.f};
#pragma unroll
    for (int ks = 0; ks < 2; ++ks) {
      bf16x8 aq0 = lds_frag(sQw, lr, ks * 32 + lq, LDP);
      bf16x8 aq1 = lds_frag(sQw, 16 + lr, ks * 32 + lq, LDP);
#pragma unroll
      for (int n = 0; n < 4; ++n) {
        bf16x8 kf = lds_frag(kS, n * 16 + lr, ks * 32 + lq, LDP);
        sc[0][n] = __builtin_amdgcn_mfma_f32_16x16x32_bf16(kf, aq0, sc[0][n], 0, 0, 0);
        sc[1][n] = __builtin_amdgcn_mfma_f32_16x16x32_bf16(kf, aq1, sc[1][n], 0, 0, 0);
      }
    }
    f32x4 csv[4];
#pragma unroll
    for (int n = 0; n < 4; ++n) csv[n] = *reinterpret_cast<const f32x4*>(cS + n * 16 + lg4);
    const bool diag = (kt >= 2 * qb);
    bf16x8 pf[2][2];
#pragma unroll
    for (int mi = 0; mi < 2; ++mi) {
      const int qrow = r0 + w * 32 + mi * 16 + lr;
      float ps = 0.f;
#pragma unroll
      for (int n = 0; n < 4; ++n)
#pragma unroll
        for (int j = 0; j < 4; ++j) {
          float v = (sc[mi][n][j] + ct[mi]) - csv[n][j];
          if (diag && (kt * 64 + n * 16 + lg4 + j > qrow)) v = -INFINITY;
          const float pv = __builtin_amdgcn_exp2f(v);
          sc[mi][n][j] = pv;
          ps += pv;
        }
      l_run[mi] += ps;
#pragma unroll
      for (int ks = 0; ks < 2; ++ks) {
        union { bf16x8 v; unsigned u[4]; } pk;
        pk.u[0] = pg8::cvt_pk_bf16(sc[mi][2 * ks][0], sc[mi][2 * ks][1]);
        pk.u[1] = pg8::cvt_pk_bf16(sc[mi][2 * ks][2], sc[mi][2 * ks][3]);
        pk.u[2] = pg8::cvt_pk_bf16(sc[mi][2 * ks + 1][0], sc[mi][2 * ks + 1][1]);
        pk.u[3] = pg8::cvt_pk_bf16(sc[mi][2 * ks + 1][2], sc[mi][2 * ks + 1][3]);
        pf[mi][ks] = pk.v;
      }
    }
#pragma unroll
    for (int ks = 0; ks < 2; ++ks) {
#pragma unroll
      for (int ef = 0; ef < 4; ++ef) {
        union { bf16x8 v; uint2 h2[2]; } vf;
        vf.h2[0] = *reinterpret_cast<const uint2*>(vS + (ef * 16 + lr) * LDP + ks * 32 + lg4);
        vf.h2[1] = *reinterpret_cast<const uint2*>(vS + (ef * 16 + lr) * LDP + ks * 32 + 16 + lg4);
#pragma unroll
        for (int mi = 0; mi < 2; ++mi)
          O[mi][ef] = __builtin_amdgcn_mfma_f32_16x16x32_bf16(vf.v, pf[mi][ks], O[mi][ef], 0, 0, 0);
      }
    }
}

__device__ void attn_item(CParams& p, int l, int qb, int h, bfu* smem, int tid, int half, unsigned char* smem_raw) {
  bfu* sK = smem;
  bfu* sV = smem + 2 * 64 * LDP;
  float* s_c = reinterpret_cast<float*>(smem + 4 * 64 * LDP);
  float* s_off = s_c + 128;
  const int lane = tid & 63, w = tid >> 6;
  const int lr = lane & 15, lq = (lane >> 4) * 8, lg4 = (lane >> 4) * 4;
  const int r0 = qb * 128;
  const float L2E = 1.44269504088896f;
  s_off[tid] = ((float*)(p.ws + OFF_foxtot))[h * NCH + tid];
  __syncthreads();
  float myoff = 0.f;
  for (int i = 0; i < tid; ++i) myoff += s_off[i];
  __syncthreads();
  s_off[tid] = myoff;
  float* s_misc = reinterpret_cast<float*>(smem + 28416);
  if (tid < 64) {
    float gq = fabsf(p.in[6][l * 64 + tid]), gk = fabsf(p.in[7][l * 64 + tid]);
#pragma unroll
    for (int m = 1; m < 64; m <<= 1) { gq = fmaxf(gq, __shfl_xor(gq, m, 64)); gk = fmaxf(gk, __shfl_xor(gk, m, 64)); }
    if (tid == 0) { s_misc[0] = 40.f + 2.f * 8.f * gq * gk * 1.01f; reinterpret_cast<int*>(s_misc)[1] = 2 * qb; s_misc[2] = 8.f * gq * gk * 1.01f * 1.44269504088896f; }
  }
  __syncthreads();
  {
    const float thr = s_misc[0];
    const float cref = s_off[2 * qb];
    if (tid < 2 * qb && s_off[tid + 1] <= cref + thr) atomicMin(reinterpret_cast<int*>(s_misc) + 1, tid);
  }
  __syncthreads();
  int kt_min = reinterpret_cast<int*>(s_misc)[1];
  const int nkt = 2 * qb + 2;
  if ((nkt - kt_min) & 1) kt_min -= 1;
  const bfu* Qg = ((bfu*)(p.ws + OFF_foxq)) + (size_t)h * S_LEN * 64;
  const bfu* Kg = ((bfu*)(p.ws + OFF_foxk)) + (size_t)h * S_LEN * 64;
  const bfu* Vg = ((bfu*)(p.ws + OFF_foxvT)) + (size_t)h * 64 * S_LEN;
  const float* Cg = ((float*)(p.ws + OFF_foxc)) + (size_t)h * S_LEN;
  bfu* sQ = smem + 4 * 64 * LDP + 768;
  {
#pragma unroll
    for (int i = 0; i < 4; ++i) {
      int id = tid + i * 256;
      int r = id >> 3, c = (id & 7) * 8;
      *reinterpret_cast<uint4*>(sQ + r * LDP + c) = *reinterpret_cast<const uint4*>(Qg + (size_t)(r0 + r) * 64 + c);
    }
  }
  const bfu* sQw = sQ + (w * 32) * LDP;
  float ct[2], l_run[2];
  const float lbound = s_misc[2];
  f32x4 O[2][4];
#pragma unroll
  for (int mi = 0; mi < 2; ++mi) {
    const int qrow = r0 + w * 32 + mi * 16 + lr;
    ct[mi] = (Cg[qrow] + s_off[qrow >> 6]) * L2E - lbound;
    l_run[mi] = 0.f;
#pragma unroll
    for (int n = 0; n < 4; ++n) O[mi][n] = (f32x4){0.f, 0.f, 0.f, 0.f};
  }
  const int nkh = (nkt - kt_min) >> 1;
  const int kt0 = kt_min + half * nkh;
  const int crow0 = tid >> 3, ccol = (tid & 7) * 8;
  uint4 rk0A, rk1A, rv0A, rv1A, rk0B, rk1B, rv0B, rv1B;
  float rcA = 0.f, rcB = 0.f;
  {
    const int k0 = kt0 * 64;
    rk0A = *reinterpret_cast<const uint4*>(Kg + (size_t)(k0 + crow0) * 64 + ccol);
    rk1A = *reinterpret_cast<const uint4*>(Kg + (size_t)(k0 + crow0 + 32) * 64 + ccol);
    rv0A = *reinterpret_cast<const uint4*>(Vg + (size_t)(crow0) * S_LEN + k0 + ccol);
    rv1A = *reinterpret_cast<const uint4*>(Vg + (size_t)(crow0 + 32) * S_LEN + k0 + ccol);
    if (tid < 64) rcA = (Cg[k0 + tid] + s_off[kt0]) * L2E;
  }
  *reinterpret_cast<uint4*>(sK + (crow0) * LDP + ccol) = rk0A;
  *reinterpret_cast<uint4*>(sK + (crow0 + 32) * LDP + ccol) = rk1A;
  *reinterpret_cast<uint4*>(sV + (crow0) * LDP + ccol) = rv0A;
  *reinterpret_cast<uint4*>(sV + (crow0 + 32) * LDP + ccol) = rv1A;
  if (tid < 64) s_c[tid] = rcA;
  rk0B = rk1B = rv0B = rv1B = rk0A;
  __syncthreads();
#define ATT_LOAD(S, KT)                                                                              \
  {                                                                                                  \
    const int k0_ = (KT) * 64;                                                                       \
    rk0##S = *reinterpret_cast<const uint4*>(Kg + (size_t)(k0_ + crow0) * 64 + ccol);                \
    rk1##S = *reinterpret_cast<const uint4*>(Kg + (size_t)(k0_ + crow0 + 32) * 64 + ccol);           \
    rv0##S = *reinterpret_cast<const uint4*>(Vg + (size_t)(crow0) * S_LEN + k0_ + ccol);             \
    rv1##S = *reinterpret_cast<const uint4*>(Vg + (size_t)(crow0 + 32) * S_LEN + k0_ + ccol);        \
    if (tid < 64) rc##S = (Cg[k0_ + tid] + s_off[(KT)]) * L2E;                                       \
  }
#define ATT_STORE(S, BUF)                                                                            \
  {                                                                                                  \
    bfu* kN_ = sK + (BUF) * 64 * LDP;                                                                \
    bfu* vN_ = sV + (BUF) * 64 * LDP;                                                                \
    *reinterpret_cast<uint4*>(kN_ + (crow0) * LDP + ccol) = rk0##S;                                  \
    *reinterpret_cast<uint4*>(kN_ + (crow0 + 32) * LDP + ccol) = rk1##S;                             \
    *reinterpret_cast<uint4*>(vN_ + (crow0) * LDP + ccol) = rv0##S;                                  \
    *reinterpret_cast<uint4*>(vN_ + (crow0 + 32) * LDP + ccol) = rv1##S;                             \
    if (tid < 64) s_c[(BUF) * 64 + tid] = rc##S;                                                     \
  }
  if (nkh > 1) ATT_LOAD(B, kt0 + 1);
  for (int it = 0; it < nkh; it += 2) {
    if (it + 2 < nkh) ATT_LOAD(A, kt0 + it + 2);
    att_compute(sK, sV, s_c, sQw, ct, l_run, O, kt0 + it, qb, r0, w, lr, lq, lg4);
    if (it + 1 < nkh) ATT_STORE(B, 1);
    __syncthreads();
    if (it + 1 >= nkh) break;
    if (it + 3 < nkh) ATT_LOAD(B, kt0 + it + 3);
    att_compute(sK + 64 * LDP, sV + 64 * LDP, s_c + 64, sQw, ct, l_run, O, kt0 + it + 1, qb, r0, w, lr, lq, lg4);
    if (it + 2 < nkh) ATT_STORE(A, 0);
    __syncthreads();
  }
#undef ATT_LOAD
#undef ATT_STORE
  float* xch = reinterpret_cast<float*>(smem_raw + SMEM_HALF);
  if (half == 1) {
#pragma unroll
    for (int mi = 0; mi < 2; ++mi) {
#pragma unroll
      for (int n = 0; n < 4; ++n)
#pragma unroll
        for (int j = 0; j < 4; ++j) xch[((mi * 4 + n) * 4 + j) * 256 + tid] = O[mi][n][j];
      xch[(32 + mi) * 256 + tid] = l_run[mi];
    }
  }
  __syncthreads();
  if (half == 0) {
#pragma unroll
    for (int mi = 0; mi < 2; ++mi) {
      float lsum = l_run[mi] + xch[(32 + mi) * 256 + tid];
      lsum += __shfl_xor(lsum, 16, 64);
      lsum += __shfl_xor(lsum, 32, 64);
      const float inv = 1.f / lsum;
      const int qrow = r0 + w * 32 + mi * 16 + lr;
      bfu* yp = ((bfu*)(p.ws + OFF_y)) + (size_t)qrow * YW + h * 64 + lg4;
#pragma unroll
      for (int n = 0; n < 4; ++n) {
        float o0 = (O[mi][n][0] + xch[((mi * 4 + n) * 4 + 0) * 256 + tid]) * inv;
        float o1 = (O[mi][n][1] + xch[((mi * 4 + n) * 4 + 1) * 256 + tid]) * inv;
        float o2 = (O[mi][n][2] + xch[((mi * 4 + n) * 4 + 2) * 256 + tid]) * inv;
        float o3 = (O[mi][n][3] + xch[((mi * 4 + n) * 4 + 3) * 256 + tid]) * inv;
        uint2 wv;
        wv.x = pg8::cvt_pk_bf16(o0, o1);
        wv.y = pg8::cvt_pk_bf16(o2, o3);
        *reinterpret_cast<uint2*>(yp + n * 16) = wv;
      }
    }
  }
  __syncthreads();
}

__device__ void chunk_out_item(CParams& p, int l, int c, int hs, bfu* smem, int tid) {
  bfu* sQ = smem;
  bfu* sKi = smem + 64 * LDP;
  bfu* sV = smem + 2 * 64 * LDP;
  bfu* sS = smem + 3 * 64 * LDP;
  bfu* sP = smem + 4 * 64 * LDP;
  float* s_cs = reinterpret_cast<float*>(smem + 5 * 64 * LDP);
  const int lane = tid & 63, w = tid >> 6;
  const int lr = lane & 15, lq = (lane >> 4) * 8, lg4 = (lane >> 4) * 4;
  const int tok0 = c * 64;
  const int tl = w * 16 + lr, tok = tok0 + tl;
  const bfu *Qp, *Kp;
  int qs;
  if (hs < 4) { Qp = ((bfu*)(p.ws + OFF_u)) + (size_t)tok0 * NU + 768 + hs * 64; Kp = ((bfu*)(p.ws + OFF_u)) + (size_t)tok0 * NU + 1024 + hs * 64; qs = NU; }
  else if (hs < 8) { Qp = ((bfu*)(p.ws + OFF_u)) + (size_t)tok0 * NU + 1792 + (hs - 4) * 64; Kp = ((bfu*)(p.ws + OFF_u)) + (size_t)tok0 * NU + 2048 + (hs - 4) * 64; qs = NU; }
  else { int g = (hs - 8) >> 2; Qp = ((bfu*)(p.ws + OFF_ssdC)) + ((size_t)g * S_LEN + tok0) * 64; Kp = ((bfu*)(p.ws + OFF_ssdB)) + ((size_t)g * S_LEN + tok0) * 64; qs = 64; }
  uint2 g4[4], x4[4];
  f32x4 gn[4];
  const int hh = (hs < 8) ? (hs & 3) : (hs - 8);
  {
    const int gcol = (hs < 4) ? (1536 + hh * 64) : (hs < 8 ? (2560 + hh * 64) : (2816 + hh * 64));
    const bfu* gp = ((bfu*)(p.ws + OFF_u)) + (size_t)tok * NU + gcol + lg4;
    const bfu* xp = ((bfu*)(p.ws + OFF_ssdX)) + (size_t)tok * 512 + hh * 64 + lg4;
    const float* gnp = (hs < 4 ? p.in[10] : p.in[11]) + l * 64 + lg4;
#pragma unroll
    for (int n = 0; n < 4; ++n) {
      g4[n] = *reinterpret_cast<const uint2*>(gp + n * 16);
      x4[n] = (hs >= 8) ? *reinterpret_cast<const uint2*>(xp + n * 16) : make_uint2(0u, 0u);
      gn[n] = (hs < 8) ? *reinterpret_cast<const f32x4*>(gnp + n * 16) : (f32x4){1.f, 1.f, 1.f, 1.f};
    }
  }
  load_tile64(sQ, Qp, qs, tid);
  load_tile64(sKi, Kp, qs, tid);
  load_tile64(sV, ((bfu*)(p.ws + OFF_VT)) + ((size_t)hs * NCH + c) * 4096, 64, tid);
  load_tile64(sS, ((bfu*)(p.ws + OFF_ST)) + ((size_t)hs * NCH + c) * 4096, 64, tid);
  if (tid < 64) s_cs[tid] = ((float*)(p.ws + OFF_csb))[hs * S_LEN + tok0 + tid];
  __syncthreads();
  const bf16x8 qf0 = lds_frag(sQ, tl, lq, LDP), qf1 = lds_frag(sQ, tl, 32 + lq, LDP);
  f32x4 sc[4], o[4];
#pragma unroll
  for (int n = 0; n < 4; ++n) {
    sc[n] = (f32x4){0.f, 0.f, 0.f, 0.f};
    o[n] = (f32x4){0.f, 0.f, 0.f, 0.f};
  }
#pragma unroll
  for (int n = 0; n < 4; ++n) {
    sc[n] = __builtin_amdgcn_mfma_f32_16x16x32_bf16(lds_frag(sKi, n * 16 + lr, lq, LDP), qf0, sc[n], 0, 0, 0);
    sc[n] = __builtin_amdgcn_mfma_f32_16x16x32_bf16(lds_frag(sKi, n * 16 + lr, 32 + lq, LDP), qf1, sc[n], 0, 0, 0);
    o[n] = __builtin_amdgcn_mfma_f32_16x16x32_bf16(lds_frag(sS, n * 16 + lr, lq, LDP), qf0, o[n], 0, 0, 0);
    o[n] = __builtin_amdgcn_mfma_f32_16x16x32_bf16(lds_frag(sS, n * 16 + lr, 32 + lq, LDP), qf1, o[n], 0, 0, 0);
  }
  const float cst = s_cs[tl];
  const float rsc = __expf(cst);
#pragma unroll
  for (int n = 0; n < 4; ++n) {
    const f32x4 css = *reinterpret_cast<const f32x4*>(s_cs + n * 16 + lg4);
    float pv[4];
#pragma unroll
    for (int j = 0; j < 4; ++j) {
      const int s = n * 16 + lg4 + j;
      pv[j] = (s <= tl) ? sc[n][j] * __expf(cst - css[j]) : 0.f;
      o[n][j] *= rsc;
    }
    uint2 wv;
    wv.x = pg8::cvt_pk_bf16(pv[0], pv[1]);
    wv.y = pg8::cvt_pk_bf16(pv[2], pv[3]);
    *reinterpret_cast<uint2*>(sP + tl * LDP + n * 16 + lg4) = wv;
  }
  __syncthreads();
  {
    const bf16x8 pf0 = lds_frag(sP, tl, lq, LDP), pf1 = lds_frag(sP, tl, 32 + lq, LDP);
#pragma unroll
    for (int n = 0; n < 4; ++n) {
      o[n] = __builtin_amdgcn_mfma_f32_16x16x32_bf16(lds_frag(sV, n * 16 + lr, lq, LDP), pf0, o[n], 0, 0, 0);
      o[n] = __builtin_amdgcn_mfma_f32_16x16x32_bf16(lds_frag(sV, n * 16 + lr, 32 + lq, LDP), pf1, o[n], 0, 0, 0);
    }
  }
  float ss = 0.f;
  if (hs < 8) {
#pragma unroll
    for (int n = 0; n < 4; ++n) ss += (o[n][0] * o[n][0] + o[n][1] * o[n][1]) + (o[n][2] * o[n][2] + o[n][3] * o[n][3]);
    ss += __shfl_xor(ss, 16, 64);
    ss += __shfl_xor(ss, 32, 64);
    const float rstd = rsqrtf(ss * (1.f / 64.f) + EPS);
    bfu* yp = ((bfu*)(p.ws + OFF_y)) + (size_t)tok * YW + (hs < 4 ? 256 : 512) + hh * 64 + lg4;
#pragma unroll
    for (int n = 0; n < 4; ++n) {
      const float t0 = __uint_as_float(g4[n].x << 16), t1 = __uint_as_float(g4[n].x & 0xffff0000u);
      const float t2 = __uint_as_float(g4[n].y << 16), t3 = __uint_as_float(g4[n].y & 0xffff0000u);
      uint2 wv;
      wv.x = pg8::cvt_pk_bf16(o[n][0] * rstd * gn[n][0] * siluf_(t0), o[n][1] * rstd * gn[n][1] * siluf_(t1));
      wv.y = pg8::cvt_pk_bf16(o[n][2] * rstd * gn[n][2] * siluf_(t2), o[n][3] * rstd * gn[n][3] * siluf_(t3));
      *reinterpret_cast<uint2*>(yp + n * 16) = wv;
    }
  } else {
    const float dsk = p.in[16][l * 8 + hh];
    bfu* yp = ((bfu*)(p.ws + OFF_y)) + (size_t)tok * YW + 768 + hh * 64 + lg4;
#pragma unroll
    for (int n = 0; n < 4; ++n) {
      const float z0 = __uint_as_float(g4[n].x << 16), z1 = __uint_as_float(g4[n].x & 0xffff0000u);
      const float z2 = __uint_as_float(g4[n].y << 16), z3 = __uint_as_float(g4[n].y & 0xffff0000u);
      const float a0 = __uint_as_float(x4[n].x << 16), a1 = __uint_as_float(x4[n].x & 0xffff0000u);
      const float a2 = __uint_as_float(x4[n].y << 16), a3 = __uint_as_float(x4[n].y & 0xffff0000u);
      const float y0 = (o[n][0] + dsk * a0) * siluf_(z0), y1 = (o[n][1] + dsk * a1) * siluf_(z1);
      const float y2 = (o[n][2] + dsk * a2) * siluf_(z2), y3 = (o[n][3] + dsk * a3) * siluf_(z3);
      ss += (y0 * y0 + y1 * y1) + (y2 * y2 + y3 * y3);
      uint2 wv;
      wv.x = pg8::cvt_pk_bf16(y0, y1);
      wv.y = pg8::cvt_pk_bf16(y2, y3);
      *reinterpret_cast<uint2*>(yp + n * 16) = wv;
    }
    ss += __shfl_xor(ss, 16, 64);
    ss += __shfl_xor(ss, 32, 64);
    if (lg4 == 0) ((float*)(p.ws + OFF_ssq))[tok * 8 + hh] = ss;
  }
  __syncthreads();
}

__device__ void phase_mix(CParams& p_o, int l, bfu* smem, int tid, int half, int cidx, unsigned char* smem_raw) {
  __shared__ int s_item;
  const int total = 512 + NCH * 8;
  while (true) {
    __syncthreads();
    if (threadIdx.x == 0) s_item = (int)atomicAdd(&((unsigned*)(p_o.ws + OFF_ctr))[cidx], 1u);
    __syncthreads();
    const int it = s_item;
    if (it >= total) break;
    CParams* pp_ = &p_o;
    asm volatile("" : "+s"(pp_));
    CParams& p = *pp_;
    if (it < 512) {
      int qb = 127 - (it >> 2), h = it & 3;
      attn_item(p, l, qb, h, smem, tid, half, smem_raw);
    } else {
      int j = (it - 512) * 2 + half;
      chunk_out_item(p, l, j >> 4, j & 15, smem, tid);
    }
  }
}

__device__ void phase_upmerge(CParams& p, bfu* smem, int tid, int vb, int vg) {
  bfu* sA = smem;
  bfu* sB = smem + 2 * 128 * LDP;
  float* s_rs = reinterpret_cast<float*>(smem + 2 * 128 * LDP + 2 * 64 * LDP);
  const int lane = tid & 63, w = tid >> 6, wm = w >> 1, wn = w & 1;
  const int lr = lane & 15, lq = (lane >> 4) * 8, lg4 = (lane >> 4) * 4;
  const int crow = tid >> 3, ccol = (tid & 7) * 8;
  for (int it = vb; it < 128 * 16; it += vg) {
    const int mt = it >> 4, nt = it & 15;
    const bfu* Ap = ((bfu*)(p.ws + OFF_y)) + (size_t)(mt * 128 + crow) * YW + ccol;
    const bfu* Bp = ((bfu*)(p.ws + OFF_WupT)) + (size_t)(nt * 64 + crow) * YW + ccol;
    const bfu* Gp = ((bfu*)(p.ws + OFF_u)) + (size_t)(mt * 128 + wm * 64 + lr) * NU + 4096 + nt * 64 + wn * 32 + lg4;
    {
      const int row = tid >> 1, g = tid & 1;
      const float4 q4 = *reinterpret_cast<const float4*>(((float*)(p.ws + OFF_ssq)) + (mt * 128 + row) * 8 + g * 4);
      s_rs[g * 128 + row] = rsqrtf((q4.x + q4.y + q4.z + q4.w) * (1.f / 256.f) + EPS);
    }
    uint4 a0_0, a0_1, a0_2, a0_3, b0_0, b0_1, a1_0, a1_1, a1_2, a1_3, b1_0, b1_1;
#define U_LOAD(S, KT)                                                                \
  {                                                                                  \
    const int ko_ = (KT) * 64;                                                       \
    a##S##_0 = *reinterpret_cast<const uint4*>(Ap + (size_t)0 * 32 * YW + ko_);      \
    a##S##_1 = *reinterpret_cast<const uint4*>(Ap + (size_t)1 * 32 * YW + ko_);      \
    a##S##_2 = *reinterpret_cast<const uint4*>(Ap + (size_t)2 * 32 * YW + ko_);      \
    a##S##_3 = *reinterpret_cast<const uint4*>(Ap + (size_t)3 * 32 * YW + ko_);      \
    b##S##_0 = *reinterpret_cast<const uint4*>(Bp + (size_t)0 * 32 * YW + ko_);      \
    b##S##_1 = *reinterpret_cast<const uint4*>(Bp + (size_t)1 * 32 * YW + ko_);      \
  }
#define U_STORE(S, BUF)                                                              \
  {                                                                                  \
    bfu* sAn_ = sA + (BUF) * 128 * LDP + crow * LDP + ccol;                          \
    bfu* sBn_ = sB + (BUF) * 64 * LDP + crow * LDP + ccol;                           \
    *reinterpret_cast<uint4*>(sAn_ + 0 * 32 * LDP) = a##S##_0;                       \
    *reinterpret_cast<uint4*>(sAn_ + 1 * 32 * LDP) = a##S##_1;                       \
    *reinterpret_cast<uint4*>(sAn_ + 2 * 32 * LDP) = a##S##_2;                       \
    *reinterpret_cast<uint4*>(sAn_ + 3 * 32 * LDP) = a##S##_3;                       \
    *reinterpret_cast<uint4*>(sBn_ + 0 * 32 * LDP) = b##S##_0;                       \
    *reinterpret_cast<uint4*>(sBn_ + 1 * 32 * LDP) = b##S##_1;                       \
  }
#define U_COMPUTE(BUF)                                                               \
  {                                                                                  \
    const bfu* a_s = sA + (BUF) * 128 * LDP + (wm * 64) * LDP;                       \
    const bfu* b_s = sB + (BUF) * 64 * LDP + (wn * 32) * LDP;                        \
    _Pragma("unroll") for (int ks = 0; ks < 2; ++ks) {                               \
      bf16x8 af0 = lds_frag(a_s, 0 * 16 + lr, ks * 32 + lq, LDP);                    \
      bf16x8 af1 = lds_frag(a_s, 1 * 16 + lr, ks * 32 + lq, LDP);                    \
      bf16x8 af2 = lds_frag(a_s, 2 * 16 + lr, ks * 32 + lq, LDP);                    \
      bf16x8 af3 = lds_frag(a_s, 3 * 16 + lr, ks * 32 + lq, LDP);                    \
      _Pragma("unroll") for (int ni = 0; ni < 2; ++ni) {                             \
        bf16x8 bf_ = lds_frag(b_s, ni * 16 + lr, ks * 32 + lq, LDP);                 \
        acc[0][ni] = __builtin_amdgcn_mfma_f32_16x16x32_bf16(bf_, af0, acc[0][ni], 0, 0, 0); \
        acc[1][ni] = __builtin_amdgcn_mfma_f32_16x16x32_bf16(bf_, af1, acc[1][ni], 0, 0, 0); \
        acc[2][ni] = __builtin_amdgcn_mfma_f32_16x16x32_bf16(bf_, af2, acc[2][ni], 0, 0, 0); \
        acc[3][ni] = __builtin_amdgcn_mfma_f32_16x16x32_bf16(bf_, af3, acc[3][ni], 0, 0, 0); \
      }                                                                              \
    }                                                                                \
  }
    f32x4 acc[4][2], tot[4][2];
    zero_acc<2>(acc);
    zero_acc<2>(tot);
    uint2 gt[4][2];
    U_LOAD(0, 0);
    U_LOAD(1, 1);
    U_STORE(0, 0);
    __syncthreads();
#pragma unroll 1
    for (int kt = 0; kt < 20; kt += 2) {
      if ((kt & 3) == 0) {
        const int br = kt >> 2, gb = br < 3 ? br : 3;
#pragma unroll
        for (int mi = 0; mi < 4; ++mi)
#pragma unroll
          for (int ni = 0; ni < 2; ++ni)
            gt[mi][ni] = *reinterpret_cast<const uint2*>(Gp + (size_t)(mi * 16) * NU + gb * 1024 + ni * 16);
      }
      if (kt + 2 < 20) U_LOAD(0, kt + 2);
      U_COMPUTE(0);
      U_STORE(1, 1);
      __syncthreads();
      if (kt + 3 < 20) U_LOAD(1, kt + 3);
      U_COMPUTE(1);
      if (kt + 2 < 20) U_STORE(0, 0);
      if ((kt & 3) == 2) {
        const int br = kt >> 2;
#pragma unroll
        for (int mi = 0; mi < 4; ++mi) {
          float rsc = 1.f;
          if (br >= 3) rsc = s_rs[(br - 3) * 128 + wm * 64 + mi * 16 + lr];
#pragma unroll
          for (int ni = 0; ni < 2; ++ni) {
            const uint2 g2 = gt[mi][ni];
            tot[mi][ni][0] += acc[mi][ni][0] * (__uint_as_float(g2.x << 16) * rsc);
            tot[mi][ni][1] += acc[mi][ni][1] * (__uint_as_float(g2.x & 0xffff0000u) * rsc);
            tot[mi][ni][2] += acc[mi][ni][2] * (__uint_as_float(g2.y << 16) * rsc);
            tot[mi][ni][3] += acc[mi][ni][3] * (__uint_as_float(g2.y & 0xffff0000u) * rsc);
            acc[mi][ni] = (f32x4){0.f, 0.f, 0.f, 0.f};
          }
        }
      }
      __syncthreads();
    }
#undef U_LOAD
#undef U_STORE
#undef U_COMPUTE
    bfu* Hp = ((bfu*)(p.ws + OFF_h)) + (size_t)(mt * 128 + wm * 64 + lr) * DM + nt * 64 + wn * 32 + lg4;
#pragma unroll
    for (int mi = 0; mi < 4; ++mi)
#pragma unroll
      for (int ni = 0; ni < 2; ++ni) {
        uint2 wv;
        wv.x = pg8::cvt_pk_bf16(tot[mi][ni][0], tot[mi][ni][1]);
        wv.y = pg8::cvt_pk_bf16(tot[mi][ni][2], tot[mi][ni][3]);
        *reinterpret_cast<uint2*>(Hp + (size_t)(mi * 16) * DM + ni * 16) = wv;
      }
  }
}

namespace pg8 {
#define PG8_LAS __attribute__((address_space(3)))
typedef unsigned short bf16_t;
typedef short bf16x8 __attribute__((ext_vector_type(8)));
typedef float f32x4 __attribute__((ext_vector_type(4)));
typedef unsigned u32x4 __attribute__((ext_vector_type(4)));
typedef unsigned u32x2 __attribute__((ext_vector_type(2)));
constexpr int BM = 256, BK = 64, HALF = 128, HTB = HALF * BK * 2, STAGE_BYTES = 8 * HTB, NXCD = 8, WGM = 8;
__device__ __forceinline__ int lds_byte(int r, int c) { const int st = (r >> 4) * 2 + (c >> 5), rr = r & 15, cc = c & 31, ob = rr * 64 + cc * 2; return st * 1024 + (ob ^ (((ob >> 9) & 1) << 5)); }
__device__ __forceinline__ void stage_rc(int b, int& R, int& C) { const int st = b / 1024, sb = b % 1024, swz = sb ^ (((sb >> 9) & 1) << 5); R = (st >> 1) * 16 + swz / 64; C = (st & 1) * 32 + (swz % 64) / 2; }
__device__ __forceinline__ int perm32(int rho) { const int n = rho >> 4, i = rho & 15; return 8 * (i >> 2) + 4 * n + (i & 3); }
struct Unit { int pm, pn; };
struct Gemm { const bf16_t* A; const bf16_t* Bt; int M, N, K; };
struct StaticOrder {
    int nM, nN, nwg, G, c;
    __device__ void init(int M, int N, int G_, int c_) { nM = M / BM; nN = N / BM; nwg = nM * nN; G = G_; c = c_; }
    __device__ bool next(int i, Unit& u) const {
        const long L = (long)i * G + c; if (L >= nwg) return false;
        int wgid = (int)L; { const int q = nwg / NXCD, r = nwg % NXCD, xcd = wgid % NXCD, off = wgid / NXCD; wgid = (xcd < r ? xcd * (q + 1) : r * (q + 1) + (xcd - r) * q) + off; }
        const int nig = WGM * nN, gid = wgid / nig, fm = gid * WGM, gsz = (nM - fm) < WGM ? (nM - fm) : WGM;
        u.pm = fm + ((wgid % nig) % gsz); u.pn = (wgid % nig) / gsz; return true;
    }
    __device__ __forceinline__ void a_ready(const Unit&) const {}
    __device__ __forceinline__ void done(const Unit&) const {}
};
__device__ __forceinline__ unsigned cvt_pk_bf16(float lo, float hi) { unsigned r; asm volatile("v_cvt_pk_bf16_f32 %0, %1, %2" : "=v"(r) : "v"(lo), "v"(hi)); return r; }

template <class Epi, class Sched>
__device__ __forceinline__ void gemm_phase(PG8_LAS unsigned char* lds, const Gemm g, const Sched& S, const Epi& E) {
    const int tid = threadIdx.x, wid = __builtin_amdgcn_readfirstlane(tid >> 6), lane = tid & 63, wr = wid >> 2, wc = wid & 3, fr = lane & 15, fq = lane >> 4;
    const int K = g.K, nt = K / BK;
    unsigned voffA[2], voffB[2];
#pragma unroll
    for (int i = 0; i < 2; ++i) { int R, C; stage_rc(tid * 16 + i * 8192, R, C); const int Rb = Epi::PERM ? ((R & ~31) + perm32(R & 31)) : R;
        voffA[i] = (unsigned)(R * K + C) * 2u; voffB[i] = (unsigned)(Rb * K + C) * 2u; }
    const size_t kstep = (size_t)(BK * 2);
    const size_t hstep = (size_t)HALF * K * 2;
    const size_t tstep = 2 * hstep;
    const unsigned ldsw = (unsigned)wid * 1024u;
    const int aoff = lds_byte(wr * 64 + fr, fq * 8), boff = lds_byte(wc * 32 + fr, fq * 8);
#define PG8_SA(b, h) (((b) * 2 + (h)) * HTB)
#define PG8_SB(b, h) ((4 + (b) * 2 + (h)) * HTB)
#define PG8_STAGE(bufoff, gbase, voff) do { _Pragma("unroll") for (int _i = 0; _i < 2; ++_i) \
        __builtin_amdgcn_global_load_lds((const unsigned*)((const char*)(gbase) + (voff)[_i]), (PG8_LAS unsigned*)(lds + (bufoff) + ldsw + _i * 8192), 16, 0, 0); } while (0)
#define PG8_LDA(dst, b, h) do { _Pragma("unroll") for (int m = 0; m < 4; ++m) _Pragma("unroll") for (int k = 0; k < 2; ++k) dst[m][k] = *(const PG8_LAS bf16x8*)(lds + PG8_SA(b, h) + aoff + m * 2048 + k * 1024); } while (0)
#define PG8_LDB(dst, b, h) do { _Pragma("unroll") for (int n = 0; n < 2; ++n) _Pragma("unroll") for (int k = 0; k < 2; ++k) dst[n][k] = *(const PG8_LAS bf16x8*)(lds + PG8_SB(b, h) + boff + n * 2048 + k * 1024); } while (0)
#define PG8_MMA(ai, bj, At, Bt) do { __builtin_amdgcn_s_setprio(1); _Pragma("unroll") for (int m = 0; m < 4; ++m) _Pragma("unroll") for (int n = 0; n < 2; ++n) _Pragma("unroll") for (int k = 0; k < 2; ++k) \
        acc[ai][bj][m][n] = __builtin_amdgcn_mfma_f32_16x16x32_bf16(Bt[n][k], At[m][k], acc[ai][bj][m][n], 0, 0, 0); __builtin_amdgcn_s_setprio(0); } while (0)
#define PG8_WAIT_V(n) asm volatile("s_waitcnt vmcnt(" #n ")" ::: "memory")
#define PG8_WAIT_L(n) asm volatile("s_waitcnt lgkmcnt(" #n ")" ::: "memory")
#define PG8_BAR __builtin_amdgcn_s_barrier()
#define PG8_SCHED __builtin_amdgcn_sched_barrier(0)
    Unit cur, nxt; int ui = 0;
    if (!S.next(0, cur)) return;
    f32x4 acc[2][2][4][2];
#pragma unroll
    for (int a = 0; a < 2; ++a)
#pragma unroll
        for (int b = 0; b < 2; ++b)
#pragma unroll
            for (int m = 0; m < 4; ++m)
#pragma unroll
                for (int n = 0; n < 2; ++n) acc[a][b][m][n] = (f32x4){0.f, 0.f, 0.f, 0.f};
    bf16x8 At[4][2], B0[2][2], B1[2][2];
    const char* cA = (const char*)g.A + (size_t)cur.pm * tstep; const char* cB = (const char*)g.Bt + (size_t)cur.pn * tstep;
    S.a_ready(cur);
    PG8_STAGE(PG8_SB(0, 0), cB, voffB); PG8_STAGE(PG8_SA(0, 0), cA, voffA); PG8_STAGE(PG8_SB(0, 1), cB + hstep, voffB); PG8_STAGE(PG8_SA(0, 1), cA + hstep, voffA);
    if (wr == 1) PG8_BAR;
    PG8_WAIT_V(4); PG8_BAR;
    PG8_STAGE(PG8_SB(1, 0), cB + kstep, voffB); PG8_STAGE(PG8_SA(1, 0), cA + kstep, voffA); PG8_STAGE(PG8_SB(1, 1), cB + hstep + kstep, voffB);
    PG8_WAIT_V(6); PG8_BAR;
    for (;;) {
        const bool has_next = S.next(ui + 1, nxt);
        const char* nA = has_next ? (const char*)g.A + (size_t)nxt.pm * tstep : cA; const char* nB = has_next ? (const char*)g.Bt + (size_t)nxt.pn * tstep : cB;
        for (int t = 0; t < nt; t += 2) {
            const bool last = (t == nt - 2);
            const char* a1 = cA + (size_t)(t + 1) * kstep;
            const char* a2 = last ? nA : cA + (size_t)(t + 2) * kstep; const char* b2 = last ? nB : cB + (size_t)(t + 2) * kstep;
            const char* a3 = a2 + kstep; const char* b3 = b2 + kstep;
            if (last && has_next) S.a_ready(nxt);
            PG8_LDB(B0, 0, 0); PG8_SCHED; PG8_LDA(At, 0, 0); PG8_STAGE(PG8_SA(1, 1), a1 + hstep, voffA);
            PG8_WAIT_L(8); PG8_BAR; PG8_WAIT_L(0); PG8_MMA(0, 0, At, B0); PG8_BAR; PG8_SCHED;
            PG8_LDB(B1, 0, 1); PG8_STAGE(PG8_SB(0, 0), b2, voffB);
            PG8_BAR; PG8_WAIT_L(0); PG8_MMA(0, 1, At, B1); PG8_BAR;
            PG8_LDA(At, 0, 1); PG8_STAGE(PG8_SA(0, 0), a2, voffA);
            PG8_BAR; PG8_WAIT_L(0); PG8_MMA(1, 0, At, B0); PG8_BAR; PG8_SCHED;
            PG8_STAGE(PG8_SB(0, 1), b2 + hstep, voffB);
            PG8_WAIT_V(6); PG8_BAR; PG8_MMA(1, 1, At, B1); PG8_BAR;
            PG8_LDB(B0, 1, 0); PG8_SCHED; PG8_LDA(At, 1, 0); PG8_STAGE(PG8_SA(0, 1), a2 + hstep, voffA);
            PG8_WAIT_L(8); PG8_BAR; PG8_WAIT_L(0); PG8_MMA(0, 0, At, B0); PG8_BAR; PG8_SCHED;
            PG8_LDB(B1, 1, 1); PG8_STAGE(PG8_SB(1, 0), b3, voffB);
            PG8_BAR; PG8_WAIT_L(0); PG8_MMA(0, 1, At, B1); PG8_BAR;
            PG8_LDA(At, 1, 1); PG8_STAGE(PG8_SA(1, 0), a3, voffA);
            PG8_BAR; PG8_WAIT_L(0); PG8_MMA(1, 0, At, B0); PG8_BAR; PG8_SCHED;
            PG8_STAGE(PG8_SB(1, 1), b3 + hstep, voffB);
            PG8_WAIT_V(6); PG8_BAR; PG8_MMA(1, 1, At, B1); PG8_BAR;
        }
            if constexpr (!Epi::AFTER_DRAIN) { E(acc, cur, wr, wc, fr, fq); S.done(cur); }
            if (!has_next) break;
#pragma unroll
        for (int a = 0; a < 2; ++a)
#pragma unroll
            for (int b = 0; b < 2; ++b)
#pragma unroll
                for (int m = 0; m < 4; ++m)
#pragma unroll
                    for (int n = 0; n < 2; ++n) acc[a][b][m][n] = (f32x4){0.f, 0.f, 0.f, 0.f};
        cur = nxt; cA = nA; cB = nB; ++ui;
    }
    PG8_WAIT_V(0);
    if (wr == 0) PG8_BAR;
    PG8_BAR;
    if constexpr (Epi::AFTER_DRAIN) { E.fused(acc, cur, wr, wc, fr, fq, lds, wid, lane); S.done(cur); }
#undef PG8_SA
#undef PG8_SB
#undef PG8_STAGE
#undef PG8_LDA
#undef PG8_LDB
#undef PG8_MMA
#undef PG8_WAIT_V
#undef PG8_WAIT_L
#undef PG8_BAR
#undef PG8_SCHED
}

}

struct EpiInproj {
  static constexpr bool PERM = true, AFTER_DRAIN = false;
  bfu* u; float* small;
  __device__ __forceinline__ void operator()(const pg8::f32x4 (&acc)[2][2][4][2], const pg8::Unit& un, int wr, int wc, int fr, int fq) const {
    const int row0 = un.pm * 256 + wr * 64 + fr;
    if (un.pn < 32) {
      const bool sig = un.pn >= 16;
      const int col0 = un.pn * 256 + wc * 32 + 8 * fq;
#pragma unroll
      for (int ai = 0; ai < 2; ++ai)
#pragma unroll
        for (int m = 0; m < 4; ++m) {
          bfu* rowp = u + (size_t)(row0 + ai * 128 + m * 16) * NU + col0;
#pragma unroll
          for (int bj = 0; bj < 2; ++bj) {
            pg8::f32x4 v0 = acc[ai][bj][m][0], v1 = acc[ai][bj][m][1];
            if (sig) {
#pragma unroll
              for (int j = 0; j < 4; ++j) { v0[j] = sigmoidf_(v0[j]); v1[j] = sigmoidf_(v1[j]); }
            }
            pg8::u32x4 w;
            w.x = pg8::cvt_pk_bf16(v0[0], v0[1]); w.y = pg8::cvt_pk_bf16(v0[2], v0[3]);
            w.z = pg8::cvt_pk_bf16(v1[0], v1[1]); w.w = pg8::cvt_pk_bf16(v1[2], v1[3]);
            *(pg8::u32x4*)(rowp + bj * 128) = w;
          }
        }
    } else if (wc == 0) {
#pragma unroll
      for (int ai = 0; ai < 2; ++ai)
#pragma unroll
        for (int m = 0; m < 4; ++m) {
          float* sp = small + (size_t)(row0 + ai * 128 + m * 16) * 32 + 8 * fq;
          *(pg8::f32x4*)(sp) = acc[ai][0][m][0];
          *(pg8::f32x4*)(sp + 4) = acc[ai][0][m][1];
        }
    }
  }
};
struct EpiResid {
  static constexpr bool PERM = false, AFTER_DRAIN = false;
  const float* xold; float* out;
  __device__ __forceinline__ void operator()(const pg8::f32x4 (&acc)[2][2][4][2], const pg8::Unit& un, int wr, int wc, int fr, int fq) const {
    const int row0 = un.pm * 256 + wr * 64 + fr, col0 = un.pn * 256 + wc * 32 + 4 * fq;
#pragma unroll
    for (int ai = 0; ai < 2; ++ai)
#pragma unroll
      for (int m = 0; m < 4; ++m) {
        const size_t off = (size_t)(row0 + ai * 128 + m * 16) * DM + col0;
#pragma unroll
        for (int bj = 0; bj < 2; ++bj)
#pragma unroll
          for (int n = 0; n < 2; ++n) {
            const pg8::f32x4 b = *(const pg8::f32x4*)(xold + off + bj * 128 + n * 16);
            *(pg8::f32x4*)(out + off + bj * 128 + n * 16) = b + acc[ai][bj][m][n];
          }
        asm volatile("" ::: "memory");
      }
  }
};
struct EpiSwiglu {
  static constexpr bool PERM = true, AFTER_DRAIN = false;
  bfu* hidden;
  __device__ __forceinline__ void operator()(const pg8::f32x4 (&acc)[2][2][4][2], const pg8::Unit& un, int wr, int wc, int fr, int fq) const {
    const int row0 = un.pm * 256 + wr * 64 + fr;
#pragma unroll
    for (int ai = 0; ai < 2; ++ai)
#pragma unroll
      for (int m = 0; m < 4; ++m) {
        bfu* rowp = hidden + (size_t)(row0 + ai * 128 + m * 16) * FH + (un.pn * 8 + wc) * 16 + 4 * fq;
#pragma unroll
        for (int bj = 0; bj < 2; ++bj) {
          const pg8::f32x4 g = acc[ai][bj][m][0], uu = acc[ai][bj][m][1];
          pg8::u32x2 w;
          w.x = pg8::cvt_pk_bf16(siluf_(g[0]) * uu[0], siluf_(g[1]) * uu[1]);
          w.y = pg8::cvt_pk_bf16(siluf_(g[2]) * uu[2], siluf_(g[3]) * uu[3]);
          *(pg8::u32x2*)(rowp + bj * 64) = w;
        }
      }
  }
};

__device__ __forceinline__ void grid_barrier(unsigned* ctr, unsigned target) {
  asm volatile("s_waitcnt vmcnt(0)" ::: "memory");
  __syncthreads();
  if (threadIdx.x == 0) {
    __builtin_amdgcn_fence(__ATOMIC_RELEASE, "agent");
    asm volatile("s_waitcnt vmcnt(0)" ::: "memory");
    __hip_atomic_fetch_add(ctr, 1u, __ATOMIC_RELAXED, __HIP_MEMORY_SCOPE_AGENT);
    while (__hip_atomic_load(ctr, __ATOMIC_RELAXED, __HIP_MEMORY_SCOPE_AGENT) < target) __builtin_amdgcn_s_sleep(1);
    __builtin_amdgcn_fence(__ATOMIC_ACQUIRE, "agent");
    asm volatile("s_waitcnt vmcnt(0)" ::: "memory");
  }
  __syncthreads();
}

__global__ void __launch_bounds__(NTHREADS, 2) mega(Params p_in, int ph_lo, int ph_hi, int use_cg) {
  extern __shared__ __attribute__((aligned(16))) unsigned char smem_raw[];
  unsigned nbar = 0;
  for (int ph = ph_lo; ph < ph_hi; ++ph) {
#if PROBE_DUP >= 0
    const int l = ph / (PH_PER_LAYER + 1);
    const int ks = ph - l * (PH_PER_LAYER + 1);
    const int k = (ks <= PROBE_DUP) ? ks : ks - 1;
    const int wr = (ks == PROBE_DUP) ? 0 : 1;
#else
    const int wr = 1;
    const int l = ph / PH_PER_LAYER, k = ph - l * PH_PER_LAYER;
#endif
    int t512 = threadIdx.x;
    asm volatile("" : "+v"(t512));
    const int tid = t512 & 255;
    const int half = __builtin_amdgcn_readfirstlane(t512 >> 8);
    const int vb = blockIdx.x * 2 + half, vg = gridDim.x * 2;
    bfu* smem = reinterpret_cast<bfu*>(smem_raw + half * SMEM_HALF);
    CParams* pp = (CParams*)__builtin_amdgcn_kernarg_segment_ptr();
    asm volatile("" : "+s"(pp));
    CParams& p = *pp;
    switch (k) {
      case 0: phase_convert_norm(p, l, smem, tid, vb, vg); break;
      case 1: {
        pg8::Gemm g; g.A = (bfu*)(p.ws + OFF_h); g.Bt = (bfu*)(p.ws + OFF_WinT); g.M = S_LEN; g.N = NINP; g.K = DM;
        pg8::StaticOrder so; so.init(S_LEN, NINP, gridDim.x, blockIdx.x);
        EpiInproj e; e.u = (bfu*)(p.ws + OFF_u); e.small = (float*)(p.ws + OFF_small);
        pg8::gemm_phase<EpiInproj, pg8::StaticOrder>((PG8_LAS unsigned char*)smem_raw, g, so, e);
      } break;
      case 2: phase_prep(p, l, smem, tid, wr, vb, vg); break;
      case 3: phase_scan(p, tid, wr, vb, vg); break;
      case 4: phase_mix(p, l, smem, tid, half, ph, smem_raw); break;
      case 5: phase_upmerge(p, smem, tid, vb, vg); break;
      case 6: {
        pg8::Gemm g; g.A = (bfu*)(p.ws + OFF_h); g.Bt = (bfu*)(p.ws + OFF_WoutT); g.M = S_LEN; g.N = DM; g.K = DM;
        pg8::StaticOrder so; so.init(S_LEN, DM, gridDim.x, blockIdx.x);
        EpiResid e; e.xold = (l == 0 ? p.in[0] : p.out); e.out = p.out;
        pg8::gemm_phase<EpiResid, pg8::StaticOrder>((PG8_LAS unsigned char*)smem_raw, g, so, e);
      } break;
      case 7: phase_norm2(p, l, tid, vb, vg); break;
      case 8: {
        pg8::Gemm g; g.A = (bfu*)(p.ws + OFF_h); g.Bt = (bfu*)(p.ws + OFF_WfiT); g.M = S_LEN; g.N = 2 * FH; g.K = DM;
        pg8::StaticOrder so; so.init(S_LEN, 2 * FH, gridDim.x, blockIdx.x);
        EpiSwiglu e; e.hidden = (bfu*)(p.ws + OFF_u);
        pg8::gemm_phase<EpiSwiglu, pg8::StaticOrder>((PG8_LAS unsigned char*)smem_raw, g, so, e);
      } break;
      default: {
        pg8::Gemm g; g.A = (bfu*)(p.ws + OFF_u); g.Bt = (bfu*)(p.ws + OFF_WfoT); g.M = S_LEN; g.N = DM; g.K = FH;
        pg8::StaticOrder so; so.init(S_LEN, DM, gridDim.x, blockIdx.x);
        EpiResid e; e.xold = p.out; e.out = p.out;
        pg8::gemm_phase<EpiResid, pg8::StaticOrder>((PG8_LAS unsigned char*)smem_raw, g, so, e);
      } break;
    }
    if (ph + 1 < ph_hi) {
      if (use_cg) cg::this_grid().sync();
      else { ++nbar; grid_barrier((unsigned*)(p_in.ws + OFF_bar), nbar * gridDim.x); }
    }
  }
}

#ifndef MK_COOP
#define MK_COOP 1
#endif

extern "C" void kernel_launch(void* const* d_in, const int* in_sizes, int n_in, void* d_out, int out_size, void* d_ws,
                              size_t ws_size, hipStream_t stream) {
  Params p{};
  for (int i = 0; i < 25; ++i) p.in[i] = reinterpret_cast<const float*>(d_in[i]);
  p.out = reinterpret_cast<float*>(d_out);
  p.ws = reinterpret_cast<unsigned char*>(d_ws);
  if (WS_NEED > ws_size) { fprintf(stderr, "workspace too small: need %zu have %zu\n", (size_t)WS_NEED, ws_size); return; }

  static int grid_blocks = 0;
  if (!grid_blocks) {
    (void)hipFuncSetAttribute((const void*)mega, hipFuncAttributeMaxDynamicSharedMemorySize, SMEM_BYTES);
    int dev = 0, cus = 0, per_cu = 0;
    (void)hipGetDevice(&dev);
    (void)hipDeviceGetAttribute(&cus, hipDeviceAttributeMultiprocessorCount, dev);
    (void)hipOccupancyMaxActiveBlocksPerMultiprocessor(&per_cu, mega, NTHREADS, SMEM_BYTES);
    per_cu = 1;
    grid_blocks = cus * per_cu;
  }
  const int nph = 4 * (PH_PER_LAYER + (PROBE_DUP >= 0 ? 1 : 0));
#if MK_COOP
  int lo = 0, hi = nph, use_cg = 0;
  void* args[] = {&p, &lo, &hi, &use_cg};
  (void)hipMemsetAsync(p.ws + OFF_bar, 0, 256, stream);
  hipError_t e = hipLaunchCooperativeKernel((const void*)mega, dim3(grid_blocks), dim3(NTHREADS), args, SMEM_BYTES, stream);
  if (e != hipSuccess) fprintf(stderr, "cooperative launch failed: %s (grid %d)\n", hipGetErrorString(e), grid_blocks);
#else
  for (int ph = 0; ph < nph; ++ph)
    hipLaunchKernelGGL(mega, dim3(grid_blocks), dim3(NTHREADS), SMEM_BYTES, stream, p, ph, ph + 1, 0);
#endif
}
```

```cpp
#include <hip/hip_runtime.h>
#include <hip/hip_bf16.h>
#include <hip/hip_cooperative_groups.h>
#include <cstdio>
namespace cg = cooperative_groups;

typedef __attribute__((ext_vector_type(8))) short bf16x8;
typedef __attribute__((ext_vector_type(4))) float f32x4;
typedef unsigned short bfu;

#define S_LEN 16384
#define DM 1024
#define NU 8192
#define NINP 8448
#define NSRC 8220
#define FH 2816
#define NCH 256
#define LDP 72
#define YW 1280
#define EPS 1e-6f
#define SMEM_HALF 73728
#define SMEM_BYTES 147456
#define NTHREADS 512
#define PH_PER_LAYER 10
#ifndef PROBE_DUP
#define PROBE_DUP -1
#endif

struct Params {
  const float* in[25];
  float* out;
  unsigned char* ws;
};
typedef const __attribute__((address_space(4))) Params CParams;
constexpr size_t OFF_WinT = 0;
constexpr size_t OFF_WupT = OFF_WinT + (((size_t)NINP*DM*2 + 255) & ~(size_t)255);
constexpr size_t OFF_WoutT = OFF_WupT + (((size_t)DM*YW*2 + 255) & ~(size_t)255);
constexpr size_t OFF_WfiT = OFF_WoutT + (((size_t)DM*DM*2 + 255) & ~(size_t)255);
constexpr size_t OFF_WfoT = OFF_WfiT + (((size_t)2*FH*DM*2 + 255) & ~(size_t)255);
constexpr size_t OFF_u = OFF_WfoT + (((size_t)DM*FH*2 + 255) & ~(size_t)255);
constexpr size_t OFF_small = OFF_u + (((size_t)S_LEN*NU*2 + 255) & ~(size_t)255);
constexpr size_t OFF_h = OFF_small + (((size_t)S_LEN*32*4 + 255) & ~(size_t)255);
constexpr size_t OFF_y = OFF_h + (((size_t)S_LEN*DM*2 + 255) & ~(size_t)255);
constexpr size_t OFF_ssq = OFF_y + (((size_t)S_LEN*YW*2 + 255) & ~(size_t)255);
constexpr size_t OFF_foxq = OFF_ssq + (((size_t)S_LEN*8*4 + 255) & ~(size_t)255);
constexpr size_t OFF_foxk = OFF_foxq + (((size_t)4*S_LEN*64*2 + 255) & ~(size_t)255);
constexpr size_t OFF_foxvT = OFF_foxk + (((size_t)4*S_LEN*64*2 + 255) & ~(size_t)255);
constexpr size_t OFF_foxc = OFF_foxvT + (((size_t)4*S_LEN*64*2 + 255) & ~(size_t)255);
constexpr size_t OFF_foxtot = OFF_foxc + (((size_t)4*S_LEN*4 + 255) & ~(size_t)255);
constexpr size_t OFF_VT = OFF_foxtot + (((size_t)4*NCH*4 + 255) & ~(size_t)255);
constexpr size_t OFF_ST = OFF_VT + (((size_t)16*NCH*4096*2 + 255) & ~(size_t)255);
constexpr size_t OFF_dec = OFF_ST + (((size_t)16*NCH*4096*2 + 255) & ~(size_t)255);
constexpr size_t OFF_csb = OFF_dec + (((size_t)16*NCH*64*4 + 255) & ~(size_t)255);
constexpr size_t OFF_ssdX = OFF_csb + (((size_t)16*S_LEN*4 + 255) & ~(size_t)255);
constexpr size_t OFF_ssdB = OFF_ssdX + (((size_t)S_LEN*512*2 + 255) & ~(size_t)255);
constexpr size_t OFF_ssdC = OFF_ssdB + (((size_t)2*S_LEN*64*2 + 255) & ~(size_t)255);
constexpr size_t OFF_rcos = OFF_ssdC + (((size_t)2*S_LEN*64*2 + 255) & ~(size_t)255);
constexpr size_t OFF_rsin = OFF_rcos + (((size_t)S_LEN*32*4 + 255) & ~(size_t)255);
constexpr size_t OFF_ctr = OFF_rsin + (((size_t)S_LEN*32*4 + 255) & ~(size_t)255);
constexpr size_t OFF_bar = OFF_ctr + (((size_t)256 + 255) & ~(size_t)255);
constexpr size_t WS_NEED = OFF_bar + 256;

__device__ __forceinline__ bfu f2bf(float f) {
  unsigned u = __float_as_uint(f);
  u += 0x7fffu + ((u >> 16) & 1u);
  return (bfu)(u >> 16);
}
__device__ __forceinline__ float bf2f(bfu b) { return __uint_as_float(((unsigned)b) << 16); }
__device__ __forceinline__ float sigmoidf_(float x) { return 1.f / (1.f + __expf(-x)); }
__device__ __forceinline__ float siluf_(float x) { return x / (1.f + __expf(-x)); }
__device__ __forceinline__ float logsigmoidf_(float z) { return fminf(z, 0.f) - log1pf(expf(-fabsf(z))); }
__device__ __forceinline__ float logsigmoid_fast(float z) { return fminf(z, 0.f) - __logf(1.f + __expf(-fabsf(z))); }
__device__ __forceinline__ float softplus_fast(float z) { return fmaxf(z, 0.f) + __logf(1.f + __expf(-fabsf(z))); }
__device__ __forceinline__ float softplusf_(float z) { return fmaxf(z, 0.f) + log1pf(expf(-fabsf(z))); }

namespace pg8 { __device__ __forceinline__ unsigned cvt_pk_bf16(float lo, float hi); }
__device__ __forceinline__ bf16x8 lds_frag(const bfu* base, int row, int kofs, int stride) {
  return *reinterpret_cast<const bf16x8*>(base + row * stride + kofs);
}

__device__ __forceinline__ void mma16x64(f32x4 (&acc)[4], const bfu* sA, int arow0, const bfu* sB, int lane) {
  const int r = lane & 15, q = (lane >> 4) * 8;
#pragma unroll
  for (int ks = 0; ks < 2; ++ks) {
    bf16x8 a = lds_frag(sA, arow0 + r, ks * 32 + q, LDP);
#pragma unroll
    for (int n = 0; n < 4; ++n) {
      bf16x8 b = lds_frag(sB, n * 16 + r, ks * 32 + q, LDP);
      acc[n] = __builtin_amdgcn_mfma_f32_16x16x32_bf16(a, b, acc[n], 0, 0, 0);
    }
  }
}

__device__ __forceinline__ void load_tile64(bfu* s, const bfu* g, int gs, int tid) {
#pragma unroll
  for (int i = 0; i < 2; ++i) {
    int id = tid + i * 256;
    int r = id >> 3, c = (id & 7) * 8;
    *reinterpret_cast<uint4*>(s + r * LDP + c) = *reinterpret_cast<const uint4*>(g + (size_t)r * gs + c);
  }
}

template <int NI>
__device__ __forceinline__ void gemm_main(f32x4 (&acc)[4][NI], const bfu* __restrict__ A, int lda,
                                          const bfu* __restrict__ Bt, int ldb, int K, bfu* smem, int tid) {
  bfu* sA = smem;
  bfu* sB = smem + 2 * 128 * LDP;
  const int lane = tid & 63, w = tid >> 6, wm = w >> 1, wn = w & 1;
  const int lr = lane & 15, lq = (lane >> 4) * 8;
  const int crow = tid >> 3, ccol = (tid & 7) * 8;
  const bfu* Ap = A + (size_t)crow * lda + ccol;
  const bfu* Bp = Bt + (size_t)crow * ldb + ccol;
  uint4 ra[4], rb[NI];
#pragma unroll
  for (int i = 0; i < 4; ++i) ra[i] = *reinterpret_cast<const uint4*>(Ap + (size_t)i * 32 * lda);
#pragma unroll
  for (int i = 0; i < NI; ++i) rb[i] = *reinterpret_cast<const uint4*>(Bp + (size_t)i * 32 * ldb);
#pragma unroll
  for (int i = 0; i < 4; ++i) *reinterpret_cast<uint4*>(sA + (crow + i * 32) * LDP + ccol) = ra[i];
#pragma unroll
  for (int i = 0; i < NI; ++i) *reinterpret_cast<uint4*>(sB + (crow + i * 32) * LDP + ccol) = rb[i];
  __syncthreads();
  const int nk = K >> 6;
  for (int kt = 0; kt < nk; ++kt) {
    const int cur = kt & 1;
    if (kt + 1 < nk) {
      const int ko = (kt + 1) * 64;
#pragma unroll
      for (int i = 0; i < 4; ++i) ra[i] = *reinterpret_cast<const uint4*>(Ap + (size_t)i * 32 * lda + ko);
#pragma unroll
      for (int i = 0; i < NI; ++i) rb[i] = *reinterpret_cast<const uint4*>(Bp + (size_t)i * 32 * ldb + ko);
    }
    const bfu* a_s = sA + cur * 128 * LDP + (wm * 64) * LDP;
    const bfu* b_s = sB + cur * 128 * LDP + (wn * NI * 16) * LDP;
#pragma unroll
    for (int ks = 0; ks < 2; ++ks) {
      bf16x8 af[4], bfr[NI];
#pragma unroll
      for (int mi = 0; mi < 4; ++mi) af[mi] = lds_frag(a_s, mi * 16 + lr, ks * 32 + lq, LDP);
#pragma unroll
      for (int ni = 0; ni < NI; ++ni) bfr[ni] = lds_frag(b_s, ni * 16 + lr, ks * 32 + lq, LDP);
#pragma unroll
      for (int mi = 0; mi < 4; ++mi)
#pragma unroll
        for (int ni = 0; ni < NI; ++ni)
          acc[mi][ni] = __builtin_amdgcn_mfma_f32_16x16x32_bf16(af[mi], bfr[ni], acc[mi][ni], 0, 0, 0);
    }
    if (kt + 1 < nk) {
      bfu* sAn = sA + (cur ^ 1) * 128 * LDP;
      bfu* sBn = sB + (cur ^ 1) * 128 * LDP;
#pragma unroll
      for (int i = 0; i < 4; ++i) *reinterpret_cast<uint4*>(sAn + (crow + i * 32) * LDP + ccol) = ra[i];
#pragma unroll
      for (int i = 0; i < NI; ++i) *reinterpret_cast<uint4*>(sBn + (crow + i * 32) * LDP + ccol) = rb[i];
    }
    __syncthreads();
  }
}

template <int NI>
__device__ __forceinline__ void zero_acc(f32x4 (&acc)[4][NI]) {
#pragma unroll
  for (int i = 0; i < 4; ++i)
#pragma unroll
    for (int j = 0; j < NI; ++j) acc[i][j] = (f32x4){0.f, 0.f, 0.f, 0.f};
}

__device__ __forceinline__ int win_src(int dc) {
  if (dc < 768) return dc;
  if (dc < 1536) return dc + 4;
  if (dc < 4096) return dc + 20;
  if (dc < 8192) return dc + 28;
  int s = dc - 8192;
  if (s < 4) return 768 + s;
  if (s < 20) return 1540 + (s - 4);
  if (s < 28) return 4116 + (s - 20);
  return -1;
}
__device__ __forceinline__ int ffi_src(int dc) {
  const int G = dc >> 5, w = dc & 31, f = w >> 3, r = w & 7;
  return (r < 4) ? (G * 16 + f * 4 + r) : (FH + G * 16 + f * 4 + (r - 4));
}

__device__ __forceinline__ void convert_tile(const float* __restrict__ W, int ldw, int kt, int ntd, bfu* __restrict__ Wt,
                                             int ldt, int kofs, int mode, const float* __restrict__ rowgain,
                                             bfu* sT, int tid) {
  const int c4 = (tid & 15) * 4, r0 = tid >> 4;
  const int dc = ntd * 64 + c4;
  int sc = dc;
  if (mode == 1) sc = win_src(dc);
  else if (mode == 2) sc = ffi_src(dc);
#pragma unroll
  for (int ps = 0; ps < 4; ++ps) {
    int kk = r0 + ps * 16;
    int k = kt * 64 + kk;
    float4 v = make_float4(0.f, 0.f, 0.f, 0.f);
    if (sc >= 0) v = *reinterpret_cast<const float4*>(W + (size_t)k * ldw + sc);
    if (rowgain) { float g = rowgain[k]; v.x *= g; v.y *= g; v.z *= g; v.w *= g; }
    sT[(c4 + 0) * LDP + kk] = f2bf(v.x);
    sT[(c4 + 1) * LDP + kk] = f2bf(v.y);
    sT[(c4 + 2) * LDP + kk] = f2bf(v.z);
    sT[(c4 + 3) * LDP + kk] = f2bf(v.w);
  }
  __syncthreads();
#pragma unroll
  for (int i = 0; i < 2; ++i) {
    int id = tid + i * 256;
    int nn = id >> 3, kc = (id & 7) * 8;
    *reinterpret_cast<uint4*>(Wt + (size_t)(ntd * 64 + nn) * ldt + kofs + kt * 64 + kc) =
        *reinterpret_cast<const uint4*>(sT + nn * LDP + kc);
  }
  __syncthreads();
}

__device__ void phase_convert_norm(CParams& p_o, int l, bfu* smem, int tid, int vb, int vg) {
  const int nconv = 4800, nnorm = 4096;
  const int nrot = (l == 0) ? 64 : 0;
  const int total = nconv + nnorm + nrot;
  if (l == 0 && vb == 0 && tid < 64) ((unsigned*)(p_o.ws + OFF_ctr))[tid] = 0u;
  for (int it = vb; it < total; it += vg) {
    CParams* pp_ = &p_o;
    asm volatile("" : "+s"(pp_));
    CParams& p = *pp_;
    if (it < nconv) {
      if (it < 2112) {
        int kt = it & 15, nt = it >> 4;
        convert_tile(p.in[4] + (size_t)l * DM * NSRC, NSRC, kt, nt, ((bfu*)(p.ws + OFF_WinT)), DM, 0, 1, nullptr, smem, tid);
      } else if (it < 2304) {
        int j = it - 2112; int br = j >> 6; j &= 63;
        int kt = j & 3, nt = j >> 2;
        const float* W = (br == 0 ? p.in[18] : (br == 1 ? p.in[19] : p.in[20])) + (size_t)l * 256 * DM;
        convert_tile(W, DM, kt, nt, ((bfu*)(p.ws + OFF_WupT)), YW, br * 256, 0, nullptr, smem, tid);
      } else if (it < 2432) {
        int j = it - 2304; int kt = j & 7, nt = j >> 3;
        convert_tile(p.in[21] + (size_t)l * 512 * DM, DM, kt, nt, ((bfu*)(p.ws + OFF_WupT)), YW, 768, 0, p.in[17] + l * 512, smem, tid);
      } else if (it < 2688) {
        int j = it - 2432; int kt = j & 15, nt = j >> 4;
        convert_tile(p.in[22] + (size_t)l * DM * DM, DM, kt, nt, ((bfu*)(p.ws + OFF_WoutT)), DM, 0, 0, nullptr, smem, tid);
      } else if (it < 4096) {
        int j = it - 2688; int kt = j & 15, nt = j >> 4;
        convert_tile(p.in[23] + (size_t)l * DM * 2 * FH, 2 * FH, kt, nt, ((bfu*)(p.ws + OFF_WfiT)), DM, 0, 2, nullptr, smem, tid);
      } else {
        int j = it - 4096; int kt = j % 44, nt = j / 44;
        convert_tile(p.in[24] + (size_t)l * FH * DM, DM, kt, nt, ((bfu*)(p.ws + OFF_WfoT)), FH, 0, 0, nullptr, smem, tid);
      }
    } else if (it < nconv + nnorm) {
      int row = (it - nconv) * 4 + (tid >> 6);
      int lane = tid & 63;
      const float* xr = (l == 0 ? p.in[0] : p.out) + (size_t)row * DM;
      const float* g = p.in[2] + l * DM;
      float4 v[4];
      float ss = 0.f;
#pragma unroll
      for (int i = 0; i < 4; ++i) {
        v[i] = *reinterpret_cast<const float4*>(xr + i * 256 + lane * 4);
        ss += v[i].x * v[i].x + v[i].y * v[i].y + v[i].z * v[i].z + v[i].w * v[i].w;
      }
#pragma unroll
      for (int m = 1; m < 64; m <<= 1) ss += __shfl_xor(ss, m, 64);
      float rstd = rsqrtf(ss * (1.f / DM) + EPS);
#pragma unroll
      for (int i = 0; i < 4; ++i) {
        float4 gg = *reinterpret_cast<const float4*>(g + i * 256 + lane * 4);
        ushort4 o;
        o.x = f2bf(v[i].x * rstd * gg.x); o.y = f2bf(v[i].y * rstd * gg.y);
        o.z = f2bf(v[i].z * rstd * gg.z); o.w = f2bf(v[i].w * rstd * gg.w);
        *reinterpret_cast<ushort4*>(((bfu*)(p.ws + OFF_h)) + (size_t)row * DM + i * 256 + lane * 4) = o;
      }
    } else {
      int base = (it - nconv - nnorm) * 256;
      for (int e = tid; e < 256 * 32; e += 256) {
        int tok = base + (e >> 5), i = e & 31;
        float inv = powf(10000.f, -(float)i / 32.f);
        float ang = (float)((const int*)p.in[1])[tok] * inv;
        double a = (double)ang;
        double kq = rint(a * 0.15915494309189535);
        float r = (float)(a - kq * 6.283185307179586);
        ((float*)(p.ws + OFF_rcos))[tok * 32 + i] = cosf(r);
        ((float*)(p.ws + OFF_rsin))[tok * 32 + i] = sinf(r);
      }
    }
  }
}

__device__ void phase_norm2(CParams& p, int l, int tid, int vb, int vg) {
  for (int it = vb; it < 4096; it += vg) {
    int row = it * 4 + (tid >> 6);
    int lane = tid & 63;
    const float* xr = p.out + (size_t)row * DM;
    const float* g = p.in[3] + l * DM;
    float4 v[4];
    float ss = 0.f;
#pragma unroll
    for (int i = 0; i < 4; ++i) {
      v[i] = *reinterpret_cast<const float4*>(xr + i * 256 + lane * 4);
      ss += v[i].x * v[i].x + v[i].y * v[i].y + v[i].z * v[i].z + v[i].w * v[i].w;
    }
#pragma unroll
    for (int m = 1; m < 64; m <<= 1) ss += __shfl_xor(ss, m, 64);
    float rstd = rsqrtf(ss * (1.f / DM) + EPS);
#pragma unroll
    for (int i = 0; i < 4; ++i) {
      float4 gg = *reinterpret_cast<const float4*>(g + i * 256 + lane * 4);
      ushort4 o;
      o.x = f2bf(v[i].x * rstd * gg.x); o.y = f2bf(v[i].y * rstd * gg.y);
      o.z = f2bf(v[i].z * rstd * gg.z); o.w = f2bf(v[i].w * rstd * gg.w);
      *reinterpret_cast<ushort4*>(((bfu*)(p.ws + OFF_h)) + (size_t)row * DM + i * 256 + lane * 4) = o;
    }
  }
}

__device__ __forceinline__ float wave_incl_scan(float v, int lane) {
#pragma unroll
  for (int d = 1; d < 64; d <<= 1) {
    float o = __shfl_up(v, d, 64);
    if (lane >= d) v += o;
  }
  return v;
}

__device__ void phase_prep(CParams& p_o, int l, bfu* smem, int tid, int wr, int vb, int vg) {
  bfu* sK = smem;
  bfu* sV = smem + 64 * LDP;
  float* sF = reinterpret_cast<float*>(smem + 2 * 64 * LDP);
  float* s_glr = sF;
  float* s_seg = sF + 1024;
  float* s_ps = sF + 1280;
  float* s_cs = sF + 1344;
  float* s_dt = sF + 1408;
  const int lane = tid & 63, seg = tid >> 6, col = lane;
  const int total = NCH * 20;
  for (int it = vb; it < total; it += vg) {
    CParams* pp_ = &p_o;
    asm volatile("" : "+s"(pp_));
    CParams& p = *pp_;
    const int c = it / 20, hs = it - c * 20;
    const int tok0 = c * 64;
    bfu kreg[16], vreg[16];
    if (hs < 4) {
      const int h = hs;
      for (int i = tid; i < 1024; i += 256) s_glr[i] = ((float*)(p.ws + OFF_small))[(tok0 + (i >> 4)) * 32 + 4 + (i & 15)];
      float wv[16];
#pragma unroll
      for (int r = 0; r < 16; ++r) wv[r] = p.in[8][(l * 16 + r) * 256 + h * 64 + col];
      const float bias = p.in[9][l * 256 + h * 64 + col];
      __syncthreads();
      float lb[16];
      float run = 0.f;
#pragma unroll
      for (int i = 0; i < 16; ++i) {
        int t = seg * 16 + i;
        float z = bias;
#pragma unroll
        for (int r = 0; r < 16; ++r) z += s_glr[t * 16 + r] * wv[r];
        run += logsigmoid_fast(z) * (1.f / 16.f);
        lb[i] = run;
      }
      s_seg[seg * 64 + col] = run;
      __syncthreads();
      float pre = 0.f, blast = 0.f;
#pragma unroll
      for (int s2 = 0; s2 < 4; ++s2) {
        float v = s_seg[s2 * 64 + col];
        if (s2 < seg) pre += v;
        blast += v;
      }
      if (seg == 0) {
        float e = __expf(blast);
        s_ps[col] = e;
        ((float*)(p.ws + OFF_dec))[(hs * NCH + c) * 64 + col] = e;
        ((float*)(p.ws + OFF_csb))[hs * S_LEN + tok0 + col] = 0.f;
      }
#pragma unroll
      for (int i = 0; i < 16; ++i) {
        int tok = tok0 + seg * 16 + i;
        float b = lb[i] + pre;
        bfu* ur = ((bfu*)(p.ws + OFF_u)) + (size_t)tok * NU + h * 64 + col;
        float q = bf2f(ur[768]), k = bf2f(ur[1024]);
        vreg[i] = ur[1280];
        bfu qd = f2bf(q * 0.125f * __expf(b));
        bfu ki = f2bf(k * __expf(-b));
        if (wr) { ur[768] = qd; ur[1024] = ki; }
        kreg[i] = ki;
      }
    } else if (hs < 8) {
      const int h = hs - 4;
      const float lg = log1pf(-exp2f(-5.f - (float)h));
      if (seg == 0) {
        s_ps[col] = 1.f;
        ((float*)(p.ws + OFF_dec))[(hs * NCH + c) * 64 + col] = __expf(64.f * lg);
        ((float*)(p.ws + OFF_csb))[hs * S_LEN + tok0 + col] = (float)(col + 1) * lg;
      }
#pragma unroll
      for (int i = 0; i < 16; ++i) {
        int t = seg * 16 + i, tok = tok0 + t;
        float cs = ((float*)(p.ws + OFF_rcos))[tok * 32 + (col & 31)], sn = ((float*)(p.ws + OFF_rsin))[tok * 32 + (col & 31)];
        bfu* ur = ((bfu*)(p.ws + OFF_u)) + (size_t)tok * NU + h * 64;
        float qo = bf2f(ur[1792 + col]), qx = bf2f(ur[1792 + (col ^ 32)]);
        float ko = bf2f(ur[2048 + col]), kx = bf2f(ur[2048 + (col ^ 32)]);
        vreg[i] = ur[2304 + col];
        float qr, kr;
        if (col < 32) { qr = qo * cs - qx * sn; kr = ko * cs - kx * sn; }
        else          { qr = qx * sn + qo * cs; kr = kx * sn + ko * cs; }
        kr *= 0.125f;
        bfu kb = f2bf(kr);
        if (wr) { ur[1792 + col] = f2bf(qr); ur[2048 + col] = kb; }
        kreg[i] = f2bf(bf2f(kb) * __expf(lg * (float)(63 - t)));
      }
    } else if (hs < 16) {
      const int h = hs - 8, g = h >> 2;
      if (seg == 0) {
        float dtv = softplus_fast(((float*)(p.ws + OFF_small))[(tok0 + lane) * 32 + 20 + h] + p.in[14][l * 8 + h]);
        float a = -__expf(p.in[15][l * 8 + h]);
        float cs = wave_incl_scan(dtv * a, lane);
        s_cs[lane] = cs;
        s_dt[lane] = dtv;
        ((float*)(p.ws + OFF_csb))[hs * S_LEN + tok0 + lane] = cs;
        s_ps[lane] = 1.f;
      }
      __syncthreads();
      const float cs_last = s_cs[63];
      if (seg == 0) ((float*)(p.ws + OFF_dec))[(hs * NCH + c) * 64 + col] = __expf(cs_last);
      const int chx = h * 64 + col, chb = 512 + g * 64 + col, chc = 640 + g * 64 + col;
      float wx[4], wb[4], wc[4];
#pragma unroll
      for (int j = 0; j < 4; ++j) {
        wx[j] = p.in[12][(l * 4 + j) * 768 + chx];
        wb[j] = p.in[12][(l * 4 + j) * 768 + chb];
        wc[j] = p.in[12][(l * 4 + j) * 768 + chc];
      }
      const float bx = p.in[13][l * 768 + chx], bb = p.in[13][l * 768 + chb], bc = p.in[13][l * 768 + chc];
      float x0, x1, x2, b0, b1, b2, c0, c1, c2;
      {
        int tb = tok0 + seg * 16;
        const bfu* ub = ((bfu*)(p.ws + OFF_u)) + 3328;
        x0 = (tb - 3 >= 0) ? bf2f(ub[(size_t)(tb - 3) * NU + chx]) : 0.f;
        x1 = (tb - 2 >= 0) ? bf2f(ub[(size_t)(tb - 2) * NU + chx]) : 0.f;
        x2 = (tb - 1 >= 0) ? bf2f(ub[(size_t)(tb - 1) * NU + chx]) : 0.f;
        b0 = (tb - 3 >= 0) ? bf2f(ub[(size_t)(tb - 3) * NU + chb]) : 0.f;
        b1 = (tb - 2 >= 0) ? bf2f(ub[(size_t)(tb - 2) * NU + chb]) : 0.f;
        b2 = (tb - 1 >= 0) ? bf2f(ub[(size_t)(tb - 1) * NU + chb]) : 0.f;
        c0 = (tb - 3 >= 0) ? bf2f(ub[(size_t)(tb - 3) * NU + chc]) : 0.f;
        c1 = (tb - 2 >= 0) ? bf2f(ub[(size_t)(tb - 2) * NU + chc]) : 0.f;
        c2 = (tb - 1 >= 0) ? bf2f(ub[(size_t)(tb - 1) * NU + chc]) : 0.f;
      }
#pragma unroll
      for (int i = 0; i < 16; ++i) {
        int t = seg * 16 + i, tok = tok0 + t;
        const bfu* ur = ((bfu*)(p.ws + OFF_u)) + (size_t)tok * NU + 3328;
        float x3 = bf2f(ur[chx]), b3 = bf2f(ur[chb]), c3 = bf2f(ur[chc]);
        float xs = siluf_(bx + wx[0] * x0 + wx[1] * x1 + wx[2] * x2 + wx[3] * x3);
        float bs = siluf_(bb + wb[0] * b0 + wb[1] * b1 + wb[2] * b2 + wb[3] * b3);
        float cv = siluf_(bc + wc[0] * c0 + wc[1] * c1 + wc[2] * c2 + wc[3] * c3);
        x0 = x1; x1 = x2; x2 = x3; b0 = b1; b1 = b2; b2 = b3; c0 = c1; c1 = c2; c2 = c3;
        bfu xb = f2bf(xs);
        ((bfu*)(p.ws + OFF_ssdX))[(size_t)tok * 512 + chx] = xb;
        if ((h & 3) == 0) {
          ((bfu*)(p.ws + OFF_ssdB))[((size_t)g * S_LEN + tok) * 64 + col] = f2bf(bs);
          ((bfu*)(p.ws + OFF_ssdC))[((size_t)g * S_LEN + tok) * 64 + col] = f2bf(cv);
        }
        vreg[i] = f2bf(xs * s_dt[t]);
        kreg[i] = f2bf(bs * __expf(cs_last - s_cs[t]));
      }
    } else {
      const int h = hs - 16;
      if (seg == 0) {
        float lf = logsigmoid_fast(((float*)(p.ws + OFF_small))[(tok0 + lane) * 32 + h] + p.in[5][l * 4 + h]);
        float cs = wave_incl_scan(lf, lane);
        ((float*)(p.ws + OFF_foxc))[h * S_LEN + tok0 + lane] = cs;
        if (lane == 63) ((float*)(p.ws + OFF_foxtot))[h * NCH + c] = cs;
      }
      const float qg = p.in[6][l * 64 + col], kg = p.in[7][l * 64 + col];
#pragma unroll
      for (int i = 0; i < 16; ++i) {
        int tok = tok0 + seg * 16 + i;
        const bfu* ur = ((bfu*)(p.ws + OFF_u)) + (size_t)tok * NU + h * 64 + col;
        float q = bf2f(ur[0]), k = bf2f(ur[256]);
        vreg[i] = ur[512];
        float sq = q * q, sk = k * k;
#pragma unroll
        for (int m = 1; m < 64; m <<= 1) { sq += __shfl_xor(sq, m, 64); sk += __shfl_xor(sk, m, 64); }
        ((bfu*)(p.ws + OFF_foxq))[((size_t)h * S_LEN + tok) * 64 + col] = f2bf(q * rsqrtf(sq * (1.f / 64.f) + EPS) * qg * (0.125f * 1.44269504088896f));
        ((bfu*)(p.ws + OFF_foxk))[((size_t)h * S_LEN + tok) * 64 + col] = f2bf(k * rsqrtf(sk * (1.f / 64.f) + EPS) * kg);
      }
      uint4 v0, v1;
      v0.x = vreg[0] | ((unsigned)vreg[1] << 16); v0.y = vreg[2] | ((unsigned)vreg[3] << 16);
      v0.z = vreg[4] | ((unsigned)vreg[5] << 16); v0.w = vreg[6] | ((unsigned)vreg[7] << 16);
      v1.x = vreg[8] | ((unsigned)vreg[9] << 16); v1.y = vreg[10] | ((unsigned)vreg[11] << 16);
      v1.z = vreg[12] | ((unsigned)vreg[13] << 16); v1.w = vreg[14] | ((unsigned)vreg[15] << 16);
      bfu* dst = ((bfu*)(p.ws + OFF_foxvT)) + ((size_t)h * 64 + col) * S_LEN + tok0 + seg * 16;
      *reinterpret_cast<uint4*>(dst) = v0;
      *reinterpret_cast<uint4*>(dst + 8) = v1;
      continue;
    }
    {
      uint4 k0, k1, v0, v1;
      k0.x = kreg[0] | ((unsigned)kreg[1] << 16); k0.y = kreg[2] | ((unsigned)kreg[3] << 16);
      k0.z = kreg[4] | ((unsigned)kreg[5] << 16); k0.w = kreg[6] | ((unsigned)kreg[7] << 16);
      k1.x = kreg[8] | ((unsigned)kreg[9] << 16); k1.y = kreg[10] | ((unsigned)kreg[11] << 16);
      k1.z = kreg[12] | ((unsigned)kreg[13] << 16); k1.w = kreg[14] | ((unsigned)kreg[15] << 16);
      v0.x = vreg[0] | ((unsigned)vreg[1] << 16); v0.y = vreg[2] | ((unsigned)vreg[3] << 16);
      v0.z = vreg[4] | ((unsigned)vreg[5] << 16); v0.w = vreg[6] | ((unsigned)vreg[7] << 16);
      v1.x = vreg[8] | ((unsigned)vreg[9] << 16); v1.y = vreg[10] | ((unsigned)vreg[11] << 16);
      v1.z = vreg[12] | ((unsigned)vreg[13] << 16); v1.w = vreg[14] | ((unsigned)vreg[15] << 16);
      *reinterpret_cast<uint4*>(sK + col * LDP + seg * 16) = k0;
      *reinterpret_cast<uint4*>(sK + col * LDP + seg * 16 + 8) = k1;
      *reinterpret_cast<uint4*>(sV + col * LDP + seg * 16) = v0;
      *reinterpret_cast<uint4*>(sV + col * LDP + seg * 16 + 8) = v1;
      bfu* dst = ((bfu*)(p.ws + OFF_VT)) + (((size_t)hs * NCH + c) * 64 + col) * 64 + seg * 16;
      *reinterpret_cast<uint4*>(dst) = v0;
      *reinterpret_cast<uint4*>(dst + 8) = v1;
    }
    __syncthreads();
    {
      f32x4 acc[4];
#pragma unroll
      for (int n = 0; n < 4; ++n) acc[n] = (f32x4){0.f, 0.f, 0.f, 0.f};
      mma16x64(acc, sV, seg * 16, sK, lane);
      bfu* st = ((bfu*)(p.ws + OFF_ST)) + ((size_t)hs * NCH + c) * 4096;
#pragma unroll
      for (int n = 0; n < 4; ++n) {
        int d = n * 16 + (lane & 15);
        float ps = s_ps[d];
#pragma unroll
        for (int j = 0; j < 4; ++j) {
          int e = seg * 16 + (lane >> 4) * 4 + j;
          st[e * 64 + d] = f2bf(acc[n][j] * ps);
        }
      }
    }
    __syncthreads();
  }
}

__device__ void phase_scan(CParams& p, bfu* smem, int tid, int wr, int vb, int vg) {
  float* s_x = reinterpret_cast<float*>(smem);
  const int g = tid >> 5, dp = tid & 31;
  for (int it = vb; it < 16 * 64; it += vg) {
    const int hs = it >> 6, e = it & 63;
    unsigned* stp = reinterpret_cast<unsigned*>(((bfu*)(p.ws + OFF_ST)) + ((size_t)hs * NCH + g * 32) * 4096 + e * 64 + dp * 2);
    const float2* dcp = reinterpret_cast<const float2*>(((float*)(p.ws + OFF_dec)) + ((size_t)hs * NCH + g * 32) * 64 + dp * 2);
    unsigned kv[32];
    float2 dc[32];
#pragma unroll
    for (int i = 0; i < 32; ++i) {
      kv[i] = stp[(size_t)i * 2048];
      dc[i] = dcp[i * 32];
    }
    float t0 = 0.f, t1 = 0.f, d0 = 1.f, d1 = 1.f;
#pragma unroll
    for (int i = 0; i < 32; ++i) {
      t0 = t0 * dc[i].x + bf2f((bfu)(kv[i] & 0xffffu));
      t1 = t1 * dc[i].y + bf2f((bfu)(kv[i] >> 16));
      d0 *= dc[i].x;
      d1 *= dc[i].y;
    }
    *reinterpret_cast<float4*>(s_x + (g * 32 + dp) * 4) = make_float4(t0, t1, d0, d1);
    __syncthreads();
    float s0 = 0.f, s1 = 0.f;
    for (int gg = 0; gg < g; ++gg) {
      const float4 x = *reinterpret_cast<const float4*>(s_x + (gg * 32 + dp) * 4);
      s0 = s0 * x.z + x.x;
      s1 = s1 * x.w + x.y;
    }
#pragma unroll
    for (int i = 0; i < 32; ++i) {
      const unsigned o = pg8::cvt_pk_bf16(s0, s1);
      if (wr) stp[(size_t)i * 2048] = o;
      s0 = s0 * dc[i].x + bf2f((bfu)(kv[i] & 0xffffu));
      s1 = s1 * dc[i].y + bf2f((bfu)(kv[i] >> 16));
    }
    __syncthreads();
  }
}

__device__ __forceinline__ void att_compute(const bfu* kS, const bfu* vS, const float* cS, const bfu* sQw,
                                            const float (&ct)[2], float (&l_run)[2], f32x4 (&O)[2][4],
                                            int kt, int qb, int r0, int w, int lr, int lq, int lg4) {
    f32x4 sc[2][4];
#pragma unroll
    for (int mi = 0; mi < 2; ++mi)
#pragma unroll
      for (int n = 0; n < 4; ++n) sc[mi][n] = (f32x4){0.f, 0.f, 0.f, 0.f};
#pragma unroll
    for (int ks = 0; ks < 2; ++ks) {
      bf16x8 aq0 = lds_frag(sQw, lr, ks * 32 + lq, LDP);
      bf16x8 aq1 = lds_frag(sQw, 16 + lr, ks * 32 + lq, LDP);
#pragma unroll
      for (int n = 0; n < 4; ++n) {
        bf16x8 kf = lds_frag(kS, n * 16 + lr, ks * 32 + lq, LDP);
        sc[0][n] = __builtin_amdgcn_mfma_f32_16x16x32_bf16(kf, aq0, sc[0][n], 0, 0, 0);
        sc[1][n] = __builtin_amdgcn_mfma_f32_16x16x32_bf16(kf, aq1, sc[1][n], 0, 0, 0);
      }
    }
    f32x4 csv[4];
#pragma unroll
    for (int n = 0; n < 4; ++n) csv[n] = *reinterpret_cast<const f32x4*>(cS + n * 16 + lg4);
    const bool diag = (kt >= 2 * qb);
    bf16x8 pf[2][2];
#pragma unroll
    for (int mi = 0; mi < 2; ++mi) {
      const int qrow = r0 + w * 32 + mi * 16 + lr;
      float ps = 0.f;
#pragma unroll
      for (int n = 0; n < 4; ++n)
#pragma unroll
        for (int j = 0; j < 4; ++j) {
          float v = (sc[mi][n][j] + ct[mi]) - csv[n][j];
          if (diag && (kt * 64 + n * 16 + lg4 + j > qrow)) v = -INFINITY;
          const float pv = __builtin_amdgcn_exp2f(v);
          sc[mi][n][j] = pv;
          ps += pv;
        }
      l_run[mi] += ps;
#pragma unroll
      for (int ks = 0; ks < 2; ++ks) {
        union { bf16x8 v; unsigned u[4]; } pk;
        pk.u[0] = pg8::cvt_pk_bf16(sc[mi][2 * ks][0], sc[mi][2 * ks][1]);
        pk.u[1] = pg8::cvt_pk_bf16(sc[mi][2 * ks][2], sc[mi][2 * ks][3]);
        pk.u[2] = pg8::cvt_pk_bf16(sc[mi][2 * ks + 1][0], sc[mi][2 * ks + 1][1]);
        pk.u[3] = pg8::cvt_pk_bf16(sc[mi][2 * ks + 1][2], sc[mi][2 * ks + 1][3]);
        pf[mi][ks] = pk.v;
      }
    }
#pragma unroll
    for (int ks = 0; ks < 2; ++ks) {
#pragma unroll
      for (int ef = 0; ef < 4; ++ef) {
        union { bf16x8 v; uint2 h2[2]; } vf;
        vf.h2[0] = *reinterpret_cast<const uint2*>(vS + (ef * 16 + lr) * LDP + ks * 32 + lg4);
        vf.h2[1] = *reinterpret_cast<const uint2*>(vS + (ef * 16 + lr) * LDP + ks * 32 + 16 + lg4);
#pragma unroll
        for (int mi = 0; mi < 2; ++mi)
          O[mi][ef] = __builtin_amdgcn_mfma_f32_16x16x32_bf16(vf.v, pf[mi][ks], O[mi][ef], 0, 0, 0);
      }
    }
}

__device__ void attn_item(CParams& p, int l, int qb, int h, bfu* smem, int tid, int half, unsigned char* smem_raw) {
  bfu* sK = smem;
  bfu* sV = smem + 2 * 64 * LDP;
  float* s_c = reinterpret_cast<float*>(smem + 4 * 64 * LDP);
  float* s_off = s_c + 128;
  const int lane = tid & 63, w = tid >> 6;
  const int lr = lane & 15, lq = (lane >> 4) * 8, lg4 = (lane >> 4) * 4;
  const int r0 = qb * 128;
  const float L2E = 1.44269504088896f;
  s_off[tid] = ((float*)(p.ws + OFF_foxtot))[h * NCH + tid];
  __syncthreads();
  float myoff = 0.f;
  for (int i = 0; i < tid; ++i) myoff += s_off[i];
  __syncthreads();
  s_off[tid] = myoff;
  float* s_misc = reinterpret_cast<float*>(smem + 28416);
  if (tid < 64) {
    float gq = fabsf(p.in[6][l * 64 + tid]), gk = fabsf(p.in[7][l * 64 + tid]);
#pragma unroll
    for (int m = 1; m < 64; m <<= 1) { gq = fmaxf(gq, __shfl_xor(gq, m, 64)); gk = fmaxf(gk, __shfl_xor(gk, m, 64)); }
    if (tid == 0) { s_misc[0] = 40.f + 2.f * 8.f * gq * gk * 1.01f; reinterpret_cast<int*>(s_misc)[1] = 2 * qb; s_misc[2] = 8.f * gq * gk * 1.01f * 1.44269504088896f; }
  }
  __syncthreads();
  {
    const float thr = s_misc[0];
    const float cref = s_off[2 * qb];
    if (tid < 2 * qb && s_off[tid + 1] <= cref + thr) atomicMin(reinterpret_cast<int*>(s_misc) + 1, tid);
  }
  __syncthreads();
  int kt_min = reinterpret_cast<int*>(s_misc)[1];
  const int nkt = 2 * qb + 2;
  if ((nkt - kt_min) & 1) kt_min -= 1;
  const bfu* Qg = ((bfu*)(p.ws + OFF_foxq)) + (size_t)h * S_LEN * 64;
  const bfu* Kg = ((bfu*)(p.ws + OFF_foxk)) + (size_t)h * S_LEN * 64;
  const bfu* Vg = ((bfu*)(p.ws + OFF_foxvT)) + (size_t)h * 64 * S_LEN;
  const float* Cg = ((float*)(p.ws + OFF_foxc)) + (size_t)h * S_LEN;
  bfu* sQ = smem + 4 * 64 * LDP + 768;
  {
#pragma unroll
    for (int i = 0; i < 4; ++i) {
      int id = tid + i * 256;
      int r = id >> 3, c = (id & 7) * 8;
      *reinterpret_cast<uint4*>(sQ + r * LDP + c) = *reinterpret_cast<const uint4*>(Qg + (size_t)(r0 + r) * 64 + c);
    }
  }
  const bfu* sQw = sQ + (w * 32) * LDP;
  float ct[2], l_run[2];
  const float lbound = s_misc[2];
  f32x4 O[2][4];
#pragma unroll
  for (int mi = 0; mi < 2; ++mi) {
    const int qrow = r0 + w * 32 + mi * 16 + lr;
    ct[mi] = (Cg[qrow] + s_off[qrow >> 6]) * L2E - lbound;
    l_run[mi] = 0.f;
#pragma unroll
    for (int n = 0; n < 4; ++n) O[mi][n] = (f32x4){0.f, 0.f, 0.f, 0.f};
  }
  const int nkh = (nkt - kt_min) >> 1;
  const int kt0 = kt_min + half * nkh;
  const int crow0 = tid >> 3, ccol = (tid & 7) * 8;
  uint4 rk0A, rk1A, rv0A, rv1A, rk0B, rk1B, rv0B, rv1B;
  float rcA = 0.f, rcB = 0.f;
  {
    const int k0 = kt0 * 64;
    rk0A = *reinterpret_cast<const uint4*>(Kg + (size_t)(k0 + crow0) * 64 + ccol);
    rk1A = *reinterpret_cast<const uint4*>(Kg + (size_t)(k0 + crow0 + 32) * 64 + ccol);
    rv0A = *reinterpret_cast<const uint4*>(Vg + (size_t)(crow0) * S_LEN + k0 + ccol);
    rv1A = *reinterpret_cast<const uint4*>(Vg + (size_t)(crow0 + 32) * S_LEN + k0 + ccol);
    if (tid < 64) rcA = (Cg[k0 + tid] + s_off[kt0]) * L2E;
  }
  *reinterpret_cast<uint4*>(sK + (crow0) * LDP + ccol) = rk0A;
  *reinterpret_cast<uint4*>(sK + (crow0 + 32) * LDP + ccol) = rk1A;
  *reinterpret_cast<uint4*>(sV + (crow0) * LDP + ccol) = rv0A;
  *reinterpret_cast<uint4*>(sV + (crow0 + 32) * LDP + ccol) = rv1A;
  if (tid < 64) s_c[tid] = rcA;
  rk0B = rk1B = rv0B = rv1B = rk0A;
  __syncthreads();
#define ATT_LOAD(S, KT)                                                                              \
  {                                                                                                  \
    const int k0_ = (KT) * 64;                                                                       \
    rk0##S = *reinterpret_cast<const uint4*>(Kg + (size_t)(k0_ + crow0) * 64 + ccol);                \
    rk1##S = *reinterpret_cast<const uint4*>(Kg + (size_t)(k0_ + crow0 + 32) * 64 + ccol);           \
    rv0##S = *reinterpret_cast<const uint4*>(Vg + (size_t)(crow0) * S_LEN + k0_ + ccol);             \
    rv1##S = *reinterpret_cast<const uint4*>(Vg + (size_t)(crow0 + 32) * S_LEN + k0_ + ccol);        \
    if (tid < 64) rc##S = (Cg[k0_ + tid] + s_off[(KT)]) * L2E;                                       \
  }
#define ATT_STORE(S, BUF)                                                                            \
  {                                                                                                  \
    bfu* kN_ = sK + (BUF) * 64 * LDP;                                                                \
    bfu* vN_ = sV + (BUF) * 64 * LDP;                                                                \
    *reinterpret_cast<uint4*>(kN_ + (crow0) * LDP + ccol) = rk0##S;                                  \
    *reinterpret_cast<uint4*>(kN_ + (crow0 + 32) * LDP + ccol) = rk1##S;                             \
    *reinterpret_cast<uint4*>(vN_ + (crow0) * LDP + ccol) = rv0##S;                                  \
    *reinterpret_cast<uint4*>(vN_ + (crow0 + 32) * LDP + ccol) = rv1##S;                             \
    if (tid < 64) s_c[(BUF) * 64 + tid] = rc##S;                                                     \
  }
  if (nkh > 1) ATT_LOAD(B, kt0 + 1);
  for (int it = 0; it < nkh; it += 2) {
    if (it + 2 < nkh) ATT_LOAD(A, kt0 + it + 2);
    att_compute(sK, sV, s_c, sQw, ct, l_run, O, kt0 + it, qb, r0, w, lr, lq, lg4);
    if (it + 1 < nkh) ATT_STORE(B, 1);
    __syncthreads();
    if (it + 1 >= nkh) break;
    if (it + 3 < nkh) ATT_LOAD(B, kt0 + it + 3);
    att_compute(sK + 64 * LDP, sV + 64 * LDP, s_c + 64, sQw, ct, l_run, O, kt0 + it + 1, qb, r0, w, lr, lq, lg4);
    if (it + 2 < nkh) ATT_STORE(A, 0);
    __syncthreads();
  }
#undef ATT_LOAD
#undef ATT_STORE
  float* xch = reinterpret_cast<float*>(smem_raw + SMEM_HALF);
  if (half == 1) {
#pragma unroll
    for (int mi = 0; mi < 2; ++mi) {
#pragma unroll
      for (int n = 0; n < 4; ++n)
#pragma unroll
        for (int j = 0; j < 4; ++j) xch[((mi * 4 + n) * 4 + j) * 256 + tid] = O[mi][n][j];
      xch[(32 + mi) * 256 + tid] = l_run[mi];
    }
  }
  __syncthreads();
  if (half == 0) {
#pragma unroll
    for (int mi = 0; mi < 2; ++mi) {
      float lsum = l_run[mi] + xch[(32 + mi) * 256 + tid];
      lsum += __shfl_xor(lsum, 16, 64);
      lsum += __shfl_xor(lsum, 32, 64);
      const float inv = 1.f / lsum;
      const int qrow = r0 + w * 32 + mi * 16 + lr;
      bfu* yp = ((bfu*)(p.ws + OFF_y)) + (size_t)qrow * YW + h * 64 + lg4;
#pragma unroll
      for (int n = 0; n < 4; ++n) {
        float o0 = (O[mi][n][0] + xch[((mi * 4 + n) * 4 + 0) * 256 + tid]) * inv;
        float o1 = (O[mi][n][1] + xch[((mi * 4 + n) * 4 + 1) * 256 + tid]) * inv;
        float o2 = (O[mi][n][2] + xch[((mi * 4 + n) * 4 + 2) * 256 + tid]) * inv;
        float o3 = (O[mi][n][3] + xch[((mi * 4 + n) * 4 + 3) * 256 + tid]) * inv;
        uint2 wv;
        wv.x = pg8::cvt_pk_bf16(o0, o1);
        wv.y = pg8::cvt_pk_bf16(o2, o3);
        *reinterpret_cast<uint2*>(yp + n * 16) = wv;
      }
    }
  }
  __syncthreads();
}

__device__ void chunk_out_item(CParams& p, int l, int c, int hs, bfu* smem, int tid) {
  bfu* sQ = smem;
  bfu* sKi = smem + 64 * LDP;
  bfu* sV = smem + 2 * 64 * LDP;
  bfu* sS = smem + 3 * 64 * LDP;
  bfu* sP = smem + 4 * 64 * LDP;
  float* s_cs = reinterpret_cast<float*>(smem + 5 * 64 * LDP);
  const int lane = tid & 63, w = tid >> 6;
  const int lr = lane & 15, lq = (lane >> 4) * 8, lg4 = (lane >> 4) * 4;
  const int tok0 = c * 64;
  const int tl = w * 16 + lr, tok = tok0 + tl;
  const bfu *Qp, *Kp;
  int qs;
  if (hs < 4) { Qp = ((bfu*)(p.ws + OFF_u)) + (size_t)tok0 * NU + 768 + hs * 64; Kp = ((bfu*)(p.ws + OFF_u)) + (size_t)tok0 * NU + 1024 + hs * 64; qs = NU; }
  else if (hs < 8) { Qp = ((bfu*)(p.ws + OFF_u)) + (size_t)tok0 * NU + 1792 + (hs - 4) * 64; Kp = ((bfu*)(p.ws + OFF_u)) + (size_t)tok0 * NU + 2048 + (hs - 4) * 64; qs = NU; }
  else { int g = (hs - 8) >> 2; Qp = ((bfu*)(p.ws + OFF_ssdC)) + ((size_t)g * S_LEN + tok0) * 64; Kp = ((bfu*)(p.ws + OFF_ssdB)) + ((size_t)g * S_LEN + tok0) * 64; qs = 64; }
  uint2 g4[4], x4[4];
  f32x4 gn[4];
  const int hh = (hs < 8) ? (hs & 3) : (hs - 8);
  {
    const int gcol = (hs < 4) ? (1536 + hh * 64) : (hs < 8 ? (2560 + hh * 64) : (2816 + hh * 64));
    const bfu* gp = ((bfu*)(p.ws + OFF_u)) + (size_t)tok * NU + gcol + lg4;
    const bfu* xp = ((bfu*)(p.ws + OFF_ssdX)) + (size_t)tok * 512 + hh * 64 + lg4;
    const float* gnp = (hs < 4 ? p.in[10] : p.in[11]) + l * 64 + lg4;
#pragma unroll
    for (int n = 0; n < 4; ++n) {
      g4[n] = *reinterpret_cast<const uint2*>(gp + n * 16);
      x4[n] = (hs >= 8) ? *reinterpret_cast<const uint2*>(xp + n * 16) : make_uint2(0u, 0u);
      gn[n] = (hs < 8) ? *reinterpret_cast<const f32x4*>(gnp + n * 16) : (f32x4){1.f, 1.f, 1.f, 1.f};
    }
  }
  load_tile64(sQ, Qp, qs, tid);
  load_tile64(sKi, Kp, qs, tid);
  load_tile64(sV, ((bfu*)(p.ws + OFF_VT)) + ((size_t)hs * NCH + c) * 4096, 64, tid);
  load_tile64(sS, ((bfu*)(p.ws + OFF_ST)) + ((size_t)hs * NCH + c) * 4096, 64, tid);
  if (tid < 64) s_cs[tid] = ((float*)(p.ws + OFF_csb))[hs * S_LEN + tok0 + tid];
  __syncthreads();
  const bf16x8 qf0 = lds_frag(sQ, tl, lq, LDP), qf1 = lds_frag(sQ, tl, 32 + lq, LDP);
  f32x4 sc[4], o[4];
#pragma unroll
  for (int n = 0; n < 4; ++n) {
    sc[n] = (f32x4){0.f, 0.f, 0.f, 0.f};
    o[n] = (f32x4){0.f, 0.f, 0.f, 0.f};
  }
#pragma unroll
  for (int n = 0; n < 4; ++n) {
    sc[n] = __builtin_amdgcn_mfma_f32_16x16x32_bf16(lds_frag(sKi, n * 16 + lr, lq, LDP), qf0, sc[n], 0, 0, 0);
    sc[n] = __builtin_amdgcn_mfma_f32_16x16x32_bf16(lds_frag(sKi, n * 16 + lr, 32 + lq, LDP), qf1, sc[n], 0, 0, 0);
    o[n] = __builtin_amdgcn_mfma_f32_16x16x32_bf16(lds_frag(sS, n * 16 + lr, lq, LDP), qf0, o[n], 0, 0, 0);
    o[n] = __builtin_amdgcn_mfma_f32_16x16x32_bf16(lds_frag(sS, n * 16 + lr, 32 + lq, LDP), qf1, o[n], 0, 0, 0);
  }
  const float cst = s_cs[tl];
  const float rsc = __expf(cst);
#pragma unroll
  for (int n = 0; n < 4; ++n) {
    const f32x4 css = *reinterpret_cast<const f32x4*>(s_cs + n * 16 + lg4);
    float pv[4];
#pragma unroll
    for (int j = 0; j < 4; ++j) {
      const int s = n * 16 + lg4 + j;
      pv[j] = (s <= tl) ? sc[n][j] * __expf(cst - css[j]) : 0.f;
      o[n][j] *= rsc;
    }
    uint2 wv;
    wv.x = pg8::cvt_pk_bf16(pv[0], pv[1]);
    wv.y = pg8::cvt_pk_bf16(pv[2], pv[3]);
    *reinterpret_cast<uint2*>(sP + tl * LDP + n * 16 + lg4) = wv;
  }
  __syncthreads();
  {
    const bf16x8 pf0 = lds_frag(sP, tl, lq, LDP), pf1 = lds_frag(sP, tl, 32 + lq, LDP);
#pragma unroll
    for (int n = 0; n < 4; ++n) {
      o[n] = __builtin_amdgcn_mfma_f32_16x16x32_bf16(lds_frag(sV, n * 16 + lr, lq, LDP), pf0, o[n], 0, 0, 0);
      o[n] = __builtin_amdgcn_mfma_f32_16x16x32_bf16(lds_frag(sV, n * 16 + lr, 32 + lq, LDP), pf1, o[n], 0, 0, 0);
    }
  }
  float ss = 0.f;
  if (hs < 8) {
#pragma unroll
    for (int n = 0; n < 4; ++n) ss += (o[n][0] * o[n][0] + o[n][1] * o[n][1]) + (o[n][2] * o[n][2] + o[n][3] * o[n][3]);
    ss += __shfl_xor(ss, 16, 64);
    ss += __shfl_xor(ss, 32, 64);
    const float rstd = rsqrtf(ss * (1.f / 64.f) + EPS);
    bfu* yp = ((bfu*)(p.ws + OFF_y)) + (size_t)tok * YW + (hs < 4 ? 256 : 512) + hh * 64 + lg4;
#pragma unroll
    for (int n = 0; n < 4; ++n) {
      const float t0 = __uint_as_float(g4[n].x << 16), t1 = __uint_as_float(g4[n].x & 0xffff0000u);
      const float t2 = __uint_as_float(g4[n].y << 16), t3 = __uint_as_float(g4[n].y & 0xffff0000u);
      uint2 wv;
      wv.x = pg8::cvt_pk_bf16(o[n][0] * rstd * gn[n][0] * siluf_(t0), o[n][1] * rstd * gn[n][1] * siluf_(t1));
      wv.y = pg8::cvt_pk_bf16(o[n][2] * rstd * gn[n][2] * siluf_(t2), o[n][3] * rstd * gn[n][3] * siluf_(t3));
      *reinterpret_cast<uint2*>(yp + n * 16) = wv;
    }
  } else {
    const float dsk = p.in[16][l * 8 + hh];
    bfu* yp = ((bfu*)(p.ws + OFF_y)) + (size_t)tok * YW + 768 + hh * 64 + lg4;
#pragma unroll
    for (int n = 0; n < 4; ++n) {
      const float z0 = __uint_as_float(g4[n].x << 16), z1 = __uint_as_float(g4[n].x & 0xffff0000u);
      const float z2 = __uint_as_float(g4[n].y << 16), z3 = __uint_as_float(g4[n].y & 0xffff0000u);
      const float a0 = __uint_as_float(x4[n].x << 16), a1 = __uint_as_float(x4[n].x & 0xffff0000u);
      const float a2 = __uint_as_float(x4[n].y << 16), a3 = __uint_as_float(x4[n].y & 0xffff0000u);
      const float y0 = (o[n][0] + dsk * a0) * siluf_(z0), y1 = (o[n][1] + dsk * a1) * siluf_(z1);
      const float y2 = (o[n][2] + dsk * a2) * siluf_(z2), y3 = (o[n][3] + dsk * a3) * siluf_(z3);
      ss += (y0 * y0 + y1 * y1) + (y2 * y2 + y3 * y3);
      uint2 wv;
      wv.x = pg8::cvt_pk_bf16(y0, y1);
      wv.y = pg8::cvt_pk_bf16(y2, y3);
      *reinterpret_cast<uint2*>(yp + n * 16) = wv;
    }
    ss += __shfl_xor(ss, 16, 64);
    ss += __shfl_xor(ss, 32, 64);
    if (lg4 == 0) ((float*)(p.ws + OFF_ssq))[tok * 8 + hh] = ss;
  }
  __syncthreads();
}

__device__ void phase_mix(CParams& p_o, int l, bfu* smem, int tid, int half, int cidx, unsigned char* smem_raw) {
  __shared__ int s_item;
  const int total = 512 + NCH * 8;
  while (true) {
    __syncthreads();
    if (threadIdx.x == 0) s_item = (int)atomicAdd(&((unsigned*)(p_o.ws + OFF_ctr))[cidx], 1u);
    __syncthreads();
    const int it = s_item;
    if (it >= total) break;
    CParams* pp_ = &p_o;
    asm volatile("" : "+s"(pp_));
    CParams& p = *pp_;
    if (it < 512) {
      int qb = 127 - (it >> 2), h = it & 3;
      attn_item(p, l, qb, h, smem, tid, half, smem_raw);
    } else {
      int j = (it - 512) * 2 + half;
      chunk_out_item(p, l, j >> 4, j & 15, smem, tid);
    }
  }
}

__device__ void phase_upmerge(CParams& p, bfu* smem, int tid, int vb, int vg) {
  bfu* sA = smem;
  bfu* sB = smem + 2 * 128 * LDP;
  float* s_rs = reinterpret_cast<float*>(smem + 2 * 128 * LDP + 2 * 64 * LDP);
  const int lane = tid & 63, w = tid >> 6, wm = w >> 1, wn = w & 1;
  const int lr = lane & 15, lq = (lane >> 4) * 8, lg4 = (lane >> 4) * 4;
  const int crow = tid >> 3, ccol = (tid & 7) * 8;
  const int xcd = (vb >> 1) & 7, jl = ((vb >> 4) << 1) | (vb & 1), per = vg >> 3;
  for (int il = jl; il < 16 * 16; il += per) {
    const int mt = xcd * 16 + (il >> 4), nt = il & 15;
    const bfu* Ap = ((bfu*)(p.ws + OFF_y)) + (size_t)(mt * 128 + crow) * YW + ccol;
    const bfu* Bp = ((bfu*)(p.ws + OFF_WupT)) + (size_t)(nt * 64 + crow) * YW + ccol;
    const bfu* Gp = ((bfu*)(p.ws + OFF_u)) + (size_t)(mt * 128 + wm * 64 + lr) * NU + 4096 + nt * 64 + wn * 32 + lg4;
    {
      const int row = tid >> 1, g = tid & 1;
      const float4 q4 = *reinterpret_cast<const float4*>(((float*)(p.ws + OFF_ssq)) + (mt * 128 + row) * 8 + g * 4);
      s_rs[g * 128 + row] = rsqrtf((q4.x + q4.y + q4.z + q4.w) * (1.f / 256.f) + EPS);
    }
    uint4 a0_0, a0_1, a0_2, a0_3, b0_0, b0_1, a1_0, a1_1, a1_2, a1_3, b1_0, b1_1;
#define U_LOAD(S, KT)                                                                \
  {                                                                                  \
    const int ko_ = (KT) * 64;                                                       \
    a##S##_0 = *reinterpret_cast<const uint4*>(Ap + (size_t)0 * 32 * YW + ko_);      \
    a##S##_1 = *reinterpret_cast<const uint4*>(Ap + (size_t)1 * 32 * YW + ko_);      \
    a##S##_2 = *reinterpret_cast<const uint4*>(Ap + (size_t)2 * 32 * YW + ko_);      \
    a##S##_3 = *reinterpret_cast<const uint4*>(Ap + (size_t)3 * 32 * YW + ko_);      \
    b##S##_0 = *reinterpret_cast<const uint4*>(Bp + (size_t)0 * 32 * YW + ko_);      \
    b##S##_1 = *reinterpret_cast<const uint4*>(Bp + (size_t)1 * 32 * YW + ko_);      \
  }
#define U_STORE(S, BUF)                                                              \
  {                                                                                  \
    bfu* sAn_ = sA + (BUF) * 128 * LDP + crow * LDP + ccol;                          \
    bfu* sBn_ = sB + (BUF) * 64 * LDP + crow * LDP + ccol;                           \
    *reinterpret_cast<uint4*>(sAn_ + 0 * 32 * LDP) = a##S##_0;                       \
    *reinterpret_cast<uint4*>(sAn_ + 1 * 32 * LDP) = a##S##_1;                       \
    *reinterpret_cast<uint4*>(sAn_ + 2 * 32 * LDP) = a##S##_2;                       \
    *reinterpret_cast<uint4*>(sAn_ + 3 * 32 * LDP) = a##S##_3;                       \
    *reinterpret_cast<uint4*>(sBn_ + 0 * 32 * LDP) = b##S##_0;                       \
    *reinterpret_cast<uint4*>(sBn_ + 1 * 32 * LDP) = b##S##_1;                       \
  }
#define U_COMPUTE(BUF)                                                               \
  {                                                                                  \
    const bfu* a_s = sA + (BUF) * 128 * LDP + (wm * 64) * LDP;                       \
    const bfu* b_s = sB + (BUF) * 64 * LDP + (wn * 32) * LDP;                        \
    _Pragma("unroll") for (int ks = 0; ks < 2; ++ks) {                               \
      bf16x8 af0 = lds_frag(a_s, 0 * 16 + lr, ks * 32 + lq, LDP);                    \
      bf16x8 af1 = lds_frag(a_s, 1 * 16 + lr, ks * 32 + lq, LDP);                    \
      bf16x8 af2 = lds_frag(a_s, 2 * 16 + lr, ks * 32 + lq, LDP);                    \
      bf16x8 af3 = lds_frag(a_s, 3 * 16 + lr, ks * 32 + lq, LDP);                    \
      _Pragma("unroll") for (int ni = 0; ni < 2; ++ni) {                             \
        bf16x8 bf_ = lds_frag(b_s, ni * 16 + lr, ks * 32 + lq, LDP);                 \
        acc[0][ni] = __builtin_amdgcn_mfma_f32_16x16x32_bf16(bf_, af0, acc[0][ni], 0, 0, 0); \
        acc[1][ni] = __builtin_amdgcn_mfma_f32_16x16x32_bf16(bf_, af1, acc[1][ni], 0, 0, 0); \
        acc[2][ni] = __builtin_amdgcn_mfma_f32_16x16x32_bf16(bf_, af2, acc[2][ni], 0, 0, 0); \
        acc[3][ni] = __builtin_amdgcn_mfma_f32_16x16x32_bf16(bf_, af3, acc[3][ni], 0, 0, 0); \
      }                                                                              \
    }                                                                                \
  }
    f32x4 acc[4][2], tot[4][2];
    zero_acc<2>(acc);
    zero_acc<2>(tot);
    uint2 gt[4][2];
    U_LOAD(0, 0);
    U_LOAD(1, 1);
    U_STORE(0, 0);
    __syncthreads();
#pragma unroll 1
    for (int kt = 0; kt < 20; kt += 2) {
      if ((kt & 3) == 0) {
        const int br = kt >> 2, gb = br < 3 ? br : 3;
#pragma unroll
        for (int mi = 0; mi < 4; ++mi)
#pragma unroll
          for (int ni = 0; ni < 2; ++ni)
            gt[mi][ni] = *reinterpret_cast<const uint2*>(Gp + (size_t)(mi * 16) * NU + gb * 1024 + ni * 16);
      }
      if (kt + 2 < 20) U_LOAD(0, kt + 2);
      U_COMPUTE(0);
      U_STORE(1, 1);
      __syncthreads();
      if (kt + 3 < 20) U_LOAD(1, kt + 3);
      U_COMPUTE(1);
      if (kt + 2 < 20) U_STORE(0, 0);
      if ((kt & 3) == 2) {
        const int br = kt >> 2;
#pragma unroll
        for (int mi = 0; mi < 4; ++mi) {
          float rsc = 1.f;
          if (br >= 3) rsc = s_rs[(br - 3) * 128 + wm * 64 + mi * 16 + lr];
#pragma unroll
          for (int ni = 0; ni < 2; ++ni) {
            const uint2 g2 = gt[mi][ni];
            tot[mi][ni][0] += acc[mi][ni][0] * (__uint_as_float(g2.x << 16) * rsc);
            tot[mi][ni][1] += acc[mi][ni][1] * (__uint_as_float(g2.x & 0xffff0000u) * rsc);
            tot[mi][ni][2] += acc[mi][ni][2] * (__uint_as_float(g2.y << 16) * rsc);
            tot[mi][ni][3] += acc[mi][ni][3] * (__uint_as_float(g2.y & 0xffff0000u) * rsc);
            acc[mi][ni] = (f32x4){0.f, 0.f, 0.f, 0.f};
          }
        }
      }
      __syncthreads();
    }
#undef U_LOAD
#undef U_STORE
#undef U_COMPUTE
    bfu* Hp = ((bfu*)(p.ws + OFF_h)) + (size_t)(mt * 128 + wm * 64 + lr) * DM + nt * 64 + wn * 32 + lg4;
#pragma unroll
    for (int mi = 0; mi < 4; ++mi)
#pragma unroll
      for (int ni = 0; ni < 2; ++ni) {
        uint2 wv;
        wv.x = pg8::cvt_pk_bf16(tot[mi][ni][0], tot[mi][ni][1]);
        wv.y = pg8::cvt_pk_bf16(tot[mi][ni][2], tot[mi][ni][3]);
        *reinterpret_cast<uint2*>(Hp + (size_t)(mi * 16) * DM + ni * 16) = wv;
      }
  }
}

namespace pg8 {
#define PG8_LAS __attribute__((address_space(3)))
typedef unsigned short bf16_t;
typedef short bf16x8 __attribute__((ext_vector_type(8)));
typedef float f32x4 __attribute__((ext_vector_type(4)));
typedef unsigned u32x4 __attribute__((ext_vector_type(4)));
typedef unsigned u32x2 __attribute__((ext_vector_type(2)));
constexpr int BM = 256, BK = 64, HALF = 128, HTB = HALF * BK * 2, STAGE_BYTES = 8 * HTB, NXCD = 8, WGM = 8;
__device__ __forceinline__ int lds_byte(int r, int c) { const int st = (r >> 4) * 2 + (c >> 5), rr = r & 15, cc = c & 31, ob = rr * 64 + cc * 2; return st * 1024 + (ob ^ (((ob >> 9) & 1) << 5)); }
__device__ __forceinline__ void stage_rc(int b, int& R, int& C) { const int st = b / 1024, sb = b % 1024, swz = sb ^ (((sb >> 9) & 1) << 5); R = (st >> 1) * 16 + swz / 64; C = (st & 1) * 32 + (swz % 64) / 2; }
__device__ __forceinline__ int perm32(int rho) { const int n = rho >> 4, i = rho & 15; return 8 * (i >> 2) + 4 * n + (i & 3); }
struct Unit { int pm, pn; };
struct Gemm { const bf16_t* A; const bf16_t* Bt; int M, N, K; };
struct StaticOrder {
    int nM, nN, nwg, G, c;
    __device__ void init(int M, int N, int G_, int c_) { nM = M / BM; nN = N / BM; nwg = nM * nN; G = G_; c = c_; }
    __device__ bool next(int i, Unit& u) const {
        const long L = (long)i * G + c; if (L >= nwg) return false;
        int wgid = (int)L; { const int q = nwg / NXCD, r = nwg % NXCD, xcd = wgid % NXCD, off = wgid / NXCD; wgid = (xcd < r ? xcd * (q + 1) : r * (q + 1) + (xcd - r) * q) + off; }
        const int nig = WGM * nN, gid = wgid / nig, fm = gid * WGM, gsz = (nM - fm) < WGM ? (nM - fm) : WGM;
        u.pm = fm + ((wgid % nig) % gsz); u.pn = (wgid % nig) / gsz; return true;
    }
    __device__ __forceinline__ void a_ready(const Unit&) const {}
    __device__ __forceinline__ void done(const Unit&) const {}
};
__device__ __forceinline__ unsigned cvt_pk_bf16(float lo, float hi) { unsigned r; asm volatile("v_cvt_pk_bf16_f32 %0, %1, %2" : "=v"(r) : "v"(lo), "v"(hi)); return r; }

template <class Epi, class Sched>
__device__ __forceinline__ void gemm_phase(PG8_LAS unsigned char* lds, const Gemm g, const Sched& S, const Epi& E) {
    const int tid = threadIdx.x, wid = __builtin_amdgcn_readfirstlane(tid >> 6), lane = tid & 63, wr = wid >> 2, wc = wid & 3, fr = lane & 15, fq = lane >> 4;
    const int K = g.K, nt = K / BK;
    unsigned voffA[2], voffB[2];
#pragma unroll
    for (int i = 0; i < 2; ++i) { int R, C; stage_rc(tid * 16 + i * 8192, R, C); const int Rb = Epi::PERM ? ((R & ~31) + perm32(R & 31)) : R;
        voffA[i] = (unsigned)(R * K + C) * 2u; voffB[i] = (unsigned)(Rb * K + C) * 2u; }
    const size_t kstep = (size_t)(BK * 2);
    const size_t hstep = (size_t)HALF * K * 2;
    const size_t tstep = 2 * hstep;
    const unsigned ldsw = (unsigned)wid * 1024u;
    const int aoff = lds_byte(wr * 64 + fr, fq * 8), boff = lds_byte(wc * 32 + fr, fq * 8);
#define PG8_SA(b, h) (((b) * 2 + (h)) * HTB)
#define PG8_SB(b, h) ((4 + (b) * 2 + (h)) * HTB)
#define PG8_STAGE(bufoff, gbase, voff) do { _Pragma("unroll") for (int _i = 0; _i < 2; ++_i) \
        __builtin_amdgcn_global_load_lds((const unsigned*)((const char*)(gbase) + (voff)[_i]), (PG8_LAS unsigned*)(lds + (bufoff) + ldsw + _i * 8192), 16, 0, 0); } while (0)
#define PG8_LDA(dst, b, h) do { _Pragma("unroll") for (int m = 0; m < 4; ++m) _Pragma("unroll") for (int k = 0; k < 2; ++k) dst[m][k] = *(const PG8_LAS bf16x8*)(lds + PG8_SA(b, h) + aoff + m * 2048 + k * 1024); } while (0)
#define PG8_LDB(dst, b, h) do { _Pragma("unroll") for (int n = 0; n < 2; ++n) _Pragma("unroll") for (int k = 0; k < 2; ++k) dst[n][k] = *(const PG8_LAS bf16x8*)(lds + PG8_SB(b, h) + boff + n * 2048 + k * 1024); } while (0)
#define PG8_MMA(ai, bj, At, Bt) do { __builtin_amdgcn_s_setprio(1); _Pragma("unroll") for (int m = 0; m < 4; ++m) _Pragma("unroll") for (int n = 0; n < 2; ++n) _Pragma("unroll") for (int k = 0; k < 2; ++k) \
        acc[ai][bj][m][n] = __builtin_amdgcn_mfma_f32_16x16x32_bf16(Bt[n][k], At[m][k], acc[ai][bj][m][n], 0, 0, 0); __builtin_amdgcn_s_setprio(0); } while (0)
#define PG8_WAIT_V(n) asm volatile("s_waitcnt vmcnt(" #n ")" ::: "memory")
#define PG8_WAIT_L(n) asm volatile("s_waitcnt lgkmcnt(" #n ")" ::: "memory")
#define PG8_BAR __builtin_amdgcn_s_barrier()
#define PG8_SCHED __builtin_amdgcn_sched_barrier(0)
    Unit cur, nxt; int ui = 0;
    if (!S.next(0, cur)) return;
    f32x4 acc[2][2][4][2];
#pragma unroll
    for (int a = 0; a < 2; ++a)
#pragma unroll
        for (int b = 0; b < 2; ++b)
#pragma unroll
            for (int m = 0; m < 4; ++m)
#pragma unroll
                for (int n = 0; n < 2; ++n) acc[a][b][m][n] = (f32x4){0.f, 0.f, 0.f, 0.f};
    bf16x8 At[4][2], B0[2][2], B1[2][2];
    const char* cA = (const char*)g.A + (size_t)cur.pm * tstep; const char* cB = (const char*)g.Bt + (size_t)cur.pn * tstep;
    S.a_ready(cur);
    PG8_STAGE(PG8_SB(0, 0), cB, voffB); PG8_STAGE(PG8_SA(0, 0), cA, voffA); PG8_STAGE(PG8_SB(0, 1), cB + hstep, voffB); PG8_STAGE(PG8_SA(0, 1), cA + hstep, voffA);
    if (wr == 1) PG8_BAR;
    PG8_WAIT_V(4); PG8_BAR;
    PG8_STAGE(PG8_SB(1, 0), cB + kstep, voffB); PG8_STAGE(PG8_SA(1, 0), cA + kstep, voffA); PG8_STAGE(PG8_SB(1, 1), cB + hstep + kstep, voffB);
    PG8_WAIT_V(6); PG8_BAR;
    for (;;) {
        const bool has_next = S.next(ui + 1, nxt);
        const char* nA = has_next ? (const char*)g.A + (size_t)nxt.pm * tstep : cA; const char* nB = has_next ? (const char*)g.Bt + (size_t)nxt.pn * tstep : cB;
        for (int t = 0; t < nt; t += 2) {
            const bool last = (t == nt - 2);
            const char* a1 = cA + (size_t)(t + 1) * kstep;
            const char* a2 = last ? nA : cA + (size_t)(t + 2) * kstep; const char* b2 = last ? nB : cB + (size_t)(t + 2) * kstep;
            const char* a3 = a2 + kstep; const char* b3 = b2 + kstep;
            if (last && has_next) S.a_ready(nxt);
            PG8_LDB(B0, 0, 0); PG8_SCHED; PG8_LDA(At, 0, 0); PG8_STAGE(PG8_SA(1, 1), a1 + hstep, voffA);
            PG8_WAIT_L(8); PG8_BAR; PG8_WAIT_L(0); PG8_MMA(0, 0, At, B0); PG8_BAR; PG8_SCHED;
            PG8_LDB(B1, 0, 1); PG8_STAGE(PG8_SB(0, 0), b2, voffB);
            PG8_BAR; PG8_WAIT_L(0); PG8_MMA(0, 1, At, B1); PG8_BAR;
            PG8_LDA(At, 0, 1); PG8_STAGE(PG8_SA(0, 0), a2, voffA);
            PG8_BAR; PG8_WAIT_L(0); PG8_MMA(1, 0, At, B0); PG8_BAR; PG8_SCHED;
            PG8_STAGE(PG8_SB(0, 1), b2 + hstep, voffB);
            PG8_WAIT_V(6); PG8_BAR; PG8_MMA(1, 1, At, B1); PG8_BAR;
            PG8_LDB(B0, 1, 0); PG8_SCHED; PG8_LDA(At, 1, 0); PG8_STAGE(PG8_SA(0, 1), a2 + hstep, voffA);
            PG8_WAIT_L(8); PG8_BAR; PG8_WAIT_L(0); PG8_MMA(0, 0, At, B0); PG8_BAR; PG8_SCHED;
            PG8_LDB(B1, 1, 1); PG8_STAGE(PG8_SB(1, 0), b3, voffB);
            PG8_BAR; PG8_WAIT_L(0); PG8_MMA(0, 1, At, B1); PG8_BAR;
            PG8_LDA(At, 1, 1); PG8_STAGE(PG8_SA(1, 0), a3, voffA);
            PG8_BAR; PG8_WAIT_L(0); PG8_MMA(1, 0, At, B0); PG8_BAR; PG8_SCHED;
            PG8_STAGE(PG8_SB(1, 1), b3 + hstep, voffB);
            PG8_WAIT_V(6); PG8_BAR; PG8_MMA(1, 1, At, B1); PG8_BAR;
        }
            if constexpr (!Epi::AFTER_DRAIN) { E(acc, cur, wr, wc, fr, fq); S.done(cur); }
            if (!has_next) break;
#pragma unroll
        for (int a = 0; a < 2; ++a)
#pragma unroll
            for (int b = 0; b < 2; ++b)
#pragma unroll
                for (int m = 0; m < 4; ++m)
#pragma unroll
                    for (int n = 0; n < 2; ++n) acc[a][b][m][n] = (f32x4){0.f, 0.f, 0.f, 0.f};
        cur = nxt; cA = nA; cB = nB; ++ui;
    }
    PG8_WAIT_V(0);
    if (wr == 0) PG8_BAR;
    PG8_BAR;
    if constexpr (Epi::AFTER_DRAIN) { E.fused(acc, cur, wr, wc, fr, fq, lds, wid, lane); S.done(cur); }
#undef PG8_SA
#undef PG8_SB
#undef PG8_STAGE
#undef PG8_LDA
#undef PG8_LDB
#undef PG8_MMA
#undef PG8_WAIT_V
#undef PG8_WAIT_L
#undef PG8_BAR
#undef PG8_SCHED
}

}

struct EpiInproj {
  static constexpr bool PERM = true, AFTER_DRAIN = false;
  bfu* u; float* small;
  __device__ __forceinline__ void operator()(const pg8::f32x4 (&acc)[2][2][4][2], const pg8::Unit& un, int wr, int wc, int fr, int fq) const {
    const int row0 = un.pm * 256 + wr * 64 + fr;
    if (un.pn < 32) {
      const bool sig = un.pn >= 16;
      const int col0 = un.pn * 256 + wc * 32 + 8 * fq;
#pragma unroll
      for (int ai = 0; ai < 2; ++ai)
#pragma unroll
        for (int m = 0; m < 4; ++m) {
          bfu* rowp = u + (size_t)(row0 + ai * 128 + m * 16) * NU + col0;
#pragma unroll
          for (int bj = 0; bj < 2; ++bj) {
            pg8::f32x4 v0 = acc[ai][bj][m][0], v1 = acc[ai][bj][m][1];
            if (sig) {
#pragma unroll
              for (int j = 0; j < 4; ++j) { v0[j] = sigmoidf_(v0[j]); v1[j] = sigmoidf_(v1[j]); }
            }
            pg8::u32x4 w;
            w.x = pg8::cvt_pk_bf16(v0[0], v0[1]); w.y = pg8::cvt_pk_bf16(v0[2], v0[3]);
            w.z = pg8::cvt_pk_bf16(v1[0], v1[1]); w.w = pg8::cvt_pk_bf16(v1[2], v1[3]);
            *(pg8::u32x4*)(rowp + bj * 128) = w;
          }
        }
    } else if (wc == 0) {
#pragma unroll
      for (int ai = 0; ai < 2; ++ai)
#pragma unroll
        for (int m = 0; m < 4; ++m) {
          float* sp = small + (size_t)(row0 + ai * 128 + m * 16) * 32 + 8 * fq;
          *(pg8::f32x4*)(sp) = acc[ai][0][m][0];
          *(pg8::f32x4*)(sp + 4) = acc[ai][0][m][1];
        }
    }
  }
};
struct EpiResid {
  static constexpr bool PERM = false, AFTER_DRAIN = false;
  const float* xold; float* out;
  __device__ __forceinline__ void operator()(const pg8::f32x4 (&acc)[2][2][4][2], const pg8::Unit& un, int wr, int wc, int fr, int fq) const {
    const int row0 = un.pm * 256 + wr * 64 + fr, col0 = un.pn * 256 + wc * 32 + 4 * fq;
#pragma unroll
    for (int ai = 0; ai < 2; ++ai)
#pragma unroll
      for (int m = 0; m < 4; ++m) {
        const size_t off = (size_t)(row0 + ai * 128 + m * 16) * DM + col0;
#pragma unroll
        for (int bj = 0; bj < 2; ++bj)
#pragma unroll
          for (int n = 0; n < 2; ++n) {
            const pg8::f32x4 b = *(const pg8::f32x4*)(xold + off + bj * 128 + n * 16);
            *(pg8::f32x4*)(out + off + bj * 128 + n * 16) = b + acc[ai][bj][m][n];
          }
        asm volatile("" ::: "memory");
      }
  }
};
struct EpiSwiglu {
  static constexpr bool PERM = true, AFTER_DRAIN = false;
  bfu* hidden;
  __device__ __forceinline__ void operator()(const pg8::f32x4 (&acc)[2][2][4][2], const pg8::Unit& un, int wr, int wc, int fr, int fq) const {
    const int row0 = un.pm * 256 + wr * 64 + fr;
#pragma unroll
    for (int ai = 0; ai < 2; ++ai)
#pragma unroll
      for (int m = 0; m < 4; ++m) {
        bfu* rowp = hidden + (size_t)(row0 + ai * 128 + m * 16) * FH + (un.pn * 8 + wc) * 16 + 4 * fq;
#pragma unroll
        for (int bj = 0; bj < 2; ++bj) {
          const pg8::f32x4 g = acc[ai][bj][m][0], uu = acc[ai][bj][m][1];
          pg8::u32x2 w;
          w.x = pg8::cvt_pk_bf16(siluf_(g[0]) * uu[0], siluf_(g[1]) * uu[1]);
          w.y = pg8::cvt_pk_bf16(siluf_(g[2]) * uu[2], siluf_(g[3]) * uu[3]);
          *(pg8::u32x2*)(rowp + bj * 64) = w;
        }
      }
  }
};

__device__ __forceinline__ void grid_barrier(unsigned* ctr, unsigned target) {
  asm volatile("s_waitcnt vmcnt(0)" ::: "memory");
  __syncthreads();
  if (threadIdx.x == 0) {
    __builtin_amdgcn_fence(__ATOMIC_RELEASE, "agent");
    asm volatile("s_waitcnt vmcnt(0)" ::: "memory");
    __hip_atomic_fetch_add(ctr, 1u, __ATOMIC_RELAXED, __HIP_MEMORY_SCOPE_AGENT);
    while (__hip_atomic_load(ctr, __ATOMIC_RELAXED, __HIP_MEMORY_SCOPE_AGENT) < target) __builtin_amdgcn_s_sleep(1);
    __builtin_amdgcn_fence(__ATOMIC_ACQUIRE, "agent");
    asm volatile("s_waitcnt vmcnt(0)" ::: "memory");
  }
  __syncthreads();
}

__global__ void __launch_bounds__(NTHREADS, 2) mega(Params p_in, int ph_lo, int ph_hi, int use_cg) {
  extern __shared__ __attribute__((aligned(16))) unsigned char smem_raw[];
  unsigned nbar = 0;
  for (int ph = ph_lo; ph < ph_hi; ++ph) {
#if PROBE_DUP >= 0
    const int l = ph / (PH_PER_LAYER + 1);
    const int ks = ph - l * (PH_PER_LAYER + 1);
    const int k = (ks <= PROBE_DUP) ? ks : ks - 1;
    const int wr = (ks == PROBE_DUP) ? 0 : 1;
#else
    const int wr = 1;
    const int l = ph / PH_PER_LAYER, k = ph - l * PH_PER_LAYER;
#endif
    int t512 = threadIdx.x;
    asm volatile("" : "+v"(t512));
    const int tid = t512 & 255;
    const int half = __builtin_amdgcn_readfirstlane(t512 >> 8);
    const int vb = blockIdx.x * 2 + half, vg = gridDim.x * 2;
    bfu* smem = reinterpret_cast<bfu*>(smem_raw + half * SMEM_HALF);
    CParams* pp = (CParams*)__builtin_amdgcn_kernarg_segment_ptr();
    asm volatile("" : "+s"(pp));
    CParams& p = *pp;
    switch (k) {
      case 0: phase_convert_norm(p, l, smem, tid, vb, vg); break;
      case 1: {
        pg8::Gemm g; g.A = (bfu*)(p.ws + OFF_h); g.Bt = (bfu*)(p.ws + OFF_WinT); g.M = S_LEN; g.N = NINP; g.K = DM;
        pg8::StaticOrder so; so.init(S_LEN, NINP, gridDim.x, blockIdx.x);
        EpiInproj e; e.u = (bfu*)(p.ws + OFF_u); e.small = (float*)(p.ws + OFF_small);
        pg8::gemm_phase<EpiInproj, pg8::StaticOrder>((PG8_LAS unsigned char*)smem_raw, g, so, e);
      } break;
      case 2: phase_prep(p, l, smem, tid, wr, vb, vg); break;
      case 3: phase_scan(p, smem, tid, wr, vb, vg); break;
      case 4: phase_mix(p, l, smem, tid, half, ph, smem_raw); break;
      case 5: phase_upmerge(p, smem, tid, vb, vg); break;
      case 6: {
        pg8::Gemm g; g.A = (bfu*)(p.ws + OFF_h); g.Bt = (bfu*)(p.ws + OFF_WoutT); g.M = S_LEN; g.N = DM; g.K = DM;
        pg8::StaticOrder so; so.init(S_LEN, DM, gridDim.x, blockIdx.x);
        EpiResid e; e.xold = (l == 0 ? p.in[0] : p.out); e.out = p.out;
        pg8::gemm_phase<EpiResid, pg8::StaticOrder>((PG8_LAS unsigned char*)smem_raw, g, so, e);
      } break;
      case 7: phase_norm2(p, l, tid, vb, vg); break;
      case 8: {
        pg8::Gemm g; g.A = (bfu*)(p.ws + OFF_h); g.Bt = (bfu*)(p.ws + OFF_WfiT); g.M = S_LEN; g.N = 2 * FH; g.K = DM;
        pg8::StaticOrder so; so.init(S_LEN, 2 * FH, gridDim.x, blockIdx.x);
        EpiSwiglu e; e.hidden = (bfu*)(p.ws + OFF_u);
        pg8::gemm_phase<EpiSwiglu, pg8::StaticOrder>((PG8_LAS unsigned char*)smem_raw, g, so, e);
      } break;
      default: {
        pg8::Gemm g; g.A = (bfu*)(p.ws + OFF_u); g.Bt = (bfu*)(p.ws + OFF_WfoT); g.M = S_LEN; g.N = DM; g.K = FH;
        pg8::StaticOrder so; so.init(S_LEN, DM, gridDim.x, blockIdx.x);
        EpiResid e; e.xold = p.out; e.out = p.out;
        pg8::gemm_phase<EpiResid, pg8::StaticOrder>((PG8_LAS unsigned char*)smem_raw, g, so, e);
      } break;
    }
    if (ph + 1 < ph_hi) {
      if (use_cg) cg::this_grid().sync();
      else { ++nbar; grid_barrier((unsigned*)(p_in.ws + OFF_bar), nbar * gridDim.x); }
    }
  }
}

#ifndef MK_COOP
#define MK_COOP 1
#endif

extern "C" void kernel_launch(void* const* d_in, const int* in_sizes, int n_in, void* d_out, int out_size, void* d_ws,
                              size_t ws_size, hipStream_t stream) {
  Params p{};
  for (int i = 0; i < 25; ++i) p.in[i] = reinterpret_cast<const float*>(d_in[i]);
  p.out = reinterpret_cast<float*>(d_out);
  p.ws = reinterpret_cast<unsigned char*>(d_ws);
  if (WS_NEED > ws_size) { fprintf(stderr, "workspace too small: need %zu have %zu\n", (size_t)WS_NEED, ws_size); return; }

  static int grid_blocks = 0;
  if (!grid_blocks) {
    (void)hipFuncSetAttribute((const void*)mega, hipFuncAttributeMaxDynamicSharedMemorySize, SMEM_BYTES);
    int dev = 0, cus = 0, per_cu = 0;
    (void)hipGetDevice(&dev);
    (void)hipDeviceGetAttribute(&cus, hipDeviceAttributeMultiprocessorCount, dev);
    (void)hipOccupancyMaxActiveBlocksPerMultiprocessor(&per_cu, mega, NTHREADS, SMEM_BYTES);
    per_cu = 1;
    grid_blocks = cus * per_cu;
  }
  const int nph = 4 * (PH_PER_LAYER + (PROBE_DUP >= 0 ? 1 : 0));
#if MK_COOP
  int lo = 0, hi = nph, use_cg = 0;
  void* args[] = {&p, &lo, &hi, &use_cg};
  (void)hipMemsetAsync(p.ws + OFF_bar, 0, 256, stream);
  hipError_t e = hipLaunchCooperativeKernel((const void*)mega, dim3(grid_blocks), dim3(NTHREADS), args, SMEM_BYTES, stream);
  if (e != hipSuccess) fprintf(stderr, "cooperative launch failed: %s (grid %d)\n", hipGetErrorString(e), grid_blocks);
#else
  for (int ph = 0; ph < nph; ++ph)
    hipLaunchKernelGGL(mega, dim3(grid_blocks), dim3(NTHREADS), SMEM_BYTES, stream, p, ph, ph + 1, 0);
#endif
}
```

```cpp
#include <hip/hip_runtime.h>
#include <hip/hip_bf16.h>
#include <hip/hip_cooperative_groups.h>
#include <cstdio>
namespace cg = cooperative_groups;

typedef __attribute__((ext_vector_type(8))) short bf16x8;
typedef __attribute__((ext_vector_type(4))) float f32x4;
typedef unsigned short bfu;

#define S_LEN 16384
#define DM 1024
#define NU 8192
#define NINP 8448
#define NSRC 8220
#define FH 2816
#define NCH 256
#define LDP 72
#define YW 1280
#define EPS 1e-6f
#define SMEM_HALF 73728
#define SMEM_BYTES 147456
#define NTHREADS 512
#define PH_PER_LAYER 10
#ifndef PROBE_DUP
#define PROBE_DUP -1
#endif

struct Params {
  const float* in[25];
  float* out;
  unsigned char* ws;
};
typedef const __attribute__((address_space(4))) Params CParams;
constexpr size_t OFF_WinT = 0;
constexpr size_t OFF_WupT = OFF_WinT + (((size_t)NINP*DM*2 + 255) & ~(size_t)255);
constexpr size_t OFF_WoutT = OFF_WupT + (((size_t)DM*YW*2 + 255) & ~(size_t)255);
constexpr size_t OFF_WfiT = OFF_WoutT + (((size_t)DM*DM*2 + 255) & ~(size_t)255);
constexpr size_t OFF_WfoT = OFF_WfiT + (((size_t)2*FH*DM*2 + 255) & ~(size_t)255);
constexpr size_t OFF_u = OFF_WfoT + (((size_t)DM*FH*2 + 255) & ~(size_t)255);
constexpr size_t OFF_small = OFF_u + (((size_t)S_LEN*NU*2 + 255) & ~(size_t)255);
constexpr size_t OFF_h = OFF_small + (((size_t)S_LEN*32*4 + 255) & ~(size_t)255);
constexpr size_t OFF_y = OFF_h + (((size_t)S_LEN*DM*2 + 255) & ~(size_t)255);
constexpr size_t OFF_ssq = OFF_y + (((size_t)S_LEN*YW*2 + 255) & ~(size_t)255);
constexpr size_t OFF_foxq = OFF_ssq + (((size_t)S_LEN*8*4 + 255) & ~(size_t)255);
constexpr size_t OFF_foxk = OFF_foxq + (((size_t)4*S_LEN*64*2 + 255) & ~(size_t)255);
constexpr size_t OFF_foxvT = OFF_foxk + (((size_t)4*S_LEN*64*2 + 255) & ~(size_t)255);
constexpr size_t OFF_foxc = OFF_foxvT + (((size_t)4*S_LEN*64*2 + 255) & ~(size_t)255);
constexpr size_t OFF_foxtot = OFF_foxc + (((size_t)4*S_LEN*4 + 255) & ~(size_t)255);
constexpr size_t OFF_VT = OFF_foxtot + (((size_t)4*NCH*4 + 255) & ~(size_t)255);
constexpr size_t OFF_ST = OFF_VT + (((size_t)16*NCH*4096*2 + 255) & ~(size_t)255);
constexpr size_t OFF_dec = OFF_ST + (((size_t)16*NCH*4096*2 + 255) & ~(size_t)255);
constexpr size_t OFF_csb = OFF_dec + (((size_t)16*NCH*64*4 + 255) & ~(size_t)255);
constexpr size_t OFF_ssdX = OFF_csb + (((size_t)16*S_LEN*4 + 255) & ~(size_t)255);
constexpr size_t OFF_ssdB = OFF_ssdX + (((size_t)S_LEN*512*2 + 255) & ~(size_t)255);
constexpr size_t OFF_ssdC = OFF_ssdB + (((size_t)2*S_LEN*64*2 + 255) & ~(size_t)255);
constexpr size_t OFF_rcos = OFF_ssdC + (((size_t)2*S_LEN*64*2 + 255) & ~(size_t)255);
constexpr size_t OFF_rsin = OFF_rcos + (((size_t)S_LEN*32*4 + 255) & ~(size_t)255);
constexpr size_t OFF_ctr = OFF_rsin + (((size_t)S_LEN*32*4 + 255) & ~(size_t)255);
constexpr size_t OFF_bar = OFF_ctr + (((size_t)256 + 255) & ~(size_t)255);
constexpr size_t WS_NEED = OFF_bar + 256;

__device__ __forceinline__ bfu f2bf(float f) {
  unsigned u = __float_as_uint(f);
  u += 0x7fffu + ((u >> 16) & 1u);
  return (bfu)(u >> 16);
}
__device__ __forceinline__ float bf2f(bfu b) { return __uint_as_float(((unsigned)b) << 16); }
__device__ __forceinline__ float sigmoidf_(float x) { return 1.f / (1.f + __expf(-x)); }
__device__ __forceinline__ float siluf_(float x) { return x / (1.f + __expf(-x)); }
__device__ __forceinline__ float logsigmoidf_(float z) { return fminf(z, 0.f) - log1pf(expf(-fabsf(z))); }
__device__ __forceinline__ float logsigmoid_fast(float z) { return fminf(z, 0.f) - __logf(1.f + __expf(-fabsf(z))); }
__device__ __forceinline__ float softplus_fast(float z) { return fmaxf(z, 0.f) + __logf(1.f + __expf(-fabsf(z))); }
__device__ __forceinline__ float softplusf_(float z) { return fmaxf(z, 0.f) + log1pf(expf(-fabsf(z))); }

namespace pg8 { __device__ __forceinline__ unsigned cvt_pk_bf16(float lo, float hi); }
__device__ __forceinline__ bf16x8 lds_frag(const bfu* base, int row, int kofs, int stride) {
  return *reinterpret_cast<const bf16x8*>(base + row * stride + kofs);
}

__device__ __forceinline__ void mma16x64(f32x4 (&acc)[4], const bfu* sA, int arow0, const bfu* sB, int lane) {
  const int r = lane & 15, q = (lane >> 4) * 8;
#pragma unroll
  for (int ks = 0; ks < 2; ++ks) {
    bf16x8 a = lds_frag(sA, arow0 + r, ks * 32 + q, LDP);
#pragma unroll
    for (int n = 0; n < 4; ++n) {
      bf16x8 b = lds_frag(sB, n * 16 + r, ks * 32 + q, LDP);
      acc[n] = __builtin_amdgcn_mfma_f32_16x16x32_bf16(a, b, acc[n], 0, 0, 0);
    }
  }
}

__device__ __forceinline__ void load_tile64(bfu* s, const bfu* g, int gs, int tid) {
#pragma unroll
  for (int i = 0; i < 2; ++i) {
    int id = tid + i * 256;
    int r = id >> 3, c = (id & 7) * 8;
    *reinterpret_cast<uint4*>(s + r * LDP + c) = *reinterpret_cast<const uint4*>(g + (size_t)r * gs + c);
  }
}

template <int NI>
__device__ __forceinline__ void gemm_main(f32x4 (&acc)[4][NI], const bfu* __restrict__ A, int lda,
                                          const bfu* __restrict__ Bt, int ldb, int K, bfu* smem, int tid) {
  bfu* sA = smem;
  bfu* sB = smem + 2 * 128 * LDP;
  const int lane = tid & 63, w = tid >> 6, wm = w >> 1, wn = w & 1;
  const int lr = lane & 15, lq = (lane >> 4) * 8;
  const int crow = tid >> 3, ccol = (tid & 7) * 8;
  const bfu* Ap = A + (size_t)crow * lda + ccol;
  const bfu* Bp = Bt + (size_t)crow * ldb + ccol;
  uint4 ra[4], rb[NI];
#pragma unroll
  for (int i = 0; i < 4; ++i) ra[i] = *reinterpret_cast<const uint4*>(Ap + (size_t)i * 32 * lda);
#pragma unroll
  for (int i = 0; i < NI; ++i) rb[i] = *reinterpret_cast<const uint4*>(Bp + (size_t)i * 32 * ldb);
#pragma unroll
  for (int i = 0; i < 4; ++i) *reinterpret_cast<uint4*>(sA + (crow + i * 32) * LDP + ccol) = ra[i];
#pragma unroll
  for (int i = 0; i < NI; ++i) *reinterpret_cast<uint4*>(sB + (crow + i * 32) * LDP + ccol) = rb[i];
  __syncthreads();
  const int nk = K >> 6;
  for (int kt = 0; kt < nk; ++kt) {
    const int cur = kt & 1;
    if (kt + 1 < nk) {
      const int ko = (kt + 1) * 64;
#pragma unroll
      for (int i = 0; i < 4; ++i) ra[i] = *reinterpret_cast<const uint4*>(Ap + (size_t)i * 32 * lda + ko);
#pragma unroll
      for (int i = 0; i < NI; ++i) rb[i] = *reinterpret_cast<const uint4*>(Bp + (size_t)i * 32 * ldb + ko);
    }
    const bfu* a_s = sA + cur * 128 * LDP + (wm * 64) * LDP;
    const bfu* b_s = sB + cur * 128 * LDP + (wn * NI * 16) * LDP;
#pragma unroll
    for (int ks = 0; ks < 2; ++ks) {
      bf16x8 af[4], bfr[NI];
#pragma unroll
      for (int mi = 0; mi < 4; ++mi) af[mi] = lds_frag(a_s, mi * 16 + lr, ks * 32 + lq, LDP);
#pragma unroll
      for (int ni = 0; ni < NI; ++ni) bfr[ni] = lds_frag(b_s, ni * 16 + lr, ks * 32 + lq, LDP);
#pragma unroll
      for (int mi = 0; mi < 4; ++mi)
#pragma unroll
        for (int ni = 0; ni < NI; ++ni)
          acc[mi][ni] = __builtin_amdgcn_mfma_f32_16x16x32_bf16(af[mi], bfr[ni], acc[mi][ni], 0, 0, 0);
    }
    if (kt + 1 < nk) {
      bfu* sAn = sA + (cur ^ 1) * 128 * LDP;
      bfu* sBn = sB + (cur ^ 1) * 128 * LDP;
#pragma unroll
      for (int i = 0; i < 4; ++i) *reinterpret_cast<uint4*>(sAn + (crow + i * 32) * LDP + ccol) = ra[i];
#pragma unroll
      for (int i = 0; i < NI; ++i) *reinterpret_cast<uint4*>(sBn + (crow + i * 32) * LDP + ccol) = rb[i];
    }
    __syncthreads();
  }
}

template <int NI>
__device__ __forceinline__ void zero_acc(f32x4 (&acc)[4][NI]) {
#pragma unroll
  for (int i = 0; i < 4; ++i)
#pragma unroll
    for (int j = 0; j < NI; ++j) acc[i][j] = (f32x4){0.f, 0.f, 0.f, 0.f};
}

__device__ __forceinline__ int win_src(int dc) {
  if (dc < 768) return dc;
  if (dc < 1536) return dc + 4;
  if (dc < 4096) return dc + 20;
  if (dc < 8192) return dc + 28;
  int s = dc - 8192;
  if (s < 4) return 768 + s;
  if (s < 20) return 1540 + (s - 4);
  if (s < 28) return 4116 + (s - 20);
  return -1;
}
__device__ __forceinline__ int ffi_src(int dc) {
  const int G = dc >> 5, w = dc & 31, f = w >> 3, r = w & 7;
  return (r < 4) ? (G * 16 + f * 4 + r) : (FH + G * 16 + f * 4 + (r - 4));
}

__device__ __forceinline__ void convert_tile(const float* __restrict__ W, int ldw, int kt, int ntd, bfu* __restrict__ Wt,
                                             int ldt, int kofs, int mode, const float* __restrict__ rowgain,
                                             bfu* sT, int tid) {
  const int c4 = (tid & 15) * 4, r0 = tid >> 4;
  const int dc = ntd * 64 + c4;
  int sc = dc;
  if (mode == 1) sc = win_src(dc);
  else if (mode == 2) sc = ffi_src(dc);
  float4 v[8];
  float gg[8];
#pragma unroll
  for (int ps = 0; ps < 8; ++ps) {
    const int k = kt * 64 + r0 + ps * 16;
    v[ps] = make_float4(0.f, 0.f, 0.f, 0.f);
    if (sc >= 0) v[ps] = *reinterpret_cast<const float4*>(W + (size_t)k * ldw + sc);
    gg[ps] = rowgain ? rowgain[k] : 1.f;
  }
#pragma unroll
  for (int ps = 0; ps < 8; ++ps) {
    const int kk = r0 + (ps & 3) * 16;
    bfu* sTt = sT + (ps >> 2) * 64 * LDP;
    const float g = gg[ps];
    sTt[(c4 + 0) * LDP + kk] = f2bf(v[ps].x * g);
    sTt[(c4 + 1) * LDP + kk] = f2bf(v[ps].y * g);
    sTt[(c4 + 2) * LDP + kk] = f2bf(v[ps].z * g);
    sTt[(c4 + 3) * LDP + kk] = f2bf(v[ps].w * g);
  }
  __syncthreads();
#pragma unroll
  for (int i = 0; i < 4; ++i) {
    const int id = tid + (i & 1) * 256;
    const int nn = id >> 3, kc = (id & 7) * 8;
    const int tt = i >> 1;
    *reinterpret_cast<uint4*>(Wt + (size_t)(ntd * 64 + nn) * ldt + kofs + (kt + tt) * 64 + kc) =
        *reinterpret_cast<const uint4*>(sT + tt * 64 * LDP + nn * LDP + kc);
  }
  __syncthreads();
}

__device__ void phase_convert_norm(CParams& p_o, int l, bfu* smem, int tid, int vb, int vg) {
  const int nconv = 2400, nnorm = 4096;
  const int nrot = (l == 0) ? 64 : 0;
  const int total = nconv + nnorm + nrot;
  if (l == 0 && vb == 0 && tid < 64) ((unsigned*)(p_o.ws + OFF_ctr))[tid] = 0u;
  for (int it = vb; it < total; it += vg) {
    CParams* pp_ = &p_o;
    asm volatile("" : "+s"(pp_));
    CParams& p = *pp_;
    if (it < nconv) {
      if (it < 1056) {
        int kt = (it & 7) * 2, nt = it >> 3;
        convert_tile(p.in[4] + (size_t)l * DM * NSRC, NSRC, kt, nt, ((bfu*)(p.ws + OFF_WinT)), DM, 0, 1, nullptr, smem, tid);
      } else if (it < 1152) {
        int j = it - 1056; int br = j >> 5; j &= 31;
        int kt = (j & 1) * 2, nt = j >> 1;
        const float* W = (br == 0 ? p.in[18] : (br == 1 ? p.in[19] : p.in[20])) + (size_t)l * 256 * DM;
        convert_tile(W, DM, kt, nt, ((bfu*)(p.ws + OFF_WupT)), YW, br * 256, 0, nullptr, smem, tid);
      } else if (it < 1216) {
        int j = it - 1152; int kt = (j & 3) * 2, nt = j >> 2;
        convert_tile(p.in[21] + (size_t)l * 512 * DM, DM, kt, nt, ((bfu*)(p.ws + OFF_WupT)), YW, 768, 0, p.in[17] + l * 512, smem, tid);
      } else if (it < 1344) {
        int j = it - 1216; int kt = (j & 7) * 2, nt = j >> 3;
        convert_tile(p.in[22] + (size_t)l * DM * DM, DM, kt, nt, ((bfu*)(p.ws + OFF_WoutT)), DM, 0, 0, nullptr, smem, tid);
      } else if (it < 2048) {
        int j = it - 1344; int kt = (j & 7) * 2, nt = j >> 3;
        convert_tile(p.in[23] + (size_t)l * DM * 2 * FH, 2 * FH, kt, nt, ((bfu*)(p.ws + OFF_WfiT)), DM, 0, 2, nullptr, smem, tid);
      } else {
        int j = it - 2048; int kt = (j % 22) * 2, nt = j / 22;
        convert_tile(p.in[24] + (size_t)l * FH * DM, DM, kt, nt, ((bfu*)(p.ws + OFF_WfoT)), FH, 0, 0, nullptr, smem, tid);
      }
    } else if (it < nconv + nnorm) {
      int row = (it - nconv) * 4 + (tid >> 6);
      int lane = tid & 63;
      const float* xr = (l == 0 ? p.in[0] : p.out) + (size_t)row * DM;
      const float* g = p.in[2] + l * DM;
      float4 v[4];
      float ss = 0.f;
#pragma unroll
      for (int i = 0; i < 4; ++i) {
        v[i] = *reinterpret_cast<const float4*>(xr + i * 256 + lane * 4);
        ss += v[i].x * v[i].x + v[i].y * v[i].y + v[i].z * v[i].z + v[i].w * v[i].w;
      }
#pragma unroll
      for (int m = 1; m < 64; m <<= 1) ss += __shfl_xor(ss, m, 64);
      float rstd = rsqrtf(ss * (1.f / DM) + EPS);
#pragma unroll
      for (int i = 0; i < 4; ++i) {
        float4 gg = *reinterpret_cast<const float4*>(g + i * 256 + lane * 4);
        ushort4 o;
        o.x = f2bf(v[i].x * rstd * gg.x); o.y = f2bf(v[i].y * rstd * gg.y);
        o.z = f2bf(v[i].z * rstd * gg.z); o.w = f2bf(v[i].w * rstd * gg.w);
        *reinterpret_cast<ushort4*>(((bfu*)(p.ws + OFF_h)) + (size_t)row * DM + i * 256 + lane * 4) = o;
      }
    } else {
      int base = (it - nconv - nnorm) * 256;
      for (int e = tid; e < 256 * 32; e += 256) {
        int tok = base + (e >> 5), i = e & 31;
        float inv = powf(10000.f, -(float)i / 32.f);
        float ang = (float)((const int*)p.in[1])[tok] * inv;
        double a = (double)ang;
        double kq = rint(a * 0.15915494309189535);
        float r = (float)(a - kq * 6.283185307179586);
        ((float*)(p.ws + OFF_rcos))[tok * 32 + i] = cosf(r);
        ((float*)(p.ws + OFF_rsin))[tok * 32 + i] = sinf(r);
      }
    }
  }
}

__device__ void phase_norm2(CParams& p, int l, int tid, int vb, int vg) {
  for (int it = vb; it < 4096; it += vg) {
    int row = it * 4 + (tid >> 6);
    int lane = tid & 63;
    const float* xr = p.out + (size_t)row * DM;
    const float* g = p.in[3] + l * DM;
    float4 v[4];
    float ss = 0.f;
#pragma unroll
    for (int i = 0; i < 4; ++i) {
      v[i] = *reinterpret_cast<const float4*>(xr + i * 256 + lane * 4);
      ss += v[i].x * v[i].x + v[i].y * v[i].y + v[i].z * v[i].z + v[i].w * v[i].w;
    }
#pragma unroll
    for (int m = 1; m < 64; m <<= 1) ss += __shfl_xor(ss, m, 64);
    float rstd = rsqrtf(ss * (1.f / DM) + EPS);
#pragma unroll
    for (int i = 0; i < 4; ++i) {
      float4 gg = *reinterpret_cast<const float4*>(g + i * 256 + lane * 4);
      ushort4 o;
      o.x = f2bf(v[i].x * rstd * gg.x); o.y = f2bf(v[i].y * rstd * gg.y);
      o.z = f2bf(v[i].z * rstd * gg.z); o.w = f2bf(v[i].w * rstd * gg.w);
      *reinterpret_cast<ushort4*>(((bfu*)(p.ws + OFF_h)) + (size_t)row * DM + i * 256 + lane * 4) = o;
    }
  }
}

__device__ __forceinline__ float wave_incl_scan(float v, int lane) {
#pragma unroll
  for (int d = 1; d < 64; d <<= 1) {
    float o = __shfl_up(v, d, 64);
    if (lane >= d) v += o;
  }
  return v;
}

__device__ void phase_prep(CParams& p_o, int l, bfu* smem, int tid, int wr, int vb, int vg) {
  bfu* sK = smem;
  bfu* sV = smem + 64 * LDP;
  float* sF = reinterpret_cast<float*>(smem + 2 * 64 * LDP);
  float* s_glr = sF;
  float* s_seg = sF + 1024;
  float* s_ps = sF + 1280;
  float* s_cs = sF + 1344;
  float* s_dt = sF + 1408;
  const int lane = tid & 63, seg = tid >> 6, col = lane;
  const int total = NCH * 20;
  for (int it = vb; it < total; it += vg) {
    CParams* pp_ = &p_o;
    asm volatile("" : "+s"(pp_));
    CParams& p = *pp_;
    const int c = it / 20, hs = it - c * 20;
    const int tok0 = c * 64;
    bfu kreg[16], vreg[16];
    if (hs < 4) {
      const int h = hs;
      for (int i = tid; i < 1024; i += 256) s_glr[i] = ((float*)(p.ws + OFF_small))[(tok0 + (i >> 4)) * 32 + 4 + (i & 15)];
      float wv[16];
#pragma unroll
      for (int r = 0; r < 16; ++r) wv[r] = p.in[8][(l * 16 + r) * 256 + h * 64 + col];
      const float bias = p.in[9][l * 256 + h * 64 + col];
      bfu qraw[16], kraw[16];
#pragma unroll
      for (int i = 0; i < 16; ++i) {
        const bfu* ur = ((bfu*)(p.ws + OFF_u)) + (size_t)(tok0 + seg * 16 + i) * NU + h * 64 + col;
        qraw[i] = ur[768]; kraw[i] = ur[1024]; vreg[i] = ur[1280];
      }
      __syncthreads();
      float lb[16];
      float run = 0.f;
#pragma unroll
      for (int i = 0; i < 16; ++i) {
        int t = seg * 16 + i;
        float z = bias;
#pragma unroll
        for (int r = 0; r < 16; ++r) z += s_glr[t * 16 + r] * wv[r];
        run += logsigmoid_fast(z) * (1.f / 16.f);
        lb[i] = run;
      }
      s_seg[seg * 64 + col] = run;
      __syncthreads();
      float pre = 0.f, blast = 0.f;
#pragma unroll
      for (int s2 = 0; s2 < 4; ++s2) {
        float v = s_seg[s2 * 64 + col];
        if (s2 < seg) pre += v;
        blast += v;
      }
      if (seg == 0) {
        float e = __expf(blast);
        s_ps[col] = e;
        ((float*)(p.ws + OFF_dec))[(hs * NCH + c) * 64 + col] = e;
        ((float*)(p.ws + OFF_csb))[hs * S_LEN + tok0 + col] = 0.f;
      }
#pragma unroll
      for (int i = 0; i < 16; ++i) {
        int tok = tok0 + seg * 16 + i;
        float b = lb[i] + pre;
        bfu* ur = ((bfu*)(p.ws + OFF_u)) + (size_t)tok * NU + h * 64 + col;
        float q = bf2f(qraw[i]), k = bf2f(kraw[i]);
        bfu qd = f2bf(q * 0.125f * __expf(b));
        bfu ki = f2bf(k * __expf(-b));
        if (wr) { ur[768] = qd; ur[1024] = ki; }
        kreg[i] = ki;
      }
    } else if (hs < 8) {
      const int h = hs - 4;
      const float lg = log1pf(-exp2f(-5.f - (float)h));
      if (seg == 0) {
        s_ps[col] = 1.f;
        ((float*)(p.ws + OFF_dec))[(hs * NCH + c) * 64 + col] = __expf(64.f * lg);
        ((float*)(p.ws + OFF_csb))[hs * S_LEN + tok0 + col] = (float)(col + 1) * lg;
      }
#pragma unroll
      for (int i = 0; i < 16; ++i) {
        int t = seg * 16 + i, tok = tok0 + t;
        float cs = ((float*)(p.ws + OFF_rcos))[tok * 32 + (col & 31)], sn = ((float*)(p.ws + OFF_rsin))[tok * 32 + (col & 31)];
        bfu* ur = ((bfu*)(p.ws + OFF_u)) + (size_t)tok * NU + h * 64;
        float qo = bf2f(ur[1792 + col]), qx = bf2f(ur[1792 + (col ^ 32)]);
        float ko = bf2f(ur[2048 + col]), kx = bf2f(ur[2048 + (col ^ 32)]);
        vreg[i] = ur[2304 + col];
        float qr, kr;
        if (col < 32) { qr = qo * cs - qx * sn; kr = ko * cs - kx * sn; }
        else          { qr = qx * sn + qo * cs; kr = kx * sn + ko * cs; }
        kr *= 0.125f;
        bfu kb = f2bf(kr);
        if (wr) { ur[1792 + col] = f2bf(qr); ur[2048 + col] = kb; }
        kreg[i] = f2bf(bf2f(kb) * __expf(lg * (float)(63 - t)));
      }
    } else if (hs < 16) {
      const int h = hs - 8, g = h >> 2;
      const int chx = h * 64 + col, chb = 512 + g * 64 + col, chc = 640 + g * 64 + col;
      bfu xin[19], bin[19], cin[19];
      {
        const int tb = tok0 + seg * 16 - 3;
        const bfu* ub = ((bfu*)(p.ws + OFF_u)) + 3328;
#pragma unroll
        for (int i = 0; i < 19; ++i) {
          const int tk = tb + i;
          const bool ok = tk >= 0;
          const bfu* ur = ub + (size_t)(ok ? tk : 0) * NU;
          xin[i] = ok ? ur[chx] : (bfu)0;
          bin[i] = ok ? ur[chb] : (bfu)0;
          cin[i] = ok ? ur[chc] : (bfu)0;
        }
      }
      if (seg == 0) {
        float dtv = softplus_fast(((float*)(p.ws + OFF_small))[(tok0 + lane) * 32 + 20 + h] + p.in[14][l * 8 + h]);
        float a = -__expf(p.in[15][l * 8 + h]);
        float cs = wave_incl_scan(dtv * a, lane);
        s_cs[lane] = cs;
        s_dt[lane] = dtv;
        ((float*)(p.ws + OFF_csb))[hs * S_LEN + tok0 + lane] = cs;
        s_ps[lane] = 1.f;
      }
      __syncthreads();
      const float cs_last = s_cs[63];
      if (seg == 0) ((float*)(p.ws + OFF_dec))[(hs * NCH + c) * 64 + col] = __expf(cs_last);
      float wx[4], wb[4], wc[4];
#pragma unroll
      for (int j = 0; j < 4; ++j) {
        wx[j] = p.in[12][(l * 4 + j) * 768 + chx];
        wb[j] = p.in[12][(l * 4 + j) * 768 + chb];
        wc[j] = p.in[12][(l * 4 + j) * 768 + chc];
      }
      const float bx = p.in[13][l * 768 + chx], bb = p.in[13][l * 768 + chb], bc = p.in[13][l * 768 + chc];
#pragma unroll
      for (int i = 0; i < 16; ++i) {
        int t = seg * 16 + i, tok = tok0 + t;
        float xs = siluf_(bx + wx[0] * bf2f(xin[i]) + wx[1] * bf2f(xin[i + 1]) + wx[2] * bf2f(xin[i + 2]) + wx[3] * bf2f(xin[i + 3]));
        float bs = siluf_(bb + wb[0] * bf2f(bin[i]) + wb[1] * bf2f(bin[i + 1]) + wb[2] * bf2f(bin[i + 2]) + wb[3] * bf2f(bin[i + 3]));
        float cv = siluf_(bc + wc[0] * bf2f(cin[i]) + wc[1] * bf2f(cin[i + 1]) + wc[2] * bf2f(cin[i + 2]) + wc[3] * bf2f(cin[i + 3]));
        bfu xb = f2bf(xs);
        ((bfu*)(p.ws + OFF_ssdX))[(size_t)tok * 512 + chx] = xb;
        if ((h & 3) == 0) {
          ((bfu*)(p.ws + OFF_ssdB))[((size_t)g * S_LEN + tok) * 64 + col] = f2bf(bs);
          ((bfu*)(p.ws + OFF_ssdC))[((size_t)g * S_LEN + tok) * 64 + col] = f2bf(cv);
        }
        vreg[i] = f2bf(xs * s_dt[t]);
        kreg[i] = f2bf(bs * __expf(cs_last - s_cs[t]));
      }
    } else {
      const int h = hs - 16;
      if (seg == 0) {
        float lf = logsigmoid_fast(((float*)(p.ws + OFF_small))[(tok0 + lane) * 32 + h] + p.in[5][l * 4 + h]);
        float cs = wave_incl_scan(lf, lane);
        ((float*)(p.ws + OFF_foxc))[h * S_LEN + tok0 + lane] = cs;
        if (lane == 63) ((float*)(p.ws + OFF_foxtot))[h * NCH + c] = cs;
      }
      const float qg = p.in[6][l * 64 + col], kg = p.in[7][l * 64 + col];
#pragma unroll
      for (int i = 0; i < 16; ++i) {
        int tok = tok0 + seg * 16 + i;
        const bfu* ur = ((bfu*)(p.ws + OFF_u)) + (size_t)tok * NU + h * 64 + col;
        float q = bf2f(ur[0]), k = bf2f(ur[256]);
        vreg[i] = ur[512];
        float sq = q * q, sk = k * k;
#pragma unroll
        for (int m = 1; m < 64; m <<= 1) { sq += __shfl_xor(sq, m, 64); sk += __shfl_xor(sk, m, 64); }
        ((bfu*)(p.ws + OFF_foxq))[((size_t)h * S_LEN + tok) * 64 + col] = f2bf(q * rsqrtf(sq * (1.f / 64.f) + EPS) * qg * (0.125f * 1.44269504088896f));
        ((bfu*)(p.ws + OFF_foxk))[((size_t)h * S_LEN + tok) * 64 + col] = f2bf(k * rsqrtf(sk * (1.f / 64.f) + EPS) * kg);
      }
      uint4 v0, v1;
      v0.x = vreg[0] | ((unsigned)vreg[1] << 16); v0.y = vreg[2] | ((unsigned)vreg[3] << 16);
      v0.z = vreg[4] | ((unsigned)vreg[5] << 16); v0.w = vreg[6] | ((unsigned)vreg[7] << 16);
      v1.x = vreg[8] | ((unsigned)vreg[9] << 16); v1.y = vreg[10] | ((unsigned)vreg[11] << 16);
      v1.z = vreg[12] | ((unsigned)vreg[13] << 16); v1.w = vreg[14] | ((unsigned)vreg[15] << 16);
      bfu* dst = ((bfu*)(p.ws + OFF_foxvT)) + ((size_t)h * 64 + col) * S_LEN + tok0 + seg * 16;
      *reinterpret_cast<uint4*>(dst) = v0;
      *reinterpret_cast<uint4*>(dst + 8) = v1;
      continue;
    }
    {
      uint4 k0, k1, v0, v1;
      k0.x = kreg[0] | ((unsigned)kreg[1] << 16); k0.y = kreg[2] | ((unsigned)kreg[3] << 16);
      k0.z = kreg[4] | ((unsigned)kreg[5] << 16); k0.w = kreg[6] | ((unsigned)kreg[7] << 16);
      k1.x = kreg[8] | ((unsigned)kreg[9] << 16); k1.y = kreg[10] | ((unsigned)kreg[11] << 16);
      k1.z = kreg[12] | ((unsigned)kreg[13] << 16); k1.w = kreg[14] | ((unsigned)kreg[15] << 16);
      v0.x = vreg[0] | ((unsigned)vreg[1] << 16); v0.y = vreg[2] | ((unsigned)vreg[3] << 16);
      v0.z = vreg[4] | ((unsigned)vreg[5] << 16); v0.w = vreg[6] | ((unsigned)vreg[7] << 16);
      v1.x = vreg[8] | ((unsigned)vreg[9] << 16); v1.y = vreg[10] | ((unsigned)vreg[11] << 16);
      v1.z = vreg[12] | ((unsigned)vreg[13] << 16); v1.w = vreg[14] | ((unsigned)vreg[15] << 16);
      *reinterpret_cast<uint4*>(sK + col * LDP + seg * 16) = k0;
      *reinterpret_cast<uint4*>(sK + col * LDP + seg * 16 + 8) = k1;
      *reinterpret_cast<uint4*>(sV + col * LDP + seg * 16) = v0;
      *reinterpret_cast<uint4*>(sV + col * LDP + seg * 16 + 8) = v1;
      bfu* dst = ((bfu*)(p.ws + OFF_VT)) + (((size_t)hs * NCH + c) * 64 + col) * 64 + seg * 16;
      *reinterpret_cast<uint4*>(dst) = v0;
      *reinterpret_cast<uint4*>(dst + 8) = v1;
    }
    __syncthreads();
    {
      f32x4 acc[4];
#pragma unroll
      for (int n = 0; n < 4; ++n) acc[n] = (f32x4){0.f, 0.f, 0.f, 0.f};
      {
        const int r = lane & 15, q8 = (lane >> 4) * 8;
#pragma unroll
        for (int ks = 0; ks < 2; ++ks) {
          const bf16x8 vfr = lds_frag(sV, seg * 16 + r, ks * 32 + q8, LDP);
#pragma unroll
          for (int n = 0; n < 4; ++n)
            acc[n] = __builtin_amdgcn_mfma_f32_16x16x32_bf16(lds_frag(sK, n * 16 + r, ks * 32 + q8, LDP), vfr, acc[n], 0, 0, 0);
        }
      }
      bfu* st = ((bfu*)(p.ws + OFF_ST)) + ((size_t)hs * NCH + c) * 4096 + (seg * 16 + (lane & 15)) * 64 + (lane >> 4) * 4;
#pragma unroll
      for (int n = 0; n < 4; ++n) {
        const f32x4 ps = *reinterpret_cast<const f32x4*>(s_ps + n * 16 + (lane >> 4) * 4);
        uint2 wv;
        wv.x = pg8::cvt_pk_bf16(acc[n][0] * ps[0], acc[n][1] * ps[1]);
        wv.y = pg8::cvt_pk_bf16(acc[n][2] * ps[2], acc[n][3] * ps[3]);
        *reinterpret_cast<uint2*>(st + n * 16) = wv;
      }
    }
    __syncthreads();
  }
}

__device__ void phase_scan(CParams& p, bfu* smem, int tid, int wr, int vb, int vg) {
  float* s_x = reinterpret_cast<float*>(smem);
  const int g = tid >> 5, dp = tid & 31;
  for (int it = vb; it < 16 * 64; it += vg) {
    const int hs = it >> 6, e = it & 63;
    unsigned* stp = reinterpret_cast<unsigned*>(((bfu*)(p.ws + OFF_ST)) + ((size_t)hs * NCH + g * 32) * 4096 + e * 64 + dp * 2);
    const float2* dcp = reinterpret_cast<const float2*>(((float*)(p.ws + OFF_dec)) + ((size_t)hs * NCH + g * 32) * 64 + dp * 2);
    unsigned kv[32];
    float2 dc[32];
#pragma unroll
    for (int i = 0; i < 32; ++i) {
      kv[i] = stp[(size_t)i * 2048];
      dc[i] = dcp[i * 32];
    }
    float t0 = 0.f, t1 = 0.f, d0 = 1.f, d1 = 1.f;
#pragma unroll
    for (int i = 0; i < 32; ++i) {
      t0 = t0 * dc[i].x + bf2f((bfu)(kv[i] & 0xffffu));
      t1 = t1 * dc[i].y + bf2f((bfu)(kv[i] >> 16));
      d0 *= dc[i].x;
      d1 *= dc[i].y;
    }
    *reinterpret_cast<float4*>(s_x + (g * 32 + dp) * 4) = make_float4(t0, t1, d0, d1);
    __syncthreads();
    float s0 = 0.f, s1 = 0.f;
    for (int gg = 0; gg < g; ++gg) {
      const float4 x = *reinterpret_cast<const float4*>(s_x + (gg * 32 + dp) * 4);
      s0 = s0 * x.z + x.x;
      s1 = s1 * x.w + x.y;
    }
#pragma unroll
    for (int i = 0; i < 32; ++i) {
      const unsigned o = pg8::cvt_pk_bf16(s0, s1);
      if (wr) stp[(size_t)i * 2048] = o;
      s0 = s0 * dc[i].x + bf2f((bfu)(kv[i] & 0xffffu));
      s1 = s1 * dc[i].y + bf2f((bfu)(kv[i] >> 16));
    }
    __syncthreads();
  }
}

__device__ __forceinline__ void att_compute(const bfu* kS, const bfu* vS, const float* cS, const bfu* sQw,
                                            const float (&ct)[2], float (&l_run)[2], f32x4 (&O)[2][4],
                                            int kt, int qb, int r0, int w, int lr, int lq, int lg4) {
    f32x4 sc[2][4];
#pragma unroll
    for (int mi = 0; mi < 2; ++mi)
#pragma unroll
      for (int n = 0; n < 4; ++n) sc[mi][n] = (f32x4){0.f, 0.f, 0.f, 0.f};
#pragma unroll
    for (int ks = 0; ks < 2; ++ks) {
      bf16x8 aq0 = lds_frag(sQw, lr, ks * 32 + lq, LDP);
      bf16x8 aq1 = lds_frag(sQw, 16 + lr, ks * 32 + lq, LDP);
#pragma unroll
      for (int n = 0; n < 4; ++n) {
        bf16x8 kf = lds_frag(kS, n * 16 + lr, ks * 32 + lq, LDP);
        sc[0][n] = __builtin_amdgcn_mfma_f32_16x16x32_bf16(kf, aq0, sc[0][n], 0, 0, 0);
        sc[1][n] = __builtin_amdgcn_mfma_f32_16x16x32_bf16(kf, aq1, sc[1][n], 0, 0, 0);
      }
    }
    f32x4 csv[4];
#pragma unroll
    for (int n = 0; n < 4; ++n) csv[n] = *reinterpret_cast<const f32x4*>(cS + n * 16 + lg4);
    const bool diag = (kt >= 2 * qb);
    bf16x8 pf[2][2];
#pragma unroll
    for (int mi = 0; mi < 2; ++mi) {
      const int qrow = r0 + w * 32 + mi * 16 + lr;
      float ps = 0.f;
#pragma unroll
      for (int n = 0; n < 4; ++n)
#pragma unroll
        for (int j = 0; j < 4; ++j) {
          float v = (sc[mi][n][j] + ct[mi]) - csv[n][j];
          if (diag && (kt * 64 + n * 16 + lg4 + j > qrow)) v = -INFINITY;
          const float pv = __builtin_amdgcn_exp2f(v);
          sc[mi][n][j] = pv;
          ps += pv;
        }
      l_run[mi] += ps;
#pragma unroll
      for (int ks = 0; ks < 2; ++ks) {
        union { bf16x8 v; unsigned u[4]; } pk;
        pk.u[0] = pg8::cvt_pk_bf16(sc[mi][2 * ks][0], sc[mi][2 * ks][1]);
        pk.u[1] = pg8::cvt_pk_bf16(sc[mi][2 * ks][2], sc[mi][2 * ks][3]);
        pk.u[2] = pg8::cvt_pk_bf16(sc[mi][2 * ks + 1][0], sc[mi][2 * ks + 1][1]);
        pk.u[3] = pg8::cvt_pk_bf16(sc[mi][2 * ks + 1][2], sc[mi][2 * ks + 1][3]);
        pf[mi][ks] = pk.v;
      }
    }
#pragma unroll
    for (int ks = 0; ks < 2; ++ks) {
#pragma unroll
      for (int ef = 0; ef < 4; ++ef) {
        union { bf16x8 v; uint2 h2[2]; } vf;
        vf.h2[0] = *reinterpret_cast<const uint2*>(vS + (ef * 16 + lr) * LDP + ks * 32 + lg4);
        vf.h2[1] = *reinterpret_cast<const uint2*>(vS + (ef * 16 + lr) * LDP + ks * 32 + 16 + lg4);
#pragma unroll
        for (int mi = 0; mi < 2; ++mi)
          O[mi][ef] = __builtin_amdgcn_mfma_f32_16x16x32_bf16(vf.v, pf[mi][ks], O[mi][ef], 0, 0, 0);
      }
    }
}

__device__ void attn_item(CParams& p, int l, int qb, int h, bfu* smem, int tid, int half, unsigned char* smem_raw) {
  bfu* sK = smem;
  bfu* sV = smem + 2 * 64 * LDP;
  float* s_c = reinterpret_cast<float*>(smem + 4 * 64 * LDP);
  float* s_off = s_c + 128;
  const int lane = tid & 63, w = tid >> 6;
  const int lr = lane & 15, lq = (lane >> 4) * 8, lg4 = (lane >> 4) * 4;
  const int r0 = qb * 128;
  const float L2E = 1.44269504088896f;
  s_off[tid] = ((float*)(p.ws + OFF_foxtot))[h * NCH + tid];
  __syncthreads();
  float myoff = 0.f;
  for (int i = 0; i < tid; ++i) myoff += s_off[i];
  __syncthreads();
  s_off[tid] = myoff;
  float* s_misc = reinterpret_cast<float*>(smem + 28416);
  if (tid < 64) {
    float gq = fabsf(p.in[6][l * 64 + tid]), gk = fabsf(p.in[7][l * 64 + tid]);
#pragma unroll
    for (int m = 1; m < 64; m <<= 1) { gq = fmaxf(gq, __shfl_xor(gq, m, 64)); gk = fmaxf(gk, __shfl_xor(gk, m, 64)); }
    if (tid == 0) { s_misc[0] = 40.f + 2.f * 8.f * gq * gk * 1.01f; reinterpret_cast<int*>(s_misc)[1] = 2 * qb; s_misc[2] = 8.f * gq * gk * 1.01f * 1.44269504088896f; }
  }
  __syncthreads();
  {
    const float thr = s_misc[0];
    const float cref = s_off[2 * qb];
    if (tid < 2 * qb && s_off[tid + 1] <= cref + thr) atomicMin(reinterpret_cast<int*>(s_misc) + 1, tid);
  }
  __syncthreads();
  int kt_min = reinterpret_cast<int*>(s_misc)[1];
  const int nkt = 2 * qb + 2;
  if ((nkt - kt_min) & 1) kt_min -= 1;
  const bfu* Qg = ((bfu*)(p.ws + OFF_foxq)) + (size_t)h * S_LEN * 64;
  const bfu* Kg = ((bfu*)(p.ws + OFF_foxk)) + (size_t)h * S_LEN * 64;
  const bfu* Vg = ((bfu*)(p.ws + OFF_foxvT)) + (size_t)h * 64 * S_LEN;
  const float* Cg = ((float*)(p.ws + OFF_foxc)) + (size_t)h * S_LEN;
  bfu* sQ = smem + 4 * 64 * LDP + 768;
  {
#pragma unroll
    for (int i = 0; i < 4; ++i) {
      int id = tid + i * 256;
      int r = id >> 3, c = (id & 7) * 8;
      *reinterpret_cast<uint4*>(sQ + r * LDP + c) = *reinterpret_cast<const uint4*>(Qg + (size_t)(r0 + r) * 64 + c);
    }
  }
  const bfu* sQw = sQ + (w * 32) * LDP;
  float ct[2], l_run[2];
  const float lbound = s_misc[2];
  f32x4 O[2][4];
#pragma unroll
  for (int mi = 0; mi < 2; ++mi) {
    const int qrow = r0 + w * 32 + mi * 16 + lr;
    ct[mi] = (Cg[qrow] + s_off[qrow >> 6]) * L2E - lbound;
    l_run[mi] = 0.f;
#pragma unroll
    for (int n = 0; n < 4; ++n) O[mi][n] = (f32x4){0.f, 0.f, 0.f, 0.f};
  }
  const int nkh = (nkt - kt_min) >> 1;
  const int kt0 = kt_min + half * nkh;
  const int crow0 = tid >> 3, ccol = (tid & 7) * 8;
  uint4 rk0A, rk1A, rv0A, rv1A, rk0B, rk1B, rv0B, rv1B;
  float rcA = 0.f, rcB = 0.f;
  {
    const int k0 = kt0 * 64;
    rk0A = *reinterpret_cast<const uint4*>(Kg + (size_t)(k0 + crow0) * 64 + ccol);
    rk1A = *reinterpret_cast<const uint4*>(Kg + (size_t)(k0 + crow0 + 32) * 64 + ccol);
    rv0A = *reinterpret_cast<const uint4*>(Vg + (size_t)(crow0) * S_LEN + k0 + ccol);
    rv1A = *reinterpret_cast<const uint4*>(Vg + (size_t)(crow0 + 32) * S_LEN + k0 + ccol);
    if (tid < 64) rcA = (Cg[k0 + tid] + s_off[kt0]) * L2E;
  }
  *reinterpret_cast<uint4*>(sK + (crow0) * LDP + ccol) = rk0A;
  *reinterpret_cast<uint4*>(sK + (crow0 + 32) * LDP + ccol) = rk1A;
  *reinterpret_cast<uint4*>(sV + (crow0) * LDP + ccol) = rv0A;
  *reinterpret_cast<uint4*>(sV + (crow0 + 32) * LDP + ccol) = rv1A;
  if (tid < 64) s_c[tid] = rcA;
  rk0B = rk1B = rv0B = rv1B = rk0A;
  __syncthreads();
#define ATT_LOAD(S, KT)                                                                              \
  {                                                                                                  \
    const int k0_ = (KT) * 64;                                                                       \
    rk0##S = *reinterpret_cast<const uint4*>(Kg + (size_t)(k0_ + crow0) * 64 + ccol);                \
    rk1##S = *reinterpret_cast<const uint4*>(Kg + (size_t)(k0_ + crow0 + 32) * 64 + ccol);           \
    rv0##S = *reinterpret_cast<const uint4*>(Vg + (size_t)(crow0) * S_LEN + k0_ + ccol);             \
    rv1##S = *reinterpret_cast<const uint4*>(Vg + (size_t)(crow0 + 32) * S_LEN + k0_ + ccol);        \
    if (tid < 64) rc##S = (Cg[k0_ + tid] + s_off[(KT)]) * L2E;                                       \
  }
#define ATT_STORE(S, BUF)                                                                            \
  {                                                                                                  \
    bfu* kN_ = sK + (BUF) * 64 * LDP;                                                                \
    bfu* vN_ = sV + (BUF) * 64 * LDP;                                                                \
    *reinterpret_cast<uint4*>(kN_ + (crow0) * LDP + ccol) = rk0##S;                                  \
    *reinterpret_cast<uint4*>(kN_ + (crow0 + 32) * LDP + ccol) = rk1##S;                             \
    *reinterpret_cast<uint4*>(vN_ + (crow0) * LDP + ccol) = rv0##S;                                  \
    *reinterpret_cast<uint4*>(vN_ + (crow0 + 32) * LDP + ccol) = rv1##S;                             \
    if (tid < 64) s_c[(BUF) * 64 + tid] = rc##S;                                                     \
  }
  if (nkh > 1) ATT_LOAD(B, kt0 + 1);
  for (int it = 0; it < nkh; it += 2) {
    if (it + 2 < nkh) ATT_LOAD(A, kt0 + it + 2);
    att_compute(sK, sV, s_c, sQw, ct, l_run, O, kt0 + it, qb, r0, w, lr, lq, lg4);
    if (it + 1 < nkh) ATT_STORE(B, 1);
    __syncthreads();
    if (it + 1 >= nkh) break;
    if (it + 3 < nkh) ATT_LOAD(B, kt0 + it + 3);
    att_compute(sK + 64 * LDP, sV + 64 * LDP, s_c + 64, sQw, ct, l_run, O, kt0 + it + 1, qb, r0, w, lr, lq, lg4);
    if (it + 2 < nkh) ATT_STORE(A, 0);
    __syncthreads();
  }
#undef ATT_LOAD
#undef ATT_STORE
  float* xch = reinterpret_cast<float*>(smem_raw + SMEM_HALF);
  if (half == 1) {
#pragma unroll
    for (int mi = 0; mi < 2; ++mi) {
#pragma unroll
      for (int n = 0; n < 4; ++n)
#pragma unroll
        for (int j = 0; j < 4; ++j) xch[((mi * 4 + n) * 4 + j) * 256 + tid] = O[mi][n][j];
      xch[(32 + mi) * 256 + tid] = l_run[mi];
    }
  }
  __syncthreads();
  if (half == 0) {
#pragma unroll
    for (int mi = 0; mi < 2; ++mi) {
      float lsum = l_run[mi] + xch[(32 + mi) * 256 + tid];
      lsum += __shfl_xor(lsum, 16, 64);
      lsum += __shfl_xor(lsum, 32, 64);
      const float inv = 1.f / lsum;
      const int qrow = r0 + w * 32 + mi * 16 + lr;
      bfu* yp = ((bfu*)(p.ws + OFF_y)) + (size_t)qrow * YW + h * 64 + lg4;
#pragma unroll
      for (int n = 0; n < 4; ++n) {
        float o0 = (O[mi][n][0] + xch[((mi * 4 + n) * 4 + 0) * 256 + tid]) * inv;
        float o1 = (O[mi][n][1] + xch[((mi * 4 + n) * 4 + 1) * 256 + tid]) * inv;
        float o2 = (O[mi][n][2] + xch[((mi * 4 + n) * 4 + 2) * 256 + tid]) * inv;
        float o3 = (O[mi][n][3] + xch[((mi * 4 + n) * 4 + 3) * 256 + tid]) * inv;
        uint2 wv;
        wv.x = pg8::cvt_pk_bf16(o0, o1);
        wv.y = pg8::cvt_pk_bf16(o2, o3);
        *reinterpret_cast<uint2*>(yp + n * 16) = wv;
      }
    }
  }
  __syncthreads();
}

__device__ void chunk_out_item(CParams& p, int l, int c, int hs, bfu* smem, int tid) {
  bfu* sQ = smem;
  bfu* sKi = smem + 64 * LDP;
  bfu* sV = smem + 2 * 64 * LDP;
  bfu* sS = smem + 3 * 64 * LDP;
  bfu* sP = smem + 4 * 64 * LDP;
  float* s_cs = reinterpret_cast<float*>(smem + 5 * 64 * LDP);
  const int lane = tid & 63, w = tid >> 6;
  const int lr = lane & 15, lq = (lane >> 4) * 8, lg4 = (lane >> 4) * 4;
  const int tok0 = c * 64;
  const int tl = w * 16 + lr, tok = tok0 + tl;
  const bfu *Qp, *Kp;
  int qs;
  if (hs < 4) { Qp = ((bfu*)(p.ws + OFF_u)) + (size_t)tok0 * NU + 768 + hs * 64; Kp = ((bfu*)(p.ws + OFF_u)) + (size_t)tok0 * NU + 1024 + hs * 64; qs = NU; }
  else if (hs < 8) { Qp = ((bfu*)(p.ws + OFF_u)) + (size_t)tok0 * NU + 1792 + (hs - 4) * 64; Kp = ((bfu*)(p.ws + OFF_u)) + (size_t)tok0 * NU + 2048 + (hs - 4) * 64; qs = NU; }
  else { int g = (hs - 8) >> 2; Qp = ((bfu*)(p.ws + OFF_ssdC)) + ((size_t)g * S_LEN + tok0) * 64; Kp = ((bfu*)(p.ws + OFF_ssdB)) + ((size_t)g * S_LEN + tok0) * 64; qs = 64; }
  uint2 g4[4], x4[4];
  f32x4 gn[4];
  const int hh = (hs < 8) ? (hs & 3) : (hs - 8);
  {
    const int gcol = (hs < 4) ? (1536 + hh * 64) : (hs < 8 ? (2560 + hh * 64) : (2816 + hh * 64));
    const bfu* gp = ((bfu*)(p.ws + OFF_u)) + (size_t)tok * NU + gcol + lg4;
    const bfu* xp = ((bfu*)(p.ws + OFF_ssdX)) + (size_t)tok * 512 + hh * 64 + lg4;
    const float* gnp = (hs < 4 ? p.in[10] : p.in[11]) + l * 64 + lg4;
#pragma unroll
    for (int n = 0; n < 4; ++n) {
      g4[n] = *reinterpret_cast<const uint2*>(gp + n * 16);
      x4[n] = (hs >= 8) ? *reinterpret_cast<const uint2*>(xp + n * 16) : make_uint2(0u, 0u);
      gn[n] = (hs < 8) ? *reinterpret_cast<const f32x4*>(gnp + n * 16) : (f32x4){1.f, 1.f, 1.f, 1.f};
    }
  }
  load_tile64(sQ, Qp, qs, tid);
  load_tile64(sKi, Kp, qs, tid);
  load_tile64(sV, ((bfu*)(p.ws + OFF_VT)) + ((size_t)hs * NCH + c) * 4096, 64, tid);
  load_tile64(sS, ((bfu*)(p.ws + OFF_ST)) + ((size_t)hs * NCH + c) * 4096, 64, tid);
  if (tid < 64) s_cs[tid] = ((float*)(p.ws + OFF_csb))[hs * S_LEN + tok0 + tid];
  __syncthreads();
  const bf16x8 qf0 = lds_frag(sQ, tl, lq, LDP), qf1 = lds_frag(sQ, tl, 32 + lq, LDP);
  f32x4 sc[4], o[4];
#pragma unroll
  for (int n = 0; n < 4; ++n) {
    sc[n] = (f32x4){0.f, 0.f, 0.f, 0.f};
    o[n] = (f32x4){0.f, 0.f, 0.f, 0.f};
  }
#pragma unroll
  for (int n = 0; n < 4; ++n) {
    sc[n] = __builtin_amdgcn_mfma_f32_16x16x32_bf16(lds_frag(sKi, n * 16 + lr, lq, LDP), qf0, sc[n], 0, 0, 0);
    sc[n] = __builtin_amdgcn_mfma_f32_16x16x32_bf16(lds_frag(sKi, n * 16 + lr, 32 + lq, LDP), qf1, sc[n], 0, 0, 0);
    o[n] = __builtin_amdgcn_mfma_f32_16x16x32_bf16(lds_frag(sS, n * 16 + lr, lq, LDP), qf0, o[n], 0, 0, 0);
    o[n] = __builtin_amdgcn_mfma_f32_16x16x32_bf16(lds_frag(sS, n * 16 + lr, 32 + lq, LDP), qf1, o[n], 0, 0, 0);
  }
  const float cst = s_cs[tl];
  const float rsc = __expf(cst);
#pragma unroll
  for (int n = 0; n < 4; ++n) {
    const f32x4 css = *reinterpret_cast<const f32x4*>(s_cs + n * 16 + lg4);
    float pv[4];
#pragma unroll
    for (int j = 0; j < 4; ++j) {
      const int s = n * 16 + lg4 + j;
      pv[j] = (s <= tl) ? sc[n][j] * __expf(cst - css[j]) : 0.f;
      o[n][j] *= rsc;
    }
    uint2 wv;
    wv.x = pg8::cvt_pk_bf16(pv[0], pv[1]);
    wv.y = pg8::cvt_pk_bf16(pv[2], pv[3]);
    *reinterpret_cast<uint2*>(sP + tl * LDP + n * 16 + lg4) = wv;
  }
  __syncthreads();
  {
    const bf16x8 pf0 = lds_frag(sP, tl, lq, LDP), pf1 = lds_frag(sP, tl, 32 + lq, LDP);
#pragma unroll
    for (int n = 0; n < 4; ++n) {
      o[n] = __builtin_amdgcn_mfma_f32_16x16x32_bf16(lds_frag(sV, n * 16 + lr, lq, LDP), pf0, o[n], 0, 0, 0);
      o[n] = __builtin_amdgcn_mfma_f32_16x16x32_bf16(lds_frag(sV, n * 16 + lr, 32 + lq, LDP), pf1, o[n], 0, 0, 0);
    }
  }
  float ss = 0.f;
  if (hs < 8) {
#pragma unroll
    for (int n = 0; n < 4; ++n) ss += (o[n][0] * o[n][0] + o[n][1] * o[n][1]) + (o[n][2] * o[n][2] + o[n][3] * o[n][3]);
    ss += __shfl_xor(ss, 16, 64);
    ss += __shfl_xor(ss, 32, 64);
    const float rstd = rsqrtf(ss * (1.f / 64.f) + EPS);
    bfu* yp = ((bfu*)(p.ws + OFF_y)) + (size_t)tok * YW + (hs < 4 ? 256 : 512) + hh * 64 + lg4;
#pragma unroll
    for (int n = 0; n < 4; ++n) {
      const float t0 = __uint_as_float(g4[n].x << 16), t1 = __uint_as_float(g4[n].x & 0xffff0000u);
      const float t2 = __uint_as_float(g4[n].y << 16), t3 = __uint_as_float(g4[n].y & 0xffff0000u);
      uint2 wv;
      wv.x = pg8::cvt_pk_bf16(o[n][0] * rstd * gn[n][0] * siluf_(t0), o[n][1] * rstd * gn[n][1] * siluf_(t1));
      wv.y = pg8::cvt_pk_bf16(o[n][2] * rstd * gn[n][2] * siluf_(t2), o[n][3] * rstd * gn[n][3] * siluf_(t3));
      *reinterpret_cast<uint2*>(yp + n * 16) = wv;
    }
  } else {
    const float dsk = p.in[16][l * 8 + hh];
    bfu* yp = ((bfu*)(p.ws + OFF_y)) + (size_t)tok * YW + 768 + hh * 64 + lg4;
#pragma unroll
    for (int n = 0; n < 4; ++n) {
      const float z0 = __uint_as_float(g4[n].x << 16), z1 = __uint_as_float(g4[n].x & 0xffff0000u);
      const float z2 = __uint_as_float(g4[n].y << 16), z3 = __uint_as_float(g4[n].y & 0xffff0000u);
      const float a0 = __uint_as_float(x4[n].x << 16), a1 = __uint_as_float(x4[n].x & 0xffff0000u);
      const float a2 = __uint_as_float(x4[n].y << 16), a3 = __uint_as_float(x4[n].y & 0xffff0000u);
      const float y0 = (o[n][0] + dsk * a0) * siluf_(z0), y1 = (o[n][1] + dsk * a1) * siluf_(z1);
      const float y2 = (o[n][2] + dsk * a2) * siluf_(z2), y3 = (o[n][3] + dsk * a3) * siluf_(z3);
      ss += (y0 * y0 + y1 * y1) + (y2 * y2 + y3 * y3);
      uint2 wv;
      wv.x = pg8::cvt_pk_bf16(y0, y1);
      wv.y = pg8::cvt_pk_bf16(y2, y3);
      *reinterpret_cast<uint2*>(yp + n * 16) = wv;
    }
    ss += __shfl_xor(ss, 16, 64);
    ss += __shfl_xor(ss, 32, 64);
    if (lg4 == 0) ((float*)(p.ws + OFF_ssq))[tok * 8 + hh] = ss;
  }
  __syncthreads();
}

__device__ void phase_mix(CParams& p_o, int l, bfu* smem, int tid, int half, int cidx, unsigned char* smem_raw) {
  __shared__ int s_item;
  const int total = 512 + NCH * 8;
  while (true) {
    __syncthreads();
    if (threadIdx.x == 0) s_item = (int)atomicAdd(&((unsigned*)(p_o.ws + OFF_ctr))[cidx], 1u);
    __syncthreads();
    const int it = s_item;
    if (it >= total) break;
    CParams* pp_ = &p_o;
    asm volatile("" : "+s"(pp_));
    CParams& p = *pp_;
    if (it < 512) {
      int qb = 127 - (it >> 2), h = it & 3;
      attn_item(p, l, qb, h, smem, tid, half, smem_raw);
    } else {
      int j = (it - 512) * 2 + half;
      chunk_out_item(p, l, j >> 4, j & 15, smem, tid);
    }
  }
}

__device__ void phase_upmerge(CParams& p, bfu* smem, int tid, int vb, int vg, int half, unsigned char* smem_raw) {
  bfu* sA = reinterpret_cast<bfu*>(smem_raw);
  bfu* sB = smem + 2 * 128 * LDP;
  float* s_rs = reinterpret_cast<float*>(smem + 2 * 128 * LDP + 2 * 64 * LDP);
  const int lane = tid & 63, w = tid >> 6, wm = w >> 1, wn = w & 1;
  const int lr = lane & 15, lq = (lane >> 4) * 8, lg4 = (lane >> 4) * 4;
  const int crow = tid >> 3, ccol = (tid & 7) * 8;
  const int t512 = half * 256 + tid, arow = t512 >> 3;
  const int xcd = (vb >> 1) & 7, jl = ((vb >> 4) << 1) | (vb & 1), per = vg >> 3;
  for (int il = jl; il < 16 * 16; il += per) {
    const int mt = xcd * 16 + (il >> 4), nt = il & 15;
    const bfu* Ap = ((bfu*)(p.ws + OFF_y)) + (size_t)(mt * 128 + arow) * YW + ccol;
    const bfu* Bp = ((bfu*)(p.ws + OFF_WupT)) + (size_t)(nt * 64 + crow) * YW + ccol;
    const bfu* Gp = ((bfu*)(p.ws + OFF_u)) + (size_t)(mt * 128 + wm * 64 + lr) * NU + 4096 + nt * 64 + wn * 32 + lg4;
    {
      const int row = tid >> 1, g = tid & 1;
      const float4 q4 = *reinterpret_cast<const float4*>(((float*)(p.ws + OFF_ssq)) + (mt * 128 + row) * 8 + g * 4);
      s_rs[g * 128 + row] = rsqrtf((q4.x + q4.y + q4.z + q4.w) * (1.f / 256.f) + EPS);
    }
    uint4 a0_0, a0_1, b0_0, b0_1, a1_0, a1_1, b1_0, b1_1;
#define U_LOAD(S, KT)                                                                \
  {                                                                                  \
    const int ko_ = (KT) * 64;                                                       \
    a##S##_0 = *reinterpret_cast<const uint4*>(Ap + (size_t)0 * 64 * YW + ko_);      \
    a##S##_1 = *reinterpret_cast<const uint4*>(Ap + (size_t)1 * 64 * YW + ko_);      \
    b##S##_0 = *reinterpret_cast<const uint4*>(Bp + (size_t)0 * 32 * YW + ko_);      \
    b##S##_1 = *reinterpret_cast<const uint4*>(Bp + (size_t)1 * 32 * YW + ko_);      \
  }
#define U_STORE(S, BUF)                                                              \
  {                                                                                  \
    bfu* sAn_ = sA + (BUF) * 128 * LDP + arow * LDP + ccol;                          \
    bfu* sBn_ = sB + (BUF) * 64 * LDP + crow * LDP + ccol;                           \
    *reinterpret_cast<uint4*>(sAn_ + 0 * 64 * LDP) = a##S##_0;                       \
    *reinterpret_cast<uint4*>(sAn_ + 1 * 64 * LDP) = a##S##_1;                       \
    *reinterpret_cast<uint4*>(sBn_ + 0 * 32 * LDP) = b##S##_0;                       \
    *reinterpret_cast<uint4*>(sBn_ + 1 * 32 * LDP) = b##S##_1;                       \
  }
#define U_COMPUTE(BUF)                                                               \
  {                                                                                  \
    const bfu* a_s = sA + (BUF) * 128 * LDP + (wm * 64) * LDP;                       \
    const bfu* b_s = sB + (BUF) * 64 * LDP + (wn * 32) * LDP;                        \
    _Pragma("unroll") for (int ks = 0; ks < 2; ++ks) {                               \
      bf16x8 af0 = lds_frag(a_s, 0 * 16 + lr, ks * 32 + lq, LDP);                    \
      bf16x8 af1 = lds_frag(a_s, 1 * 16 + lr, ks * 32 + lq, LDP);                    \
      bf16x8 af2 = lds_frag(a_s, 2 * 16 + lr, ks * 32 + lq, LDP);                    \
      bf16x8 af3 = lds_frag(a_s, 3 * 16 + lr, ks * 32 + lq, LDP);                    \
      _Pragma("unroll") for (int ni = 0; ni < 2; ++ni) {                             \
        bf16x8 bf_ = lds_frag(b_s, ni * 16 + lr, ks * 32 + lq, LDP);                 \
        acc[0][ni] = __builtin_amdgcn_mfma_f32_16x16x32_bf16(bf_, af0, acc[0][ni], 0, 0, 0); \
        acc[1][ni] = __builtin_amdgcn_mfma_f32_16x16x32_bf16(bf_, af1, acc[1][ni], 0, 0, 0); \
        acc[2][ni] = __builtin_amdgcn_mfma_f32_16x16x32_bf16(bf_, af2, acc[2][ni], 0, 0, 0); \
        acc[3][ni] = __builtin_amdgcn_mfma_f32_16x16x32_bf16(bf_, af3, acc[3][ni], 0, 0, 0); \
      }                                                                              \
    }                                                                                \
  }
    f32x4 acc[4][2], tot[4][2];
    zero_acc<2>(acc);
    zero_acc<2>(tot);
    uint2 gt[4][2];
    U_LOAD(0, 0);
    U_LOAD(1, 1);
    U_STORE(0, 0);
    __syncthreads();
#pragma unroll 1
    for (int kt = 0; kt < 20; kt += 2) {
      if ((kt & 3) == 0) {
        const int br = kt >> 2, gb = br < 3 ? br : 3;
#pragma unroll
        for (int mi = 0; mi < 4; ++mi)
#pragma unroll
          for (int ni = 0; ni < 2; ++ni)
            gt[mi][ni] = *reinterpret_cast<const uint2*>(Gp + (size_t)(mi * 16) * NU + gb * 1024 + ni * 16);
      }
      if (kt + 2 < 20) U_LOAD(0, kt + 2);
      U_COMPUTE(0);
      U_STORE(1, 1);
      __syncthreads();
      if (kt + 3 < 20) U_LOAD(1, kt + 3);
      U_COMPUTE(1);
      if (kt + 2 < 20) U_STORE(0, 0);
      if ((kt & 3) == 2) {
        const int br = kt >> 2;
#pragma unroll
        for (int mi = 0; mi < 4; ++mi) {
          float rsc = 1.f;
          if (br >= 3) rsc = s_rs[(br - 3) * 128 + wm * 64 + mi * 16 + lr];
#pragma unroll
          for (int ni = 0; ni < 2; ++ni) {
            const uint2 g2 = gt[mi][ni];
            tot[mi][ni][0] += acc[mi][ni][0] * (__uint_as_float(g2.x << 16) * rsc);
            tot[mi][ni][1] += acc[mi][ni][1] * (__uint_as_float(g2.x & 0xffff0000u) * rsc);
            tot[mi][ni][2] += acc[mi][ni][2] * (__uint_as_float(g2.y << 16) * rsc);
            tot[mi][ni][3] += acc[mi][ni][3] * (__uint_as_float(g2.y & 0xffff0000u) * rsc);
            acc[mi][ni] = (f32x4){0.f, 0.f, 0.f, 0.f};
          }
        }
      }
      __syncthreads();
    }
#undef U_LOAD
#undef U_STORE
#undef U_COMPUTE
    bfu* Hp = ((bfu*)(p.ws + OFF_h)) + (size_t)(mt * 128 + wm * 64 + lr) * DM + nt * 64 + wn * 32 + lg4;
#pragma unroll
    for (int mi = 0; mi < 4; ++mi)
#pragma unroll
      for (int ni = 0; ni < 2; ++ni) {
        uint2 wv;
        wv.x = pg8::cvt_pk_bf16(tot[mi][ni][0], tot[mi][ni][1]);
        wv.y = pg8::cvt_pk_bf16(tot[mi][ni][2], tot[mi][ni][3]);
        *reinterpret_cast<uint2*>(Hp + (size_t)(mi * 16) * DM + ni * 16) = wv;
      }
  }
}

namespace pg8 {
#define PG8_LAS __attribute__((address_space(3)))
typedef unsigned short bf16_t;
typedef short bf16x8 __attribute__((ext_vector_type(8)));
typedef float f32x4 __attribute__((ext_vector_type(4)));
typedef unsigned u32x4 __attribute__((ext_vector_type(4)));
typedef unsigned u32x2 __attribute__((ext_vector_type(2)));
constexpr int BM = 256, BK = 64, HALF = 128, HTB = HALF * BK * 2, STAGE_BYTES = 8 * HTB, NXCD = 8, WGM = 8;
__device__ __forceinline__ int lds_byte(int r, int c) { const int st = (r >> 4) * 2 + (c >> 5), rr = r & 15, cc = c & 31, ob = rr * 64 + cc * 2; return st * 1024 + (ob ^ (((ob >> 9) & 1) << 5)); }
__device__ __forceinline__ void stage_rc(int b, int& R, int& C) { const int st = b / 1024, sb = b % 1024, swz = sb ^ (((sb >> 9) & 1) << 5); R = (st >> 1) * 16 + swz / 64; C = (st & 1) * 32 + (swz % 64) / 2; }
__device__ __forceinline__ int perm32(int rho) { const int n = rho >> 4, i = rho & 15; return 8 * (i >> 2) + 4 * n + (i & 3); }
struct Unit { int pm, pn; };
struct Gemm { const bf16_t* A; const bf16_t* Bt; int M, N, K; };
struct StaticOrder {
    int nM, nN, nwg, G, c;
    __device__ void init(int M, int N, int G_, int c_) { nM = M / BM; nN = N / BM; nwg = nM * nN; G = G_; c = c_; }
    __device__ bool next(int i, Unit& u) const {
        const long L = (long)i * G + c; if (L >= nwg) return false;
        int wgid = (int)L; { const int q = nwg / NXCD, r = nwg % NXCD, xcd = wgid % NXCD, off = wgid / NXCD; wgid = (xcd < r ? xcd * (q + 1) : r * (q + 1) + (xcd - r) * q) + off; }
        const int nig = WGM * nN, gid = wgid / nig, fm = gid * WGM, gsz = (nM - fm) < WGM ? (nM - fm) : WGM;
        u.pm = fm + ((wgid % nig) % gsz); u.pn = (wgid % nig) / gsz; return true;
    }
    __device__ __forceinline__ void a_ready(const Unit&) const {}
    __device__ __forceinline__ void done(const Unit&) const {}
};
__device__ __forceinline__ unsigned cvt_pk_bf16(float lo, float hi) { unsigned r; asm volatile("v_cvt_pk_bf16_f32 %0, %1, %2" : "=v"(r) : "v"(lo), "v"(hi)); return r; }

template <class Epi, class Sched>
__device__ __forceinline__ void gemm_phase(PG8_LAS unsigned char* lds, const Gemm g, const Sched& S, const Epi& E) {
    const int tid = threadIdx.x, wid = __builtin_amdgcn_readfirstlane(tid >> 6), lane = tid & 63, wr = wid >> 2, wc = wid & 3, fr = lane & 15, fq = lane >> 4;
    const int K = g.K, nt = K / BK;
    unsigned voffA[2], voffB[2];
#pragma unroll
    for (int i = 0; i < 2; ++i) { int R, C; stage_rc(tid * 16 + i * 8192, R, C); const int Rb = Epi::PERM ? ((R & ~31) + perm32(R & 31)) : R;
        voffA[i] = (unsigned)(R * K + C) * 2u; voffB[i] = (unsigned)(Rb * K + C) * 2u; }
    const size_t kstep = (size_t)(BK * 2);
    const size_t hstep = (size_t)HALF * K * 2;
    const size_t tstep = 2 * hstep;
    const unsigned ldsw = (unsigned)wid * 1024u;
    const int aoff = lds_byte(wr * 64 + fr, fq * 8), boff = lds_byte(wc * 32 + fr, fq * 8);
#define PG8_SA(b, h) (((b) * 2 + (h)) * HTB)
#define PG8_SB(b, h) ((4 + (b) * 2 + (h)) * HTB)
#define PG8_STAGE(bufoff, gbase, voff) do { _Pragma("unroll") for (int _i = 0; _i < 2; ++_i) \
        __builtin_amdgcn_global_load_lds((const unsigned*)((const char*)(gbase) + (voff)[_i]), (PG8_LAS unsigned*)(lds + (bufoff) + ldsw + _i * 8192), 16, 0, 0); } while (0)
#define PG8_LDA(dst, b, h) do { _Pragma("unroll") for (int m = 0; m < 4; ++m) _Pragma("unroll") for (int k = 0; k < 2; ++k) dst[m][k] = *(const PG8_LAS bf16x8*)(lds + PG8_SA(b, h) + aoff + m * 2048 + k * 1024); } while (0)
#define PG8_LDB(dst, b, h) do { _Pragma("unroll") for (int n = 0; n < 2; ++n) _Pragma("unroll") for (int k = 0; k < 2; ++k) dst[n][k] = *(const PG8_LAS bf16x8*)(lds + PG8_SB(b, h) + boff + n * 2048 + k * 1024); } while (0)
#define PG8_MMA(ai, bj, At, Bt) do { __builtin_amdgcn_s_setprio(1); _Pragma("unroll") for (int m = 0; m < 4; ++m) _Pragma("unroll") for (int n = 0; n < 2; ++n) _Pragma("unroll") for (int k = 0; k < 2; ++k) \
        acc[ai][bj][m][n] = __builtin_amdgcn_mfma_f32_16x16x32_bf16(Bt[n][k], At[m][k], acc[ai][bj][m][n], 0, 0, 0); __builtin_amdgcn_s_setprio(0); } while (0)
#define PG8_WAIT_V(n) asm volatile("s_waitcnt vmcnt(" #n ")" ::: "memory")
#define PG8_WAIT_L(n) asm volatile("s_waitcnt lgkmcnt(" #n ")" ::: "memory")
#define PG8_BAR __builtin_amdgcn_s_barrier()
#define PG8_SCHED __builtin_amdgcn_sched_barrier(0)
    Unit cur, nxt; int ui = 0;
    if (!S.next(0, cur)) return;
    f32x4 acc[2][2][4][2];
#pragma unroll
    for (int a = 0; a < 2; ++a)
#pragma unroll
        for (int b = 0; b < 2; ++b)
#pragma unroll
            for (int m = 0; m < 4; ++m)
#pragma unroll
                for (int n = 0; n < 2; ++n) acc[a][b][m][n] = (f32x4){0.f, 0.f, 0.f, 0.f};
    bf16x8 At[4][2], B0[2][2], B1[2][2];
    const char* cA = (const char*)g.A + (size_t)cur.pm * tstep; const char* cB = (const char*)g.Bt + (size_t)cur.pn * tstep;
    S.a_ready(cur);
    PG8_STAGE(PG8_SB(0, 0), cB, voffB); PG8_STAGE(PG8_SA(0, 0), cA, voffA); PG8_STAGE(PG8_SB(0, 1), cB + hstep, voffB); PG8_STAGE(PG8_SA(0, 1), cA + hstep, voffA);
    if (wr == 1) PG8_BAR;
    PG8_WAIT_V(4); PG8_BAR;
    PG8_STAGE(PG8_SB(1, 0), cB + kstep, voffB); PG8_STAGE(PG8_SA(1, 0), cA + kstep, voffA); PG8_STAGE(PG8_SB(1, 1), cB + hstep + kstep, voffB);
    PG8_WAIT_V(6); PG8_BAR;
    for (;;) {
        const bool has_next = S.next(ui + 1, nxt);
        const char* nA = has_next ? (const char*)g.A + (size_t)nxt.pm * tstep : cA; const char* nB = has_next ? (const char*)g.Bt + (size_t)nxt.pn * tstep : cB;
        for (int t = 0; t < nt; t += 2) {
            const bool last = (t == nt - 2);
            const char* a1 = cA + (size_t)(t + 1) * kstep;
            const char* a2 = last ? nA : cA + (size_t)(t + 2) * kstep; const char* b2 = last ? nB : cB + (size_t)(t + 2) * kstep;
            const char* a3 = a2 + kstep; const char* b3 = b2 + kstep;
            if (last && has_next) S.a_ready(nxt);
            PG8_LDB(B0, 0, 0); PG8_SCHED; PG8_LDA(At, 0, 0); PG8_STAGE(PG8_SA(1, 1), a1 + hstep, voffA);
            PG8_WAIT_L(8); PG8_BAR; PG8_WAIT_L(0); PG8_MMA(0, 0, At, B0); PG8_BAR; PG8_SCHED;
            PG8_LDB(B1, 0, 1); PG8_STAGE(PG8_SB(0, 0), b2, voffB);
            PG8_BAR; PG8_WAIT_L(0); PG8_MMA(0, 1, At, B1); PG8_BAR;
            PG8_LDA(At, 0, 1); PG8_STAGE(PG8_SA(0, 0), a2, voffA);
            PG8_BAR; PG8_WAIT_L(0); PG8_MMA(1, 0, At, B0); PG8_BAR; PG8_SCHED;
            PG8_STAGE(PG8_SB(0, 1), b2 + hstep, voffB);
            PG8_WAIT_V(6); PG8_BAR; PG8_MMA(1, 1, At, B1); PG8_BAR;
            PG8_LDB(B0, 1, 0); PG8_SCHED; PG8_LDA(At, 1, 0); PG8_STAGE(PG8_SA(0, 1), a2 + hstep, voffA);
            PG8_WAIT_L(8); PG8_BAR; PG8_WAIT_L(0); PG8_MMA(0, 0, At, B0); PG8_BAR; PG8_SCHED;
            PG8_LDB(B1, 1, 1); PG8_STAGE(PG8_SB(1, 0), b3, voffB);
            PG8_BAR; PG8_WAIT_L(0); PG8_MMA(0, 1, At, B1); PG8_BAR;
            PG8_LDA(At, 1, 1); PG8_STAGE(PG8_SA(1, 0), a3, voffA);
            PG8_BAR; PG8_WAIT_L(0); PG8_MMA(1, 0, At, B0); PG8_BAR; PG8_SCHED;
            PG8_STAGE(PG8_SB(1, 1), b3 + hstep, voffB);
            PG8_WAIT_V(6); PG8_BAR; PG8_MMA(1, 1, At, B1); PG8_BAR;
        }
            if constexpr (!Epi::AFTER_DRAIN) { E(acc, cur, wr, wc, fr, fq); S.done(cur); }
            if (!has_next) break;
#pragma unroll
        for (int a = 0; a < 2; ++a)
#pragma unroll
            for (int b = 0; b < 2; ++b)
#pragma unroll
                for (int m = 0; m < 4; ++m)
#pragma unroll
                    for (int n = 0; n < 2; ++n) acc[a][b][m][n] = (f32x4){0.f, 0.f, 0.f, 0.f};
        cur = nxt; cA = nA; cB = nB; ++ui;
    }
    PG8_WAIT_V(0);
    if (wr == 0) PG8_BAR;
    PG8_BAR;
    if constexpr (Epi::AFTER_DRAIN) { E.fused(acc, cur, wr, wc, fr, fq, lds, wid, lane); S.done(cur); }
#undef PG8_SA
#undef PG8_SB
#undef PG8_STAGE
#undef PG8_LDA
#undef PG8_LDB
#undef PG8_MMA
#undef PG8_WAIT_V
#undef PG8_WAIT_L
#undef PG8_BAR
#undef PG8_SCHED
}

}

struct EpiInproj {
  static constexpr bool PERM = true, AFTER_DRAIN = false;
  bfu* u; float* small;
  __device__ __forceinline__ void operator()(const pg8::f32x4 (&acc)[2][2][4][2], const pg8::Unit& un, int wr, int wc, int fr, int fq) const {
    const int row0 = un.pm * 256 + wr * 64 + fr;
    if (un.pn < 32) {
      const bool sig = un.pn >= 16;
      const int col0 = un.pn * 256 + wc * 32 + 8 * fq;
#pragma unroll
      for (int ai = 0; ai < 2; ++ai)
#pragma unroll
        for (int m = 0; m < 4; ++m) {
          bfu* rowp = u + (size_t)(row0 + ai * 128 + m * 16) * NU + col0;
#pragma unroll
          for (int bj = 0; bj < 2; ++bj) {
            pg8::f32x4 v0 = acc[ai][bj][m][0], v1 = acc[ai][bj][m][1];
            if (sig) {
#pragma unroll
              for (int j = 0; j < 4; ++j) { v0[j] = sigmoidf_(v0[j]); v1[j] = sigmoidf_(v1[j]); }
            }
            pg8::u32x4 w;
            w.x = pg8::cvt_pk_bf16(v0[0], v0[1]); w.y = pg8::cvt_pk_bf16(v0[2], v0[3]);
            w.z = pg8::cvt_pk_bf16(v1[0], v1[1]); w.w = pg8::cvt_pk_bf16(v1[2], v1[3]);
            *(pg8::u32x4*)(rowp + bj * 128) = w;
          }
        }
    } else if (wc == 0) {
#pragma unroll
      for (int ai = 0; ai < 2; ++ai)
#pragma unroll
        for (int m = 0; m < 4; ++m) {
          float* sp = small + (size_t)(row0 + ai * 128 + m * 16) * 32 + 8 * fq;
          *(pg8::f32x4*)(sp) = acc[ai][0][m][0];
          *(pg8::f32x4*)(sp + 4) = acc[ai][0][m][1];
        }
    }
  }
};
struct EpiResid {
  static constexpr bool PERM = false, AFTER_DRAIN = false;
  const float* xold; float* out;
  __device__ __forceinline__ void operator()(const pg8::f32x4 (&acc)[2][2][4][2], const pg8::Unit& un, int wr, int wc, int fr, int fq) const {
    const int row0 = un.pm * 256 + wr * 64 + fr, col0 = un.pn * 256 + wc * 32 + 4 * fq;
#pragma unroll
    for (int ai = 0; ai < 2; ++ai)
#pragma unroll
      for (int m = 0; m < 4; ++m) {
        const size_t off = (size_t)(row0 + ai * 128 + m * 16) * DM + col0;
#pragma unroll
        for (int bj = 0; bj < 2; ++bj)
#pragma unroll
          for (int n = 0; n < 2; ++n) {
            const pg8::f32x4 b = *(const pg8::f32x4*)(xold + off + bj * 128 + n * 16);
            *(pg8::f32x4*)(out + off + bj * 128 + n * 16) = b + acc[ai][bj][m][n];
          }
        asm volatile("" ::: "memory");
      }
  }
};
struct EpiSwiglu {
  static constexpr bool PERM = true, AFTER_DRAIN = false;
  bfu* hidden;
  __device__ __forceinline__ void operator()(const pg8::f32x4 (&acc)[2][2][4][2], const pg8::Unit& un, int wr, int wc, int fr, int fq) const {
    const int row0 = un.pm * 256 + wr * 64 + fr;
#pragma unroll
    for (int ai = 0; ai < 2; ++ai)
#pragma unroll
      for (int m = 0; m < 4; ++m) {
        bfu* rowp = hidden + (size_t)(row0 + ai * 128 + m * 16) * FH + (un.pn * 8 + wc) * 16 + 4 * fq;
#pragma unroll
        for (int bj = 0; bj < 2; ++bj) {
          const pg8::f32x4 g = acc[ai][bj][m][0], uu = acc[ai][bj][m][1];
          pg8::u32x2 w;
          w.x = pg8::cvt_pk_bf16(siluf_(g[0]) * uu[0], siluf_(g[1]) * uu[1]);
          w.y = pg8::cvt_pk_bf16(siluf_(g[2]) * uu[2], siluf_(g[3]) * uu[3]);
          *(pg8::u32x2*)(rowp + bj * 64) = w;
        }
      }
  }
};

__device__ __forceinline__ void grid_barrier(unsigned* ctr, unsigned target) {
  asm volatile("s_waitcnt vmcnt(0)" ::: "memory");
  __syncthreads();
  if (threadIdx.x == 0) {
    __builtin_amdgcn_fence(__ATOMIC_RELEASE, "agent");
    asm volatile("s_waitcnt vmcnt(0)" ::: "memory");
    __hip_atomic_fetch_add(ctr, 1u, __ATOMIC_RELAXED, __HIP_MEMORY_SCOPE_AGENT);
    while (__hip_atomic_load(ctr, __ATOMIC_RELAXED, __HIP_MEMORY_SCOPE_AGENT) < target) __builtin_amdgcn_s_sleep(1);
    __builtin_amdgcn_fence(__ATOMIC_ACQUIRE, "agent");
    asm volatile("s_waitcnt vmcnt(0)" ::: "memory");
  }
  __syncthreads();
}

__global__ void __launch_bounds__(NTHREADS, 2) mega(Params p_in, int ph_lo, int ph_hi, int use_cg) {
  extern __shared__ __attribute__((aligned(16))) unsigned char smem_raw[];
  unsigned nbar = 0;
  for (int ph = ph_lo; ph < ph_hi; ++ph) {
#if PROBE_DUP >= 0
    const int l = ph / (PH_PER_LAYER + 1);
    const int ks = ph - l * (PH_PER_LAYER + 1);
    const int k = (ks <= PROBE_DUP) ? ks : ks - 1;
    const int wr = (ks == PROBE_DUP) ? 0 : 1;
#else
    const int wr = 1;
    const int l = ph / PH_PER_LAYER, k = ph - l * PH_PER_LAYER;
#endif
    int t512 = threadIdx.x;
    asm volatile("" : "+v"(t512));
    const int tid = t512 & 255;
    const int half = __builtin_amdgcn_readfirstlane(t512 >> 8);
    const int vb = blockIdx.x * 2 + half, vg = gridDim.x * 2;
    bfu* smem = reinterpret_cast<bfu*>(smem_raw + half * SMEM_HALF);
    CParams* pp = (CParams*)__builtin_amdgcn_kernarg_segment_ptr();
    asm volatile("" : "+s"(pp));
    CParams& p = *pp;
    switch (k) {
      case 0: phase_convert_norm(p, l, smem, tid, vb, vg); break;
      case 1: {
        pg8::Gemm g; g.A = (bfu*)(p.ws + OFF_h); g.Bt = (bfu*)(p.ws + OFF_WinT); g.M = S_LEN; g.N = NINP; g.K = DM;
        pg8::StaticOrder so; so.init(S_LEN, NINP, gridDim.x, blockIdx.x);
        EpiInproj e; e.u = (bfu*)(p.ws + OFF_u); e.small = (float*)(p.ws + OFF_small);
        pg8::gemm_phase<EpiInproj, pg8::StaticOrder>((PG8_LAS unsigned char*)smem_raw, g, so, e);
      } break;
      case 2: phase_prep(p, l, smem, tid, wr, vb, vg); break;
      case 3: phase_scan(p, smem, tid, wr, vb, vg); break;
      case 4: phase_mix(p, l, smem, tid, half, ph, smem_raw); break;
      case 5: phase_upmerge(p, smem, tid, vb, vg, half, smem_raw); break;
      case 6: {
        pg8::Gemm g; g.A = (bfu*)(p.ws + OFF_h); g.Bt = (bfu*)(p.ws + OFF_WoutT); g.M = S_LEN; g.N = DM; g.K = DM;
        pg8::StaticOrder so; so.init(S_LEN, DM, gridDim.x, blockIdx.x);
        EpiResid e; e.xold = (l == 0 ? p.in[0] : p.out); e.out = p.out;
        pg8::gemm_phase<EpiResid, pg8::StaticOrder>((PG8_LAS unsigned char*)smem_raw, g, so, e);
      } break;
      case 7: phase_norm2(p, l, tid, vb, vg); break;
      case 8: {
        pg8::Gemm g; g.A = (bfu*)(p.ws + OFF_h); g.Bt = (bfu*)(p.ws + OFF_WfiT); g.M = S_LEN; g.N = 2 * FH; g.K = DM;
        pg8::StaticOrder so; so.init(S_LEN, 2 * FH, gridDim.x, blockIdx.x);
        EpiSwiglu e; e.hidden = (bfu*)(p.ws + OFF_u);
        pg8::gemm_phase<EpiSwiglu, pg8::StaticOrder>((PG8_LAS unsigned char*)smem_raw, g, so, e);
      } break;
      default: {
        pg8::Gemm g; g.A = (bfu*)(p.ws + OFF_u); g.Bt = (bfu*)(p.ws + OFF_WfoT); g.M = S_LEN; g.N = DM; g.K = FH;
        pg8::StaticOrder so; so.init(S_LEN, DM, gridDim.x, blockIdx.x);
        EpiResid e; e.xold = p.out; e.out = p.out;
        pg8::gemm_phase<EpiResid, pg8::StaticOrder>((PG8_LAS unsigned char*)smem_raw, g, so, e);
      } break;
    }
    if (ph + 1 < ph_hi) {
      if (use_cg) cg::this_grid().sync();
      else { ++nbar; grid_barrier((unsigned*)(p_in.ws + OFF_bar), nbar * gridDim.x); }
    }
  }
}

#ifndef MK_COOP
#define MK_COOP 1
#endif

extern "C" void kernel_launch(void* const* d_in, const int* in_sizes, int n_in, void* d_out, int out_size, void* d_ws,
                              size_t ws_size, hipStream_t stream) {
  Params p{};
  for (int i = 0; i < 25; ++i) p.in[i] = reinterpret_cast<const float*>(d_in[i]);
  p.out = reinterpret_cast<float*>(d_out);
  p.ws = reinterpret_cast<unsigned char*>(d_ws);
  if (WS_NEED > ws_size) { fprintf(stderr, "workspace too small: need %zu have %zu\n", (size_t)WS_NEED, ws_size); return; }

  static int grid_blocks = 0;
  if (!grid_blocks) {
    (void)hipFuncSetAttribute((const void*)mega, hipFuncAttributeMaxDynamicSharedMemorySize, SMEM_BYTES);
    int dev = 0, cus = 0, per_cu = 0;
    (void)hipGetDevice(&dev);
    (void)hipDeviceGetAttribute(&cus, hipDeviceAttributeMultiprocessorCount, dev);
    (void)hipOccupancyMaxActiveBlocksPerMultiprocessor(&per_cu, mega, NTHREADS, SMEM_BYTES);
    per_cu = 1;
    grid_blocks = cus * per_cu;
  }
  const int nph = 4 * (PH_PER_LAYER + (PROBE_DUP >= 0 ? 1 : 0));
#if MK_COOP
  int lo = 0, hi = nph, use_cg = 0;
  void* args[] = {&p, &lo, &hi, &use_cg};
  (void)hipMemsetAsync(p.ws + OFF_bar, 0, 256, stream);
  hipError_t e = hipLaunchCooperativeKernel((const void*)mega, dim3(grid_blocks), dim3(NTHREADS), args, SMEM_BYTES, stream);
  if (e != hipSuccess) fprintf(stderr, "cooperative launch failed: %s (grid %d)\n", hipGetErrorString(e), grid_blocks);
#else
  for (int ph = 0; ph < nph; ++ph)
    hipLaunchKernelGGL(mega, dim3(grid_blocks), dim3(NTHREADS), SMEM_BYTES, stream, p, ph, ph + 1, 0);
#endif
}
```

```cpp
#include <hip/hip_runtime.h>
#include <hip/hip_bf16.h>
#include <hip/hip_cooperative_groups.h>
#include <cstdio>
namespace cg = cooperative_groups;

typedef __attribute__((ext_vector_type(8))) short bf16x8;
typedef __attribute__((ext_vector_type(4))) float f32x4;
typedef unsigned short bfu;

#define S_LEN 16384
#define DM 1024
#define NU 8192
#define NINP 8448
#define NSRC 8220
#define FH 2816
#define NCH 256
#define LDP 72
#define YW 1280
#define EPS 1e-6f
#define SMEM_HALF 73728
#define SMEM_BYTES 147456
#define NTHREADS 512
#define PH_PER_LAYER 10
#ifndef PROBE_DUP
#define PROBE_DUP -1
#endif

struct Params {
  const float* in[25];
  float* out;
  unsigned char* ws;
};
typedef const __attribute__((address_space(4))) Params CParams;
constexpr size_t OFF_WinT = 0;
constexpr size_t OFF_WupT = OFF_WinT + (((size_t)NINP*DM*2 + 255) & ~(size_t)255);
constexpr size_t OFF_WoutT = OFF_WupT + (((size_t)DM*YW*2 + 255) & ~(size_t)255);
constexpr size_t OFF_WfiT = OFF_WoutT + (((size_t)DM*DM*2 + 255) & ~(size_t)255);
constexpr size_t OFF_WfoT = OFF_WfiT + (((size_t)2*FH*DM*2 + 255) & ~(size_t)255);
constexpr size_t OFF_u = OFF_WfoT + (((size_t)DM*FH*2 + 255) & ~(size_t)255);
constexpr size_t OFF_small = OFF_u + (((size_t)S_LEN*NU*2 + 255) & ~(size_t)255);
constexpr size_t OFF_h = OFF_small + (((size_t)S_LEN*32*4 + 255) & ~(size_t)255);
constexpr size_t OFF_y = OFF_h + (((size_t)S_LEN*DM*2 + 255) & ~(size_t)255);
constexpr size_t OFF_ssq = OFF_y + (((size_t)S_LEN*YW*2 + 255) & ~(size_t)255);
constexpr size_t OFF_foxq = OFF_ssq + (((size_t)S_LEN*8*4 + 255) & ~(size_t)255);
constexpr size_t OFF_foxk = OFF_foxq + (((size_t)4*S_LEN*64*2 + 255) & ~(size_t)255);
constexpr size_t OFF_foxvT = OFF_foxk + (((size_t)4*S_LEN*64*2 + 255) & ~(size_t)255);
constexpr size_t OFF_foxc = OFF_foxvT + (((size_t)4*S_LEN*64*2 + 255) & ~(size_t)255);
constexpr size_t OFF_foxtot = OFF_foxc + (((size_t)4*S_LEN*4 + 255) & ~(size_t)255);
constexpr size_t OFF_VT = OFF_foxtot + (((size_t)4*NCH*4 + 255) & ~(size_t)255);
constexpr size_t OFF_ST = OFF_VT + (((size_t)16*NCH*4096*2 + 255) & ~(size_t)255);
constexpr size_t OFF_dec = OFF_ST + (((size_t)16*NCH*4096*2 + 255) & ~(size_t)255);
constexpr size_t OFF_csb = OFF_dec + (((size_t)16*NCH*64*4 + 255) & ~(size_t)255);
constexpr size_t OFF_ssdX = OFF_csb + (((size_t)16*S_LEN*4 + 255) & ~(size_t)255);
constexpr size_t OFF_ssdB = OFF_ssdX + (((size_t)S_LEN*512*2 + 255) & ~(size_t)255);
constexpr size_t OFF_ssdC = OFF_ssdB + (((size_t)2*S_LEN*64*2 + 255) & ~(size_t)255);
constexpr size_t OFF_rcos = OFF_ssdC + (((size_t)2*S_LEN*64*2 + 255) & ~(size_t)255);
constexpr size_t OFF_rsin = OFF_rcos + (((size_t)S_LEN*32*4 + 255) & ~(size_t)255);
constexpr size_t OFF_ctr = OFF_rsin + (((size_t)S_LEN*32*4 + 255) & ~(size_t)255);
constexpr size_t OFF_bar = OFF_ctr + (((size_t)256 + 255) & ~(size_t)255);
constexpr size_t WS_NEED = OFF_bar + 8192;

__device__ __forceinline__ bfu f2bf(float f) {
  unsigned u = __float_as_uint(f);
  u += 0x7fffu + ((u >> 16) & 1u);
  return (bfu)(u >> 16);
}
__device__ __forceinline__ float bf2f(bfu b) { return __uint_as_float(((unsigned)b) << 16); }
__device__ __forceinline__ float sigmoidf_(float x) { return 1.f / (1.f + __expf(-x)); }
__device__ __forceinline__ float siluf_(float x) { return x / (1.f + __expf(-x)); }
__device__ __forceinline__ float logsigmoidf_(float z) { return fminf(z, 0.f) - log1pf(expf(-fabsf(z))); }
__device__ __forceinline__ float logsigmoid_fast(float z) { return fminf(z, 0.f) - __logf(1.f + __expf(-fabsf(z))); }
__device__ __forceinline__ float softplus_fast(float z) { return fmaxf(z, 0.f) + __logf(1.f + __expf(-fabsf(z))); }
__device__ __forceinline__ float softplusf_(float z) { return fmaxf(z, 0.f) + log1pf(expf(-fabsf(z))); }

namespace pg8 { __device__ __forceinline__ unsigned cvt_pk_bf16(float lo, float hi); }
__device__ __forceinline__ bf16x8 lds_frag(const bfu* base, int row, int kofs, int stride) {
  return *reinterpret_cast<const bf16x8*>(base + row * stride + kofs);
}

__device__ __forceinline__ void mma16x64(f32x4 (&acc)[4], const bfu* sA, int arow0, const bfu* sB, int lane) {
  const int r = lane & 15, q = (lane >> 4) * 8;
#pragma unroll
  for (int ks = 0; ks < 2; ++ks) {
    bf16x8 a = lds_frag(sA, arow0 + r, ks * 32 + q, LDP);
#pragma unroll
    for (int n = 0; n < 4; ++n) {
      bf16x8 b = lds_frag(sB, n * 16 + r, ks * 32 + q, LDP);
      acc[n] = __builtin_amdgcn_mfma_f32_16x16x32_bf16(a, b, acc[n], 0, 0, 0);
    }
  }
}

__device__ __forceinline__ void load_tile64(bfu* s, const bfu* g, int gs, int tid) {
#pragma unroll
  for (int i = 0; i < 2; ++i) {
    int id = tid + i * 256;
    int r = id >> 3, c = (id & 7) * 8;
    *reinterpret_cast<uint4*>(s + r * LDP + c) = *reinterpret_cast<const uint4*>(g + (size_t)r * gs + c);
  }
}

template <int NI>
__device__ __forceinline__ void gemm_main(f32x4 (&acc)[4][NI], const bfu* __restrict__ A, int lda,
                                          const bfu* __restrict__ Bt, int ldb, int K, bfu* smem, int tid) {
  bfu* sA = smem;
  bfu* sB = smem + 2 * 128 * LDP;
  const int lane = tid & 63, w = tid >> 6, wm = w >> 1, wn = w & 1;
  const int lr = lane & 15, lq = (lane >> 4) * 8;
  const int crow = tid >> 3, ccol = (tid & 7) * 8;
  const bfu* Ap = A + (size_t)crow * lda + ccol;
  const bfu* Bp = Bt + (size_t)crow * ldb + ccol;
  uint4 ra[4], rb[NI];
#pragma unroll
  for (int i = 0; i < 4; ++i) ra[i] = *reinterpret_cast<const uint4*>(Ap + (size_t)i * 32 * lda);
#pragma unroll
  for (int i = 0; i < NI; ++i) rb[i] = *reinterpret_cast<const uint4*>(Bp + (size_t)i * 32 * ldb);
#pragma unroll
  for (int i = 0; i < 4; ++i) *reinterpret_cast<uint4*>(sA + (crow + i * 32) * LDP + ccol) = ra[i];
#pragma unroll
  for (int i = 0; i < NI; ++i) *reinterpret_cast<uint4*>(sB + (crow + i * 32) * LDP + ccol) = rb[i];
  __syncthreads();
  const int nk = K >> 6;
  for (int kt = 0; kt < nk; ++kt) {
    const int cur = kt & 1;
    if (kt + 1 < nk) {
      const int ko = (kt + 1) * 64;
#pragma unroll
      for (int i = 0; i < 4; ++i) ra[i] = *reinterpret_cast<const uint4*>(Ap + (size_t)i * 32 * lda + ko);
#pragma unroll
      for (int i = 0; i < NI; ++i) rb[i] = *reinterpret_cast<const uint4*>(Bp + (size_t)i * 32 * ldb + ko);
    }
    const bfu* a_s = sA + cur * 128 * LDP + (wm * 64) * LDP;
    const bfu* b_s = sB + cur * 128 * LDP + (wn * NI * 16) * LDP;
#pragma unroll
    for (int ks = 0; ks < 2; ++ks) {
      bf16x8 af[4], bfr[NI];
#pragma unroll
      for (int mi = 0; mi < 4; ++mi) af[mi] = lds_frag(a_s, mi * 16 + lr, ks * 32 + lq, LDP);
#pragma unroll
      for (int ni = 0; ni < NI; ++ni) bfr[ni] = lds_frag(b_s, ni * 16 + lr, ks * 32 + lq, LDP);
#pragma unroll
      for (int mi = 0; mi < 4; ++mi)
#pragma unroll
        for (int ni = 0; ni < NI; ++ni)
          acc[mi][ni] = __builtin_amdgcn_mfma_f32_16x16x32_bf16(af[mi], bfr[ni], acc[mi][ni], 0, 0, 0);
    }
    if (kt + 1 < nk) {
      bfu* sAn = sA + (cur ^ 1) * 128 * LDP;
      bfu* sBn = sB + (cur ^ 1) * 128 * LDP;
#pragma unroll
      for (int i = 0; i < 4; ++i) *reinterpret_cast<uint4*>(sAn + (crow + i * 32) * LDP + ccol) = ra[i];
#pragma unroll
      for (int i = 0; i < NI; ++i) *reinterpret_cast<uint4*>(sBn + (crow + i * 32) * LDP + ccol) = rb[i];
    }
    __syncthreads();
  }
}

template <int NI>
__device__ __forceinline__ void zero_acc(f32x4 (&acc)[4][NI]) {
#pragma unroll
  for (int i = 0; i < 4; ++i)
#pragma unroll
    for (int j = 0; j < NI; ++j) acc[i][j] = (f32x4){0.f, 0.f, 0.f, 0.f};
}

__device__ __forceinline__ int win_src(int dc) {
  if (dc < 768) return dc;
  if (dc < 1536) return dc + 4;
  if (dc < 4096) return dc + 20;
  if (dc < 8192) return dc + 28;
  int s = dc - 8192;
  if (s < 4) return 768 + s;
  if (s < 20) return 1540 + (s - 4);
  if (s < 28) return 4116 + (s - 20);
  return -1;
}
__device__ __forceinline__ int ffi_src(int dc) {
  const int G = dc >> 5, w = dc & 31, f = w >> 3, r = w & 7;
  return (r < 4) ? (G * 16 + f * 4 + r) : (FH + G * 16 + f * 4 + (r - 4));
}

__device__ __forceinline__ void convert_tile(const float* __restrict__ W, int ldw, int kt, int ntd, bfu* __restrict__ Wt,
                                             int ldt, int kofs, int mode, const float* __restrict__ rowgain,
                                             bfu* sT, int tid) {
  const int c4 = (tid & 15) * 4, r0 = tid >> 4;
  const int dc = ntd * 64 + c4;
  int sc = dc;
  if (mode == 1) sc = win_src(dc);
  else if (mode == 2) sc = ffi_src(dc);
  float4 v[8];
  float gg[8];
#pragma unroll
  for (int ps = 0; ps < 8; ++ps) {
    const int k = kt * 64 + r0 + ps * 16;
    v[ps] = make_float4(0.f, 0.f, 0.f, 0.f);
    if (sc >= 0) v[ps] = *reinterpret_cast<const float4*>(W + (size_t)k * ldw + sc);
    gg[ps] = rowgain ? rowgain[k] : 1.f;
  }
#pragma unroll
  for (int ps = 0; ps < 8; ++ps) {
    const int kk = r0 + (ps & 3) * 16;
    bfu* sTt = sT + (ps >> 2) * 64 * LDP;
    const float g = gg[ps];
    sTt[(c4 + 0) * LDP + kk] = f2bf(v[ps].x * g);
    sTt[(c4 + 1) * LDP + kk] = f2bf(v[ps].y * g);
    sTt[(c4 + 2) * LDP + kk] = f2bf(v[ps].z * g);
    sTt[(c4 + 3) * LDP + kk] = f2bf(v[ps].w * g);
  }
  __syncthreads();
#pragma unroll
  for (int i = 0; i < 4; ++i) {
    const int id = tid + (i & 1) * 256;
    const int nn = id >> 3, kc = (id & 7) * 8;
    const int tt = i >> 1;
    *reinterpret_cast<uint4*>(Wt + (size_t)(ntd * 64 + nn) * ldt + kofs + (kt + tt) * 64 + kc) =
        *reinterpret_cast<const uint4*>(sT + tt * 64 * LDP + nn * LDP + kc);
  }
  __syncthreads();
}

__device__ void phase_convert_norm(CParams& p_o, int l, bfu* smem, int tid, int vb, int vg) {
  const int nconv = 2400, nnorm = 4096;
  const int nrot = (l == 0) ? 64 : 0;
  const int total = nconv + nnorm + nrot;
  if (l == 0 && vb == 0 && tid < 64) ((unsigned*)(p_o.ws + OFF_ctr))[tid] = 0u;
  for (int it = vb; it < total; it += vg) {
    CParams* pp_ = &p_o;
    asm volatile("" : "+s"(pp_));
    CParams& p = *pp_;
    if (it < nconv) {
      if (it < 1056) {
        int kt = (it & 7) * 2, nt = it >> 3;
        convert_tile(p.in[4] + (size_t)l * DM * NSRC, NSRC, kt, nt, ((bfu*)(p.ws + OFF_WinT)), DM, 0, 1, nullptr, smem, tid);
      } else if (it < 1152) {
        int j = it - 1056; int br = j >> 5; j &= 31;
        int kt = (j & 1) * 2, nt = j >> 1;
        const float* W = (br == 0 ? p.in[18] : (br == 1 ? p.in[19] : p.in[20])) + (size_t)l * 256 * DM;
        convert_tile(W, DM, kt, nt, ((bfu*)(p.ws + OFF_WupT)), YW, br * 256, 0, nullptr, smem, tid);
      } else if (it < 1216) {
        int j = it - 1152; int kt = (j & 3) * 2, nt = j >> 2;
        convert_tile(p.in[21] + (size_t)l * 512 * DM, DM, kt, nt, ((bfu*)(p.ws + OFF_WupT)), YW, 768, 0, p.in[17] + l * 512, smem, tid);
      } else if (it < 1344) {
        int j = it - 1216; int kt = (j & 7) * 2, nt = j >> 3;
        convert_tile(p.in[22] + (size_t)l * DM * DM, DM, kt, nt, ((bfu*)(p.ws + OFF_WoutT)), DM, 0, 0, nullptr, smem, tid);
      } else if (it < 2048) {
        int j = it - 1344; int kt = (j & 7) * 2, nt = j >> 3;
        convert_tile(p.in[23] + (size_t)l * DM * 2 * FH, 2 * FH, kt, nt, ((bfu*)(p.ws + OFF_WfiT)), DM, 0, 2, nullptr, smem, tid);
      } else {
        int j = it - 2048; int kt = (j % 22) * 2, nt = j / 22;
        convert_tile(p.in[24] + (size_t)l * FH * DM, DM, kt, nt, ((bfu*)(p.ws + OFF_WfoT)), FH, 0, 0, nullptr, smem, tid);
      }
    } else if (it < nconv + nnorm) {
      int row = (it - nconv) * 4 + (tid >> 6);
      int lane = tid & 63;
      const float* xr = (l == 0 ? p.in[0] : p.out) + (size_t)row * DM;
      const float* g = p.in[2] + l * DM;
      float4 v[4];
      float ss = 0.f;
#pragma unroll
      for (int i = 0; i < 4; ++i) {
        v[i] = *reinterpret_cast<const float4*>(xr + i * 256 + lane * 4);
        ss += v[i].x * v[i].x + v[i].y * v[i].y + v[i].z * v[i].z + v[i].w * v[i].w;
      }
#pragma unroll
      for (int m = 1; m < 64; m <<= 1) ss += __shfl_xor(ss, m, 64);
      float rstd = rsqrtf(ss * (1.f / DM) + EPS);
#pragma unroll
      for (int i = 0; i < 4; ++i) {
        float4 gg = *reinterpret_cast<const float4*>(g + i * 256 + lane * 4);
        ushort4 o;
        o.x = f2bf(v[i].x * rstd * gg.x); o.y = f2bf(v[i].y * rstd * gg.y);
        o.z = f2bf(v[i].z * rstd * gg.z); o.w = f2bf(v[i].w * rstd * gg.w);
        *reinterpret_cast<ushort4*>(((bfu*)(p.ws + OFF_h)) + (size_t)row * DM + i * 256 + lane * 4) = o;
      }
    } else {
      int base = (it - nconv - nnorm) * 256;
      for (int e = tid; e < 256 * 32; e += 256) {
        int tok = base + (e >> 5), i = e & 31;
        float inv = powf(10000.f, -(float)i / 32.f);
        float ang = (float)((const int*)p.in[1])[tok] * inv;
        double a = (double)ang;
        double kq = rint(a * 0.15915494309189535);
        float r = (float)(a - kq * 6.283185307179586);
        ((float*)(p.ws + OFF_rcos))[tok * 32 + i] = cosf(r);
        ((float*)(p.ws + OFF_rsin))[tok * 32 + i] = sinf(r);
      }
    }
  }
}

__device__ void phase_norm2(CParams& p, int l, int tid, int vb, int vg) {
  for (int it = vb; it < 4096; it += vg) {
    int row = it * 4 + (tid >> 6);
    int lane = tid & 63;
    const float* xr = p.out + (size_t)row * DM;
    const float* g = p.in[3] + l * DM;
    float4 v[4];
    float ss = 0.f;
#pragma unroll
    for (int i = 0; i < 4; ++i) {
      v[i] = *reinterpret_cast<const float4*>(xr + i * 256 + lane * 4);
      ss += v[i].x * v[i].x + v[i].y * v[i].y + v[i].z * v[i].z + v[i].w * v[i].w;
    }
#pragma unroll
    for (int m = 1; m < 64; m <<= 1) ss += __shfl_xor(ss, m, 64);
    float rstd = rsqrtf(ss * (1.f / DM) + EPS);
#pragma unroll
    for (int i = 0; i < 4; ++i) {
      float4 gg = *reinterpret_cast<const float4*>(g + i * 256 + lane * 4);
      ushort4 o;
      o.x = f2bf(v[i].x * rstd * gg.x); o.y = f2bf(v[i].y * rstd * gg.y);
      o.z = f2bf(v[i].z * rstd * gg.z); o.w = f2bf(v[i].w * rstd * gg.w);
      *reinterpret_cast<ushort4*>(((bfu*)(p.ws + OFF_h)) + (size_t)row * DM + i * 256 + lane * 4) = o;
    }
  }
}

__device__ __forceinline__ float wave_incl_scan(float v, int lane) {
#pragma unroll
  for (int d = 1; d < 64; d <<= 1) {
    float o = __shfl_up(v, d, 64);
    if (lane >= d) v += o;
  }
  return v;
}

__device__ void phase_prep(CParams& p_o, int l, bfu* smem, int tid, int wr, int vb, int vg) {
  bfu* sK = smem;
  bfu* sV = smem + 64 * LDP;
  float* sF = reinterpret_cast<float*>(smem + 2 * 64 * LDP);
  float* s_glr = sF;
  float* s_seg = sF + 1024;
  float* s_ps = sF + 1280;
  float* s_cs = sF + 1344;
  float* s_dt = sF + 1408;
  const int lane = tid & 63, seg = tid >> 6, col = lane;
  const int total = NCH * 20;
  for (int it = vb; it < total; it += vg) {
    CParams* pp_ = &p_o;
    asm volatile("" : "+s"(pp_));
    CParams& p = *pp_;
    const int c = it / 20, hs = it - c * 20;
    const int tok0 = c * 64;
    bfu kreg[16], vreg[16];
    if (hs < 4) {
      const int h = hs;
      for (int i = tid; i < 1024; i += 256) s_glr[i] = ((float*)(p.ws + OFF_small))[(tok0 + (i >> 4)) * 32 + 4 + (i & 15)];
      float wv[16];
#pragma unroll
      for (int r = 0; r < 16; ++r) wv[r] = p.in[8][(l * 16 + r) * 256 + h * 64 + col];
      const float bias = p.in[9][l * 256 + h * 64 + col];
      bfu qraw[16], kraw[16];
#pragma unroll
      for (int i = 0; i < 16; ++i) {
        const bfu* ur = ((bfu*)(p.ws + OFF_u)) + (size_t)(tok0 + seg * 16 + i) * NU + h * 64 + col;
        qraw[i] = ur[768]; kraw[i] = ur[1024]; vreg[i] = ur[1280];
      }
      __syncthreads();
      float lb[16];
      float run = 0.f;
#pragma unroll
      for (int i = 0; i < 16; ++i) {
        int t = seg * 16 + i;
        float z = bias;
#pragma unroll
        for (int r = 0; r < 16; ++r) z += s_glr[t * 16 + r] * wv[r];
        run += logsigmoid_fast(z) * (1.f / 16.f);
        lb[i] = run;
      }
      s_seg[seg * 64 + col] = run;
      __syncthreads();
      float pre = 0.f, blast = 0.f;
#pragma unroll
      for (int s2 = 0; s2 < 4; ++s2) {
        float v = s_seg[s2 * 64 + col];
        if (s2 < seg) pre += v;
        blast += v;
      }
      if (seg == 0) {
        float e = __expf(blast);
        s_ps[col] = e;
        ((float*)(p.ws + OFF_dec))[(hs * NCH + c) * 64 + col] = e;
        ((float*)(p.ws + OFF_csb))[hs * S_LEN + tok0 + col] = 0.f;
      }
#pragma unroll
      for (int i = 0; i < 16; ++i) {
        int tok = tok0 + seg * 16 + i;
        float b = lb[i] + pre;
        bfu* ur = ((bfu*)(p.ws + OFF_u)) + (size_t)tok * NU + h * 64 + col;
        float q = bf2f(qraw[i]), k = bf2f(kraw[i]);
        bfu qd = f2bf(q * 0.125f * __expf(b));
        bfu ki = f2bf(k * __expf(-b));
        if (wr) { ur[768] = qd; ur[1024] = ki; }
        kreg[i] = ki;
      }
    } else if (hs < 8) {
      const int h = hs - 4;
      const float lg = log1pf(-exp2f(-5.f - (float)h));
      if (seg == 0) {
        s_ps[col] = 1.f;
        ((float*)(p.ws + OFF_dec))[(hs * NCH + c) * 64 + col] = __expf(64.f * lg);
        ((float*)(p.ws + OFF_csb))[hs * S_LEN + tok0 + col] = (float)(col + 1) * lg;
      }
#pragma unroll
      for (int i = 0; i < 16; ++i) {
        int t = seg * 16 + i, tok = tok0 + t;
        float cs = ((float*)(p.ws + OFF_rcos))[tok * 32 + (col & 31)], sn = ((float*)(p.ws + OFF_rsin))[tok * 32 + (col & 31)];
        bfu* ur = ((bfu*)(p.ws + OFF_u)) + (size_t)tok * NU + h * 64;
        float qo = bf2f(ur[1792 + col]), qx = bf2f(ur[1792 + (col ^ 32)]);
        float ko = bf2f(ur[2048 + col]), kx = bf2f(ur[2048 + (col ^ 32)]);
        vreg[i] = ur[2304 + col];
        float qr, kr;
        if (col < 32) { qr = qo * cs - qx * sn; kr = ko * cs - kx * sn; }
        else          { qr = qx * sn + qo * cs; kr = kx * sn + ko * cs; }
        kr *= 0.125f;
        bfu kb = f2bf(kr);
        if (wr) { ur[1792 + col] = f2bf(qr); ur[2048 + col] = kb; }
        kreg[i] = f2bf(bf2f(kb) * __expf(lg * (float)(63 - t)));
      }
    } else if (hs < 16) {
      const int h = hs - 8, g = h >> 2;
      const int chx = h * 64 + col, chb = 512 + g * 64 + col, chc = 640 + g * 64 + col;
      bfu xin[19], bin[19], cin[19];
      {
        const int tb = tok0 + seg * 16 - 3;
        const bfu* ub = ((bfu*)(p.ws + OFF_u)) + 3328;
#pragma unroll
        for (int i = 0; i < 19; ++i) {
          const int tk = tb + i;
          const bool ok = tk >= 0;
          const bfu* ur = ub + (size_t)(ok ? tk : 0) * NU;
          xin[i] = ok ? ur[chx] : (bfu)0;
          bin[i] = ok ? ur[chb] : (bfu)0;
          cin[i] = ok ? ur[chc] : (bfu)0;
        }
      }
      if (seg == 0) {
        float dtv = softplus_fast(((float*)(p.ws + OFF_small))[(tok0 + lane) * 32 + 20 + h] + p.in[14][l * 8 + h]);
        float a = -__expf(p.in[15][l * 8 + h]);
        float cs = wave_incl_scan(dtv * a, lane);
        s_cs[lane] = cs;
        s_dt[lane] = dtv;
        ((float*)(p.ws + OFF_csb))[hs * S_LEN + tok0 + lane] = cs;
        s_ps[lane] = 1.f;
      }
      __syncthreads();
      const float cs_last = s_cs[63];
      if (seg == 0) ((float*)(p.ws + OFF_dec))[(hs * NCH + c) * 64 + col] = __expf(cs_last);
      float wx[4], wb[4], wc[4];
#pragma unroll
      for (int j = 0; j < 4; ++j) {
        wx[j] = p.in[12][(l * 4 + j) * 768 + chx];
        wb[j] = p.in[12][(l * 4 + j) * 768 + chb];
        wc[j] = p.in[12][(l * 4 + j) * 768 + chc];
      }
      const float bx = p.in[13][l * 768 + chx], bb = p.in[13][l * 768 + chb], bc = p.in[13][l * 768 + chc];
#pragma unroll
      for (int i = 0; i < 16; ++i) {
        int t = seg * 16 + i, tok = tok0 + t;
        float xs = siluf_(bx + wx[0] * bf2f(xin[i]) + wx[1] * bf2f(xin[i + 1]) + wx[2] * bf2f(xin[i + 2]) + wx[3] * bf2f(xin[i + 3]));
        float bs = siluf_(bb + wb[0] * bf2f(bin[i]) + wb[1] * bf2f(bin[i + 1]) + wb[2] * bf2f(bin[i + 2]) + wb[3] * bf2f(bin[i + 3]));
        float cv = siluf_(bc + wc[0] * bf2f(cin[i]) + wc[1] * bf2f(cin[i + 1]) + wc[2] * bf2f(cin[i + 2]) + wc[3] * bf2f(cin[i + 3]));
        bfu xb = f2bf(xs);
        ((bfu*)(p.ws + OFF_ssdX))[(size_t)tok * 512 + chx] = xb;
        if ((h & 3) == 0) {
          ((bfu*)(p.ws + OFF_ssdB))[((size_t)g * S_LEN + tok) * 64 + col] = f2bf(bs);
          ((bfu*)(p.ws + OFF_ssdC))[((size_t)g * S_LEN + tok) * 64 + col] = f2bf(cv);
        }
        vreg[i] = f2bf(xs * s_dt[t]);
        kreg[i] = f2bf(bs * __expf(cs_last - s_cs[t]));
      }
    } else {
      const int h = hs - 16;
      if (seg == 0) {
        float lf = logsigmoid_fast(((float*)(p.ws + OFF_small))[(tok0 + lane) * 32 + h] + p.in[5][l * 4 + h]);
        float cs = wave_incl_scan(lf, lane);
        ((float*)(p.ws + OFF_foxc))[h * S_LEN + tok0 + lane] = cs;
        if (lane == 63) ((float*)(p.ws + OFF_foxtot))[h * NCH + c] = cs;
      }
      const float qg = p.in[6][l * 64 + col], kg = p.in[7][l * 64 + col];
#pragma unroll
      for (int i = 0; i < 16; ++i) {
        int tok = tok0 + seg * 16 + i;
        const bfu* ur = ((bfu*)(p.ws + OFF_u)) + (size_t)tok * NU + h * 64 + col;
        float q = bf2f(ur[0]), k = bf2f(ur[256]);
        vreg[i] = ur[512];
        float sq = q * q, sk = k * k;
#pragma unroll
        for (int m = 1; m < 64; m <<= 1) { sq += __shfl_xor(sq, m, 64); sk += __shfl_xor(sk, m, 64); }
        ((bfu*)(p.ws + OFF_foxq))[((size_t)h * S_LEN + tok) * 64 + col] = f2bf(q * rsqrtf(sq * (1.f / 64.f) + EPS) * qg * (0.125f * 1.44269504088896f));
        ((bfu*)(p.ws + OFF_foxk))[((size_t)h * S_LEN + tok) * 64 + col] = f2bf(k * rsqrtf(sk * (1.f / 64.f) + EPS) * kg);
      }
      uint4 v0, v1;
      v0.x = vreg[0] | ((unsigned)vreg[1] << 16); v0.y = vreg[2] | ((unsigned)vreg[3] << 16);
      v0.z = vreg[4] | ((unsigned)vreg[5] << 16); v0.w = vreg[6] | ((unsigned)vreg[7] << 16);
      v1.x = vreg[8] | ((unsigned)vreg[9] << 16); v1.y = vreg[10] | ((unsigned)vreg[11] << 16);
      v1.z = vreg[12] | ((unsigned)vreg[13] << 16); v1.w = vreg[14] | ((unsigned)vreg[15] << 16);
      bfu* dst = ((bfu*)(p.ws + OFF_foxvT)) + ((size_t)h * 64 + col) * S_LEN + tok0 + seg * 16;
      *reinterpret_cast<uint4*>(dst) = v0;
      *reinterpret_cast<uint4*>(dst + 8) = v1;
      continue;
    }
    {
      uint4 k0, k1, v0, v1;
      k0.x = kreg[0] | ((unsigned)kreg[1] << 16); k0.y = kreg[2] | ((unsigned)kreg[3] << 16);
      k0.z = kreg[4] | ((unsigned)kreg[5] << 16); k0.w = kreg[6] | ((unsigned)kreg[7] << 16);
      k1.x = kreg[8] | ((unsigned)kreg[9] << 16); k1.y = kreg[10] | ((unsigned)kreg[11] << 16);
      k1.z = kreg[12] | ((unsigned)kreg[13] << 16); k1.w = kreg[14] | ((unsigned)kreg[15] << 16);
      v0.x = vreg[0] | ((unsigned)vreg[1] << 16); v0.y = vreg[2] | ((unsigned)vreg[3] << 16);
      v0.z = vreg[4] | ((unsigned)vreg[5] << 16); v0.w = vreg[6] | ((unsigned)vreg[7] << 16);
      v1.x = vreg[8] | ((unsigned)vreg[9] << 16); v1.y = vreg[10] | ((unsigned)vreg[11] << 16);
      v1.z = vreg[12] | ((unsigned)vreg[13] << 16); v1.w = vreg[14] | ((unsigned)vreg[15] << 16);
      *reinterpret_cast<uint4*>(sK + col * LDP + seg * 16) = k0;
      *reinterpret_cast<uint4*>(sK + col * LDP + seg * 16 + 8) = k1;
      *reinterpret_cast<uint4*>(sV + col * LDP + seg * 16) = v0;
      *reinterpret_cast<uint4*>(sV + col * LDP + seg * 16 + 8) = v1;
      bfu* dst = ((bfu*)(p.ws + OFF_VT)) + (((size_t)hs * NCH + c) * 64 + col) * 64 + seg * 16;
      *reinterpret_cast<uint4*>(dst) = v0;
      *reinterpret_cast<uint4*>(dst + 8) = v1;
    }
    __syncthreads();
    {
      f32x4 acc[4];
#pragma unroll
      for (int n = 0; n < 4; ++n) acc[n] = (f32x4){0.f, 0.f, 0.f, 0.f};
      {
        const int r = lane & 15, q8 = (lane >> 4) * 8;
#pragma unroll
        for (int ks = 0; ks < 2; ++ks) {
          const bf16x8 vfr = lds_frag(sV, seg * 16 + r, ks * 32 + q8, LDP);
#pragma unroll
          for (int n = 0; n < 4; ++n)
            acc[n] = __builtin_amdgcn_mfma_f32_16x16x32_bf16(lds_frag(sK, n * 16 + r, ks * 32 + q8, LDP), vfr, acc[n], 0, 0, 0);
        }
      }
      bfu* st = ((bfu*)(p.ws + OFF_ST)) + ((size_t)hs * NCH + c) * 4096 + (seg * 16 + (lane & 15)) * 64 + (lane >> 4) * 4;
#pragma unroll
      for (int n = 0; n < 4; ++n) {
        const f32x4 ps = *reinterpret_cast<const f32x4*>(s_ps + n * 16 + (lane >> 4) * 4);
        uint2 wv;
        wv.x = pg8::cvt_pk_bf16(acc[n][0] * ps[0], acc[n][1] * ps[1]);
        wv.y = pg8::cvt_pk_bf16(acc[n][2] * ps[2], acc[n][3] * ps[3]);
        *reinterpret_cast<uint2*>(st + n * 16) = wv;
      }
    }
    __syncthreads();
  }
}

__device__ void phase_scan(CParams& p, bfu* smem, int tid, int wr, int vb, int vg) {
  float* s_x = reinterpret_cast<float*>(smem);
  const int g = tid >> 5, dp = tid & 31;
  for (int it = vb; it < 16 * 64; it += vg) {
    const int hs = it >> 6, e = it & 63;
    unsigned* stp = reinterpret_cast<unsigned*>(((bfu*)(p.ws + OFF_ST)) + ((size_t)hs * NCH + g * 32) * 4096 + e * 64 + dp * 2);
    const float2* dcp = reinterpret_cast<const float2*>(((float*)(p.ws + OFF_dec)) + ((size_t)hs * NCH + g * 32) * 64 + dp * 2);
    unsigned kv[32];
    float2 dc[32];
#pragma unroll
    for (int i = 0; i < 32; ++i) {
      kv[i] = stp[(size_t)i * 2048];
      dc[i] = dcp[i * 32];
    }
    float t0 = 0.f, t1 = 0.f, d0 = 1.f, d1 = 1.f;
#pragma unroll
    for (int i = 0; i < 32; ++i) {
      t0 = t0 * dc[i].x + bf2f((bfu)(kv[i] & 0xffffu));
      t1 = t1 * dc[i].y + bf2f((bfu)(kv[i] >> 16));
      d0 *= dc[i].x;
      d1 *= dc[i].y;
    }
    *reinterpret_cast<float4*>(s_x + (g * 32 + dp) * 4) = make_float4(t0, t1, d0, d1);
    __syncthreads();
    float s0 = 0.f, s1 = 0.f;
    for (int gg = 0; gg < g; ++gg) {
      const float4 x = *reinterpret_cast<const float4*>(s_x + (gg * 32 + dp) * 4);
      s0 = s0 * x.z + x.x;
      s1 = s1 * x.w + x.y;
    }
#pragma unroll
    for (int i = 0; i < 32; ++i) {
      const unsigned o = pg8::cvt_pk_bf16(s0, s1);
      if (wr) stp[(size_t)i * 2048] = o;
      s0 = s0 * dc[i].x + bf2f((bfu)(kv[i] & 0xffffu));
      s1 = s1 * dc[i].y + bf2f((bfu)(kv[i] >> 16));
    }
    __syncthreads();
  }
}

__device__ __forceinline__ void att_compute(const bfu* kS, const bfu* vS, const float* cS, const bfu* sQw,
                                            const float (&ct)[2], float (&l_run)[2], f32x4 (&O)[2][4],
                                            int kt, int qb, int r0, int w, int lr, int lq, int lg4) {
    f32x4 sc[2][4];
#pragma unroll
    for (int mi = 0; mi < 2; ++mi)
#pragma unroll
      for (int n = 0; n < 4; ++n) sc[mi][n] = (f32x4){0.f, 0.f, 0.f, 0.f};
#pragma unroll
    for (int ks = 0; ks < 2; ++ks) {
      bf16x8 aq0 = lds_frag(sQw, lr, ks * 32 + lq, LDP);
      bf16x8 aq1 = lds_frag(sQw, 16 + lr, ks * 32 + lq, LDP);
#pragma unroll
      for (int n = 0; n < 4; ++n) {
        bf16x8 kf = lds_frag(kS, n * 16 + lr, ks * 32 + lq, LDP);
        sc[0][n] = __builtin_amdgcn_mfma_f32_16x16x32_bf16(kf, aq0, sc[0][n], 0, 0, 0);
        sc[1][n] = __builtin_amdgcn_mfma_f32_16x16x32_bf16(kf, aq1, sc[1][n], 0, 0, 0);
      }
    }
    f32x4 csv[4];
#pragma unroll
    for (int n = 0; n < 4; ++n) csv[n] = *reinterpret_cast<const f32x4*>(cS + n * 16 + lg4);
    const bool diag = (kt >= 2 * qb);
    bf16x8 pf[2][2];
#pragma unroll
    for (int mi = 0; mi < 2; ++mi) {
      const int qrow = r0 + w * 32 + mi * 16 + lr;
      float ps = 0.f;
#pragma unroll
      for (int n = 0; n < 4; ++n)
#pragma unroll
        for (int j = 0; j < 4; ++j) {
          float v = (sc[mi][n][j] + ct[mi]) - csv[n][j];
          if (diag && (kt * 64 + n * 16 + lg4 + j > qrow)) v = -INFINITY;
          const float pv = __builtin_amdgcn_exp2f(v);
          sc[mi][n][j] = pv;
          ps += pv;
        }
      l_run[mi] += ps;
#pragma unroll
      for (int ks = 0; ks < 2; ++ks) {
        union { bf16x8 v; unsigned u[4]; } pk;
        pk.u[0] = pg8::cvt_pk_bf16(sc[mi][2 * ks][0], sc[mi][2 * ks][1]);
        pk.u[1] = pg8::cvt_pk_bf16(sc[mi][2 * ks][2], sc[mi][2 * ks][3]);
        pk.u[2] = pg8::cvt_pk_bf16(sc[mi][2 * ks + 1][0], sc[mi][2 * ks + 1][1]);
        pk.u[3] = pg8::cvt_pk_bf16(sc[mi][2 * ks + 1][2], sc[mi][2 * ks + 1][3]);
        pf[mi][ks] = pk.v;
      }
    }
#pragma unroll
    for (int ks = 0; ks < 2; ++ks) {
#pragma unroll
      for (int ef = 0; ef < 4; ++ef) {
        union { bf16x8 v; uint2 h2[2]; } vf;
        vf.h2[0] = *reinterpret_cast<const uint2*>(vS + (ef * 16 + lr) * LDP + ks * 32 + lg4);
        vf.h2[1] = *reinterpret_cast<const uint2*>(vS + (ef * 16 + lr) * LDP + ks * 32 + 16 + lg4);
#pragma unroll
        for (int mi = 0; mi < 2; ++mi)
          O[mi][ef] = __builtin_amdgcn_mfma_f32_16x16x32_bf16(vf.v, pf[mi][ks], O[mi][ef], 0, 0, 0);
      }
    }
}

__device__ void attn_item(CParams& p, int l, int qb, int h, bfu* smem, int tid, int half, unsigned char* smem_raw) {
  bfu* sK = smem;
  bfu* sV = smem + 2 * 64 * LDP;
  float* s_c = reinterpret_cast<float*>(smem + 4 * 64 * LDP);
  float* s_off = s_c + 128;
  const int lane = tid & 63, w = tid >> 6;
  const int lr = lane & 15, lq = (lane >> 4) * 8, lg4 = (lane >> 4) * 4;
  const int r0 = qb * 128;
  const float L2E = 1.44269504088896f;
  s_off[tid] = ((float*)(p.ws + OFF_foxtot))[h * NCH + tid];
  __syncthreads();
  float myoff = 0.f;
  for (int i = 0; i < tid; ++i) myoff += s_off[i];
  __syncthreads();
  s_off[tid] = myoff;
  float* s_misc = reinterpret_cast<float*>(smem + 28416);
  if (tid < 64) {
    float gq = fabsf(p.in[6][l * 64 + tid]), gk = fabsf(p.in[7][l * 64 + tid]);
#pragma unroll
    for (int m = 1; m < 64; m <<= 1) { gq = fmaxf(gq, __shfl_xor(gq, m, 64)); gk = fmaxf(gk, __shfl_xor(gk, m, 64)); }
    if (tid == 0) { s_misc[0] = 40.f + 2.f * 8.f * gq * gk * 1.01f; reinterpret_cast<int*>(s_misc)[1] = 2 * qb; s_misc[2] = 8.f * gq * gk * 1.01f * 1.44269504088896f; }
  }
  __syncthreads();
  {
    const float thr = s_misc[0];
    const float cref = s_off[2 * qb];
    if (tid < 2 * qb && s_off[tid + 1] <= cref + thr) atomicMin(reinterpret_cast<int*>(s_misc) + 1, tid);
  }
  __syncthreads();
  int kt_min = reinterpret_cast<int*>(s_misc)[1];
  const int nkt = 2 * qb + 2;
  if ((nkt - kt_min) & 1) kt_min -= 1;
  const bfu* Qg = ((bfu*)(p.ws + OFF_foxq)) + (size_t)h * S_LEN * 64;
  const bfu* Kg = ((bfu*)(p.ws + OFF_foxk)) + (size_t)h * S_LEN * 64;
  const bfu* Vg = ((bfu*)(p.ws + OFF_foxvT)) + (size_t)h * 64 * S_LEN;
  const float* Cg = ((float*)(p.ws + OFF_foxc)) + (size_t)h * S_LEN;
  bfu* sQ = smem + 4 * 64 * LDP + 768;
  {
#pragma unroll
    for (int i = 0; i < 4; ++i) {
      int id = tid + i * 256;
      int r = id >> 3, c = (id & 7) * 8;
      *reinterpret_cast<uint4*>(sQ + r * LDP + c) = *reinterpret_cast<const uint4*>(Qg + (size_t)(r0 + r) * 64 + c);
    }
  }
  const bfu* sQw = sQ + (w * 32) * LDP;
  float ct[2], l_run[2];
  const float lbound = s_misc[2];
  f32x4 O[2][4];
#pragma unroll
  for (int mi = 0; mi < 2; ++mi) {
    const int qrow = r0 + w * 32 + mi * 16 + lr;
    ct[mi] = (Cg[qrow] + s_off[qrow >> 6]) * L2E - lbound;
    l_run[mi] = 0.f;
#pragma unroll
    for (int n = 0; n < 4; ++n) O[mi][n] = (f32x4){0.f, 0.f, 0.f, 0.f};
  }
  const int nkh = (nkt - kt_min) >> 1;
  const int kt0 = kt_min + half * nkh;
  const int crow0 = tid >> 3, ccol = (tid & 7) * 8;
  uint4 rk0A, rk1A, rv0A, rv1A, rk0B, rk1B, rv0B, rv1B;
  float rcA = 0.f, rcB = 0.f;
  {
    const int k0 = kt0 * 64;
    rk0A = *reinterpret_cast<const uint4*>(Kg + (size_t)(k0 + crow0) * 64 + ccol);
    rk1A = *reinterpret_cast<const uint4*>(Kg + (size_t)(k0 + crow0 + 32) * 64 + ccol);
    rv0A = *reinterpret_cast<const uint4*>(Vg + (size_t)(crow0) * S_LEN + k0 + ccol);
    rv1A = *reinterpret_cast<const uint4*>(Vg + (size_t)(crow0 + 32) * S_LEN + k0 + ccol);
    if (tid < 64) rcA = (Cg[k0 + tid] + s_off[kt0]) * L2E;
  }
  *reinterpret_cast<uint4*>(sK + (crow0) * LDP + ccol) = rk0A;
  *reinterpret_cast<uint4*>(sK + (crow0 + 32) * LDP + ccol) = rk1A;
  *reinterpret_cast<uint4*>(sV + (crow0) * LDP + ccol) = rv0A;
  *reinterpret_cast<uint4*>(sV + (crow0 + 32) * LDP + ccol) = rv1A;
  if (tid < 64) s_c[tid] = rcA;
  rk0B = rk1B = rv0B = rv1B = rk0A;
  __syncthreads();
#define ATT_LOAD(S, KT)                                                                              \
  {                                                                                                  \
    const int k0_ = (KT) * 64;                                                                       \
    rk0##S = *reinterpret_cast<const uint4*>(Kg + (size_t)(k0_ + crow0) * 64 + ccol);                \
    rk1##S = *reinterpret_cast<const uint4*>(Kg + (size_t)(k0_ + crow0 + 32) * 64 + ccol);           \
    rv0##S = *reinterpret_cast<const uint4*>(Vg + (size_t)(crow0) * S_LEN + k0_ + ccol);             \
    rv1##S = *reinterpret_cast<const uint4*>(Vg + (size_t)(crow0 + 32) * S_LEN + k0_ + ccol);        \
    if (tid < 64) rc##S = (Cg[k0_ + tid] + s_off[(KT)]) * L2E;                                       \
  }
#define ATT_STORE(S, BUF)                                                                            \
  {                                                                                                  \
    bfu* kN_ = sK + (BUF) * 64 * LDP;                                                                \
    bfu* vN_ = sV + (BUF) * 64 * LDP;                                                                \
    *reinterpret_cast<uint4*>(kN_ + (crow0) * LDP + ccol) = rk0##S;                                  \
    *reinterpret_cast<uint4*>(kN_ + (crow0 + 32) * LDP + ccol) = rk1##S;                             \
    *reinterpret_cast<uint4*>(vN_ + (crow0) * LDP + ccol) = rv0##S;                                  \
    *reinterpret_cast<uint4*>(vN_ + (crow0 + 32) * LDP + ccol) = rv1##S;                             \
    if (tid < 64) s_c[(BUF) * 64 + tid] = rc##S;                                                     \
  }
  if (nkh > 1) ATT_LOAD(B, kt0 + 1);
  for (int it = 0; it < nkh; it += 2) {
    if (it + 2 < nkh) ATT_LOAD(A, kt0 + it + 2);
    att_compute(sK, sV, s_c, sQw, ct, l_run, O, kt0 + it, qb, r0, w, lr, lq, lg4);
    if (it + 1 < nkh) ATT_STORE(B, 1);
    __syncthreads();
    if (it + 1 >= nkh) break;
    if (it + 3 < nkh) ATT_LOAD(B, kt0 + it + 3);
    att_compute(sK + 64 * LDP, sV + 64 * LDP, s_c + 64, sQw, ct, l_run, O, kt0 + it + 1, qb, r0, w, lr, lq, lg4);
    if (it + 2 < nkh) ATT_STORE(A, 0);
    __syncthreads();
  }
#undef ATT_LOAD
#undef ATT_STORE
  float* xch = reinterpret_cast<float*>(smem_raw + SMEM_HALF);
  if (half == 1) {
#pragma unroll
    for (int mi = 0; mi < 2; ++mi) {
#pragma unroll
      for (int n = 0; n < 4; ++n)
#pragma unroll
        for (int j = 0; j < 4; ++j) xch[((mi * 4 + n) * 4 + j) * 256 + tid] = O[mi][n][j];
      xch[(32 + mi) * 256 + tid] = l_run[mi];
    }
  }
  __syncthreads();
  if (half == 0) {
#pragma unroll
    for (int mi = 0; mi < 2; ++mi) {
      float lsum = l_run[mi] + xch[(32 + mi) * 256 + tid];
      lsum += __shfl_xor(lsum, 16, 64);
      lsum += __shfl_xor(lsum, 32, 64);
      const float inv = 1.f / lsum;
      const int qrow = r0 + w * 32 + mi * 16 + lr;
      bfu* yp = ((bfu*)(p.ws + OFF_y)) + (size_t)qrow * YW + h * 64 + lg4;
#pragma unroll
      for (int n = 0; n < 4; ++n) {
        float o0 = (O[mi][n][0] + xch[((mi * 4 + n) * 4 + 0) * 256 + tid]) * inv;
        float o1 = (O[mi][n][1] + xch[((mi * 4 + n) * 4 + 1) * 256 + tid]) * inv;
        float o2 = (O[mi][n][2] + xch[((mi * 4 + n) * 4 + 2) * 256 + tid]) * inv;
        float o3 = (O[mi][n][3] + xch[((mi * 4 + n) * 4 + 3) * 256 + tid]) * inv;
        uint2 wv;
        wv.x = pg8::cvt_pk_bf16(o0, o1);
        wv.y = pg8::cvt_pk_bf16(o2, o3);
        *reinterpret_cast<uint2*>(yp + n * 16) = wv;
      }
    }
  }
  __syncthreads();
}

__device__ void chunk_out_item(CParams& p, int l, int c, int hs, bfu* smem, int tid) {
  bfu* sQ = smem;
  bfu* sKi = smem + 64 * LDP;
  bfu* sV = smem + 2 * 64 * LDP;
  bfu* sS = smem + 3 * 64 * LDP;
  bfu* sP = smem + 4 * 64 * LDP;
  float* s_cs = reinterpret_cast<float*>(smem + 5 * 64 * LDP);
  const int lane = tid & 63, w = tid >> 6;
  const int lr = lane & 15, lq = (lane >> 4) * 8, lg4 = (lane >> 4) * 4;
  const int tok0 = c * 64;
  const int tl = w * 16 + lr, tok = tok0 + tl;
  const bfu *Qp, *Kp;
  int qs;
  if (hs < 4) { Qp = ((bfu*)(p.ws + OFF_u)) + (size_t)tok0 * NU + 768 + hs * 64; Kp = ((bfu*)(p.ws + OFF_u)) + (size_t)tok0 * NU + 1024 + hs * 64; qs = NU; }
  else if (hs < 8) { Qp = ((bfu*)(p.ws + OFF_u)) + (size_t)tok0 * NU + 1792 + (hs - 4) * 64; Kp = ((bfu*)(p.ws + OFF_u)) + (size_t)tok0 * NU + 2048 + (hs - 4) * 64; qs = NU; }
  else { int g = (hs - 8) >> 2; Qp = ((bfu*)(p.ws + OFF_ssdC)) + ((size_t)g * S_LEN + tok0) * 64; Kp = ((bfu*)(p.ws + OFF_ssdB)) + ((size_t)g * S_LEN + tok0) * 64; qs = 64; }
  uint2 g4[4], x4[4];
  f32x4 gn[4];
  const int hh = (hs < 8) ? (hs & 3) : (hs - 8);
  {
    const int gcol = (hs < 4) ? (1536 + hh * 64) : (hs < 8 ? (2560 + hh * 64) : (2816 + hh * 64));
    const bfu* gp = ((bfu*)(p.ws + OFF_u)) + (size_t)tok * NU + gcol + lg4;
    const bfu* xp = ((bfu*)(p.ws + OFF_ssdX)) + (size_t)tok * 512 + hh * 64 + lg4;
    const float* gnp = (hs < 4 ? p.in[10] : p.in[11]) + l * 64 + lg4;
#pragma unroll
    for (int n = 0; n < 4; ++n) {
      g4[n] = *reinterpret_cast<const uint2*>(gp + n * 16);
      x4[n] = (hs >= 8) ? *reinterpret_cast<const uint2*>(xp + n * 16) : make_uint2(0u, 0u);
      gn[n] = (hs < 8) ? *reinterpret_cast<const f32x4*>(gnp + n * 16) : (f32x4){1.f, 1.f, 1.f, 1.f};
    }
  }
  load_tile64(sQ, Qp, qs, tid);
  load_tile64(sKi, Kp, qs, tid);
  load_tile64(sV, ((bfu*)(p.ws + OFF_VT)) + ((size_t)hs * NCH + c) * 4096, 64, tid);
  load_tile64(sS, ((bfu*)(p.ws + OFF_ST)) + ((size_t)hs * NCH + c) * 4096, 64, tid);
  if (tid < 64) s_cs[tid] = ((float*)(p.ws + OFF_csb))[hs * S_LEN + tok0 + tid];
  __syncthreads();
  const bf16x8 qf0 = lds_frag(sQ, tl, lq, LDP), qf1 = lds_frag(sQ, tl, 32 + lq, LDP);
  f32x4 sc[4], o[4];
#pragma unroll
  for (int n = 0; n < 4; ++n) {
    sc[n] = (f32x4){0.f, 0.f, 0.f, 0.f};
    o[n] = (f32x4){0.f, 0.f, 0.f, 0.f};
  }
#pragma unroll
  for (int n = 0; n < 4; ++n) {
    sc[n] = __builtin_amdgcn_mfma_f32_16x16x32_bf16(lds_frag(sKi, n * 16 + lr, lq, LDP), qf0, sc[n], 0, 0, 0);
    sc[n] = __builtin_amdgcn_mfma_f32_16x16x32_bf16(lds_frag(sKi, n * 16 + lr, 32 + lq, LDP), qf1, sc[n], 0, 0, 0);
    o[n] = __builtin_amdgcn_mfma_f32_16x16x32_bf16(lds_frag(sS, n * 16 + lr, lq, LDP), qf0, o[n], 0, 0, 0);
    o[n] = __builtin_amdgcn_mfma_f32_16x16x32_bf16(lds_frag(sS, n * 16 + lr, 32 + lq, LDP), qf1, o[n], 0, 0, 0);
  }
  const float cst = s_cs[tl];
  const float rsc = __expf(cst);
#pragma unroll
  for (int n = 0; n < 4; ++n) {
    const f32x4 css = *reinterpret_cast<const f32x4*>(s_cs + n * 16 + lg4);
    float pv[4];
#pragma unroll
    for (int j = 0; j < 4; ++j) {
      const int s = n * 16 + lg4 + j;
      pv[j] = (s <= tl) ? sc[n][j] * __expf(cst - css[j]) : 0.f;
      o[n][j] *= rsc;
    }
    uint2 wv;
    wv.x = pg8::cvt_pk_bf16(pv[0], pv[1]);
    wv.y = pg8::cvt_pk_bf16(pv[2], pv[3]);
    *reinterpret_cast<uint2*>(sP + tl * LDP + n * 16 + lg4) = wv;
  }
  __syncthreads();
  {
    const bf16x8 pf0 = lds_frag(sP, tl, lq, LDP), pf1 = lds_frag(sP, tl, 32 + lq, LDP);
#pragma unroll
    for (int n = 0; n < 4; ++n) {
      o[n] = __builtin_amdgcn_mfma_f32_16x16x32_bf16(lds_frag(sV, n * 16 + lr, lq, LDP), pf0, o[n], 0, 0, 0);
      o[n] = __builtin_amdgcn_mfma_f32_16x16x32_bf16(lds_frag(sV, n * 16 + lr, 32 + lq, LDP), pf1, o[n], 0, 0, 0);
    }
  }
  float ss = 0.f;
  if (hs < 8) {
#pragma unroll
    for (int n = 0; n < 4; ++n) ss += (o[n][0] * o[n][0] + o[n][1] * o[n][1]) + (o[n][2] * o[n][2] + o[n][3] * o[n][3]);
    ss += __shfl_xor(ss, 16, 64);
    ss += __shfl_xor(ss, 32, 64);
    const float rstd = rsqrtf(ss * (1.f / 64.f) + EPS);
    bfu* yp = ((bfu*)(p.ws + OFF_y)) + (size_t)tok * YW + (hs < 4 ? 256 : 512) + hh * 64 + lg4;
#pragma unroll
    for (int n = 0; n < 4; ++n) {
      const float t0 = __uint_as_float(g4[n].x << 16), t1 = __uint_as_float(g4[n].x & 0xffff0000u);
      const float t2 = __uint_as_float(g4[n].y << 16), t3 = __uint_as_float(g4[n].y & 0xffff0000u);
      uint2 wv;
      wv.x = pg8::cvt_pk_bf16(o[n][0] * rstd * gn[n][0] * siluf_(t0), o[n][1] * rstd * gn[n][1] * siluf_(t1));
      wv.y = pg8::cvt_pk_bf16(o[n][2] * rstd * gn[n][2] * siluf_(t2), o[n][3] * rstd * gn[n][3] * siluf_(t3));
      *reinterpret_cast<uint2*>(yp + n * 16) = wv;
    }
  } else {
    const float dsk = p.in[16][l * 8 + hh];
    bfu* yp = ((bfu*)(p.ws + OFF_y)) + (size_t)tok * YW + 768 + hh * 64 + lg4;
#pragma unroll
    for (int n = 0; n < 4; ++n) {
      const float z0 = __uint_as_float(g4[n].x << 16), z1 = __uint_as_float(g4[n].x & 0xffff0000u);
      const float z2 = __uint_as_float(g4[n].y << 16), z3 = __uint_as_float(g4[n].y & 0xffff0000u);
      const float a0 = __uint_as_float(x4[n].x << 16), a1 = __uint_as_float(x4[n].x & 0xffff0000u);
      const float a2 = __uint_as_float(x4[n].y << 16), a3 = __uint_as_float(x4[n].y & 0xffff0000u);
      const float y0 = (o[n][0] + dsk * a0) * siluf_(z0), y1 = (o[n][1] + dsk * a1) * siluf_(z1);
      const float y2 = (o[n][2] + dsk * a2) * siluf_(z2), y3 = (o[n][3] + dsk * a3) * siluf_(z3);
      ss += (y0 * y0 + y1 * y1) + (y2 * y2 + y3 * y3);
      uint2 wv;
      wv.x = pg8::cvt_pk_bf16(y0, y1);
      wv.y = pg8::cvt_pk_bf16(y2, y3);
      *reinterpret_cast<uint2*>(yp + n * 16) = wv;
    }
    ss += __shfl_xor(ss, 16, 64);
    ss += __shfl_xor(ss, 32, 64);
    if (lg4 == 0) ((float*)(p.ws + OFF_ssq))[tok * 8 + hh] = ss;
  }
  __syncthreads();
}

__device__ void phase_mix(CParams& p_o, int l, bfu* smem, int tid, int half, int cidx, unsigned char* smem_raw) {
  __shared__ int s_item;
  const int total = 512 + NCH * 8;
  while (true) {
    __syncthreads();
    if (threadIdx.x == 0) s_item = (int)atomicAdd(&((unsigned*)(p_o.ws + OFF_ctr))[cidx], 1u);
    __syncthreads();
    const int it = s_item;
    if (it >= total) break;
    CParams* pp_ = &p_o;
    asm volatile("" : "+s"(pp_));
    CParams& p = *pp_;
    if (it < 512) {
      int qb = 127 - (it >> 2), h = it & 3;
      attn_item(p, l, qb, h, smem, tid, half, smem_raw);
    } else {
      int j = (it - 512) * 2 + half;
      chunk_out_item(p, l, j >> 4, j & 15, smem, tid);
    }
  }
}

__device__ void phase_upmerge(CParams& p, bfu* smem, int tid, int vb, int vg, int half, unsigned char* smem_raw) {
  bfu* sA = reinterpret_cast<bfu*>(smem_raw);
  bfu* sB = smem + 2 * 128 * LDP;
  float* s_rs = reinterpret_cast<float*>(smem + 2 * 128 * LDP + 2 * 64 * LDP);
  const int lane = tid & 63, w = tid >> 6, wm = w >> 1, wn = w & 1;
  const int lr = lane & 15, lq = (lane >> 4) * 8, lg4 = (lane >> 4) * 4;
  const int crow = tid >> 3, ccol = (tid & 7) * 8;
  const int t512 = half * 256 + tid, arow = t512 >> 3;
  const int xcd = (vb >> 1) & 7, jl = ((vb >> 4) << 1) | (vb & 1), per = vg >> 3;
  for (int il = jl; il < 16 * 16; il += per) {
    const int mt = xcd * 16 + (il >> 4), nt = il & 15;
    const bfu* Ap = ((bfu*)(p.ws + OFF_y)) + (size_t)(mt * 128 + arow) * YW + ccol;
    const bfu* Bp = ((bfu*)(p.ws + OFF_WupT)) + (size_t)(nt * 64 + crow) * YW + ccol;
    const bfu* Gp = ((bfu*)(p.ws + OFF_u)) + (size_t)(mt * 128 + wm * 64 + lr) * NU + 4096 + nt * 64 + wn * 32 + lg4;
    {
      const int row = tid >> 1, g = tid & 1;
      const float4 q4 = *reinterpret_cast<const float4*>(((float*)(p.ws + OFF_ssq)) + (mt * 128 + row) * 8 + g * 4);
      s_rs[g * 128 + row] = rsqrtf((q4.x + q4.y + q4.z + q4.w) * (1.f / 256.f) + EPS);
    }
    uint4 a0_0, a0_1, b0_0, b0_1, a1_0, a1_1, b1_0, b1_1;
#define U_LOAD(S, KT)                                                                \
  {                                                                                  \
    const int ko_ = (KT) * 64;                                                       \
    a##S##_0 = *reinterpret_cast<const uint4*>(Ap + (size_t)0 * 64 * YW + ko_);      \
    a##S##_1 = *reinterpret_cast<const uint4*>(Ap + (size_t)1 * 64 * YW + ko_);      \
    b##S##_0 = *reinterpret_cast<const uint4*>(Bp + (size_t)0 * 32 * YW + ko_);      \
    b##S##_1 = *reinterpret_cast<const uint4*>(Bp + (size_t)1 * 32 * YW + ko_);      \
  }
#define U_STORE(S, BUF)                                                              \
  {                                                                                  \
    bfu* sAn_ = sA + (BUF) * 128 * LDP + arow * LDP + ccol;                          \
    bfu* sBn_ = sB + (BUF) * 64 * LDP + crow * LDP + ccol;                           \
    *reinterpret_cast<uint4*>(sAn_ + 0 * 64 * LDP) = a##S##_0;                       \
    *reinterpret_cast<uint4*>(sAn_ + 1 * 64 * LDP) = a##S##_1;                       \
    *reinterpret_cast<uint4*>(sBn_ + 0 * 32 * LDP) = b##S##_0;                       \
    *reinterpret_cast<uint4*>(sBn_ + 1 * 32 * LDP) = b##S##_1;                       \
  }
#define U_COMPUTE(BUF)                                                               \
  {                                                                                  \
    const bfu* a_s = sA + (BUF) * 128 * LDP + (wm * 64) * LDP;                       \
    const bfu* b_s = sB + (BUF) * 64 * LDP + (wn * 32) * LDP;                        \
    _Pragma("unroll") for (int ks = 0; ks < 2; ++ks) {                               \
      bf16x8 af0 = lds_frag(a_s, 0 * 16 + lr, ks * 32 + lq, LDP);                    \
      bf16x8 af1 = lds_frag(a_s, 1 * 16 + lr, ks * 32 + lq, LDP);                    \
      bf16x8 af2 = lds_frag(a_s, 2 * 16 + lr, ks * 32 + lq, LDP);                    \
      bf16x8 af3 = lds_frag(a_s, 3 * 16 + lr, ks * 32 + lq, LDP);                    \
      _Pragma("unroll") for (int ni = 0; ni < 2; ++ni) {                             \
        bf16x8 bf_ = lds_frag(b_s, ni * 16 + lr, ks * 32 + lq, LDP);                 \
        acc[0][ni] = __builtin_amdgcn_mfma_f32_16x16x32_bf16(bf_, af0, acc[0][ni], 0, 0, 0); \
        acc[1][ni] = __builtin_amdgcn_mfma_f32_16x16x32_bf16(bf_, af1, acc[1][ni], 0, 0, 0); \
        acc[2][ni] = __builtin_amdgcn_mfma_f32_16x16x32_bf16(bf_, af2, acc[2][ni], 0, 0, 0); \
        acc[3][ni] = __builtin_amdgcn_mfma_f32_16x16x32_bf16(bf_, af3, acc[3][ni], 0, 0, 0); \
      }                                                                              \
    }                                                                                \
  }
    f32x4 acc[4][2], tot[4][2];
    zero_acc<2>(acc);
    zero_acc<2>(tot);
    uint2 gt[4][2];
    U_LOAD(0, 0);
    U_LOAD(1, 1);
    U_STORE(0, 0);
    __syncthreads();
#pragma unroll 1
    for (int kt = 0; kt < 20; kt += 2) {
      if ((kt & 3) == 0) {
        const int br = kt >> 2, gb = br < 3 ? br : 3;
#pragma unroll
        for (int mi = 0; mi < 4; ++mi)
#pragma unroll
          for (int ni = 0; ni < 2; ++ni)
            gt[mi][ni] = *reinterpret_cast<const uint2*>(Gp + (size_t)(mi * 16) * NU + gb * 1024 + ni * 16);
      }
      if (kt + 2 < 20) U_LOAD(0, kt + 2);
      U_COMPUTE(0);
      U_STORE(1, 1);
      __syncthreads();
      if (kt + 3 < 20) U_LOAD(1, kt + 3);
      U_COMPUTE(1);
      if (kt + 2 < 20) U_STORE(0, 0);
      if ((kt & 3) == 2) {
        const int br = kt >> 2;
#pragma unroll
        for (int mi = 0; mi < 4; ++mi) {
          float rsc = 1.f;
          if (br >= 3) rsc = s_rs[(br - 3) * 128 + wm * 64 + mi * 16 + lr];
#pragma unroll
          for (int ni = 0; ni < 2; ++ni) {
            const uint2 g2 = gt[mi][ni];
            tot[mi][ni][0] += acc[mi][ni][0] * (__uint_as_float(g2.x << 16) * rsc);
            tot[mi][ni][1] += acc[mi][ni][1] * (__uint_as_float(g2.x & 0xffff0000u) * rsc);
            tot[mi][ni][2] += acc[mi][ni][2] * (__uint_as_float(g2.y << 16) * rsc);
            tot[mi][ni][3] += acc[mi][ni][3] * (__uint_as_float(g2.y & 0xffff0000u) * rsc);
            acc[mi][ni] = (f32x4){0.f, 0.f, 0.f, 0.f};
          }
        }
      }
      __syncthreads();
    }
#undef U_LOAD
#undef U_STORE
#undef U_COMPUTE
    bfu* Hp = ((bfu*)(p.ws + OFF_h)) + (size_t)(mt * 128 + wm * 64 + lr) * DM + nt * 64 + wn * 32 + lg4;
#pragma unroll
    for (int mi = 0; mi < 4; ++mi)
#pragma unroll
      for (int ni = 0; ni < 2; ++ni) {
        uint2 wv;
        wv.x = pg8::cvt_pk_bf16(tot[mi][ni][0], tot[mi][ni][1]);
        wv.y = pg8::cvt_pk_bf16(tot[mi][ni][2], tot[mi][ni][3]);
        *reinterpret_cast<uint2*>(Hp + (size_t)(mi * 16) * DM + ni * 16) = wv;
      }
  }
}

namespace pg8 {
#define PG8_LAS __attribute__((address_space(3)))
typedef unsigned short bf16_t;
typedef short bf16x8 __attribute__((ext_vector_type(8)));
typedef float f32x4 __attribute__((ext_vector_type(4)));
typedef unsigned u32x4 __attribute__((ext_vector_type(4)));
typedef unsigned u32x2 __attribute__((ext_vector_type(2)));
constexpr int BM = 256, BK = 64, HALF = 128, HTB = HALF * BK * 2, STAGE_BYTES = 8 * HTB, NXCD = 8, WGM = 8;
__device__ __forceinline__ int lds_byte(int r, int c) { const int st = (r >> 4) * 2 + (c >> 5), rr = r & 15, cc = c & 31, ob = rr * 64 + cc * 2; return st * 1024 + (ob ^ (((ob >> 9) & 1) << 5)); }
__device__ __forceinline__ void stage_rc(int b, int& R, int& C) { const int st = b / 1024, sb = b % 1024, swz = sb ^ (((sb >> 9) & 1) << 5); R = (st >> 1) * 16 + swz / 64; C = (st & 1) * 32 + (swz % 64) / 2; }
__device__ __forceinline__ int perm32(int rho) { const int n = rho >> 4, i = rho & 15; return 8 * (i >> 2) + 4 * n + (i & 3); }
struct Unit { int pm, pn; };
struct Gemm { const bf16_t* A; const bf16_t* Bt; int M, N, K; };
struct StaticOrder {
    int nM, nN, nwg, G, c;
    __device__ void init(int M, int N, int G_, int c_) { nM = M / BM; nN = N / BM; nwg = nM * nN; G = G_; c = c_; }
    __device__ bool next(int i, Unit& u) const {
        const long L = (long)i * G + c; if (L >= nwg) return false;
        int wgid = (int)L; { const int q = nwg / NXCD, r = nwg % NXCD, xcd = wgid % NXCD, off = wgid / NXCD; wgid = (xcd < r ? xcd * (q + 1) : r * (q + 1) + (xcd - r) * q) + off; }
        const int nig = WGM * nN, gid = wgid / nig, fm = gid * WGM, gsz = (nM - fm) < WGM ? (nM - fm) : WGM;
        u.pm = fm + ((wgid % nig) % gsz); u.pn = (wgid % nig) / gsz; return true;
    }
    __device__ __forceinline__ void a_ready(const Unit&) const {}
    __device__ __forceinline__ void done(const Unit&) const {}
};
__device__ __forceinline__ unsigned cvt_pk_bf16(float lo, float hi) { unsigned r; asm volatile("v_cvt_pk_bf16_f32 %0, %1, %2" : "=v"(r) : "v"(lo), "v"(hi)); return r; }

template <class Epi, class Sched>
__device__ __forceinline__ void gemm_phase(PG8_LAS unsigned char* lds, const Gemm g, const Sched& S, const Epi& E) {
    const int tid = threadIdx.x, wid = __builtin_amdgcn_readfirstlane(tid >> 6), lane = tid & 63, wr = wid >> 2, wc = wid & 3, fr = lane & 15, fq = lane >> 4;
    const int K = g.K, nt = K / BK;
    unsigned voffA[2], voffB[2];
#pragma unroll
    for (int i = 0; i < 2; ++i) { int R, C; stage_rc(tid * 16 + i * 8192, R, C); const int Rb = Epi::PERM ? ((R & ~31) + perm32(R & 31)) : R;
        voffA[i] = (unsigned)(R * K + C) * 2u; voffB[i] = (unsigned)(Rb * K + C) * 2u; }
    const size_t kstep = (size_t)(BK * 2);
    const size_t hstep = (size_t)HALF * K * 2;
    const size_t tstep = 2 * hstep;
    const unsigned ldsw = (unsigned)wid * 1024u;
    const int aoff = lds_byte(wr * 64 + fr, fq * 8), boff = lds_byte(wc * 32 + fr, fq * 8);
#define PG8_SA(b, h) (((b) * 2 + (h)) * HTB)
#define PG8_SB(b, h) ((4 + (b) * 2 + (h)) * HTB)
#define PG8_STAGE(bufoff, gbase, voff) do { _Pragma("unroll") for (int _i = 0; _i < 2; ++_i) \
        __builtin_amdgcn_global_load_lds((const unsigned*)((const char*)(gbase) + (voff)[_i]), (PG8_LAS unsigned*)(lds + (bufoff) + ldsw + _i * 8192), 16, 0, 0); } while (0)
#define PG8_LDA(dst, b, h) do { _Pragma("unroll") for (int m = 0; m < 4; ++m) _Pragma("unroll") for (int k = 0; k < 2; ++k) dst[m][k] = *(const PG8_LAS bf16x8*)(lds + PG8_SA(b, h) + aoff + m * 2048 + k * 1024); } while (0)
#define PG8_LDB(dst, b, h) do { _Pragma("unroll") for (int n = 0; n < 2; ++n) _Pragma("unroll") for (int k = 0; k < 2; ++k) dst[n][k] = *(const PG8_LAS bf16x8*)(lds + PG8_SB(b, h) + boff + n * 2048 + k * 1024); } while (0)
#define PG8_MMA(ai, bj, At, Bt) do { __builtin_amdgcn_s_setprio(1); _Pragma("unroll") for (int m = 0; m < 4; ++m) _Pragma("unroll") for (int n = 0; n < 2; ++n) _Pragma("unroll") for (int k = 0; k < 2; ++k) \
        acc[ai][bj][m][n] = __builtin_amdgcn_mfma_f32_16x16x32_bf16(Bt[n][k], At[m][k], acc[ai][bj][m][n], 0, 0, 0); __builtin_amdgcn_s_setprio(0); } while (0)
#define PG8_WAIT_V(n) asm volatile("s_waitcnt vmcnt(" #n ")" ::: "memory")
#define PG8_WAIT_L(n) asm volatile("s_waitcnt lgkmcnt(" #n ")" ::: "memory")
#define PG8_BAR __builtin_amdgcn_s_barrier()
#define PG8_SCHED __builtin_amdgcn_sched_barrier(0)
    Unit cur, nxt; int ui = 0;
    if (!S.next(0, cur)) return;
    f32x4 acc[2][2][4][2];
#pragma unroll
    for (int a = 0; a < 2; ++a)
#pragma unroll
        for (int b = 0; b < 2; ++b)
#pragma unroll
            for (int m = 0; m < 4; ++m)
#pragma unroll
                for (int n = 0; n < 2; ++n) acc[a][b][m][n] = (f32x4){0.f, 0.f, 0.f, 0.f};
    bf16x8 At[4][2], B0[2][2], B1[2][2];
    const char* cA = (const char*)g.A + (size_t)cur.pm * tstep; const char* cB = (const char*)g.Bt + (size_t)cur.pn * tstep;
    S.a_ready(cur);
    PG8_STAGE(PG8_SB(0, 0), cB, voffB); PG8_STAGE(PG8_SA(0, 0), cA, voffA); PG8_STAGE(PG8_SB(0, 1), cB + hstep, voffB); PG8_STAGE(PG8_SA(0, 1), cA + hstep, voffA);
    if (wr == 1) PG8_BAR;
    PG8_WAIT_V(4); PG8_BAR;
    PG8_STAGE(PG8_SB(1, 0), cB + kstep, voffB); PG8_STAGE(PG8_SA(1, 0), cA + kstep, voffA); PG8_STAGE(PG8_SB(1, 1), cB + hstep + kstep, voffB);
    PG8_WAIT_V(6); PG8_BAR;
    for (;;) {
        const bool has_next = S.next(ui + 1, nxt);
        const char* nA = has_next ? (const char*)g.A + (size_t)nxt.pm * tstep : cA; const char* nB = has_next ? (const char*)g.Bt + (size_t)nxt.pn * tstep : cB;
        for (int t = 0; t < nt; t += 2) {
            const bool last = (t == nt - 2);
            const char* a1 = cA + (size_t)(t + 1) * kstep;
            const char* a2 = last ? nA : cA + (size_t)(t + 2) * kstep; const char* b2 = last ? nB : cB + (size_t)(t + 2) * kstep;
            const char* a3 = a2 + kstep; const char* b3 = b2 + kstep;
            if (last && has_next) S.a_ready(nxt);
            PG8_LDB(B0, 0, 0); PG8_SCHED; PG8_LDA(At, 0, 0); PG8_STAGE(PG8_SA(1, 1), a1 + hstep, voffA);
            PG8_WAIT_L(8); PG8_BAR; PG8_WAIT_L(0); PG8_MMA(0, 0, At, B0); PG8_BAR; PG8_SCHED;
            PG8_LDB(B1, 0, 1); PG8_STAGE(PG8_SB(0, 0), b2, voffB);
            PG8_BAR; PG8_WAIT_L(0); PG8_MMA(0, 1, At, B1); PG8_BAR;
            PG8_LDA(At, 0, 1); PG8_STAGE(PG8_SA(0, 0), a2, voffA);
            PG8_BAR; PG8_WAIT_L(0); PG8_MMA(1, 0, At, B0); PG8_BAR; PG8_SCHED;
            PG8_STAGE(PG8_SB(0, 1), b2 + hstep, voffB);
            PG8_WAIT_V(6); PG8_BAR; PG8_MMA(1, 1, At, B1); PG8_BAR;
            PG8_LDB(B0, 1, 0); PG8_SCHED; PG8_LDA(At, 1, 0); PG8_STAGE(PG8_SA(0, 1), a2 + hstep, voffA);
            PG8_WAIT_L(8); PG8_BAR; PG8_WAIT_L(0); PG8_MMA(0, 0, At, B0); PG8_BAR; PG8_SCHED;
            PG8_LDB(B1, 1, 1); PG8_STAGE(PG8_SB(1, 0), b3, voffB);
            PG8_BAR; PG8_WAIT_L(0); PG8_MMA(0, 1, At, B1); PG8_BAR;
            PG8_LDA(At, 1, 1); PG8_STAGE(PG8_SA(1, 0), a3, voffA);
            PG8_BAR; PG8_WAIT_L(0); PG8_MMA(1, 0, At, B0); PG8_BAR; PG8_SCHED;
            PG8_STAGE(PG8_SB(1, 1), b3 + hstep, voffB);
            PG8_WAIT_V(6); PG8_BAR; PG8_MMA(1, 1, At, B1); PG8_BAR;
        }
            if constexpr (!Epi::AFTER_DRAIN) { E(acc, cur, wr, wc, fr, fq); S.done(cur); }
            if (!has_next) break;
#pragma unroll
        for (int a = 0; a < 2; ++a)
#pragma unroll
            for (int b = 0; b < 2; ++b)
#pragma unroll
                for (int m = 0; m < 4; ++m)
#pragma unroll
                    for (int n = 0; n < 2; ++n) acc[a][b][m][n] = (f32x4){0.f, 0.f, 0.f, 0.f};
        cur = nxt; cA = nA; cB = nB; ++ui;
    }
    PG8_WAIT_V(0);
    if (wr == 0) PG8_BAR;
    PG8_BAR;
    if constexpr (Epi::AFTER_DRAIN) { E.fused(acc, cur, wr, wc, fr, fq, lds, wid, lane); S.done(cur); }
#undef PG8_SA
#undef PG8_SB
#undef PG8_STAGE
#undef PG8_LDA
#undef PG8_LDB
#undef PG8_MMA
#undef PG8_WAIT_V
#undef PG8_WAIT_L
#undef PG8_BAR
#undef PG8_SCHED
}

}

struct EpiInproj {
  static constexpr bool PERM = true, AFTER_DRAIN = false;
  bfu* u; float* small;
  __device__ __forceinline__ void operator()(const pg8::f32x4 (&acc)[2][2][4][2], const pg8::Unit& un, int wr, int wc, int fr, int fq) const {
    const int row0 = un.pm * 256 + wr * 64 + fr;
    if (un.pn < 32) {
      const bool sig = un.pn >= 16;
      const int col0 = un.pn * 256 + wc * 32 + 8 * fq;
#pragma unroll
      for (int ai = 0; ai < 2; ++ai)
#pragma unroll
        for (int m = 0; m < 4; ++m) {
          bfu* rowp = u + (size_t)(row0 + ai * 128 + m * 16) * NU + col0;
#pragma unroll
          for (int bj = 0; bj < 2; ++bj) {
            pg8::f32x4 v0 = acc[ai][bj][m][0], v1 = acc[ai][bj][m][1];
            if (sig) {
#pragma unroll
              for (int j = 0; j < 4; ++j) { v0[j] = sigmoidf_(v0[j]); v1[j] = sigmoidf_(v1[j]); }
            }
            pg8::u32x4 w;
            w.x = pg8::cvt_pk_bf16(v0[0], v0[1]); w.y = pg8::cvt_pk_bf16(v0[2], v0[3]);
            w.z = pg8::cvt_pk_bf16(v1[0], v1[1]); w.w = pg8::cvt_pk_bf16(v1[2], v1[3]);
            *(pg8::u32x4*)(rowp + bj * 128) = w;
          }
        }
    } else if (wc == 0) {
#pragma unroll
      for (int ai = 0; ai < 2; ++ai)
#pragma unroll
        for (int m = 0; m < 4; ++m) {
          float* sp = small + (size_t)(row0 + ai * 128 + m * 16) * 32 + 8 * fq;
          *(pg8::f32x4*)(sp) = acc[ai][0][m][0];
          *(pg8::f32x4*)(sp + 4) = acc[ai][0][m][1];
        }
    }
  }
};
struct EpiResid {
  static constexpr bool PERM = false, AFTER_DRAIN = false;
  const float* xold; float* out;
  __device__ __forceinline__ void operator()(const pg8::f32x4 (&acc)[2][2][4][2], const pg8::Unit& un, int wr, int wc, int fr, int fq) const {
    const int row0 = un.pm * 256 + wr * 64 + fr, col0 = un.pn * 256 + wc * 32 + 4 * fq;
#pragma unroll
    for (int ai = 0; ai < 2; ++ai)
#pragma unroll
      for (int m = 0; m < 4; ++m) {
        const size_t off = (size_t)(row0 + ai * 128 + m * 16) * DM + col0;
#pragma unroll
        for (int bj = 0; bj < 2; ++bj)
#pragma unroll
          for (int n = 0; n < 2; ++n) {
            const pg8::f32x4 b = *(const pg8::f32x4*)(xold + off + bj * 128 + n * 16);
            *(pg8::f32x4*)(out + off + bj * 128 + n * 16) = b + acc[ai][bj][m][n];
          }
        asm volatile("" ::: "memory");
      }
  }
};
struct EpiSwiglu {
  static constexpr bool PERM = true, AFTER_DRAIN = false;
  bfu* hidden;
  __device__ __forceinline__ void operator()(const pg8::f32x4 (&acc)[2][2][4][2], const pg8::Unit& un, int wr, int wc, int fr, int fq) const {
    const int row0 = un.pm * 256 + wr * 64 + fr;
#pragma unroll
    for (int ai = 0; ai < 2; ++ai)
#pragma unroll
      for (int m = 0; m < 4; ++m) {
        bfu* rowp = hidden + (size_t)(row0 + ai * 128 + m * 16) * FH + (un.pn * 8 + wc) * 16 + 4 * fq;
#pragma unroll
        for (int bj = 0; bj < 2; ++bj) {
          const pg8::f32x4 g = acc[ai][bj][m][0], uu = acc[ai][bj][m][1];
          pg8::u32x2 w;
          w.x = pg8::cvt_pk_bf16(siluf_(g[0]) * uu[0], siluf_(g[1]) * uu[1]);
          w.y = pg8::cvt_pk_bf16(siluf_(g[2]) * uu[2], siluf_(g[3]) * uu[3]);
          *(pg8::u32x2*)(rowp + bj * 64) = w;
        }
      }
  }
};

__device__ __forceinline__ void grid_barrier(unsigned* bar, unsigned nb) {
  asm volatile("s_waitcnt vmcnt(0)" ::: "memory");
  __syncthreads();
  if (threadIdx.x == 0) {
    __builtin_amdgcn_fence(__ATOMIC_RELEASE, "agent");
    asm volatile("s_waitcnt vmcnt(0)" ::: "memory");
    const unsigned g = blockIdx.x & 7u, per = gridDim.x >> 3;
    unsigned* sub = bar + 512 + 64 * g;
    unsigned* top = bar + 448;
    const unsigned old = __hip_atomic_fetch_add(sub, 1u, __ATOMIC_RELAXED, __HIP_MEMORY_SCOPE_AGENT);
    if (old + 1u == nb * per) __hip_atomic_fetch_add(top, 1u, __ATOMIC_RELAXED, __HIP_MEMORY_SCOPE_AGENT);
    while (__hip_atomic_load(top, __ATOMIC_RELAXED, __HIP_MEMORY_SCOPE_AGENT) < nb * 8u) __builtin_amdgcn_s_sleep(1);
    __builtin_amdgcn_fence(__ATOMIC_ACQUIRE, "agent");
    asm volatile("s_waitcnt vmcnt(0)" ::: "memory");
  }
  __syncthreads();
}

__global__ void __launch_bounds__(NTHREADS, 2) mega(Params p_in, int ph_lo, int ph_hi, int use_cg) {
  extern __shared__ __attribute__((aligned(16))) unsigned char smem_raw[];
  unsigned nbar = 0;
  for (int ph = ph_lo; ph < ph_hi; ++ph) {
#if PROBE_DUP >= 0
    const int l = ph / (PH_PER_LAYER + 1);
    const int ks = ph - l * (PH_PER_LAYER + 1);
    const int k = (ks <= PROBE_DUP) ? ks : ks - 1;
    const int wr = (ks == PROBE_DUP) ? 0 : 1;
#else
    const int wr = 1;
    const int l = ph / PH_PER_LAYER, k = ph - l * PH_PER_LAYER;
#endif
    int t512 = threadIdx.x;
    asm volatile("" : "+v"(t512));
    const int tid = t512 & 255;
    const int half = __builtin_amdgcn_readfirstlane(t512 >> 8);
    const int vb = blockIdx.x * 2 + half, vg = gridDim.x * 2;
    bfu* smem = reinterpret_cast<bfu*>(smem_raw + half * SMEM_HALF);
    CParams* pp = (CParams*)__builtin_amdgcn_kernarg_segment_ptr();
    asm volatile("" : "+s"(pp));
    CParams& p = *pp;
    switch (k) {
      case 0: phase_convert_norm(p, l, smem, tid, vb, vg); break;
      case 1: {
        pg8::Gemm g; g.A = (bfu*)(p.ws + OFF_h); g.Bt = (bfu*)(p.ws + OFF_WinT); g.M = S_LEN; g.N = NINP; g.K = DM;
        pg8::StaticOrder so; so.init(S_LEN, NINP, gridDim.x, blockIdx.x);
        EpiInproj e; e.u = (bfu*)(p.ws + OFF_u); e.small = (float*)(p.ws + OFF_small);
        pg8::gemm_phase<EpiInproj, pg8::StaticOrder>((PG8_LAS unsigned char*)smem_raw, g, so, e);
      } break;
      case 2: phase_prep(p, l, smem, tid, wr, vb, vg); break;
      case 3: phase_scan(p, smem, tid, wr, vb, vg); break;
      case 4: phase_mix(p, l, smem, tid, half, ph, smem_raw); break;
      case 5: phase_upmerge(p, smem, tid, vb, vg, half, smem_raw); break;
      case 6: {
        pg8::Gemm g; g.A = (bfu*)(p.ws + OFF_h); g.Bt = (bfu*)(p.ws + OFF_WoutT); g.M = S_LEN; g.N = DM; g.K = DM;
        pg8::StaticOrder so; so.init(S_LEN, DM, gridDim.x, blockIdx.x);
        EpiResid e; e.xold = (l == 0 ? p.in[0] : p.out); e.out = p.out;
        pg8::gemm_phase<EpiResid, pg8::StaticOrder>((PG8_LAS unsigned char*)smem_raw, g, so, e);
      } break;
      case 7: phase_norm2(p, l, tid, vb, vg); break;
      case 8: {
        pg8::Gemm g; g.A = (bfu*)(p.ws + OFF_h); g.Bt = (bfu*)(p.ws + OFF_WfiT); g.M = S_LEN; g.N = 2 * FH; g.K = DM;
        pg8::StaticOrder so; so.init(S_LEN, 2 * FH, gridDim.x, blockIdx.x);
        EpiSwiglu e; e.hidden = (bfu*)(p.ws + OFF_u);
        pg8::gemm_phase<EpiSwiglu, pg8::StaticOrder>((PG8_LAS unsigned char*)smem_raw, g, so, e);
      } break;
      default: {
        pg8::Gemm g; g.A = (bfu*)(p.ws + OFF_u); g.Bt = (bfu*)(p.ws + OFF_WfoT); g.M = S_LEN; g.N = DM; g.K = FH;
        pg8::StaticOrder so; so.init(S_LEN, DM, gridDim.x, blockIdx.x);
        EpiResid e; e.xold = p.out; e.out = p.out;
        pg8::gemm_phase<EpiResid, pg8::StaticOrder>((PG8_LAS unsigned char*)smem_raw, g, so, e);
      } break;
    }
    if (ph + 1 < ph_hi) {
      if (use_cg) cg::this_grid().sync();
      else { ++nbar; grid_barrier((unsigned*)(p_in.ws + OFF_bar), nbar); }
    }
  }
}

#ifndef MK_COOP
#define MK_COOP 1
#endif

extern "C" void kernel_launch(void* const* d_in, const int* in_sizes, int n_in, void* d_out, int out_size, void* d_ws,
                              size_t ws_size, hipStream_t stream) {
  Params p{};
  for (int i = 0; i < 25; ++i) p.in[i] = reinterpret_cast<const float*>(d_in[i]);
  p.out = reinterpret_cast<float*>(d_out);
  p.ws = reinterpret_cast<unsigned char*>(d_ws);
  if (WS_NEED > ws_size) { fprintf(stderr, "workspace too small: need %zu have %zu\n", (size_t)WS_NEED, ws_size); return; }

  static int grid_blocks = 0;
  if (!grid_blocks) {
    (void)hipFuncSetAttribute((const void*)mega, hipFuncAttributeMaxDynamicSharedMemorySize, SMEM_BYTES);
    int dev = 0, cus = 0, per_cu = 0;
    (void)hipGetDevice(&dev);
    (void)hipDeviceGetAttribute(&cus, hipDeviceAttributeMultiprocessorCount, dev);
    (void)hipOccupancyMaxActiveBlocksPerMultiprocessor(&per_cu, mega, NTHREADS, SMEM_BYTES);
    per_cu = 1;
    grid_blocks = cus * per_cu;
  }
  const int nph = 4 * (PH_PER_LAYER + (PROBE_DUP >= 0 ? 1 : 0));
#if MK_COOP
  int lo = 0, hi = nph, use_cg = 0;
  void* args[] = {&p, &lo, &hi, &use_cg};
  (void)hipMemsetAsync(p.ws + OFF_bar, 0, 8192, stream);
  hipError_t e = hipLaunchCooperativeKernel((const void*)mega, dim3(grid_blocks), dim3(NTHREADS), args, SMEM_BYTES, stream);
  if (e != hipSuccess) fprintf(stderr, "cooperative launch failed: %s (grid %d)\n", hipGetErrorString(e), grid_blocks);
#else
  for (int ph = 0; ph < nph; ++ph)
    hipLaunchKernelGGL(mega, dim3(grid_blocks), dim3(NTHREADS), SMEM_BYTES, stream, p, ph, ph + 1, 0);
#endif
}
```

```cpp
#include <hip/hip_runtime.h>
#include <hip/hip_bf16.h>
#include <hip/hip_cooperative_groups.h>
#include <cstdio>
namespace cg = cooperative_groups;

typedef __attribute__((ext_vector_type(8))) short bf16x8;
typedef __attribute__((ext_vector_type(4))) float f32x4;
typedef unsigned short bfu;

#define S_LEN 16384
#define DM 1024
#define NU 8192
#define NINP 8448
#define NSRC 8220
#define FH 2816
#define NCH 256
#define LDP 72
#define YW 1280
#define EPS 1e-6f
#define SMEM_HALF 73728
#define SMEM_BYTES 147456
#define NTHREADS 512
#define PH_PER_LAYER 10
#ifndef PROBE_DUP
#define PROBE_DUP -1
#endif

struct Params {
  const float* in[25];
  float* out;
  unsigned char* ws;
};
typedef const __attribute__((address_space(4))) Params CParams;
constexpr size_t OFF_WinT = 0;
constexpr size_t OFF_WupT = OFF_WinT + (((size_t)NINP*DM*2 + 255) & ~(size_t)255);
constexpr size_t OFF_WoutT = OFF_WupT + (((size_t)DM*YW*2 + 255) & ~(size_t)255);
constexpr size_t OFF_WfiT = OFF_WoutT + (((size_t)DM*DM*2 + 255) & ~(size_t)255);
constexpr size_t OFF_WfoT = OFF_WfiT + (((size_t)2*FH*DM*2 + 255) & ~(size_t)255);
constexpr size_t OFF_u = OFF_WfoT + (((size_t)DM*FH*2 + 255) & ~(size_t)255);
constexpr size_t OFF_small = OFF_u + (((size_t)S_LEN*NU*2 + 255) & ~(size_t)255);
constexpr size_t OFF_h = OFF_small + (((size_t)S_LEN*32*4 + 255) & ~(size_t)255);
constexpr size_t OFF_y = OFF_h + (((size_t)S_LEN*DM*2 + 255) & ~(size_t)255);
constexpr size_t OFF_ssq = OFF_y + (((size_t)S_LEN*YW*2 + 255) & ~(size_t)255);
constexpr size_t OFF_foxq = OFF_ssq + (((size_t)S_LEN*8*4 + 255) & ~(size_t)255);
constexpr size_t OFF_foxk = OFF_foxq + (((size_t)4*S_LEN*64*2 + 255) & ~(size_t)255);
constexpr size_t OFF_foxvT = OFF_foxk + (((size_t)4*S_LEN*64*2 + 255) & ~(size_t)255);
constexpr size_t OFF_foxc = OFF_foxvT + (((size_t)4*S_LEN*64*2 + 255) & ~(size_t)255);
constexpr size_t OFF_foxtot = OFF_foxc + (((size_t)4*S_LEN*4 + 255) & ~(size_t)255);
constexpr size_t OFF_VT = OFF_foxtot + (((size_t)4*NCH*4 + 255) & ~(size_t)255);
constexpr size_t OFF_ST = OFF_VT + (((size_t)16*NCH*4096*2 + 255) & ~(size_t)255);
constexpr size_t OFF_dec = OFF_ST + (((size_t)16*NCH*4096*2 + 255) & ~(size_t)255);
constexpr size_t OFF_csb = OFF_dec + (((size_t)16*NCH*64*4 + 255) & ~(size_t)255);
constexpr size_t OFF_ssdX = OFF_csb + (((size_t)16*S_LEN*4 + 255) & ~(size_t)255);
constexpr size_t OFF_ssdB = OFF_ssdX + (((size_t)S_LEN*512*2 + 255) & ~(size_t)255);
constexpr size_t OFF_ssdC = OFF_ssdB + (((size_t)2*S_LEN*64*2 + 255) & ~(size_t)255);
constexpr size_t OFF_rcos = OFF_ssdC + (((size_t)2*S_LEN*64*2 + 255) & ~(size_t)255);
constexpr size_t OFF_rsin = OFF_rcos + (((size_t)S_LEN*32*4 + 255) & ~(size_t)255);
constexpr size_t OFF_ctr = OFF_rsin + (((size_t)S_LEN*32*4 + 255) & ~(size_t)255);
constexpr size_t OFF_bar = OFF_ctr + (((size_t)256 + 255) & ~(size_t)255);
constexpr size_t WS_NEED = OFF_bar + 16384;

__device__ __forceinline__ bfu f2bf(float f) {
  unsigned u = __float_as_uint(f);
  u += 0x7fffu + ((u >> 16) & 1u);
  return (bfu)(u >> 16);
}
__device__ __forceinline__ float bf2f(bfu b) { return __uint_as_float(((unsigned)b) << 16); }
__device__ __forceinline__ float sigmoidf_(float x) { return 1.f / (1.f + __expf(-x)); }
__device__ __forceinline__ float siluf_(float x) { return x / (1.f + __expf(-x)); }
__device__ __forceinline__ float logsigmoidf_(float z) { return fminf(z, 0.f) - log1pf(expf(-fabsf(z))); }
__device__ __forceinline__ float logsigmoid_fast(float z) { return fminf(z, 0.f) - __logf(1.f + __expf(-fabsf(z))); }
__device__ __forceinline__ float softplus_fast(float z) { return fmaxf(z, 0.f) + __logf(1.f + __expf(-fabsf(z))); }
__device__ __forceinline__ float softplusf_(float z) { return fmaxf(z, 0.f) + log1pf(expf(-fabsf(z))); }

namespace pg8 { __device__ __forceinline__ unsigned cvt_pk_bf16(float lo, float hi); }
__device__ __forceinline__ bf16x8 lds_frag(const bfu* base, int row, int kofs, int stride) {
  return *reinterpret_cast<const bf16x8*>(base + row * stride + kofs);
}

__device__ __forceinline__ void mma16x64(f32x4 (&acc)[4], const bfu* sA, int arow0, const bfu* sB, int lane) {
  const int r = lane & 15, q = (lane >> 4) * 8;
#pragma unroll
  for (int ks = 0; ks < 2; ++ks) {
    bf16x8 a = lds_frag(sA, arow0 + r, ks * 32 + q, LDP);
#pragma unroll
    for (int n = 0; n < 4; ++n) {
      bf16x8 b = lds_frag(sB, n * 16 + r, ks * 32 + q, LDP);
      acc[n] = __builtin_amdgcn_mfma_f32_16x16x32_bf16(a, b, acc[n], 0, 0, 0);
    }
  }
}

__device__ __forceinline__ void load_tile64(bfu* s, const bfu* g, int gs, int tid) {
#pragma unroll
  for (int i = 0; i < 2; ++i) {
    int id = tid + i * 256;
    int r = id >> 3, c = (id & 7) * 8;
    *reinterpret_cast<uint4*>(s + r * LDP + c) = *reinterpret_cast<const uint4*>(g + (size_t)r * gs + c);
  }
}

template <int NI>
__device__ __forceinline__ void gemm_main(f32x4 (&acc)[4][NI], const bfu* __restrict__ A, int lda,
                                          const bfu* __restrict__ Bt, int ldb, int K, bfu* smem, int tid) {
  bfu* sA = smem;
  bfu* sB = smem + 2 * 128 * LDP;
  const int lane = tid & 63, w = tid >> 6, wm = w >> 1, wn = w & 1;
  const int lr = lane & 15, lq = (lane >> 4) * 8;
  const int crow = tid >> 3, ccol = (tid & 7) * 8;
  const bfu* Ap = A + (size_t)crow * lda + ccol;
  const bfu* Bp = Bt + (size_t)crow * ldb + ccol;
  uint4 ra[4], rb[NI];
#pragma unroll
  for (int i = 0; i < 4; ++i) ra[i] = *reinterpret_cast<const uint4*>(Ap + (size_t)i * 32 * lda);
#pragma unroll
  for (int i = 0; i < NI; ++i) rb[i] = *reinterpret_cast<const uint4*>(Bp + (size_t)i * 32 * ldb);
#pragma unroll
  for (int i = 0; i < 4; ++i) *reinterpret_cast<uint4*>(sA + (crow + i * 32) * LDP + ccol) = ra[i];
#pragma unroll
  for (int i = 0; i < NI; ++i) *reinterpret_cast<uint4*>(sB + (crow + i * 32) * LDP + ccol) = rb[i];
  __syncthreads();
  const int nk = K >> 6;
  for (int kt = 0; kt < nk; ++kt) {
    const int cur = kt & 1;
    if (kt + 1 < nk) {
      const int ko = (kt + 1) * 64;
#pragma unroll
      for (int i = 0; i < 4; ++i) ra[i] = *reinterpret_cast<const uint4*>(Ap + (size_t)i * 32 * lda + ko);
#pragma unroll
      for (int i = 0; i < NI; ++i) rb[i] = *reinterpret_cast<const uint4*>(Bp + (size_t)i * 32 * ldb + ko);
    }
    const bfu* a_s = sA + cur * 128 * LDP + (wm * 64) * LDP;
    const bfu* b_s = sB + cur * 128 * LDP + (wn * NI * 16) * LDP;
#pragma unroll
    for (int ks = 0; ks < 2; ++ks) {
      bf16x8 af[4], bfr[NI];
#pragma unroll
      for (int mi = 0; mi < 4; ++mi) af[mi] = lds_frag(a_s, mi * 16 + lr, ks * 32 + lq, LDP);
#pragma unroll
      for (int ni = 0; ni < NI; ++ni) bfr[ni] = lds_frag(b_s, ni * 16 + lr, ks * 32 + lq, LDP);
#pragma unroll
      for (int mi = 0; mi < 4; ++mi)
#pragma unroll
        for (int ni = 0; ni < NI; ++ni)
          acc[mi][ni] = __builtin_amdgcn_mfma_f32_16x16x32_bf16(af[mi], bfr[ni], acc[mi][ni], 0, 0, 0);
    }
    if (kt + 1 < nk) {
      bfu* sAn = sA + (cur ^ 1) * 128 * LDP;
      bfu* sBn = sB + (cur ^ 1) * 128 * LDP;
#pragma unroll
      for (int i = 0; i < 4; ++i) *reinterpret_cast<uint4*>(sAn + (crow + i * 32) * LDP + ccol) = ra[i];
#pragma unroll
      for (int i = 0; i < NI; ++i) *reinterpret_cast<uint4*>(sBn + (crow + i * 32) * LDP + ccol) = rb[i];
    }
    __syncthreads();
  }
}

template <int NI>
__device__ __forceinline__ void zero_acc(f32x4 (&acc)[4][NI]) {
#pragma unroll
  for (int i = 0; i < 4; ++i)
#pragma unroll
    for (int j = 0; j < NI; ++j) acc[i][j] = (f32x4){0.f, 0.f, 0.f, 0.f};
}

__device__ __forceinline__ int win_src(int dc) {
  if (dc < 768) return dc;
  if (dc < 1536) return dc + 4;
  if (dc < 4096) return dc + 20;
  if (dc < 8192) return dc + 28;
  int s = dc - 8192;
  if (s < 4) return 768 + s;
  if (s < 20) return 1540 + (s - 4);
  if (s < 28) return 4116 + (s - 20);
  return -1;
}
__device__ __forceinline__ int ffi_src(int dc) {
  const int G = dc >> 5, w = dc & 31, f = w >> 3, r = w & 7;
  return (r < 4) ? (G * 16 + f * 4 + r) : (FH + G * 16 + f * 4 + (r - 4));
}

__device__ __forceinline__ void convert_tile(const float* __restrict__ W, int ldw, int kt, int ntd, bfu* __restrict__ Wt,
                                             int ldt, int kofs, int mode, const float* __restrict__ rowgain,
                                             bfu* sT, int tid) {
  const int c4 = (tid & 15) * 4, r0 = tid >> 4;
  const int dc = ntd * 64 + c4;
  int sc = dc;
  if (mode == 1) sc = win_src(dc);
  else if (mode == 2) sc = ffi_src(dc);
  float4 v[8];
  float gg[8];
#pragma unroll
  for (int ps = 0; ps < 8; ++ps) {
    const int k = kt * 64 + r0 + ps * 16;
    v[ps] = make_float4(0.f, 0.f, 0.f, 0.f);
    if (sc >= 0) v[ps] = *reinterpret_cast<const float4*>(W + (size_t)k * ldw + sc);
    gg[ps] = rowgain ? rowgain[k] : 1.f;
  }
#pragma unroll
  for (int ps = 0; ps < 8; ++ps) {
    const int kk = r0 + (ps & 3) * 16;
    bfu* sTt = sT + (ps >> 2) * 64 * LDP;
    const float g = gg[ps];
    sTt[(c4 + 0) * LDP + kk] = f2bf(v[ps].x * g);
    sTt[(c4 + 1) * LDP + kk] = f2bf(v[ps].y * g);
    sTt[(c4 + 2) * LDP + kk] = f2bf(v[ps].z * g);
    sTt[(c4 + 3) * LDP + kk] = f2bf(v[ps].w * g);
  }
  __syncthreads();
#pragma unroll
  for (int i = 0; i < 4; ++i) {
    const int id = tid + (i & 1) * 256;
    const int nn = id >> 3, kc = (id & 7) * 8;
    const int tt = i >> 1;
    *reinterpret_cast<uint4*>(Wt + (size_t)(ntd * 64 + nn) * ldt + kofs + (kt + tt) * 64 + kc) =
        *reinterpret_cast<const uint4*>(sT + tt * 64 * LDP + nn * LDP + kc);
  }
  __syncthreads();
}

__device__ void phase_convert_norm(CParams& p_o, int l, bfu* smem, int tid, int vb, int vg) {
  const int nconv = 2400, nnorm = 4096;
  const int nrot = (l == 0) ? 64 : 0;
  const int total = nconv + nnorm + nrot;
  if (l == 0 && vb == 0 && tid < 64) ((unsigned*)(p_o.ws + OFF_ctr))[tid] = 0u;
  for (int it = vb; it < total; it += vg) {
    CParams* pp_ = &p_o;
    asm volatile("" : "+s"(pp_));
    CParams& p = *pp_;
    if (it < nconv) {
      if (it < 1056) {
        int kt = (it & 7) * 2, nt = it >> 3;
        convert_tile(p.in[4] + (size_t)l * DM * NSRC, NSRC, kt, nt, ((bfu*)(p.ws + OFF_WinT)), DM, 0, 1, nullptr, smem, tid);
      } else if (it < 1152) {
        int j = it - 1056; int br = j >> 5; j &= 31;
        int kt = (j & 1) * 2, nt = j >> 1;
        const float* W = (br == 0 ? p.in[18] : (br == 1 ? p.in[19] : p.in[20])) + (size_t)l * 256 * DM;
        convert_tile(W, DM, kt, nt, ((bfu*)(p.ws + OFF_WupT)), YW, br * 256, 0, nullptr, smem, tid);
      } else if (it < 1216) {
        int j = it - 1152; int kt = (j & 3) * 2, nt = j >> 2;
        convert_tile(p.in[21] + (size_t)l * 512 * DM, DM, kt, nt, ((bfu*)(p.ws + OFF_WupT)), YW, 768, 0, p.in[17] + l * 512, smem, tid);
      } else if (it < 1344) {
        int j = it - 1216; int kt = (j & 7) * 2, nt = j >> 3;
        convert_tile(p.in[22] + (size_t)l * DM * DM, DM, kt, nt, ((bfu*)(p.ws + OFF_WoutT)), DM, 0, 0, nullptr, smem, tid);
      } else if (it < 2048) {
        int j = it - 1344; int kt = (j & 7) * 2, nt = j >> 3;
        convert_tile(p.in[23] + (size_t)l * DM * 2 * FH, 2 * FH, kt, nt, ((bfu*)(p.ws + OFF_WfiT)), DM, 0, 2, nullptr, smem, tid);
      } else {
        int j = it - 2048; int kt = (j % 22) * 2, nt = j / 22;
        convert_tile(p.in[24] + (size_t)l * FH * DM, DM, kt, nt, ((bfu*)(p.ws + OFF_WfoT)), FH, 0, 0, nullptr, smem, tid);
      }
    } else if (it < nconv + nnorm) {
      int row = (it - nconv) * 4 + (tid >> 6);
      int lane = tid & 63;
      const float* xr = (l == 0 ? p.in[0] : p.out) + (size_t)row * DM;
      const float* g = p.in[2] + l * DM;
      float4 v[4];
      float ss = 0.f;
#pragma unroll
      for (int i = 0; i < 4; ++i) {
        v[i] = *reinterpret_cast<const float4*>(xr + i * 256 + lane * 4);
        ss += v[i].x * v[i].x + v[i].y * v[i].y + v[i].z * v[i].z + v[i].w * v[i].w;
      }
#pragma unroll
      for (int m = 1; m < 64; m <<= 1) ss += __shfl_xor(ss, m, 64);
      float rstd = rsqrtf(ss * (1.f / DM) + EPS);
#pragma unroll
      for (int i = 0; i < 4; ++i) {
        float4 gg = *reinterpret_cast<const float4*>(g + i * 256 + lane * 4);
        ushort4 o;
        o.x = f2bf(v[i].x * rstd * gg.x); o.y = f2bf(v[i].y * rstd * gg.y);
        o.z = f2bf(v[i].z * rstd * gg.z); o.w = f2bf(v[i].w * rstd * gg.w);
        *reinterpret_cast<ushort4*>(((bfu*)(p.ws + OFF_h)) + (size_t)row * DM + i * 256 + lane * 4) = o;
      }
    } else {
      int base = (it - nconv - nnorm) * 256;
      for (int e = tid; e < 256 * 32; e += 256) {
        int tok = base + (e >> 5), i = e & 31;
        float inv = powf(10000.f, -(float)i / 32.f);
        float ang = (float)((const int*)p.in[1])[tok] * inv;
        double a = (double)ang;
        double kq = rint(a * 0.15915494309189535);
        float r = (float)(a - kq * 6.283185307179586);
        ((float*)(p.ws + OFF_rcos))[tok * 32 + i] = cosf(r);
        ((float*)(p.ws + OFF_rsin))[tok * 32 + i] = sinf(r);
      }
    }
  }
}

__device__ void phase_norm2(CParams& p, int l, int tid, int vb, int vg) {
  for (int it = vb; it < 4096; it += vg) {
    int row = it * 4 + (tid >> 6);
    int lane = tid & 63;
    const float* xr = p.out + (size_t)row * DM;
    const float* g = p.in[3] + l * DM;
    float4 v[4];
    float ss = 0.f;
#pragma unroll
    for (int i = 0; i < 4; ++i) {
      v[i] = *reinterpret_cast<const float4*>(xr + i * 256 + lane * 4);
      ss += v[i].x * v[i].x + v[i].y * v[i].y + v[i].z * v[i].z + v[i].w * v[i].w;
    }
#pragma unroll
    for (int m = 1; m < 64; m <<= 1) ss += __shfl_xor(ss, m, 64);
    float rstd = rsqrtf(ss * (1.f / DM) + EPS);
#pragma unroll
    for (int i = 0; i < 4; ++i) {
      float4 gg = *reinterpret_cast<const float4*>(g + i * 256 + lane * 4);
      ushort4 o;
      o.x = f2bf(v[i].x * rstd * gg.x); o.y = f2bf(v[i].y * rstd * gg.y);
      o.z = f2bf(v[i].z * rstd * gg.z); o.w = f2bf(v[i].w * rstd * gg.w);
      *reinterpret_cast<ushort4*>(((bfu*)(p.ws + OFF_h)) + (size_t)row * DM + i * 256 + lane * 4) = o;
    }
  }
}

__device__ __forceinline__ float wave_incl_scan(float v, int lane) {
#pragma unroll
  for (int d = 1; d < 64; d <<= 1) {
    float o = __shfl_up(v, d, 64);
    if (lane >= d) v += o;
  }
  return v;
}

__device__ void phase_prep(CParams& p_o, int l, bfu* smem, int tid, int wr, int vb, int vg) {
  bfu* sK = smem;
  bfu* sV = smem + 64 * LDP;
  float* sF = reinterpret_cast<float*>(smem + 2 * 64 * LDP);
  float* s_glr = sF;
  float* s_seg = sF + 1024;
  float* s_ps = sF + 1280;
  float* s_cs = sF + 1344;
  float* s_dt = sF + 1408;
  const int lane = tid & 63, seg = tid >> 6, col = lane;
  const int total = NCH * 20;
  for (int it = vb; it < total; it += vg) {
    CParams* pp_ = &p_o;
    asm volatile("" : "+s"(pp_));
    CParams& p = *pp_;
    const int c = it / 20, hs = it - c * 20;
    const int tok0 = c * 64;
    bfu kreg[16], vreg[16];
    if (hs < 4) {
      const int h = hs;
      for (int i = tid; i < 1024; i += 256) s_glr[i] = ((float*)(p.ws + OFF_small))[(tok0 + (i >> 4)) * 32 + 4 + (i & 15)];
      float wv[16];
#pragma unroll
      for (int r = 0; r < 16; ++r) wv[r] = p.in[8][(l * 16 + r) * 256 + h * 64 + col];
      const float bias = p.in[9][l * 256 + h * 64 + col];
      bfu qraw[16], kraw[16];
#pragma unroll
      for (int i = 0; i < 16; ++i) {
        const bfu* ur = ((bfu*)(p.ws + OFF_u)) + (size_t)(tok0 + seg * 16 + i) * NU + h * 64 + col;
        qraw[i] = ur[768]; kraw[i] = ur[1024]; vreg[i] = ur[1280];
      }
      __syncthreads();
      float lb[16];
      float run = 0.f;
#pragma unroll
      for (int i = 0; i < 16; ++i) {
        int t = seg * 16 + i;
        float z = bias;
#pragma unroll
        for (int r = 0; r < 16; ++r) z += s_glr[t * 16 + r] * wv[r];
        run += logsigmoid_fast(z) * (1.f / 16.f);
        lb[i] = run;
      }
      s_seg[seg * 64 + col] = run;
      __syncthreads();
      float pre = 0.f, blast = 0.f;
#pragma unroll
      for (int s2 = 0; s2 < 4; ++s2) {
        float v = s_seg[s2 * 64 + col];
        if (s2 < seg) pre += v;
        blast += v;
      }
      if (seg == 0) {
        float e = __expf(blast);
        s_ps[col] = e;
        ((float*)(p.ws + OFF_dec))[(hs * NCH + c) * 64 + col] = e;
        ((float*)(p.ws + OFF_csb))[hs * S_LEN + tok0 + col] = 0.f;
      }
#pragma unroll
      for (int i = 0; i < 16; ++i) {
        int tok = tok0 + seg * 16 + i;
        float b = lb[i] + pre;
        bfu* ur = ((bfu*)(p.ws + OFF_u)) + (size_t)tok * NU + h * 64 + col;
        float q = bf2f(qraw[i]), k = bf2f(kraw[i]);
        bfu qd = f2bf(q * 0.125f * __expf(b));
        bfu ki = f2bf(k * __expf(-b));
        if (wr) { ur[768] = qd; ur[1024] = ki; }
        kreg[i] = ki;
      }
    } else if (hs < 8) {
      const int h = hs - 4;
      const float lg = log1pf(-exp2f(-5.f - (float)h));
      if (seg == 0) {
        s_ps[col] = 1.f;
        ((float*)(p.ws + OFF_dec))[(hs * NCH + c) * 64 + col] = __expf(64.f * lg);
        ((float*)(p.ws + OFF_csb))[hs * S_LEN + tok0 + col] = (float)(col + 1) * lg;
      }
#pragma unroll
      for (int i = 0; i < 16; ++i) {
        int t = seg * 16 + i, tok = tok0 + t;
        float cs = ((float*)(p.ws + OFF_rcos))[tok * 32 + (col & 31)], sn = ((float*)(p.ws + OFF_rsin))[tok * 32 + (col & 31)];
        bfu* ur = ((bfu*)(p.ws + OFF_u)) + (size_t)tok * NU + h * 64;
        float qo = bf2f(ur[1792 + col]), qx = bf2f(ur[1792 + (col ^ 32)]);
        float ko = bf2f(ur[2048 + col]), kx = bf2f(ur[2048 + (col ^ 32)]);
        vreg[i] = ur[2304 + col];
        float qr, kr;
        if (col < 32) { qr = qo * cs - qx * sn; kr = ko * cs - kx * sn; }
        else          { qr = qx * sn + qo * cs; kr = kx * sn + ko * cs; }
        kr *= 0.125f;
        bfu kb = f2bf(kr);
        if (wr) { ur[1792 + col] = f2bf(qr); ur[2048 + col] = kb; }
        kreg[i] = f2bf(bf2f(kb) * __expf(lg * (float)(63 - t)));
      }
    } else if (hs < 16) {
      const int h = hs - 8, g = h >> 2;
      const int chx = h * 64 + col, chb = 512 + g * 64 + col, chc = 640 + g * 64 + col;
      bfu xin[19], bin[19], cin[19];
      {
        const int tb = tok0 + seg * 16 - 3;
        const bfu* ub = ((bfu*)(p.ws + OFF_u)) + 3328;
#pragma unroll
        for (int i = 0; i < 19; ++i) {
          const int tk = tb + i;
          const bool ok = tk >= 0;
          const bfu* ur = ub + (size_t)(ok ? tk : 0) * NU;
          xin[i] = ok ? ur[chx] : (bfu)0;
          bin[i] = ok ? ur[chb] : (bfu)0;
          cin[i] = ok ? ur[chc] : (bfu)0;
        }
      }
      if (seg == 0) {
        float dtv = softplus_fast(((float*)(p.ws + OFF_small))[(tok0 + lane) * 32 + 20 + h] + p.in[14][l * 8 + h]);
        float a = -__expf(p.in[15][l * 8 + h]);
        float cs = wave_incl_scan(dtv * a, lane);
        s_cs[lane] = cs;
        s_dt[lane] = dtv;
        ((float*)(p.ws + OFF_csb))[hs * S_LEN + tok0 + lane] = cs;
        s_ps[lane] = 1.f;
      }
      __syncthreads();
      const float cs_last = s_cs[63];
      if (seg == 0) ((float*)(p.ws + OFF_dec))[(hs * NCH + c) * 64 + col] = __expf(cs_last);
      float wx[4], wb[4], wc[4];
#pragma unroll
      for (int j = 0; j < 4; ++j) {
        wx[j] = p.in[12][(l * 4 + j) * 768 + chx];
        wb[j] = p.in[12][(l * 4 + j) * 768 + chb];
        wc[j] = p.in[12][(l * 4 + j) * 768 + chc];
      }
      const float bx = p.in[13][l * 768 + chx], bb = p.in[13][l * 768 + chb], bc = p.in[13][l * 768 + chc];
#pragma unroll
      for (int i = 0; i < 16; ++i) {
        int t = seg * 16 + i, tok = tok0 + t;
        float xs = siluf_(bx + wx[0] * bf2f(xin[i]) + wx[1] * bf2f(xin[i + 1]) + wx[2] * bf2f(xin[i + 2]) + wx[3] * bf2f(xin[i + 3]));
        float bs = siluf_(bb + wb[0] * bf2f(bin[i]) + wb[1] * bf2f(bin[i + 1]) + wb[2] * bf2f(bin[i + 2]) + wb[3] * bf2f(bin[i + 3]));
        float cv = siluf_(bc + wc[0] * bf2f(cin[i]) + wc[1] * bf2f(cin[i + 1]) + wc[2] * bf2f(cin[i + 2]) + wc[3] * bf2f(cin[i + 3]));
        bfu xb = f2bf(xs);
        ((bfu*)(p.ws + OFF_ssdX))[(size_t)tok * 512 + chx] = xb;
        if ((h & 3) == 0) {
          ((bfu*)(p.ws + OFF_ssdB))[((size_t)g * S_LEN + tok) * 64 + col] = f2bf(bs);
          ((bfu*)(p.ws + OFF_ssdC))[((size_t)g * S_LEN + tok) * 64 + col] = f2bf(cv);
        }
        vreg[i] = f2bf(xs * s_dt[t]);
        kreg[i] = f2bf(bs * __expf(cs_last - s_cs[t]));
      }
    } else {
      const int h = hs - 16;
      if (seg == 0) {
        float lf = logsigmoid_fast(((float*)(p.ws + OFF_small))[(tok0 + lane) * 32 + h] + p.in[5][l * 4 + h]);
        float cs = wave_incl_scan(lf, lane);
        ((float*)(p.ws + OFF_foxc))[h * S_LEN + tok0 + lane] = cs;
        if (lane == 63) ((float*)(p.ws + OFF_foxtot))[h * NCH + c] = cs;
      }
      const float qg = p.in[6][l * 64 + col], kg = p.in[7][l * 64 + col];
#pragma unroll
      for (int i = 0; i < 16; ++i) {
        int tok = tok0 + seg * 16 + i;
        const bfu* ur = ((bfu*)(p.ws + OFF_u)) + (size_t)tok * NU + h * 64 + col;
        float q = bf2f(ur[0]), k = bf2f(ur[256]);
        vreg[i] = ur[512];
        float sq = q * q, sk = k * k;
#pragma unroll
        for (int m = 1; m < 64; m <<= 1) { sq += __shfl_xor(sq, m, 64); sk += __shfl_xor(sk, m, 64); }
        ((bfu*)(p.ws + OFF_foxq))[((size_t)h * S_LEN + tok) * 64 + col] = f2bf(q * rsqrtf(sq * (1.f / 64.f) + EPS) * qg * (0.125f * 1.44269504088896f));
        ((bfu*)(p.ws + OFF_foxk))[((size_t)h * S_LEN + tok) * 64 + col] = f2bf(k * rsqrtf(sk * (1.f / 64.f) + EPS) * kg);
      }
      uint4 v0, v1;
      v0.x = vreg[0] | ((unsigned)vreg[1] << 16); v0.y = vreg[2] | ((unsigned)vreg[3] << 16);
      v0.z = vreg[4] | ((unsigned)vreg[5] << 16); v0.w = vreg[6] | ((unsigned)vreg[7] << 16);
      v1.x = vreg[8] | ((unsigned)vreg[9] << 16); v1.y = vreg[10] | ((unsigned)vreg[11] << 16);
      v1.z = vreg[12] | ((unsigned)vreg[13] << 16); v1.w = vreg[14] | ((unsigned)vreg[15] << 16);
      bfu* dst = ((bfu*)(p.ws + OFF_foxvT)) + ((size_t)h * 64 + col) * S_LEN + tok0 + seg * 16;
      *reinterpret_cast<uint4*>(dst) = v0;
      *reinterpret_cast<uint4*>(dst + 8) = v1;
      continue;
    }
    {
      uint4 k0, k1, v0, v1;
      k0.x = kreg[0] | ((unsigned)kreg[1] << 16); k0.y = kreg[2] | ((unsigned)kreg[3] << 16);
      k0.z = kreg[4] | ((unsigned)kreg[5] << 16); k0.w = kreg[6] | ((unsigned)kreg[7] << 16);
      k1.x = kreg[8] | ((unsigned)kreg[9] << 16); k1.y = kreg[10] | ((unsigned)kreg[11] << 16);
      k1.z = kreg[12] | ((unsigned)kreg[13] << 16); k1.w = kreg[14] | ((unsigned)kreg[15] << 16);
      v0.x = vreg[0] | ((unsigned)vreg[1] << 16); v0.y = vreg[2] | ((unsigned)vreg[3] << 16);
      v0.z = vreg[4] | ((unsigned)vreg[5] << 16); v0.w = vreg[6] | ((unsigned)vreg[7] << 16);
      v1.x = vreg[8] | ((unsigned)vreg[9] << 16); v1.y = vreg[10] | ((unsigned)vreg[11] << 16);
      v1.z = vreg[12] | ((unsigned)vreg[13] << 16); v1.w = vreg[14] | ((unsigned)vreg[15] << 16);
      *reinterpret_cast<uint4*>(sK + col * LDP + seg * 16) = k0;
      *reinterpret_cast<uint4*>(sK + col * LDP + seg * 16 + 8) = k1;
      *reinterpret_cast<uint4*>(sV + col * LDP + seg * 16) = v0;
      *reinterpret_cast<uint4*>(sV + col * LDP + seg * 16 + 8) = v1;
      bfu* dst = ((bfu*)(p.ws + OFF_VT)) + (((size_t)hs * NCH + c) * 64 + col) * 64 + seg * 16;
      *reinterpret_cast<uint4*>(dst) = v0;
      *reinterpret_cast<uint4*>(dst + 8) = v1;
    }
    __syncthreads();
    {
      f32x4 acc[4];
#pragma unroll
      for (int n = 0; n < 4; ++n) acc[n] = (f32x4){0.f, 0.f, 0.f, 0.f};
      {
        const int r = lane & 15, q8 = (lane >> 4) * 8;
#pragma unroll
        for (int ks = 0; ks < 2; ++ks) {
          const bf16x8 vfr = lds_frag(sV, seg * 16 + r, ks * 32 + q8, LDP);
#pragma unroll
          for (int n = 0; n < 4; ++n)
            acc[n] = __builtin_amdgcn_mfma_f32_16x16x32_bf16(lds_frag(sK, n * 16 + r, ks * 32 + q8, LDP), vfr, acc[n], 0, 0, 0);
        }
      }
      bfu* st = ((bfu*)(p.ws + OFF_ST)) + ((size_t)hs * NCH + c) * 4096 + (seg * 16 + (lane & 15)) * 64 + (lane >> 4) * 4;
#pragma unroll
      for (int n = 0; n < 4; ++n) {
        const f32x4 ps = *reinterpret_cast<const f32x4*>(s_ps + n * 16 + (lane >> 4) * 4);
        uint2 wv;
        wv.x = pg8::cvt_pk_bf16(acc[n][0] * ps[0], acc[n][1] * ps[1]);
        wv.y = pg8::cvt_pk_bf16(acc[n][2] * ps[2], acc[n][3] * ps[3]);
        *reinterpret_cast<uint2*>(st + n * 16) = wv;
      }
    }
    __syncthreads();
  }
}

__device__ void phase_scan(CParams& p, bfu* smem, int tid, int wr, int vb, int vg) {
  float* s_x = reinterpret_cast<float*>(smem);
  const int g = tid >> 5, dp = tid & 31;
  for (int it = vb; it < 16 * 64; it += vg) {
    const int hs = it >> 6, e = it & 63;
    unsigned* stp = reinterpret_cast<unsigned*>(((bfu*)(p.ws + OFF_ST)) + ((size_t)hs * NCH + g * 32) * 4096 + e * 64 + dp * 2);
    const float2* dcp = reinterpret_cast<const float2*>(((float*)(p.ws + OFF_dec)) + ((size_t)hs * NCH + g * 32) * 64 + dp * 2);
    unsigned kv[32];
    float2 dc[32];
#pragma unroll
    for (int i = 0; i < 32; ++i) {
      kv[i] = stp[(size_t)i * 2048];
      dc[i] = dcp[i * 32];
    }
    float t0 = 0.f, t1 = 0.f, d0 = 1.f, d1 = 1.f;
#pragma unroll
    for (int i = 0; i < 32; ++i) {
      t0 = t0 * dc[i].x + bf2f((bfu)(kv[i] & 0xffffu));
      t1 = t1 * dc[i].y + bf2f((bfu)(kv[i] >> 16));
      d0 *= dc[i].x;
      d1 *= dc[i].y;
    }
    *reinterpret_cast<float4*>(s_x + (g * 32 + dp) * 4) = make_float4(t0, t1, d0, d1);
    __syncthreads();
    float s0 = 0.f, s1 = 0.f;
    for (int gg = 0; gg < g; ++gg) {
      const float4 x = *reinterpret_cast<const float4*>(s_x + (gg * 32 + dp) * 4);
      s0 = s0 * x.z + x.x;
      s1 = s1 * x.w + x.y;
    }
#pragma unroll
    for (int i = 0; i < 32; ++i) {
      const unsigned o = pg8::cvt_pk_bf16(s0, s1);
      if (wr) stp[(size_t)i * 2048] = o;
      s0 = s0 * dc[i].x + bf2f((bfu)(kv[i] & 0xffffu));
      s1 = s1 * dc[i].y + bf2f((bfu)(kv[i] >> 16));
    }
    __syncthreads();
  }
}

__device__ __forceinline__ void att_compute(const bfu* kS, const bfu* vS, const float* cS, const bfu* sQw,
                                            const float (&ct)[2], float (&l_run)[2], f32x4 (&O)[2][4],
                                            int kt, int qb, int r0, int w, int lr, int lq, int lg4) {
    f32x4 sc[2][4];
#pragma unroll
    for (int mi = 0; mi < 2; ++mi)
#pragma unroll
      for (int n = 0; n < 4; ++n) sc[mi][n] = (f32x4){0.f, 0.f, 0.f, 0.f};
#pragma unroll
    for (int ks = 0; ks < 2; ++ks) {
      bf16x8 aq0 = lds_frag(sQw, lr, ks * 32 + lq, LDP);
      bf16x8 aq1 = lds_frag(sQw, 16 + lr, ks * 32 + lq, LDP);
#pragma unroll
      for (int n = 0; n < 4; ++n) {
        bf16x8 kf = lds_frag(kS, n * 16 + lr, ks * 32 + lq, LDP);
        sc[0][n] = __builtin_amdgcn_mfma_f32_16x16x32_bf16(kf, aq0, sc[0][n], 0, 0, 0);
        sc[1][n] = __builtin_amdgcn_mfma_f32_16x16x32_bf16(kf, aq1, sc[1][n], 0, 0, 0);
      }
    }
    f32x4 csv[4];
#pragma unroll
    for (int n = 0; n < 4; ++n) csv[n] = *reinterpret_cast<const f32x4*>(cS + n * 16 + lg4);
    const bool diag = (kt >= 2 * qb);
    bf16x8 pf[2][2];
#pragma unroll
    for (int mi = 0; mi < 2; ++mi) {
      const int qrow = r0 + w * 32 + mi * 16 + lr;
      float ps = 0.f;
#pragma unroll
      for (int n = 0; n < 4; ++n)
#pragma unroll
        for (int j = 0; j < 4; ++j) {
          float v = (sc[mi][n][j] + ct[mi]) - csv[n][j];
          if (diag && (kt * 64 + n * 16 + lg4 + j > qrow)) v = -INFINITY;
          const float pv = __builtin_amdgcn_exp2f(v);
          sc[mi][n][j] = pv;
          ps += pv;
        }
      l_run[mi] += ps;
#pragma unroll
      for (int ks = 0; ks < 2; ++ks) {
        union { bf16x8 v; unsigned u[4]; } pk;
        pk.u[0] = pg8::cvt_pk_bf16(sc[mi][2 * ks][0], sc[mi][2 * ks][1]);
        pk.u[1] = pg8::cvt_pk_bf16(sc[mi][2 * ks][2], sc[mi][2 * ks][3]);
        pk.u[2] = pg8::cvt_pk_bf16(sc[mi][2 * ks + 1][0], sc[mi][2 * ks + 1][1]);
        pk.u[3] = pg8::cvt_pk_bf16(sc[mi][2 * ks + 1][2], sc[mi][2 * ks + 1][3]);
        pf[mi][ks] = pk.v;
      }
    }
#pragma unroll
    for (int ks = 0; ks < 2; ++ks) {
#pragma unroll
      for (int ef = 0; ef < 4; ++ef) {
        union { bf16x8 v; uint2 h2[2]; } vf;
        vf.h2[0] = *reinterpret_cast<const uint2*>(vS + (ef * 16 + lr) * LDP + ks * 32 + lg4);
        vf.h2[1] = *reinterpret_cast<const uint2*>(vS + (ef * 16 + lr) * LDP + ks * 32 + 16 + lg4);
#pragma unroll
        for (int mi = 0; mi < 2; ++mi)
          O[mi][ef] = __builtin_amdgcn_mfma_f32_16x16x32_bf16(vf.v, pf[mi][ks], O[mi][ef], 0, 0, 0);
      }
    }
}

__device__ void attn_item(CParams& p, int l, int qb, int h, bfu* smem, int tid, int half, unsigned char* smem_raw) {
  bfu* sK = smem;
  bfu* sV = smem + 2 * 64 * LDP;
  float* s_c = reinterpret_cast<float*>(smem + 4 * 64 * LDP);
  float* s_off = s_c + 128;
  const int lane = tid & 63, w = tid >> 6;
  const int lr = lane & 15, lq = (lane >> 4) * 8, lg4 = (lane >> 4) * 4;
  const int r0 = qb * 128;
  const float L2E = 1.44269504088896f;
  s_off[tid] = ((float*)(p.ws + OFF_foxtot))[h * NCH + tid];
  __syncthreads();
  float myoff = 0.f;
  for (int i = 0; i < tid; ++i) myoff += s_off[i];
  __syncthreads();
  s_off[tid] = myoff;
  float* s_misc = reinterpret_cast<float*>(smem + 28416);
  if (tid < 64) {
    float gq = fabsf(p.in[6][l * 64 + tid]), gk = fabsf(p.in[7][l * 64 + tid]);
#pragma unroll
    for (int m = 1; m < 64; m <<= 1) { gq = fmaxf(gq, __shfl_xor(gq, m, 64)); gk = fmaxf(gk, __shfl_xor(gk, m, 64)); }
    if (tid == 0) { s_misc[0] = 40.f + 2.f * 8.f * gq * gk * 1.01f; reinterpret_cast<int*>(s_misc)[1] = 2 * qb; s_misc[2] = 8.f * gq * gk * 1.01f * 1.44269504088896f; }
  }
  __syncthreads();
  {
    const float thr = s_misc[0];
    const float cref = s_off[2 * qb];
    if (tid < 2 * qb && s_off[tid + 1] <= cref + thr) atomicMin(reinterpret_cast<int*>(s_misc) + 1, tid);
  }
  __syncthreads();
  int kt_min = reinterpret_cast<int*>(s_misc)[1];
  const int nkt = 2 * qb + 2;
  if ((nkt - kt_min) & 1) kt_min -= 1;
  const bfu* Qg = ((bfu*)(p.ws + OFF_foxq)) + (size_t)h * S_LEN * 64;
  const bfu* Kg = ((bfu*)(p.ws + OFF_foxk)) + (size_t)h * S_LEN * 64;
  const bfu* Vg = ((bfu*)(p.ws + OFF_foxvT)) + (size_t)h * 64 * S_LEN;
  const float* Cg = ((float*)(p.ws + OFF_foxc)) + (size_t)h * S_LEN;
  bfu* sQ = smem + 4 * 64 * LDP + 768;
  {
#pragma unroll
    for (int i = 0; i < 4; ++i) {
      int id = tid + i * 256;
      int r = id >> 3, c = (id & 7) * 8;
      *reinterpret_cast<uint4*>(sQ + r * LDP + c) = *reinterpret_cast<const uint4*>(Qg + (size_t)(r0 + r) * 64 + c);
    }
  }
  const bfu* sQw = sQ + (w * 32) * LDP;
  float ct[2], l_run[2];
  const float lbound = s_misc[2];
  f32x4 O[2][4];
#pragma unroll
  for (int mi = 0; mi < 2; ++mi) {
    const int qrow = r0 + w * 32 + mi * 16 + lr;
    ct[mi] = (Cg[qrow] + s_off[qrow >> 6]) * L2E - lbound;
    l_run[mi] = 0.f;
#pragma unroll
    for (int n = 0; n < 4; ++n) O[mi][n] = (f32x4){0.f, 0.f, 0.f, 0.f};
  }
  const int nkh = (nkt - kt_min) >> 1;
  const int kt0 = kt_min + half * nkh;
  const int crow0 = tid >> 3, ccol = (tid & 7) * 8;
  uint4 rk0A, rk1A, rv0A, rv1A, rk0B, rk1B, rv0B, rv1B;
  float rcA = 0.f, rcB = 0.f;
  {
    const int k0 = kt0 * 64;
    rk0A = *reinterpret_cast<const uint4*>(Kg + (size_t)(k0 + crow0) * 64 + ccol);
    rk1A = *reinterpret_cast<const uint4*>(Kg + (size_t)(k0 + crow0 + 32) * 64 + ccol);
    rv0A = *reinterpret_cast<const uint4*>(Vg + (size_t)(crow0) * S_LEN + k0 + ccol);
    rv1A = *reinterpret_cast<const uint4*>(Vg + (size_t)(crow0 + 32) * S_LEN + k0 + ccol);
    if (tid < 64) rcA = (Cg[k0 + tid] + s_off[kt0]) * L2E;
  }
  *reinterpret_cast<uint4*>(sK + (crow0) * LDP + ccol) = rk0A;
  *reinterpret_cast<uint4*>(sK + (crow0 + 32) * LDP + ccol) = rk1A;
  *reinterpret_cast<uint4*>(sV + (crow0) * LDP + ccol) = rv0A;
  *reinterpret_cast<uint4*>(sV + (crow0 + 32) * LDP + ccol) = rv1A;
  if (tid < 64) s_c[tid] = rcA;
  rk0B = rk1B = rv0B = rv1B = rk0A;
  __syncthreads();
#define ATT_LOAD(S, KT)                                                                              \
  {                                                                                                  \
    const int k0_ = (KT) * 64;                                                                       \
    rk0##S = *reinterpret_cast<const uint4*>(Kg + (size_t)(k0_ + crow0) * 64 + ccol);                \
    rk1##S = *reinterpret_cast<const uint4*>(Kg + (size_t)(k0_ + crow0 + 32) * 64 + ccol);           \
    rv0##S = *reinterpret_cast<const uint4*>(Vg + (size_t)(crow0) * S_LEN + k0_ + ccol);             \
    rv1##S = *reinterpret_cast<const uint4*>(Vg + (size_t)(crow0 + 32) * S_LEN + k0_ + ccol);        \
    if (tid < 64) rc##S = (Cg[k0_ + tid] + s_off[(KT)]) * L2E;                                       \
  }
#define ATT_STORE(S, BUF)                                                                            \
  {                                                                                                  \
    bfu* kN_ = sK + (BUF) * 64 * LDP;                                                                \
    bfu* vN_ = sV + (BUF) * 64 * LDP;                                                                \
    *reinterpret_cast<uint4*>(kN_ + (crow0) * LDP + ccol) = rk0##S;                                  \
    *reinterpret_cast<uint4*>(kN_ + (crow0 + 32) * LDP + ccol) = rk1##S;                             \
    *reinterpret_cast<uint4*>(vN_ + (crow0) * LDP + ccol) = rv0##S;                                  \
    *reinterpret_cast<uint4*>(vN_ + (crow0 + 32) * LDP + ccol) = rv1##S;                             \
    if (tid < 64) s_c[(BUF) * 64 + tid] = rc##S;                                                     \
  }
  if (nkh > 1) ATT_LOAD(B, kt0 + 1);
  for (int it = 0; it < nkh; it += 2) {
    if (it + 2 < nkh) ATT_LOAD(A, kt0 + it + 2);
    att_compute(sK, sV, s_c, sQw, ct, l_run, O, kt0 + it, qb, r0, w, lr, lq, lg4);
    if (it + 1 < nkh) ATT_STORE(B, 1);
    __syncthreads();
    if (it + 1 >= nkh) break;
    if (it + 3 < nkh) ATT_LOAD(B, kt0 + it + 3);
    att_compute(sK + 64 * LDP, sV + 64 * LDP, s_c + 64, sQw, ct, l_run, O, kt0 + it + 1, qb, r0, w, lr, lq, lg4);
    if (it + 2 < nkh) ATT_STORE(A, 0);
    __syncthreads();
  }
#undef ATT_LOAD
#undef ATT_STORE
  float* xch = reinterpret_cast<float*>(smem_raw + SMEM_HALF);
  if (half == 1) {
#pragma unroll
    for (int mi = 0; mi < 2; ++mi) {
#pragma unroll
      for (int n = 0; n < 4; ++n)
#pragma unroll
        for (int j = 0; j < 4; ++j) xch[((mi * 4 + n) * 4 + j) * 256 + tid] = O[mi][n][j];
      xch[(32 + mi) * 256 + tid] = l_run[mi];
    }
  }
  __syncthreads();
  if (half == 0) {
#pragma unroll
    for (int mi = 0; mi < 2; ++mi) {
      float lsum = l_run[mi] + xch[(32 + mi) * 256 + tid];
      lsum += __shfl_xor(lsum, 16, 64);
      lsum += __shfl_xor(lsum, 32, 64);
      const float inv = 1.f / lsum;
      const int qrow = r0 + w * 32 + mi * 16 + lr;
      bfu* yp = ((bfu*)(p.ws + OFF_y)) + (size_t)qrow * YW + h * 64 + lg4;
#pragma unroll
      for (int n = 0; n < 4; ++n) {
        float o0 = (O[mi][n][0] + xch[((mi * 4 + n) * 4 + 0) * 256 + tid]) * inv;
        float o1 = (O[mi][n][1] + xch[((mi * 4 + n) * 4 + 1) * 256 + tid]) * inv;
        float o2 = (O[mi][n][2] + xch[((mi * 4 + n) * 4 + 2) * 256 + tid]) * inv;
        float o3 = (O[mi][n][3] + xch[((mi * 4 + n) * 4 + 3) * 256 + tid]) * inv;
        uint2 wv;
        wv.x = pg8::cvt_pk_bf16(o0, o1);
        wv.y = pg8::cvt_pk_bf16(o2, o3);
        *reinterpret_cast<uint2*>(yp + n * 16) = wv;
      }
    }
  }
  __syncthreads();
}

__device__ void chunk_out_item(CParams& p, int l, int c, int hs, bfu* smem, int tid) {
  bfu* sQ = smem;
  bfu* sKi = smem + 64 * LDP;
  bfu* sV = smem + 2 * 64 * LDP;
  bfu* sS = smem + 3 * 64 * LDP;
  bfu* sP = smem + 4 * 64 * LDP;
  float* s_cs = reinterpret_cast<float*>(smem + 5 * 64 * LDP);
  const int lane = tid & 63, w = tid >> 6;
  const int lr = lane & 15, lq = (lane >> 4) * 8, lg4 = (lane >> 4) * 4;
  const int tok0 = c * 64;
  const int tl = w * 16 + lr, tok = tok0 + tl;
  const bfu *Qp, *Kp;
  int qs;
  if (hs < 4) { Qp = ((bfu*)(p.ws + OFF_u)) + (size_t)tok0 * NU + 768 + hs * 64; Kp = ((bfu*)(p.ws + OFF_u)) + (size_t)tok0 * NU + 1024 + hs * 64; qs = NU; }
  else if (hs < 8) { Qp = ((bfu*)(p.ws + OFF_u)) + (size_t)tok0 * NU + 1792 + (hs - 4) * 64; Kp = ((bfu*)(p.ws + OFF_u)) + (size_t)tok0 * NU + 2048 + (hs - 4) * 64; qs = NU; }
  else { int g = (hs - 8) >> 2; Qp = ((bfu*)(p.ws + OFF_ssdC)) + ((size_t)g * S_LEN + tok0) * 64; Kp = ((bfu*)(p.ws + OFF_ssdB)) + ((size_t)g * S_LEN + tok0) * 64; qs = 64; }
  uint2 g4[4], x4[4];
  f32x4 gn[4];
  const int hh = (hs < 8) ? (hs & 3) : (hs - 8);
  {
    const int gcol = (hs < 4) ? (1536 + hh * 64) : (hs < 8 ? (2560 + hh * 64) : (2816 + hh * 64));
    const bfu* gp = ((bfu*)(p.ws + OFF_u)) + (size_t)tok * NU + gcol + lg4;
    const bfu* xp = ((bfu*)(p.ws + OFF_ssdX)) + (size_t)tok * 512 + hh * 64 + lg4;
    const float* gnp = (hs < 4 ? p.in[10] : p.in[11]) + l * 64 + lg4;
#pragma unroll
    for (int n = 0; n < 4; ++n) {
      g4[n] = *reinterpret_cast<const uint2*>(gp + n * 16);
      x4[n] = (hs >= 8) ? *reinterpret_cast<const uint2*>(xp + n * 16) : make_uint2(0u, 0u);
      gn[n] = (hs < 8) ? *reinterpret_cast<const f32x4*>(gnp + n * 16) : (f32x4){1.f, 1.f, 1.f, 1.f};
    }
  }
  load_tile64(sQ, Qp, qs, tid);
  load_tile64(sKi, Kp, qs, tid);
  load_tile64(sV, ((bfu*)(p.ws + OFF_VT)) + ((size_t)hs * NCH + c) * 4096, 64, tid);
  load_tile64(sS, ((bfu*)(p.ws + OFF_ST)) + ((size_t)hs * NCH + c) * 4096, 64, tid);
  if (tid < 64) s_cs[tid] = ((float*)(p.ws + OFF_csb))[hs * S_LEN + tok0 + tid];
  __syncthreads();
  const bf16x8 qf0 = lds_frag(sQ, tl, lq, LDP), qf1 = lds_frag(sQ, tl, 32 + lq, LDP);
  f32x4 sc[4], o[4];
#pragma unroll
  for (int n = 0; n < 4; ++n) {
    sc[n] = (f32x4){0.f, 0.f, 0.f, 0.f};
    o[n] = (f32x4){0.f, 0.f, 0.f, 0.f};
  }
#pragma unroll
  for (int n = 0; n < 4; ++n) {
    sc[n] = __builtin_amdgcn_mfma_f32_16x16x32_bf16(lds_frag(sKi, n * 16 + lr, lq, LDP), qf0, sc[n], 0, 0, 0);
    sc[n] = __builtin_amdgcn_mfma_f32_16x16x32_bf16(lds_frag(sKi, n * 16 + lr, 32 + lq, LDP), qf1, sc[n], 0, 0, 0);
    o[n] = __builtin_amdgcn_mfma_f32_16x16x32_bf16(lds_frag(sS, n * 16 + lr, lq, LDP), qf0, o[n], 0, 0, 0);
    o[n] = __builtin_amdgcn_mfma_f32_16x16x32_bf16(lds_frag(sS, n * 16 + lr, 32 + lq, LDP), qf1, o[n], 0, 0, 0);
  }
  const float cst = s_cs[tl];
  const float rsc = __expf(cst);
#pragma unroll
  for (int n = 0; n < 4; ++n) {
    const f32x4 css = *reinterpret_cast<const f32x4*>(s_cs + n * 16 + lg4);
    float pv[4];
#pragma unroll
    for (int j = 0; j < 4; ++j) {
      const int s = n * 16 + lg4 + j;
      pv[j] = (s <= tl) ? sc[n][j] * __expf(cst - css[j]) : 0.f;
      o[n][j] *= rsc;
    }
    uint2 wv;
    wv.x = pg8::cvt_pk_bf16(pv[0], pv[1]);
    wv.y = pg8::cvt_pk_bf16(pv[2], pv[3]);
    *reinterpret_cast<uint2*>(sP + tl * LDP + n * 16 + lg4) = wv;
  }
  __syncthreads();
  {
    const bf16x8 pf0 = lds_frag(sP, tl, lq, LDP), pf1 = lds_frag(sP, tl, 32 + lq, LDP);
#pragma unroll
    for (int n = 0; n < 4; ++n) {
      o[n] = __builtin_amdgcn_mfma_f32_16x16x32_bf16(lds_frag(sV, n * 16 + lr, lq, LDP), pf0, o[n], 0, 0, 0);
      o[n] = __builtin_amdgcn_mfma_f32_16x16x32_bf16(lds_frag(sV, n * 16 + lr, 32 + lq, LDP), pf1, o[n], 0, 0, 0);
    }
  }
  float ss = 0.f;
  if (hs < 8) {
#pragma unroll
    for (int n = 0; n < 4; ++n) ss += (o[n][0] * o[n][0] + o[n][1] * o[n][1]) + (o[n][2] * o[n][2] + o[n][3] * o[n][3]);
    ss += __shfl_xor(ss, 16, 64);
    ss += __shfl_xor(ss, 32, 64);
    const float rstd = rsqrtf(ss * (1.f / 64.f) + EPS);
    bfu* yp = ((bfu*)(p.ws + OFF_y)) + (size_t)tok * YW + (hs < 4 ? 256 : 512) + hh * 64 + lg4;
#pragma unroll
    for (int n = 0; n < 4; ++n) {
      const float t0 = __uint_as_float(g4[n].x << 16), t1 = __uint_as_float(g4[n].x & 0xffff0000u);
      const float t2 = __uint_as_float(g4[n].y << 16), t3 = __uint_as_float(g4[n].y & 0xffff0000u);
      uint2 wv;
      wv.x = pg8::cvt_pk_bf16(o[n][0] * rstd * gn[n][0] * siluf_(t0), o[n][1] * rstd * gn[n][1] * siluf_(t1));
      wv.y = pg8::cvt_pk_bf16(o[n][2] * rstd * gn[n][2] * siluf_(t2), o[n][3] * rstd * gn[n][3] * siluf_(t3));
      *reinterpret_cast<uint2*>(yp + n * 16) = wv;
    }
  } else {
    const float dsk = p.in[16][l * 8 + hh];
    bfu* yp = ((bfu*)(p.ws + OFF_y)) + (size_t)tok * YW + 768 + hh * 64 + lg4;
#pragma unroll
    for (int n = 0; n < 4; ++n) {
      const float z0 = __uint_as_float(g4[n].x << 16), z1 = __uint_as_float(g4[n].x & 0xffff0000u);
      const float z2 = __uint_as_float(g4[n].y << 16), z3 = __uint_as_float(g4[n].y & 0xffff0000u);
      const float a0 = __uint_as_float(x4[n].x << 16), a1 = __uint_as_float(x4[n].x & 0xffff0000u);
      const float a2 = __uint_as_float(x4[n].y << 16), a3 = __uint_as_float(x4[n].y & 0xffff0000u);
      const float y0 = (o[n][0] + dsk * a0) * siluf_(z0), y1 = (o[n][1] + dsk * a1) * siluf_(z1);
      const float y2 = (o[n][2] + dsk * a2) * siluf_(z2), y3 = (o[n][3] + dsk * a3) * siluf_(z3);
      ss += (y0 * y0 + y1 * y1) + (y2 * y2 + y3 * y3);
      uint2 wv;
      wv.x = pg8::cvt_pk_bf16(y0, y1);
      wv.y = pg8::cvt_pk_bf16(y2, y3);
      *reinterpret_cast<uint2*>(yp + n * 16) = wv;
    }
    ss += __shfl_xor(ss, 16, 64);
    ss += __shfl_xor(ss, 32, 64);
    if (lg4 == 0) ((float*)(p.ws + OFF_ssq))[tok * 8 + hh] = ss;
  }
  __syncthreads();
}

__device__ void phase_mix(CParams& p_o, int l, bfu* smem, int tid, int half, int cidx, unsigned char* smem_raw) {
  __shared__ int s_item;
  const int total = 512 + NCH * 8;
  while (true) {
    __syncthreads();
    if (threadIdx.x == 0) s_item = (int)atomicAdd(&((unsigned*)(p_o.ws + OFF_ctr))[cidx], 1u);
    __syncthreads();
    const int it = s_item;
    if (it >= total) break;
    CParams* pp_ = &p_o;
    asm volatile("" : "+s"(pp_));
    CParams& p = *pp_;
    if (it < 512) {
      int qb = 127 - (it >> 2), h = it & 3;
      attn_item(p, l, qb, h, smem, tid, half, smem_raw);
    } else {
      int j = (it - 512) * 2 + half;
      chunk_out_item(p, l, j >> 4, j & 15, smem, tid);
    }
  }
}

__device__ void phase_upmerge(CParams& p, bfu* smem, int tid, int vb, int vg, int half, unsigned char* smem_raw) {
  bfu* sA = reinterpret_cast<bfu*>(smem_raw);
  bfu* sB = smem + 2 * 128 * LDP;
  float* s_rs = reinterpret_cast<float*>(smem + 2 * 128 * LDP + 2 * 64 * LDP);
  const int lane = tid & 63, w = tid >> 6, wm = w >> 1, wn = w & 1;
  const int lr = lane & 15, lq = (lane >> 4) * 8, lg4 = (lane >> 4) * 4;
  const int crow = tid >> 3, ccol = (tid & 7) * 8;
  const int t512 = half * 256 + tid, arow = t512 >> 3;
  const int xcd = (vb >> 1) & 7, jl = ((vb >> 4) << 1) | (vb & 1), per = vg >> 3;
  for (int il = jl; il < 16 * 16; il += per) {
    const int mt = xcd * 16 + (il >> 4), nt = il & 15;
    const bfu* Ap = ((bfu*)(p.ws + OFF_y)) + (size_t)(mt * 128 + arow) * YW + ccol;
    const bfu* Bp = ((bfu*)(p.ws + OFF_WupT)) + (size_t)(nt * 64 + crow) * YW + ccol;
    const bfu* Gp = ((bfu*)(p.ws + OFF_u)) + (size_t)(mt * 128 + wm * 64 + lr) * NU + 4096 + nt * 64 + wn * 32 + lg4;
    {
      const int row = tid >> 1, g = tid & 1;
      const float4 q4 = *reinterpret_cast<const float4*>(((float*)(p.ws + OFF_ssq)) + (mt * 128 + row) * 8 + g * 4);
      s_rs[g * 128 + row] = rsqrtf((q4.x + q4.y + q4.z + q4.w) * (1.f / 256.f) + EPS);
    }
    uint4 a0_0, a0_1, b0_0, b0_1, a1_0, a1_1, b1_0, b1_1;
#define U_LOAD(S, KT)                                                                \
  {                                                                                  \
    const int ko_ = (KT) * 64;                                                       \
    a##S##_0 = *reinterpret_cast<const uint4*>(Ap + (size_t)0 * 64 * YW + ko_);      \
    a##S##_1 = *reinterpret_cast<const uint4*>(Ap + (size_t)1 * 64 * YW + ko_);      \
    b##S##_0 = *reinterpret_cast<const uint4*>(Bp + (size_t)0 * 32 * YW + ko_);      \
    b##S##_1 = *reinterpret_cast<const uint4*>(Bp + (size_t)1 * 32 * YW + ko_);      \
  }
#define U_STORE(S, BUF)                                                              \
  {                                                                                  \
    bfu* sAn_ = sA + (BUF) * 128 * LDP + arow * LDP + ccol;                          \
    bfu* sBn_ = sB + (BUF) * 64 * LDP + crow * LDP + ccol;                           \
    *reinterpret_cast<uint4*>(sAn_ + 0 * 64 * LDP) = a##S##_0;                       \
    *reinterpret_cast<uint4*>(sAn_ + 1 * 64 * LDP) = a##S##_1;                       \
    *reinterpret_cast<uint4*>(sBn_ + 0 * 32 * LDP) = b##S##_0;                       \
    *reinterpret_cast<uint4*>(sBn_ + 1 * 32 * LDP) = b##S##_1;                       \
  }
#define U_COMPUTE(BUF)                                                               \
  {                                                                                  \
    const bfu* a_s = sA + (BUF) * 128 * LDP + (wm * 64) * LDP;                       \
    const bfu* b_s = sB + (BUF) * 64 * LDP + (wn * 32) * LDP;                        \
    _Pragma("unroll") for (int ks = 0; ks < 2; ++ks) {                               \
      bf16x8 af0 = lds_frag(a_s, 0 * 16 + lr, ks * 32 + lq, LDP);                    \
      bf16x8 af1 = lds_frag(a_s, 1 * 16 + lr, ks * 32 + lq, LDP);                    \
      bf16x8 af2 = lds_frag(a_s, 2 * 16 + lr, ks * 32 + lq, LDP);                    \
      bf16x8 af3 = lds_frag(a_s, 3 * 16 + lr, ks * 32 + lq, LDP);                    \
      _Pragma("unroll") for (int ni = 0; ni < 2; ++ni) {                             \
        bf16x8 bf_ = lds_frag(b_s, ni * 16 + lr, ks * 32 + lq, LDP);                 \
        acc[0][ni] = __builtin_amdgcn_mfma_f32_16x16x32_bf16(bf_, af0, acc[0][ni], 0, 0, 0); \
        acc[1][ni] = __builtin_amdgcn_mfma_f32_16x16x32_bf16(bf_, af1, acc[1][ni], 0, 0, 0); \
        acc[2][ni] = __builtin_amdgcn_mfma_f32_16x16x32_bf16(bf_, af2, acc[2][ni], 0, 0, 0); \
        acc[3][ni] = __builtin_amdgcn_mfma_f32_16x16x32_bf16(bf_, af3, acc[3][ni], 0, 0, 0); \
      }                                                                              \
    }                                                                                \
  }
    f32x4 acc[4][2], tot[4][2];
    zero_acc<2>(acc);
    zero_acc<2>(tot);
    uint2 gt[4][2];
    U_LOAD(0, 0);
    U_LOAD(1, 1);
    U_STORE(0, 0);
    __syncthreads();
#pragma unroll 1
    for (int kt = 0; kt < 20; kt += 2) {
      if ((kt & 3) == 0) {
        const int br = kt >> 2, gb = br < 3 ? br : 3;
#pragma unroll
        for (int mi = 0; mi < 4; ++mi)
#pragma unroll
          for (int ni = 0; ni < 2; ++ni)
            gt[mi][ni] = *reinterpret_cast<const uint2*>(Gp + (size_t)(mi * 16) * NU + gb * 1024 + ni * 16);
      }
      if (kt + 2 < 20) U_LOAD(0, kt + 2);
      U_COMPUTE(0);
      U_STORE(1, 1);
      __syncthreads();
      if (kt + 3 < 20) U_LOAD(1, kt + 3);
      U_COMPUTE(1);
      if (kt + 2 < 20) U_STORE(0, 0);
      if ((kt & 3) == 2) {
        const int br = kt >> 2;
#pragma unroll
        for (int mi = 0; mi < 4; ++mi) {
          float rsc = 1.f;
          if (br >= 3) rsc = s_rs[(br - 3) * 128 + wm * 64 + mi * 16 + lr];
#pragma unroll
          for (int ni = 0; ni < 2; ++ni) {
            const uint2 g2 = gt[mi][ni];
            tot[mi][ni][0] += acc[mi][ni][0] * (__uint_as_float(g2.x << 16) * rsc);
            tot[mi][ni][1] += acc[mi][ni][1] * (__uint_as_float(g2.x & 0xffff0000u) * rsc);
            tot[mi][ni][2] += acc[mi][ni][2] * (__uint_as_float(g2.y << 16) * rsc);
            tot[mi][ni][3] += acc[mi][ni][3] * (__uint_as_float(g2.y & 0xffff0000u) * rsc);
            acc[mi][ni] = (f32x4){0.f, 0.f, 0.f, 0.f};
          }
        }
      }
      __syncthreads();
    }
#undef U_LOAD
#undef U_STORE
#undef U_COMPUTE
    bfu* Hp = ((bfu*)(p.ws + OFF_h)) + (size_t)(mt * 128 + wm * 64 + lr) * DM + nt * 64 + wn * 32 + lg4;
#pragma unroll
    for (int mi = 0; mi < 4; ++mi)
#pragma unroll
      for (int ni = 0; ni < 2; ++ni) {
        uint2 wv;
        wv.x = pg8::cvt_pk_bf16(tot[mi][ni][0], tot[mi][ni][1]);
        wv.y = pg8::cvt_pk_bf16(tot[mi][ni][2], tot[mi][ni][3]);
        *reinterpret_cast<uint2*>(Hp + (size_t)(mi * 16) * DM + ni * 16) = wv;
      }
  }
}

namespace pg8 {
#define PG8_LAS __attribute__((address_space(3)))
typedef unsigned short bf16_t;
typedef short bf16x8 __attribute__((ext_vector_type(8)));
typedef float f32x4 __attribute__((ext_vector_type(4)));
typedef unsigned u32x4 __attribute__((ext_vector_type(4)));
typedef unsigned u32x2 __attribute__((ext_vector_type(2)));
constexpr int BM = 256, BK = 64, HALF = 128, HTB = HALF * BK * 2, STAGE_BYTES = 8 * HTB, NXCD = 8, WGM = 8;
__device__ __forceinline__ int lds_byte(int r, int c) { const int st = (r >> 4) * 2 + (c >> 5), rr = r & 15, cc = c & 31, ob = rr * 64 + cc * 2; return st * 1024 + (ob ^ (((ob >> 9) & 1) << 5)); }
__device__ __forceinline__ void stage_rc(int b, int& R, int& C) { const int st = b / 1024, sb = b % 1024, swz = sb ^ (((sb >> 9) & 1) << 5); R = (st >> 1) * 16 + swz / 64; C = (st & 1) * 32 + (swz % 64) / 2; }
__device__ __forceinline__ int perm32(int rho) { const int n = rho >> 4, i = rho & 15; return 8 * (i >> 2) + 4 * n + (i & 3); }
struct Unit { int pm, pn; };
struct Gemm { const bf16_t* A; const bf16_t* Bt; int M, N, K; };
struct StaticOrder {
    int nM, nN, nwg, G, c;
    __device__ void init(int M, int N, int G_, int c_) { nM = M / BM; nN = N / BM; nwg = nM * nN; G = G_; c = c_; }
    __device__ bool next(int i, Unit& u) const {
        const long L = (long)i * G + c; if (L >= nwg) return false;
        int wgid = (int)L; { const int q = nwg / NXCD, r = nwg % NXCD, xcd = wgid % NXCD, off = wgid / NXCD; wgid = (xcd < r ? xcd * (q + 1) : r * (q + 1) + (xcd - r) * q) + off; }
        const int nig = WGM * nN, gid = wgid / nig, fm = gid * WGM, gsz = (nM - fm) < WGM ? (nM - fm) : WGM;
        u.pm = fm + ((wgid % nig) % gsz); u.pn = (wgid % nig) / gsz; return true;
    }
    __device__ __forceinline__ void a_ready(const Unit&) const {}
    __device__ __forceinline__ void done(const Unit&) const {}
};
__device__ __forceinline__ unsigned cvt_pk_bf16(float lo, float hi) { unsigned r; asm volatile("v_cvt_pk_bf16_f32 %0, %1, %2" : "=v"(r) : "v"(lo), "v"(hi)); return r; }

template <class Epi, class Sched>
__device__ __forceinline__ void gemm_phase(PG8_LAS unsigned char* lds, const Gemm g, const Sched& S, const Epi& E) {
    const int tid = threadIdx.x, wid = __builtin_amdgcn_readfirstlane(tid >> 6), lane = tid & 63, wr = wid >> 2, wc = wid & 3, fr = lane & 15, fq = lane >> 4;
    const int K = g.K, nt = K / BK;
    unsigned voffA[2], voffB[2];
#pragma unroll
    for (int i = 0; i < 2; ++i) { int R, C; stage_rc(tid * 16 + i * 8192, R, C); const int Rb = Epi::PERM ? ((R & ~31) + perm32(R & 31)) : R;
        voffA[i] = (unsigned)(R * K + C) * 2u; voffB[i] = (unsigned)(Rb * K + C) * 2u; }
    const size_t kstep = (size_t)(BK * 2);
    const size_t hstep = (size_t)HALF * K * 2;
    const size_t tstep = 2 * hstep;
    const unsigned ldsw = (unsigned)wid * 1024u;
    const int aoff = lds_byte(wr * 64 + fr, fq * 8), boff = lds_byte(wc * 32 + fr, fq * 8);
#define PG8_SA(b, h) (((b) * 2 + (h)) * HTB)
#define PG8_SB(b, h) ((4 + (b) * 2 + (h)) * HTB)
#define PG8_STAGE(bufoff, gbase, voff) do { _Pragma("unroll") for (int _i = 0; _i < 2; ++_i) \
        __builtin_amdgcn_global_load_lds((const unsigned*)((const char*)(gbase) + (voff)[_i]), (PG8_LAS unsigned*)(lds + (bufoff) + ldsw + _i * 8192), 16, 0, 0); } while (0)
#define PG8_LDA(dst, b, h) do { _Pragma("unroll") for (int m = 0; m < 4; ++m) _Pragma("unroll") for (int k = 0; k < 2; ++k) dst[m][k] = *(const PG8_LAS bf16x8*)(lds + PG8_SA(b, h) + aoff + m * 2048 + k * 1024); } while (0)
#define PG8_LDB(dst, b, h) do { _Pragma("unroll") for (int n = 0; n < 2; ++n) _Pragma("unroll") for (int k = 0; k < 2; ++k) dst[n][k] = *(const PG8_LAS bf16x8*)(lds + PG8_SB(b, h) + boff + n * 2048 + k * 1024); } while (0)
#define PG8_MMA(ai, bj, At, Bt) do { __builtin_amdgcn_s_setprio(1); _Pragma("unroll") for (int m = 0; m < 4; ++m) _Pragma("unroll") for (int n = 0; n < 2; ++n) _Pragma("unroll") for (int k = 0; k < 2; ++k) \
        acc[ai][bj][m][n] = __builtin_amdgcn_mfma_f32_16x16x32_bf16(Bt[n][k], At[m][k], acc[ai][bj][m][n], 0, 0, 0); __builtin_amdgcn_s_setprio(0); } while (0)
#define PG8_WAIT_V(n) asm volatile("s_waitcnt vmcnt(" #n ")" ::: "memory")
#define PG8_WAIT_L(n) asm volatile("s_waitcnt lgkmcnt(" #n ")" ::: "memory")
#define PG8_BAR __builtin_amdgcn_s_barrier()
#define PG8_SCHED __builtin_amdgcn_sched_barrier(0)
    Unit cur, nxt; int ui = 0;
    if (!S.next(0, cur)) return;
    f32x4 acc[2][2][4][2];
#pragma unroll
    for (int a = 0; a < 2; ++a)
#pragma unroll
        for (int b = 0; b < 2; ++b)
#pragma unroll
            for (int m = 0; m < 4; ++m)
#pragma unroll
                for (int n = 0; n < 2; ++n) acc[a][b][m][n] = (f32x4){0.f, 0.f, 0.f, 0.f};
    bf16x8 At[4][2], B0[2][2], B1[2][2];
    const char* cA = (const char*)g.A + (size_t)cur.pm * tstep; const char* cB = (const char*)g.Bt + (size_t)cur.pn * tstep;
    S.a_ready(cur);
    PG8_STAGE(PG8_SB(0, 0), cB, voffB); PG8_STAGE(PG8_SA(0, 0), cA, voffA); PG8_STAGE(PG8_SB(0, 1), cB + hstep, voffB); PG8_STAGE(PG8_SA(0, 1), cA + hstep, voffA);
    if (wr == 1) PG8_BAR;
    PG8_WAIT_V(4); PG8_BAR;
    PG8_STAGE(PG8_SB(1, 0), cB + kstep, voffB); PG8_STAGE(PG8_SA(1, 0), cA + kstep, voffA); PG8_STAGE(PG8_SB(1, 1), cB + hstep + kstep, voffB);
    PG8_WAIT_V(6); PG8_BAR;
    for (;;) {
        const bool has_next = S.next(ui + 1, nxt);
        const char* nA = has_next ? (const char*)g.A + (size_t)nxt.pm * tstep : cA; const char* nB = has_next ? (const char*)g.Bt + (size_t)nxt.pn * tstep : cB;
        for (int t = 0; t < nt; t += 2) {
            const bool last = (t == nt - 2);
            const char* a1 = cA + (size_t)(t + 1) * kstep;
            const char* a2 = last ? nA : cA + (size_t)(t + 2) * kstep; const char* b2 = last ? nB : cB + (size_t)(t + 2) * kstep;
            const char* a3 = a2 + kstep; const char* b3 = b2 + kstep;
            if (last && has_next) S.a_ready(nxt);
            PG8_LDB(B0, 0, 0); PG8_SCHED; PG8_LDA(At, 0, 0); PG8_STAGE(PG8_SA(1, 1), a1 + hstep, voffA);
            PG8_WAIT_L(8); PG8_BAR; PG8_WAIT_L(0); PG8_MMA(0, 0, At, B0); PG8_BAR; PG8_SCHED;
            PG8_LDB(B1, 0, 1); PG8_STAGE(PG8_SB(0, 0), b2, voffB);
            PG8_BAR; PG8_WAIT_L(0); PG8_MMA(0, 1, At, B1); PG8_BAR;
            PG8_LDA(At, 0, 1); PG8_STAGE(PG8_SA(0, 0), a2, voffA);
            PG8_BAR; PG8_WAIT_L(0); PG8_MMA(1, 0, At, B0); PG8_BAR; PG8_SCHED;
            PG8_STAGE(PG8_SB(0, 1), b2 + hstep, voffB);
            PG8_WAIT_V(6); PG8_BAR; PG8_MMA(1, 1, At, B1); PG8_BAR;
            PG8_LDB(B0, 1, 0); PG8_SCHED; PG8_LDA(At, 1, 0); PG8_STAGE(PG8_SA(0, 1), a2 + hstep, voffA);
            PG8_WAIT_L(8); PG8_BAR; PG8_WAIT_L(0); PG8_MMA(0, 0, At, B0); PG8_BAR; PG8_SCHED;
            PG8_LDB(B1, 1, 1); PG8_STAGE(PG8_SB(1, 0), b3, voffB);
            PG8_BAR; PG8_WAIT_L(0); PG8_MMA(0, 1, At, B1); PG8_BAR;
            PG8_LDA(At, 1, 1); PG8_STAGE(PG8_SA(1, 0), a3, voffA);
            PG8_BAR; PG8_WAIT_L(0); PG8_MMA(1, 0, At, B0); PG8_BAR; PG8_SCHED;
            PG8_STAGE(PG8_SB(1, 1), b3 + hstep, voffB);
            PG8_WAIT_V(6); PG8_BAR; PG8_MMA(1, 1, At, B1); PG8_BAR;
        }
            if constexpr (!Epi::AFTER_DRAIN) { E(acc, cur, wr, wc, fr, fq); S.done(cur); }
            if (!has_next) break;
#pragma unroll
        for (int a = 0; a < 2; ++a)
#pragma unroll
            for (int b = 0; b < 2; ++b)
#pragma unroll
                for (int m = 0; m < 4; ++m)
#pragma unroll
                    for (int n = 0; n < 2; ++n) acc[a][b][m][n] = (f32x4){0.f, 0.f, 0.f, 0.f};
        cur = nxt; cA = nA; cB = nB; ++ui;
    }
    PG8_WAIT_V(0);
    if (wr == 0) PG8_BAR;
    PG8_BAR;
    if constexpr (Epi::AFTER_DRAIN) { E.fused(acc, cur, wr, wc, fr, fq, lds, wid, lane); S.done(cur); }
#undef PG8_SA
#undef PG8_SB
#undef PG8_STAGE
#undef PG8_LDA
#undef PG8_LDB
#undef PG8_MMA
#undef PG8_WAIT_V
#undef PG8_WAIT_L
#undef PG8_BAR
#undef PG8_SCHED
}

}

struct EpiInproj {
  static constexpr bool PERM = true, AFTER_DRAIN = false;
  bfu* u; float* small;
  __device__ __forceinline__ void operator()(const pg8::f32x4 (&acc)[2][2][4][2], const pg8::Unit& un, int wr, int wc, int fr, int fq) const {
    const int row0 = un.pm * 256 + wr * 64 + fr;
    if (un.pn < 32) {
      const bool sig = un.pn >= 16;
      const int col0 = un.pn * 256 + wc * 32 + 8 * fq;
#pragma unroll
      for (int ai = 0; ai < 2; ++ai)
#pragma unroll
        for (int m = 0; m < 4; ++m) {
          bfu* rowp = u + (size_t)(row0 + ai * 128 + m * 16) * NU + col0;
#pragma unroll
          for (int bj = 0; bj < 2; ++bj) {
            pg8::f32x4 v0 = acc[ai][bj][m][0], v1 = acc[ai][bj][m][1];
            if (sig) {
#pragma unroll
              for (int j = 0; j < 4; ++j) { v0[j] = sigmoidf_(v0[j]); v1[j] = sigmoidf_(v1[j]); }
            }
            pg8::u32x4 w;
            w.x = pg8::cvt_pk_bf16(v0[0], v0[1]); w.y = pg8::cvt_pk_bf16(v0[2], v0[3]);
            w.z = pg8::cvt_pk_bf16(v1[0], v1[1]); w.w = pg8::cvt_pk_bf16(v1[2], v1[3]);
            *(pg8::u32x4*)(rowp + bj * 128) = w;
          }
        }
    } else if (wc == 0) {
#pragma unroll
      for (int ai = 0; ai < 2; ++ai)
#pragma unroll
        for (int m = 0; m < 4; ++m) {
          float* sp = small + (size_t)(row0 + ai * 128 + m * 16) * 32 + 8 * fq;
          *(pg8::f32x4*)(sp) = acc[ai][0][m][0];
          *(pg8::f32x4*)(sp + 4) = acc[ai][0][m][1];
        }
    }
  }
};
struct EpiResid {
  static constexpr bool PERM = false, AFTER_DRAIN = false;
  const float* xold; float* out;
  __device__ __forceinline__ void operator()(const pg8::f32x4 (&acc)[2][2][4][2], const pg8::Unit& un, int wr, int wc, int fr, int fq) const {
    const int row0 = un.pm * 256 + wr * 64 + fr, col0 = un.pn * 256 + wc * 32 + 4 * fq;
#pragma unroll
    for (int ai = 0; ai < 2; ++ai)
#pragma unroll
      for (int m = 0; m < 4; ++m) {
        const size_t off = (size_t)(row0 + ai * 128 + m * 16) * DM + col0;
#pragma unroll
        for (int bj = 0; bj < 2; ++bj)
#pragma unroll
          for (int n = 0; n < 2; ++n) {
            const pg8::f32x4 b = *(const pg8::f32x4*)(xold + off + bj * 128 + n * 16);
            *(pg8::f32x4*)(out + off + bj * 128 + n * 16) = b + acc[ai][bj][m][n];
          }
        asm volatile("" ::: "memory");
      }
  }
};
struct EpiSwiglu {
  static constexpr bool PERM = true, AFTER_DRAIN = false;
  bfu* hidden;
  __device__ __forceinline__ void operator()(const pg8::f32x4 (&acc)[2][2][4][2], const pg8::Unit& un, int wr, int wc, int fr, int fq) const {
    const int row0 = un.pm * 256 + wr * 64 + fr;
#pragma unroll
    for (int ai = 0; ai < 2; ++ai)
#pragma unroll
      for (int m = 0; m < 4; ++m) {
        bfu* rowp = hidden + (size_t)(row0 + ai * 128 + m * 16) * FH + (un.pn * 8 + wc) * 16 + 4 * fq;
#pragma unroll
        for (int bj = 0; bj < 2; ++bj) {
          const pg8::f32x4 g = acc[ai][bj][m][0], uu = acc[ai][bj][m][1];
          pg8::u32x2 w;
          w.x = pg8::cvt_pk_bf16(siluf_(g[0]) * uu[0], siluf_(g[1]) * uu[1]);
          w.y = pg8::cvt_pk_bf16(siluf_(g[2]) * uu[2], siluf_(g[3]) * uu[3]);
          *(pg8::u32x2*)(rowp + bj * 64) = w;
        }
      }
  }
};

#define XB_TMO      128
#define XB_XCNT(j)  (256  + 64 * (j))
#define XB_XSUB(j)  (1280 + 64 * (j))
#define XB_XGEN(j)  (2304 + 64 * (j))
#define XB_TOP      3328
#define XB_TOPGEN   3392
#define XCD_BAR_WORDS 3456
#define XB_SPIN_CAP (1u << 18)
#define LAS __attribute__((address_space(3)))

__device__ __forceinline__ unsigned xb_ld(unsigned* p)              { return __hip_atomic_load(p, __ATOMIC_RELAXED, __HIP_MEMORY_SCOPE_AGENT); }
__device__ __forceinline__ unsigned xb_add(unsigned* p, unsigned v) { return __hip_atomic_fetch_add(p, v, __ATOMIC_RELAXED, __HIP_MEMORY_SCOPE_AGENT); }
__device__ __forceinline__ unsigned xb_xcc_id() { return (unsigned)__builtin_amdgcn_s_getreg((3 << 11) | 20) & 0xFu; }
#define XB_SPIN(cond, bar) do { unsigned _sp = 0; while (cond) { __builtin_amdgcn_s_sleep(1); \
    if ((++_sp & 255u) == 0u) { if (xb_ld(&(bar)[XB_TMO])) break; if (_sp > XB_SPIN_CAP) { atomicAdd(&(bar)[XB_TMO], 1u); break; } } } } while (0)

struct XcdBarrier {
    unsigned* bar; unsigned x;
    volatile LAS unsigned* st;
};

__device__ __forceinline__ XcdBarrier xcd_barrier_post(unsigned* bar, volatile LAS unsigned* st) {
    XcdBarrier b; b.bar = bar; b.x = xb_xcc_id(); b.st = st;
    if (threadIdx.x == 0) (void)xb_add(&bar[XB_XCNT(b.x)], 1u);
    return b;
}
__device__ __forceinline__ void xcd_barrier_complete(unsigned* bar, unsigned x, unsigned& nloc, unsigned& nx) {
    const unsigned G = gridDim.x * gridDim.y * gridDim.z;
    unsigned sum, cnt, mine, sp = 0u;
    for (;;) {
        sum = 0u; cnt = 0u; mine = 0u;
#pragma unroll
        for (unsigned j = 0; j < 16; ++j) { const unsigned c = xb_ld(&bar[XB_XCNT(j)]); sum += c; cnt += (c > 0u) ? 1u : 0u; mine = (j == x) ? c : mine; }
        if (sum == G) break;
        __builtin_amdgcn_s_sleep(1);
        if ((++sp & 255u) == 0u) { if (xb_ld(&bar[XB_TMO])) break; if (sp > XB_SPIN_CAP) { atomicAdd(&bar[XB_TMO], 1u); break; } }
    }
    nloc = mine > 0u ? mine : 1u; nx = cnt > 0u ? cnt : 1u;
}

__device__ __forceinline__ void xcd_barrier(const XcdBarrier& b) {
    asm volatile("s_waitcnt vmcnt(0)" ::: "memory");
    __syncthreads();
    if (threadIdx.x == 0) {
        unsigned* bar = b.bar;
        __builtin_amdgcn_s_waitcnt(0);
        unsigned nloc = b.st[0], nx = b.st[1];
        if (nloc == 0u) { xcd_barrier_complete(bar, b.x, nloc, nx); b.st[0] = nloc; b.st[1] = nx; }
        const unsigned old = xb_add(&bar[XB_XSUB(b.x)], 1u);
        const unsigned gen = old / nloc;
        if (old + 1u == (gen + 1u) * nloc) {
            __builtin_amdgcn_fence(__ATOMIC_RELEASE, "agent");
            asm volatile("s_waitcnt vmcnt(0)" ::: "memory");
            const unsigned og = xb_add(&bar[XB_TOP], 1u);
            const unsigned tg = og / nx;
            if (og + 1u == (tg + 1u) * nx) xb_add(&bar[XB_TOPGEN], 1u);
            else XB_SPIN(xb_ld(&bar[XB_TOPGEN]) == tg, bar);
            __builtin_amdgcn_fence(__ATOMIC_ACQUIRE, "agent");
            xb_add(&bar[XB_XGEN(b.x)], 1u);
            asm volatile("s_waitcnt vmcnt(0)" ::: "memory");
        } else {
            XB_SPIN(xb_ld(&bar[XB_XGEN(b.x)]) == gen, bar);
            __builtin_amdgcn_fence(__ATOMIC_ACQUIRE, "agent");
            asm volatile("s_waitcnt vmcnt(0)" ::: "memory");
        }
    }
    __syncthreads();
}


__global__ void __launch_bounds__(NTHREADS, 2) mega(Params p_in, int ph_lo, int ph_hi, int use_cg) {
  extern __shared__ __attribute__((aligned(16))) unsigned char smem_raw[];
  __shared__ uint4 xb_words;
  if (threadIdx.x == 0) xb_words = make_uint4(0u, 0u, 0u, 0u);
  __syncthreads();
  const XcdBarrier xbar = xcd_barrier_post((unsigned*)(p_in.ws + OFF_bar), (volatile LAS unsigned*)&xb_words);
  for (int ph = ph_lo; ph < ph_hi; ++ph) {
#if PROBE_DUP >= 0
    const int l = ph / (PH_PER_LAYER + 1);
    const int ks = ph - l * (PH_PER_LAYER + 1);
    const int k = (ks <= PROBE_DUP) ? ks : ks - 1;
    const int wr = (ks == PROBE_DUP) ? 0 : 1;
#else
    const int wr = 1;
    const int l = ph / PH_PER_LAYER, k = ph - l * PH_PER_LAYER;
#endif
    int t512 = threadIdx.x;
    asm volatile("" : "+v"(t512));
    const int tid = t512 & 255;
    const int half = __builtin_amdgcn_readfirstlane(t512 >> 8);
    const int vb = blockIdx.x * 2 + half, vg = gridDim.x * 2;
    bfu* smem = reinterpret_cast<bfu*>(smem_raw + half * SMEM_HALF);
    CParams* pp = (CParams*)__builtin_amdgcn_kernarg_segment_ptr();
    asm volatile("" : "+s"(pp));
    CParams& p = *pp;
    switch (k) {
      case 0: phase_convert_norm(p, l, smem, tid, vb, vg); break;
      case 1: {
        pg8::Gemm g; g.A = (bfu*)(p.ws + OFF_h); g.Bt = (bfu*)(p.ws + OFF_WinT); g.M = S_LEN; g.N = NINP; g.K = DM;
        pg8::StaticOrder so; so.init(S_LEN, NINP, gridDim.x, blockIdx.x);
        EpiInproj e; e.u = (bfu*)(p.ws + OFF_u); e.small = (float*)(p.ws + OFF_small);
        pg8::gemm_phase<EpiInproj, pg8::StaticOrder>((PG8_LAS unsigned char*)smem_raw, g, so, e);
      } break;
      case 2: phase_prep(p, l, smem, tid, wr, vb, vg); break;
      case 3: phase_scan(p, smem, tid, wr, vb, vg); break;
      case 4: phase_mix(p, l, smem, tid, half, ph, smem_raw); break;
      case 5: phase_upmerge(p, smem, tid, vb, vg, half, smem_raw); break;
      case 6: {
        pg8::Gemm g; g.A = (bfu*)(p.ws + OFF_h); g.Bt = (bfu*)(p.ws + OFF_WoutT); g.M = S_LEN; g.N = DM; g.K = DM;
        pg8::StaticOrder so; so.init(S_LEN, DM, gridDim.x, blockIdx.x);
        EpiResid e; e.xold = (l == 0 ? p.in[0] : p.out); e.out = p.out;
        pg8::gemm_phase<EpiResid, pg8::StaticOrder>((PG8_LAS unsigned char*)smem_raw, g, so, e);
      } break;
      case 7: phase_norm2(p, l, tid, vb, vg); break;
      case 8: {
        pg8::Gemm g; g.A = (bfu*)(p.ws + OFF_h); g.Bt = (bfu*)(p.ws + OFF_WfiT); g.M = S_LEN; g.N = 2 * FH; g.K = DM;
        pg8::StaticOrder so; so.init(S_LEN, 2 * FH, gridDim.x, blockIdx.x);
        EpiSwiglu e; e.hidden = (bfu*)(p.ws + OFF_u);
        pg8::gemm_phase<EpiSwiglu, pg8::StaticOrder>((PG8_LAS unsigned char*)smem_raw, g, so, e);
      } break;
      default: {
        pg8::Gemm g; g.A = (bfu*)(p.ws + OFF_u); g.Bt = (bfu*)(p.ws + OFF_WfoT); g.M = S_LEN; g.N = DM; g.K = FH;
        pg8::StaticOrder so; so.init(S_LEN, DM, gridDim.x, blockIdx.x);
        EpiResid e; e.xold = p.out; e.out = p.out;
        pg8::gemm_phase<EpiResid, pg8::StaticOrder>((PG8_LAS unsigned char*)smem_raw, g, so, e);
      } break;
    }
    if (ph + 1 < ph_hi) {
      if (use_cg) cg::this_grid().sync();
      else xcd_barrier(xbar);
    }
  }
}

#ifndef MK_COOP
#define MK_COOP 1
#endif

extern "C" void kernel_launch(void* const* d_in, const int* in_sizes, int n_in, void* d_out, int out_size, void* d_ws,
                              size_t ws_size, hipStream_t stream) {
  Params p{};
  for (int i = 0; i < 25; ++i) p.in[i] = reinterpret_cast<const float*>(d_in[i]);
  p.out = reinterpret_cast<float*>(d_out);
  p.ws = reinterpret_cast<unsigned char*>(d_ws);
  if (WS_NEED > ws_size) { fprintf(stderr, "workspace too small: need %zu have %zu\n", (size_t)WS_NEED, ws_size); return; }

  static int grid_blocks = 0;
  if (!grid_blocks) {
    (void)hipFuncSetAttribute((const void*)mega, hipFuncAttributeMaxDynamicSharedMemorySize, SMEM_BYTES);
    int dev = 0, cus = 0, per_cu = 0;
    (void)hipGetDevice(&dev);
    (void)hipDeviceGetAttribute(&cus, hipDeviceAttributeMultiprocessorCount, dev);
    (void)hipOccupancyMaxActiveBlocksPerMultiprocessor(&per_cu, mega, NTHREADS, SMEM_BYTES);
    per_cu = 1;
    grid_blocks = cus * per_cu;
  }
  const int nph = 4 * (PH_PER_LAYER + (PROBE_DUP >= 0 ? 1 : 0));
#if MK_COOP
  int lo = 0, hi = nph, use_cg = 0;
  void* args[] = {&p, &lo, &hi, &use_cg};
  (void)hipMemsetAsync(p.ws + OFF_bar, 0, 16384, stream);
  hipError_t e = hipLaunchCooperativeKernel((const void*)mega, dim3(grid_blocks), dim3(NTHREADS), args, SMEM_BYTES, stream);
  if (e != hipSuccess) fprintf(stderr, "cooperative launch failed: %s (grid %d)\n", hipGetErrorString(e), grid_blocks);
#else
  for (int ph = 0; ph < nph; ++ph)
    hipLaunchKernelGGL(mega, dim3(grid_blocks), dim3(NTHREADS), SMEM_BYTES, stream, p, ph, ph + 1, 0);
#endif
}
```

```cpp
#include <hip/hip_runtime.h>
#include <hip/hip_bf16.h>
#include <hip/hip_cooperative_groups.h>
#include <cstdio>
namespace cg = cooperative_groups;

typedef __attribute__((ext_vector_type(8))) short bf16x8;
typedef __attribute__((ext_vector_type(4))) float f32x4;
typedef unsigned short bfu;

#define S_LEN 16384
#define DM 1024
#define NU 8192
#define NINP 8448
#define NSRC 8220
#define FH 2816
#define NCH 256
#define LDP 72
#define YW 1280
#define EPS 1e-6f
#define SMEM_HALF 73728
#define SMEM_BYTES 147456
#define NTHREADS 512
#define PH_PER_LAYER 10
#ifndef PROBE_DUP
#define PROBE_DUP -1
#endif

struct Params {
  const float* in[25];
  float* out;
  unsigned char* ws;
};
typedef const __attribute__((address_space(4))) Params CParams;
constexpr size_t OFF_WinT = 0;
constexpr size_t OFF_WupT = OFF_WinT + (((size_t)NINP*DM*2 + 255) & ~(size_t)255);
constexpr size_t OFF_WoutT = OFF_WupT + (((size_t)DM*YW*2 + 255) & ~(size_t)255);
constexpr size_t OFF_WfiT = OFF_WoutT + (((size_t)DM*DM*2 + 255) & ~(size_t)255);
constexpr size_t OFF_WfoT = OFF_WfiT + (((size_t)2*FH*DM*2 + 255) & ~(size_t)255);
constexpr size_t OFF_u = OFF_WfoT + (((size_t)DM*FH*2 + 255) & ~(size_t)255);
constexpr size_t OFF_small = OFF_u + (((size_t)S_LEN*NU*2 + 255) & ~(size_t)255);
constexpr size_t OFF_h = OFF_small + (((size_t)S_LEN*32*4 + 255) & ~(size_t)255);
constexpr size_t OFF_y = OFF_h + (((size_t)S_LEN*DM*2 + 255) & ~(size_t)255);
constexpr size_t OFF_ssq = OFF_y + (((size_t)S_LEN*YW*2 + 255) & ~(size_t)255);
constexpr size_t OFF_foxq = OFF_ssq + (((size_t)S_LEN*8*4 + 255) & ~(size_t)255);
constexpr size_t OFF_foxk = OFF_foxq + (((size_t)4*S_LEN*64*2 + 255) & ~(size_t)255);
constexpr size_t OFF_foxvT = OFF_foxk + (((size_t)4*S_LEN*64*2 + 255) & ~(size_t)255);
constexpr size_t OFF_foxc = OFF_foxvT + (((size_t)4*S_LEN*64*2 + 255) & ~(size_t)255);
constexpr size_t OFF_foxtot = OFF_foxc + (((size_t)4*S_LEN*4 + 255) & ~(size_t)255);
constexpr size_t OFF_VT = OFF_foxtot + (((size_t)4*NCH*4 + 255) & ~(size_t)255);
constexpr size_t OFF_ST = OFF_VT + (((size_t)16*NCH*4096*2 + 255) & ~(size_t)255);
constexpr size_t OFF_dec = OFF_ST + (((size_t)16*NCH*4096*2 + 255) & ~(size_t)255);
constexpr size_t OFF_csb = OFF_dec + (((size_t)16*NCH*64*4 + 255) & ~(size_t)255);
constexpr size_t OFF_ssdX = OFF_csb + (((size_t)16*S_LEN*4 + 255) & ~(size_t)255);
constexpr size_t OFF_ssdB = OFF_ssdX + (((size_t)S_LEN*512*2 + 255) & ~(size_t)255);
constexpr size_t OFF_ssdC = OFF_ssdB + (((size_t)2*S_LEN*64*2 + 255) & ~(size_t)255);
constexpr size_t OFF_rcos = OFF_ssdC + (((size_t)2*S_LEN*64*2 + 255) & ~(size_t)255);
constexpr size_t OFF_rsin = OFF_rcos + (((size_t)S_LEN*32*4 + 255) & ~(size_t)255);
constexpr size_t OFF_ctr = OFF_rsin + (((size_t)S_LEN*32*4 + 255) & ~(size_t)255);
constexpr size_t OFF_bar = OFF_ctr + (((size_t)256 + 255) & ~(size_t)255);
constexpr size_t WS_NEED = OFF_bar + 16384;

__device__ __forceinline__ bfu f2bf(float f) {
  unsigned u = __float_as_uint(f);
  u += 0x7fffu + ((u >> 16) & 1u);
  return (bfu)(u >> 16);
}
__device__ __forceinline__ float bf2f(bfu b) { return __uint_as_float(((unsigned)b) << 16); }
__device__ __forceinline__ float sigmoidf_(float x) { return 1.f / (1.f + __expf(-x)); }
__device__ __forceinline__ float siluf_(float x) { return x / (1.f + __expf(-x)); }
__device__ __forceinline__ float logsigmoidf_(float z) { return fminf(z, 0.f) - log1pf(expf(-fabsf(z))); }
__device__ __forceinline__ float logsigmoid_fast(float z) { return fminf(z, 0.f) - __logf(1.f + __expf(-fabsf(z))); }
__device__ __forceinline__ float softplus_fast(float z) { return fmaxf(z, 0.f) + __logf(1.f + __expf(-fabsf(z))); }
__device__ __forceinline__ float softplusf_(float z) { return fmaxf(z, 0.f) + log1pf(expf(-fabsf(z))); }

namespace pg8 { __device__ __forceinline__ unsigned cvt_pk_bf16(float lo, float hi); }
__device__ __forceinline__ bf16x8 lds_frag(const bfu* base, int row, int kofs, int stride) {
  return *reinterpret_cast<const bf16x8*>(base + row * stride + kofs);
}

__device__ __forceinline__ void mma16x64(f32x4 (&acc)[4], const bfu* sA, int arow0, const bfu* sB, int lane) {
  const int r = lane & 15, q = (lane >> 4) * 8;
#pragma unroll
  for (int ks = 0; ks < 2; ++ks) {
    bf16x8 a = lds_frag(sA, arow0 + r, ks * 32 + q, LDP);
#pragma unroll
    for (int n = 0; n < 4; ++n) {
      bf16x8 b = lds_frag(sB, n * 16 + r, ks * 32 + q, LDP);
      acc[n] = __builtin_amdgcn_mfma_f32_16x16x32_bf16(a, b, acc[n], 0, 0, 0);
    }
  }
}

__device__ __forceinline__ void load_tile64(bfu* s, const bfu* g, int gs, int tid) {
#pragma unroll
  for (int i = 0; i < 2; ++i) {
    int id = tid + i * 256;
    int r = id >> 3, c = (id & 7) * 8;
    *reinterpret_cast<uint4*>(s + r * LDP + c) = *reinterpret_cast<const uint4*>(g + (size_t)r * gs + c);
  }
}

template <int NI>
__device__ __forceinline__ void gemm_main(f32x4 (&acc)[4][NI], const bfu* __restrict__ A, int lda,
                                          const bfu* __restrict__ Bt, int ldb, int K, bfu* smem, int tid) {
  bfu* sA = smem;
  bfu* sB = smem + 2 * 128 * LDP;
  const int lane = tid & 63, w = tid >> 6, wm = w >> 1, wn = w & 1;
  const int lr = lane & 15, lq = (lane >> 4) * 8;
  const int crow = tid >> 3, ccol = (tid & 7) * 8;
  const bfu* Ap = A + (size_t)crow * lda + ccol;
  const bfu* Bp = Bt + (size_t)crow * ldb + ccol;
  uint4 ra[4], rb[NI];
#pragma unroll
  for (int i = 0; i < 4; ++i) ra[i] = *reinterpret_cast<const uint4*>(Ap + (size_t)i * 32 * lda);
#pragma unroll
  for (int i = 0; i < NI; ++i) rb[i] = *reinterpret_cast<const uint4*>(Bp + (size_t)i * 32 * ldb);
#pragma unroll
  for (int i = 0; i < 4; ++i) *reinterpret_cast<uint4*>(sA + (crow + i * 32) * LDP + ccol) = ra[i];
#pragma unroll
  for (int i = 0; i < NI; ++i) *reinterpret_cast<uint4*>(sB + (crow + i * 32) * LDP + ccol) = rb[i];
  __syncthreads();
  const int nk = K >> 6;
  for (int kt = 0; kt < nk; ++kt) {
    const int cur = kt & 1;
    if (kt + 1 < nk) {
      const int ko = (kt + 1) * 64;
#pragma unroll
      for (int i = 0; i < 4; ++i) ra[i] = *reinterpret_cast<const uint4*>(Ap + (size_t)i * 32 * lda + ko);
#pragma unroll
      for (int i = 0; i < NI; ++i) rb[i] = *reinterpret_cast<const uint4*>(Bp + (size_t)i * 32 * ldb + ko);
    }
    const bfu* a_s = sA + cur * 128 * LDP + (wm * 64) * LDP;
    const bfu* b_s = sB + cur * 128 * LDP + (wn * NI * 16) * LDP;
#pragma unroll
    for (int ks = 0; ks < 2; ++ks) {
      bf16x8 af[4], bfr[NI];
#pragma unroll
      for (int mi = 0; mi < 4; ++mi) af[mi] = lds_frag(a_s, mi * 16 + lr, ks * 32 + lq, LDP);
#pragma unroll
      for (int ni = 0; ni < NI; ++ni) bfr[ni] = lds_frag(b_s, ni * 16 + lr, ks * 32 + lq, LDP);
#pragma unroll
      for (int mi = 0; mi < 4; ++mi)
#pragma unroll
        for (int ni = 0; ni < NI; ++ni)
          acc[mi][ni] = __builtin_amdgcn_mfma_f32_16x16x32_bf16(af[mi], bfr[ni], acc[mi][ni], 0, 0, 0);
    }
    if (kt + 1 < nk) {
      bfu* sAn = sA + (cur ^ 1) * 128 * LDP;
      bfu* sBn = sB + (cur ^ 1) * 128 * LDP;
#pragma unroll
      for (int i = 0; i < 4; ++i) *reinterpret_cast<uint4*>(sAn + (crow + i * 32) * LDP + ccol) = ra[i];
#pragma unroll
      for (int i = 0; i < NI; ++i) *reinterpret_cast<uint4*>(sBn + (crow + i * 32) * LDP + ccol) = rb[i];
    }
    __syncthreads();
  }
}

template <int NI>
__device__ __forceinline__ void zero_acc(f32x4 (&acc)[4][NI]) {
#pragma unroll
  for (int i = 0; i < 4; ++i)
#pragma unroll
    for (int j = 0; j < NI; ++j) acc[i][j] = (f32x4){0.f, 0.f, 0.f, 0.f};
}

__device__ __forceinline__ int win_src(int dc) {
  if (dc < 768) return dc;
  if (dc < 1536) return dc + 4;
  if (dc < 4096) return dc + 20;
  if (dc < 8192) return dc + 28;
  int s = dc - 8192;
  if (s < 4) return 768 + s;
  if (s < 20) return 1540 + (s - 4);
  if (s < 28) return 4116 + (s - 20);
  return -1;
}
__device__ __forceinline__ int ffi_src(int dc) {
  const int G = dc >> 5, w = dc & 31, f = w >> 3, r = w & 7;
  return (r < 4) ? (G * 16 + f * 4 + r) : (FH + G * 16 + f * 4 + (r - 4));
}

__device__ __forceinline__ void convert_tile(const float* __restrict__ W, int ldw, int kt, int ntd, bfu* __restrict__ Wt,
                                             int ldt, int kofs, int mode, const float* __restrict__ rowgain,
                                             bfu* sT, int tid) {
  const int c4 = (tid & 15) * 4, r0 = tid >> 4;
  const int dc = ntd * 64 + c4;
  int sc = dc;
  if (mode == 1) sc = win_src(dc);
  else if (mode == 2) sc = ffi_src(dc);
  float4 v[8];
  float gg[8];
#pragma unroll
  for (int ps = 0; ps < 8; ++ps) {
    const int k = kt * 64 + r0 + ps * 16;
    v[ps] = make_float4(0.f, 0.f, 0.f, 0.f);
    if (sc >= 0) v[ps] = *reinterpret_cast<const float4*>(W + (size_t)k * ldw + sc);
    gg[ps] = rowgain ? rowgain[k] : 1.f;
  }
#pragma unroll
  for (int ps = 0; ps < 8; ++ps) {
    const int kk = r0 + (ps & 3) * 16;
    bfu* sTt = sT + (ps >> 2) * 64 * LDP;
    const float g = gg[ps];
    sTt[(c4 + 0) * LDP + kk] = f2bf(v[ps].x * g);
    sTt[(c4 + 1) * LDP + kk] = f2bf(v[ps].y * g);
    sTt[(c4 + 2) * LDP + kk] = f2bf(v[ps].z * g);
    sTt[(c4 + 3) * LDP + kk] = f2bf(v[ps].w * g);
  }
  __syncthreads();
#pragma unroll
  for (int i = 0; i < 4; ++i) {
    const int id = tid + (i & 1) * 256;
    const int nn = id >> 3, kc = (id & 7) * 8;
    const int tt = i >> 1;
    *reinterpret_cast<uint4*>(Wt + (size_t)(ntd * 64 + nn) * ldt + kofs + (kt + tt) * 64 + kc) =
        *reinterpret_cast<const uint4*>(sT + tt * 64 * LDP + nn * LDP + kc);
  }
  __syncthreads();
}

__device__ __forceinline__ void norm_rows2(const float* __restrict__ x, const float* __restrict__ g, bfu* __restrict__ h,
                                           int row0, int lane) {
  float4 v[2][4];
#pragma unroll
  for (int r = 0; r < 2; ++r)
#pragma unroll
    for (int i = 0; i < 4; ++i) v[r][i] = *reinterpret_cast<const float4*>(x + (size_t)(row0 + r) * DM + i * 256 + lane * 4);
  float4 gg[4];
#pragma unroll
  for (int i = 0; i < 4; ++i) gg[i] = *reinterpret_cast<const float4*>(g + i * 256 + lane * 4);
#pragma unroll
  for (int r = 0; r < 2; ++r) {
    float ss = 0.f;
#pragma unroll
    for (int i = 0; i < 4; ++i)
      ss += v[r][i].x * v[r][i].x + v[r][i].y * v[r][i].y + v[r][i].z * v[r][i].z + v[r][i].w * v[r][i].w;
#pragma unroll
    for (int m = 1; m < 64; m <<= 1) ss += __shfl_xor(ss, m, 64);
    const float rstd = rsqrtf(ss * (1.f / DM) + EPS);
#pragma unroll
    for (int i = 0; i < 4; ++i) {
      uint2 o;
      o.x = pg8::cvt_pk_bf16(v[r][i].x * rstd * gg[i].x, v[r][i].y * rstd * gg[i].y);
      o.y = pg8::cvt_pk_bf16(v[r][i].z * rstd * gg[i].z, v[r][i].w * rstd * gg[i].w);
      *reinterpret_cast<uint2*>(h + (size_t)(row0 + r) * DM + i * 256 + lane * 4) = o;
    }
  }
}

__device__ void phase_convert_norm(CParams& p_o, int l, bfu* smem, int tid, int vb, int vg) {
  const int nconv = 2400, nnorm = 2048;
  const int nrot = (l == 0) ? 64 : 0;
  const int total = nconv + nnorm + nrot;
  if (l == 0 && vb == 0 && tid < 64) ((unsigned*)(p_o.ws + OFF_ctr))[tid] = 0u;
  for (int it = vb; it < total; it += vg) {
    CParams* pp_ = &p_o;
    asm volatile("" : "+s"(pp_));
    CParams& p = *pp_;
    if (it < nconv) {
      if (it < 1056) {
        int kt = (it & 7) * 2, nt = it >> 3;
        convert_tile(p.in[4] + (size_t)l * DM * NSRC, NSRC, kt, nt, ((bfu*)(p.ws + OFF_WinT)), DM, 0, 1, nullptr, smem, tid);
      } else if (it < 1152) {
        int j = it - 1056; int br = j >> 5; j &= 31;
        int kt = (j & 1) * 2, nt = j >> 1;
        const float* W = (br == 0 ? p.in[18] : (br == 1 ? p.in[19] : p.in[20])) + (size_t)l * 256 * DM;
        convert_tile(W, DM, kt, nt, ((bfu*)(p.ws + OFF_WupT)), YW, br * 256, 0, nullptr, smem, tid);
      } else if (it < 1216) {
        int j = it - 1152; int kt = (j & 3) * 2, nt = j >> 2;
        convert_tile(p.in[21] + (size_t)l * 512 * DM, DM, kt, nt, ((bfu*)(p.ws + OFF_WupT)), YW, 768, 0, p.in[17] + l * 512, smem, tid);
      } else if (it < 1344) {
        int j = it - 1216; int kt = (j & 7) * 2, nt = j >> 3;
        convert_tile(p.in[22] + (size_t)l * DM * DM, DM, kt, nt, ((bfu*)(p.ws + OFF_WoutT)), DM, 0, 0, nullptr, smem, tid);
      } else if (it < 2048) {
        int j = it - 1344; int kt = (j & 7) * 2, nt = j >> 3;
        convert_tile(p.in[23] + (size_t)l * DM * 2 * FH, 2 * FH, kt, nt, ((bfu*)(p.ws + OFF_WfiT)), DM, 0, 2, nullptr, smem, tid);
      } else {
        int j = it - 2048; int kt = (j % 22) * 2, nt = j / 22;
        convert_tile(p.in[24] + (size_t)l * FH * DM, DM, kt, nt, ((bfu*)(p.ws + OFF_WfoT)), FH, 0, 0, nullptr, smem, tid);
      }
    } else if (it < nconv + nnorm) {
      norm_rows2((l == 0 ? p.in[0] : p.out), p.in[2] + l * DM, (bfu*)(p.ws + OFF_h), (it - nconv) * 8 + (tid >> 6) * 2, tid & 63);
    } else {
      int base = (it - nconv - nnorm) * 256;
      for (int e = tid; e < 256 * 32; e += 256) {
        int tok = base + (e >> 5), i = e & 31;
        float inv = powf(10000.f, -(float)i / 32.f);
        float ang = (float)((const int*)p.in[1])[tok] * inv;
        double a = (double)ang;
        double kq = rint(a * 0.15915494309189535);
        float r = (float)(a - kq * 6.283185307179586);
        ((float*)(p.ws + OFF_rcos))[tok * 32 + i] = cosf(r);
        ((float*)(p.ws + OFF_rsin))[tok * 32 + i] = sinf(r);
      }
    }
  }
}

__device__ void phase_norm2(CParams& p, int l, int tid, int vb, int vg) {
  for (int it = vb; it < 2048; it += vg)
    norm_rows2(p.out, p.in[3] + l * DM, (bfu*)(p.ws + OFF_h), it * 8 + (tid >> 6) * 2, tid & 63);
}

__device__ __forceinline__ float wave_incl_scan(float v, int lane) {
#pragma unroll
  for (int d = 1; d < 64; d <<= 1) {
    float o = __shfl_up(v, d, 64);
    if (lane >= d) v += o;
  }
  return v;
}

__device__ void phase_prep(CParams& p_o, int l, bfu* smem, int tid, int wr, int vb, int vg) {
  bfu* sK = smem;
  bfu* sV = smem + 64 * LDP;
  float* sF = reinterpret_cast<float*>(smem + 2 * 64 * LDP);
  float* s_glr = sF;
  float* s_seg = sF + 1024;
  float* s_ps = sF + 1280;
  float* s_cs = sF + 1344;
  float* s_dt = sF + 1408;
  const int lane = tid & 63, seg = tid >> 6, col = lane;
  const int total = NCH * 20;
  for (int it = vb; it < total; it += vg) {
    CParams* pp_ = &p_o;
    asm volatile("" : "+s"(pp_));
    CParams& p = *pp_;
    const int c = it / 20, hs = it - c * 20;
    const int tok0 = c * 64;
    bfu kreg[16], vreg[16];
    if (hs < 4) {
      const int h = hs;
      for (int i = tid; i < 1024; i += 256) s_glr[i] = ((float*)(p.ws + OFF_small))[(tok0 + (i >> 4)) * 32 + 4 + (i & 15)];
      float wv[16];
#pragma unroll
      for (int r = 0; r < 16; ++r) wv[r] = p.in[8][(l * 16 + r) * 256 + h * 64 + col];
      const float bias = p.in[9][l * 256 + h * 64 + col];
      bfu qraw[16], kraw[16];
#pragma unroll
      for (int i = 0; i < 16; ++i) {
        const bfu* ur = ((bfu*)(p.ws + OFF_u)) + (size_t)(tok0 + seg * 16 + i) * NU + h * 64 + col;
        qraw[i] = ur[768]; kraw[i] = ur[1024]; vreg[i] = ur[1280];
      }
      __syncthreads();
      float lb[16];
      float run = 0.f;
#pragma unroll
      for (int i = 0; i < 16; ++i) {
        int t = seg * 16 + i;
        float z = bias;
#pragma unroll
        for (int r = 0; r < 16; ++r) z += s_glr[t * 16 + r] * wv[r];
        run += logsigmoid_fast(z) * (1.f / 16.f);
        lb[i] = run;
      }
      s_seg[seg * 64 + col] = run;
      __syncthreads();
      float pre = 0.f, blast = 0.f;
#pragma unroll
      for (int s2 = 0; s2 < 4; ++s2) {
        float v = s_seg[s2 * 64 + col];
        if (s2 < seg) pre += v;
        blast += v;
      }
      if (seg == 0) {
        float e = __expf(blast);
        s_ps[col] = e;
        ((float*)(p.ws + OFF_dec))[(hs * NCH + c) * 64 + col] = e;
        ((float*)(p.ws + OFF_csb))[hs * S_LEN + tok0 + col] = 0.f;
      }
#pragma unroll
      for (int i = 0; i < 16; ++i) {
        int tok = tok0 + seg * 16 + i;
        float b = lb[i] + pre;
        bfu* ur = ((bfu*)(p.ws + OFF_u)) + (size_t)tok * NU + h * 64 + col;
        float q = bf2f(qraw[i]), k = bf2f(kraw[i]);
        bfu qd = f2bf(q * 0.125f * __expf(b));
        bfu ki = f2bf(k * __expf(-b));
        if (wr) { ur[768] = qd; ur[1024] = ki; }
        kreg[i] = ki;
      }
    } else if (hs < 8) {
      const int h = hs - 4;
      const float lg = log1pf(-exp2f(-5.f - (float)h));
      if (seg == 0) {
        s_ps[col] = 1.f;
        ((float*)(p.ws + OFF_dec))[(hs * NCH + c) * 64 + col] = __expf(64.f * lg);
        ((float*)(p.ws + OFF_csb))[hs * S_LEN + tok0 + col] = (float)(col + 1) * lg;
      }
#pragma unroll
      for (int i = 0; i < 16; ++i) {
        int t = seg * 16 + i, tok = tok0 + t;
        float cs = ((float*)(p.ws + OFF_rcos))[tok * 32 + (col & 31)], sn = ((float*)(p.ws + OFF_rsin))[tok * 32 + (col & 31)];
        bfu* ur = ((bfu*)(p.ws + OFF_u)) + (size_t)tok * NU + h * 64;
        float qo = bf2f(ur[1792 + col]), qx = bf2f(ur[1792 + (col ^ 32)]);
        float ko = bf2f(ur[2048 + col]), kx = bf2f(ur[2048 + (col ^ 32)]);
        vreg[i] = ur[2304 + col];
        float qr, kr;
        if (col < 32) { qr = qo * cs - qx * sn; kr = ko * cs - kx * sn; }
        else          { qr = qx * sn + qo * cs; kr = kx * sn + ko * cs; }
        kr *= 0.125f;
        bfu kb = f2bf(kr);
        if (wr) { ur[1792 + col] = f2bf(qr); ur[2048 + col] = kb; }
        kreg[i] = f2bf(bf2f(kb) * __expf(lg * (float)(63 - t)));
      }
    } else if (hs < 16) {
      const int h = hs - 8, g = h >> 2;
      const int chx = h * 64 + col, chb = 512 + g * 64 + col, chc = 640 + g * 64 + col;
      bfu xin[19], bin[19], cin[19];
      {
        const int tb = tok0 + seg * 16 - 3;
        const bfu* ub = ((bfu*)(p.ws + OFF_u)) + 3328;
#pragma unroll
        for (int i = 0; i < 19; ++i) {
          const int tk = tb + i;
          const bool ok = tk >= 0;
          const bfu* ur = ub + (size_t)(ok ? tk : 0) * NU;
          xin[i] = ok ? ur[chx] : (bfu)0;
          bin[i] = ok ? ur[chb] : (bfu)0;
          cin[i] = ok ? ur[chc] : (bfu)0;
        }
      }
      if (seg == 0) {
        float dtv = softplus_fast(((float*)(p.ws + OFF_small))[(tok0 + lane) * 32 + 20 + h] + p.in[14][l * 8 + h]);
        float a = -__expf(p.in[15][l * 8 + h]);
        float cs = wave_incl_scan(dtv * a, lane);
        s_cs[lane] = cs;
        s_dt[lane] = dtv;
        ((float*)(p.ws + OFF_csb))[hs * S_LEN + tok0 + lane] = cs;
        s_ps[lane] = 1.f;
      }
      __syncthreads();
      const float cs_last = s_cs[63];
      if (seg == 0) ((float*)(p.ws + OFF_dec))[(hs * NCH + c) * 64 + col] = __expf(cs_last);
      float wx[4], wb[4], wc[4];
#pragma unroll
      for (int j = 0; j < 4; ++j) {
        wx[j] = p.in[12][(l * 4 + j) * 768 + chx];
        wb[j] = p.in[12][(l * 4 + j) * 768 + chb];
        wc[j] = p.in[12][(l * 4 + j) * 768 + chc];
      }
      const float bx = p.in[13][l * 768 + chx], bb = p.in[13][l * 768 + chb], bc = p.in[13][l * 768 + chc];
#pragma unroll
      for (int i = 0; i < 16; ++i) {
        int t = seg * 16 + i, tok = tok0 + t;
        float xs = siluf_(bx + wx[0] * bf2f(xin[i]) + wx[1] * bf2f(xin[i + 1]) + wx[2] * bf2f(xin[i + 2]) + wx[3] * bf2f(xin[i + 3]));
        float bs = siluf_(bb + wb[0] * bf2f(bin[i]) + wb[1] * bf2f(bin[i + 1]) + wb[2] * bf2f(bin[i + 2]) + wb[3] * bf2f(bin[i + 3]));
        float cv = siluf_(bc + wc[0] * bf2f(cin[i]) + wc[1] * bf2f(cin[i + 1]) + wc[2] * bf2f(cin[i + 2]) + wc[3] * bf2f(cin[i + 3]));
        bfu xb = f2bf(xs);
        ((bfu*)(p.ws + OFF_ssdX))[(size_t)tok * 512 + chx] = xb;
        if ((h & 3) == 0) {
          ((bfu*)(p.ws + OFF_ssdB))[((size_t)g * S_LEN + tok) * 64 + col] = f2bf(bs);
          ((bfu*)(p.ws + OFF_ssdC))[((size_t)g * S_LEN + tok) * 64 + col] = f2bf(cv);
        }
        vreg[i] = f2bf(xs * s_dt[t]);
        kreg[i] = f2bf(bs * __expf(cs_last - s_cs[t]));
      }
    } else {
      const int h = hs - 16;
      if (seg == 0) {
        float lf = logsigmoid_fast(((float*)(p.ws + OFF_small))[(tok0 + lane) * 32 + h] + p.in[5][l * 4 + h]);
        float cs = wave_incl_scan(lf, lane);
        ((float*)(p.ws + OFF_foxc))[h * S_LEN + tok0 + lane] = cs;
        if (lane == 63) ((float*)(p.ws + OFF_foxtot))[h * NCH + c] = cs;
      }
      const float qg = p.in[6][l * 64 + col], kg = p.in[7][l * 64 + col];
#pragma unroll
      for (int i = 0; i < 16; ++i) {
        int tok = tok0 + seg * 16 + i;
        const bfu* ur = ((bfu*)(p.ws + OFF_u)) + (size_t)tok * NU + h * 64 + col;
        float q = bf2f(ur[0]), k = bf2f(ur[256]);
        vreg[i] = ur[512];
        float sq = q * q, sk = k * k;
#pragma unroll
        for (int m = 1; m < 64; m <<= 1) { sq += __shfl_xor(sq, m, 64); sk += __shfl_xor(sk, m, 64); }
        ((bfu*)(p.ws + OFF_foxq))[((size_t)h * S_LEN + tok) * 64 + col] = f2bf(q * rsqrtf(sq * (1.f / 64.f) + EPS) * qg * (0.125f * 1.44269504088896f));
        ((bfu*)(p.ws + OFF_foxk))[((size_t)h * S_LEN + tok) * 64 + col] = f2bf(k * rsqrtf(sk * (1.f / 64.f) + EPS) * kg);
      }
      uint4 v0, v1;
      v0.x = vreg[0] | ((unsigned)vreg[1] << 16); v0.y = vreg[2] | ((unsigned)vreg[3] << 16);
      v0.z = vreg[4] | ((unsigned)vreg[5] << 16); v0.w = vreg[6] | ((unsigned)vreg[7] << 16);
      v1.x = vreg[8] | ((unsigned)vreg[9] << 16); v1.y = vreg[10] | ((unsigned)vreg[11] << 16);
      v1.z = vreg[12] | ((unsigned)vreg[13] << 16); v1.w = vreg[14] | ((unsigned)vreg[15] << 16);
      bfu* dst = ((bfu*)(p.ws + OFF_foxvT)) + ((size_t)h * 64 + col) * S_LEN + tok0 + seg * 16;
      *reinterpret_cast<uint4*>(dst) = v0;
      *reinterpret_cast<uint4*>(dst + 8) = v1;
      continue;
    }
    {
      uint4 k0, k1, v0, v1;
      k0.x = kreg[0] | ((unsigned)kreg[1] << 16); k0.y = kreg[2] | ((unsigned)kreg[3] << 16);
      k0.z = kreg[4] | ((unsigned)kreg[5] << 16); k0.w = kreg[6] | ((unsigned)kreg[7] << 16);
      k1.x = kreg[8] | ((unsigned)kreg[9] << 16); k1.y = kreg[10] | ((unsigned)kreg[11] << 16);
      k1.z = kreg[12] | ((unsigned)kreg[13] << 16); k1.w = kreg[14] | ((unsigned)kreg[15] << 16);
      v0.x = vreg[0] | ((unsigned)vreg[1] << 16); v0.y = vreg[2] | ((unsigned)vreg[3] << 16);
      v0.z = vreg[4] | ((unsigned)vreg[5] << 16); v0.w = vreg[6] | ((unsigned)vreg[7] << 16);
      v1.x = vreg[8] | ((unsigned)vreg[9] << 16); v1.y = vreg[10] | ((unsigned)vreg[11] << 16);
      v1.z = vreg[12] | ((unsigned)vreg[13] << 16); v1.w = vreg[14] | ((unsigned)vreg[15] << 16);
      *reinterpret_cast<uint4*>(sK + col * LDP + seg * 16) = k0;
      *reinterpret_cast<uint4*>(sK + col * LDP + seg * 16 + 8) = k1;
      *reinterpret_cast<uint4*>(sV + col * LDP + seg * 16) = v0;
      *reinterpret_cast<uint4*>(sV + col * LDP + seg * 16 + 8) = v1;
      bfu* dst = ((bfu*)(p.ws + OFF_VT)) + (((size_t)hs * NCH + c) * 64 + col) * 64 + seg * 16;
      *reinterpret_cast<uint4*>(dst) = v0;
      *reinterpret_cast<uint4*>(dst + 8) = v1;
    }
    __syncthreads();
    {
      f32x4 acc[4];
#pragma unroll
      for (int n = 0; n < 4; ++n) acc[n] = (f32x4){0.f, 0.f, 0.f, 0.f};
      {
        const int r = lane & 15, q8 = (lane >> 4) * 8;
#pragma unroll
        for (int ks = 0; ks < 2; ++ks) {
          const bf16x8 vfr = lds_frag(sV, seg * 16 + r, ks * 32 + q8, LDP);
#pragma unroll
          for (int n = 0; n < 4; ++n)
            acc[n] = __builtin_amdgcn_mfma_f32_16x16x32_bf16(lds_frag(sK, n * 16 + r, ks * 32 + q8, LDP), vfr, acc[n], 0, 0, 0);
        }
      }
      bfu* st = ((bfu*)(p.ws + OFF_ST)) + ((size_t)hs * NCH + c) * 4096 + (seg * 16 + (lane & 15)) * 64 + (lane >> 4) * 4;
#pragma unroll
      for (int n = 0; n < 4; ++n) {
        const f32x4 ps = *reinterpret_cast<const f32x4*>(s_ps + n * 16 + (lane >> 4) * 4);
        uint2 wv;
        wv.x = pg8::cvt_pk_bf16(acc[n][0] * ps[0], acc[n][1] * ps[1]);
        wv.y = pg8::cvt_pk_bf16(acc[n][2] * ps[2], acc[n][3] * ps[3]);
        *reinterpret_cast<uint2*>(st + n * 16) = wv;
      }
    }
    __syncthreads();
  }
}

__device__ void phase_scan(CParams& p, bfu* smem, int tid, int wr, int vb, int vg) {
  float* s_x = reinterpret_cast<float*>(smem);
  const int g = tid >> 5, dp = tid & 31;
  for (int it = vb; it < 16 * 64; it += vg) {
    const int hs = it >> 6, e = it & 63;
    unsigned* stp = reinterpret_cast<unsigned*>(((bfu*)(p.ws + OFF_ST)) + ((size_t)hs * NCH + g * 32) * 4096 + e * 64 + dp * 2);
    const float2* dcp = reinterpret_cast<const float2*>(((float*)(p.ws + OFF_dec)) + ((size_t)hs * NCH + g * 32) * 64 + dp * 2);
    unsigned kv[32];
    float2 dc[32];
#pragma unroll
    for (int i = 0; i < 32; ++i) {
      kv[i] = stp[(size_t)i * 2048];
      dc[i] = dcp[i * 32];
    }
    float t0 = 0.f, t1 = 0.f, d0 = 1.f, d1 = 1.f;
#pragma unroll
    for (int i = 0; i < 32; ++i) {
      t0 = t0 * dc[i].x + bf2f((bfu)(kv[i] & 0xffffu));
      t1 = t1 * dc[i].y + bf2f((bfu)(kv[i] >> 16));
      d0 *= dc[i].x;
      d1 *= dc[i].y;
    }
    *reinterpret_cast<float4*>(s_x + (g * 32 + dp) * 4) = make_float4(t0, t1, d0, d1);
    __syncthreads();
    float s0 = 0.f, s1 = 0.f;
    for (int gg = 0; gg < g; ++gg) {
      const float4 x = *reinterpret_cast<const float4*>(s_x + (gg * 32 + dp) * 4);
      s0 = s0 * x.z + x.x;
      s1 = s1 * x.w + x.y;
    }
#pragma unroll
    for (int i = 0; i < 32; ++i) {
      const unsigned o = pg8::cvt_pk_bf16(s0, s1);
      if (wr) stp[(size_t)i * 2048] = o;
      s0 = s0 * dc[i].x + bf2f((bfu)(kv[i] & 0xffffu));
      s1 = s1 * dc[i].y + bf2f((bfu)(kv[i] >> 16));
    }
    __syncthreads();
  }
}

__device__ __forceinline__ void att_compute(const bfu* kS, const bfu* vS, const float* cS, const bfu* sQw,
                                            const float (&ct)[2], float (&l_run)[2], f32x4 (&O)[2][4],
                                            int kt, int qb, int r0, int w, int lr, int lq, int lg4) {
    f32x4 sc[2][4];
#pragma unroll
    for (int mi = 0; mi < 2; ++mi)
#pragma unroll
      for (int n = 0; n < 4; ++n) sc[mi][n] = (f32x4){0.f, 0.f, 0.f, 0.f};
#pragma unroll
    for (int ks = 0; ks < 2; ++ks) {
      bf16x8 aq0 = lds_frag(sQw, lr, ks * 32 + lq, LDP);
      bf16x8 aq1 = lds_frag(sQw, 16 + lr, ks * 32 + lq, LDP);
#pragma unroll
      for (int n = 0; n < 4; ++n) {
        bf16x8 kf = lds_frag(kS, n * 16 + lr, ks * 32 + lq, LDP);
        sc[0][n] = __builtin_amdgcn_mfma_f32_16x16x32_bf16(kf, aq0, sc[0][n], 0, 0, 0);
        sc[1][n] = __builtin_amdgcn_mfma_f32_16x16x32_bf16(kf, aq1, sc[1][n], 0, 0, 0);
      }
    }
    f32x4 csv[4];
#pragma unroll
    for (int n = 0; n < 4; ++n) csv[n] = *reinterpret_cast<const f32x4*>(cS + n * 16 + lg4);
    const bool diag = (kt >= 2 * qb);
    bf16x8 pf[2][2];
#pragma unroll
    for (int mi = 0; mi < 2; ++mi) {
      const int qrow = r0 + w * 32 + mi * 16 + lr;
      float ps = 0.f;
#pragma unroll
      for (int n = 0; n < 4; ++n)
#pragma unroll
        for (int j = 0; j < 4; ++j) {
          float v = (sc[mi][n][j] + ct[mi]) - csv[n][j];
          if (diag && (kt * 64 + n * 16 + lg4 + j > qrow)) v = -INFINITY;
          const float pv = __builtin_amdgcn_exp2f(v);
          sc[mi][n][j] = pv;
          ps += pv;
        }
      l_run[mi] += ps;
#pragma unroll
      for (int ks = 0; ks < 2; ++ks) {
        union { bf16x8 v; unsigned u[4]; } pk;
        pk.u[0] = pg8::cvt_pk_bf16(sc[mi][2 * ks][0], sc[mi][2 * ks][1]);
        pk.u[1] = pg8::cvt_pk_bf16(sc[mi][2 * ks][2], sc[mi][2 * ks][3]);
        pk.u[2] = pg8::cvt_pk_bf16(sc[mi][2 * ks + 1][0], sc[mi][2 * ks + 1][1]);
        pk.u[3] = pg8::cvt_pk_bf16(sc[mi][2 * ks + 1][2], sc[mi][2 * ks + 1][3]);
        pf[mi][ks] = pk.v;
      }
    }
#pragma unroll
    for (int ks = 0; ks < 2; ++ks) {
#pragma unroll
      for (int ef = 0; ef < 4; ++ef) {
        union { bf16x8 v; uint2 h2[2]; } vf;
        vf.h2[0] = *reinterpret_cast<const uint2*>(vS + (ef * 16 + lr) * LDP + ks * 32 + lg4);
        vf.h2[1] = *reinterpret_cast<const uint2*>(vS + (ef * 16 + lr) * LDP + ks * 32 + 16 + lg4);
#pragma unroll
        for (int mi = 0; mi < 2; ++mi)
          O[mi][ef] = __builtin_amdgcn_mfma_f32_16x16x32_bf16(vf.v, pf[mi][ks], O[mi][ef], 0, 0, 0);
      }
    }
}

__device__ void attn_item(CParams& p, int l, int qb, int h, bfu* smem, int tid, int half, unsigned char* smem_raw) {
  bfu* sK = smem;
  bfu* sV = smem + 2 * 64 * LDP;
  float* s_c = reinterpret_cast<float*>(smem + 4 * 64 * LDP);
  float* s_off = s_c + 128;
  const int lane = tid & 63, w = tid >> 6;
  const int lr = lane & 15, lq = (lane >> 4) * 8, lg4 = (lane >> 4) * 4;
  const int r0 = qb * 128;
  const float L2E = 1.44269504088896f;
  s_off[tid] = ((float*)(p.ws + OFF_foxtot))[h * NCH + tid];
  __syncthreads();
  float myoff = 0.f;
  for (int i = 0; i < tid; ++i) myoff += s_off[i];
  __syncthreads();
  s_off[tid] = myoff;
  float* s_misc = reinterpret_cast<float*>(smem + 28416);
  if (tid < 64) {
    float gq = fabsf(p.in[6][l * 64 + tid]), gk = fabsf(p.in[7][l * 64 + tid]);
#pragma unroll
    for (int m = 1; m < 64; m <<= 1) { gq = fmaxf(gq, __shfl_xor(gq, m, 64)); gk = fmaxf(gk, __shfl_xor(gk, m, 64)); }
    if (tid == 0) { s_misc[0] = 40.f + 2.f * 8.f * gq * gk * 1.01f; reinterpret_cast<int*>(s_misc)[1] = 2 * qb; s_misc[2] = 8.f * gq * gk * 1.01f * 1.44269504088896f; }
  }
  __syncthreads();
  {
    const float thr = s_misc[0];
    const float cref = s_off[2 * qb];
    if (tid < 2 * qb && s_off[tid + 1] <= cref + thr) atomicMin(reinterpret_cast<int*>(s_misc) + 1, tid);
  }
  __syncthreads();
  int kt_min = reinterpret_cast<int*>(s_misc)[1];
  const int nkt = 2 * qb + 2;
  if ((nkt - kt_min) & 1) kt_min -= 1;
  const bfu* Qg = ((bfu*)(p.ws + OFF_foxq)) + (size_t)h * S_LEN * 64;
  const bfu* Kg = ((bfu*)(p.ws + OFF_foxk)) + (size_t)h * S_LEN * 64;
  const bfu* Vg = ((bfu*)(p.ws + OFF_foxvT)) + (size_t)h * 64 * S_LEN;
  const float* Cg = ((float*)(p.ws + OFF_foxc)) + (size_t)h * S_LEN;
  bfu* sQ = smem + 4 * 64 * LDP + 768;
  {
#pragma unroll
    for (int i = 0; i < 4; ++i) {
      int id = tid + i * 256;
      int r = id >> 3, c = (id & 7) * 8;
      *reinterpret_cast<uint4*>(sQ + r * LDP + c) = *reinterpret_cast<const uint4*>(Qg + (size_t)(r0 + r) * 64 + c);
    }
  }
  const bfu* sQw = sQ + (w * 32) * LDP;
  float ct[2], l_run[2];
  const float lbound = s_misc[2];
  f32x4 O[2][4];
#pragma unroll
  for (int mi = 0; mi < 2; ++mi) {
    const int qrow = r0 + w * 32 + mi * 16 + lr;
    ct[mi] = (Cg[qrow] + s_off[qrow >> 6]) * L2E - lbound;
    l_run[mi] = 0.f;
#pragma unroll
    for (int n = 0; n < 4; ++n) O[mi][n] = (f32x4){0.f, 0.f, 0.f, 0.f};
  }
  const int nkh = (nkt - kt_min) >> 1;
  const int kt0 = kt_min + half * nkh;
  const int crow0 = tid >> 3, ccol = (tid & 7) * 8;
  uint4 rk0A, rk1A, rv0A, rv1A, rk0B, rk1B, rv0B, rv1B;
  float rcA = 0.f, rcB = 0.f;
  {
    const int k0 = kt0 * 64;
    rk0A = *reinterpret_cast<const uint4*>(Kg + (size_t)(k0 + crow0) * 64 + ccol);
    rk1A = *reinterpret_cast<const uint4*>(Kg + (size_t)(k0 + crow0 + 32) * 64 + ccol);
    rv0A = *reinterpret_cast<const uint4*>(Vg + (size_t)(crow0) * S_LEN + k0 + ccol);
    rv1A = *reinterpret_cast<const uint4*>(Vg + (size_t)(crow0 + 32) * S_LEN + k0 + ccol);
    if (tid < 64) rcA = (Cg[k0 + tid] + s_off[kt0]) * L2E;
  }
  *reinterpret_cast<uint4*>(sK + (crow0) * LDP + ccol) = rk0A;
  *reinterpret_cast<uint4*>(sK + (crow0 + 32) * LDP + ccol) = rk1A;
  *reinterpret_cast<uint4*>(sV + (crow0) * LDP + ccol) = rv0A;
  *reinterpret_cast<uint4*>(sV + (crow0 + 32) * LDP + ccol) = rv1A;
  if (tid < 64) s_c[tid] = rcA;
  rk0B = rk1B = rv0B = rv1B = rk0A;
  __syncthreads();
#define ATT_LOAD(S, KT)                                                                              \
  {                                                                                                  \
    const int k0_ = (KT) * 64;                                                                       \
    rk0##S = *reinterpret_cast<const uint4*>(Kg + (size_t)(k0_ + crow0) * 64 + ccol);                \
    rk1##S = *reinterpret_cast<const uint4*>(Kg + (size_t)(k0_ + crow0 + 32) * 64 + ccol);           \
    rv0##S = *reinterpret_cast<const uint4*>(Vg + (size_t)(crow0) * S_LEN + k0_ + ccol);             \
    rv1##S = *reinterpret_cast<const uint4*>(Vg + (size_t)(crow0 + 32) * S_LEN + k0_ + ccol);        \
    if (tid < 64) rc##S = (Cg[k0_ + tid] + s_off[(KT)]) * L2E;                                       \
  }
#define ATT_STORE(S, BUF)                                                                            \
  {                                                                                                  \
    bfu* kN_ = sK + (BUF) * 64 * LDP;                                                                \
    bfu* vN_ = sV + (BUF) * 64 * LDP;                                                                \
    *reinterpret_cast<uint4*>(kN_ + (crow0) * LDP + ccol) = rk0##S;                                  \
    *reinterpret_cast<uint4*>(kN_ + (crow0 + 32) * LDP + ccol) = rk1##S;                             \
    *reinterpret_cast<uint4*>(vN_ + (crow0) * LDP + ccol) = rv0##S;                                  \
    *reinterpret_cast<uint4*>(vN_ + (crow0 + 32) * LDP + ccol) = rv1##S;                             \
    if (tid < 64) s_c[(BUF) * 64 + tid] = rc##S;                                                     \
  }
  if (nkh > 1) ATT_LOAD(B, kt0 + 1);
  for (int it = 0; it < nkh; it += 2) {
    if (it + 2 < nkh) ATT_LOAD(A, kt0 + it + 2);
    att_compute(sK, sV, s_c, sQw, ct, l_run, O, kt0 + it, qb, r0, w, lr, lq, lg4);
    if (it + 1 < nkh) ATT_STORE(B, 1);
    __syncthreads();
    if (it + 1 >= nkh) break;
    if (it + 3 < nkh) ATT_LOAD(B, kt0 + it + 3);
    att_compute(sK + 64 * LDP, sV + 64 * LDP, s_c + 64, sQw, ct, l_run, O, kt0 + it + 1, qb, r0, w, lr, lq, lg4);
    if (it + 2 < nkh) ATT_STORE(A, 0);
    __syncthreads();
  }
#undef ATT_LOAD
#undef ATT_STORE
  float* xch = reinterpret_cast<float*>(smem_raw + SMEM_HALF);
  if (half == 1) {
#pragma unroll
    for (int mi = 0; mi < 2; ++mi) {
#pragma unroll
      for (int n = 0; n < 4; ++n)
#pragma unroll
        for (int j = 0; j < 4; ++j) xch[((mi * 4 + n) * 4 + j) * 256 + tid] = O[mi][n][j];
      xch[(32 + mi) * 256 + tid] = l_run[mi];
    }
  }
  __syncthreads();
  if (half == 0) {
#pragma unroll
    for (int mi = 0; mi < 2; ++mi) {
      float lsum = l_run[mi] + xch[(32 + mi) * 256 + tid];
      lsum += __shfl_xor(lsum, 16, 64);
      lsum += __shfl_xor(lsum, 32, 64);
      const float inv = 1.f / lsum;
      const int qrow = r0 + w * 32 + mi * 16 + lr;
      bfu* yp = ((bfu*)(p.ws + OFF_y)) + (size_t)qrow * YW + h * 64 + lg4;
#pragma unroll
      for (int n = 0; n < 4; ++n) {
        float o0 = (O[mi][n][0] + xch[((mi * 4 + n) * 4 + 0) * 256 + tid]) * inv;
        float o1 = (O[mi][n][1] + xch[((mi * 4 + n) * 4 + 1) * 256 + tid]) * inv;
        float o2 = (O[mi][n][2] + xch[((mi * 4 + n) * 4 + 2) * 256 + tid]) * inv;
        float o3 = (O[mi][n][3] + xch[((mi * 4 + n) * 4 + 3) * 256 + tid]) * inv;
        uint2 wv;
        wv.x = pg8::cvt_pk_bf16(o0, o1);
        wv.y = pg8::cvt_pk_bf16(o2, o3);
        *reinterpret_cast<uint2*>(yp + n * 16) = wv;
      }
    }
  }
  __syncthreads();
}

__device__ void chunk_out_item(CParams& p, int l, int c, int hs, bfu* smem, int tid) {
  bfu* sQ = smem;
  bfu* sKi = smem + 64 * LDP;
  bfu* sV = smem + 2 * 64 * LDP;
  bfu* sS = smem + 3 * 64 * LDP;
  bfu* sP = smem + 4 * 64 * LDP;
  float* s_cs = reinterpret_cast<float*>(smem + 5 * 64 * LDP);
  const int lane = tid & 63, w = tid >> 6;
  const int lr = lane & 15, lq = (lane >> 4) * 8, lg4 = (lane >> 4) * 4;
  const int tok0 = c * 64;
  const int tl = w * 16 + lr, tok = tok0 + tl;
  const bfu *Qp, *Kp;
  int qs;
  if (hs < 4) { Qp = ((bfu*)(p.ws + OFF_u)) + (size_t)tok0 * NU + 768 + hs * 64; Kp = ((bfu*)(p.ws + OFF_u)) + (size_t)tok0 * NU + 1024 + hs * 64; qs = NU; }
  else if (hs < 8) { Qp = ((bfu*)(p.ws + OFF_u)) + (size_t)tok0 * NU + 1792 + (hs - 4) * 64; Kp = ((bfu*)(p.ws + OFF_u)) + (size_t)tok0 * NU + 2048 + (hs - 4) * 64; qs = NU; }
  else { int g = (hs - 8) >> 2; Qp = ((bfu*)(p.ws + OFF_ssdC)) + ((size_t)g * S_LEN + tok0) * 64; Kp = ((bfu*)(p.ws + OFF_ssdB)) + ((size_t)g * S_LEN + tok0) * 64; qs = 64; }
  uint2 g4[4], x4[4];
  f32x4 gn[4];
  const int hh = (hs < 8) ? (hs & 3) : (hs - 8);
  {
    const int gcol = (hs < 4) ? (1536 + hh * 64) : (hs < 8 ? (2560 + hh * 64) : (2816 + hh * 64));
    const bfu* gp = ((bfu*)(p.ws + OFF_u)) + (size_t)tok * NU + gcol + lg4;
    const bfu* xp = ((bfu*)(p.ws + OFF_ssdX)) + (size_t)tok * 512 + hh * 64 + lg4;
    const float* gnp = (hs < 4 ? p.in[10] : p.in[11]) + l * 64 + lg4;
#pragma unroll
    for (int n = 0; n < 4; ++n) {
      g4[n] = *reinterpret_cast<const uint2*>(gp + n * 16);
      x4[n] = (hs >= 8) ? *reinterpret_cast<const uint2*>(xp + n * 16) : make_uint2(0u, 0u);
      gn[n] = (hs < 8) ? *reinterpret_cast<const f32x4*>(gnp + n * 16) : (f32x4){1.f, 1.f, 1.f, 1.f};
    }
  }
  load_tile64(sQ, Qp, qs, tid);
  load_tile64(sKi, Kp, qs, tid);
  load_tile64(sV, ((bfu*)(p.ws + OFF_VT)) + ((size_t)hs * NCH + c) * 4096, 64, tid);
  load_tile64(sS, ((bfu*)(p.ws + OFF_ST)) + ((size_t)hs * NCH + c) * 4096, 64, tid);
  if (tid < 64) s_cs[tid] = ((float*)(p.ws + OFF_csb))[hs * S_LEN + tok0 + tid];
  __syncthreads();
  const bf16x8 qf0 = lds_frag(sQ, tl, lq, LDP), qf1 = lds_frag(sQ, tl, 32 + lq, LDP);
  f32x4 sc[4], o[4];
#pragma unroll
  for (int n = 0; n < 4; ++n) {
    sc[n] = (f32x4){0.f, 0.f, 0.f, 0.f};
    o[n] = (f32x4){0.f, 0.f, 0.f, 0.f};
  }
#pragma unroll
  for (int n = 0; n < 4; ++n) {
    sc[n] = __builtin_amdgcn_mfma_f32_16x16x32_bf16(lds_frag(sKi, n * 16 + lr, lq, LDP), qf0, sc[n], 0, 0, 0);
    sc[n] = __builtin_amdgcn_mfma_f32_16x16x32_bf16(lds_frag(sKi, n * 16 + lr, 32 + lq, LDP), qf1, sc[n], 0, 0, 0);
    o[n] = __builtin_amdgcn_mfma_f32_16x16x32_bf16(lds_frag(sS, n * 16 + lr, lq, LDP), qf0, o[n], 0, 0, 0);
    o[n] = __builtin_amdgcn_mfma_f32_16x16x32_bf16(lds_frag(sS, n * 16 + lr, 32 + lq, LDP), qf1, o[n], 0, 0, 0);
  }
  const float cst = s_cs[tl];
  const float rsc = __expf(cst);
#pragma unroll
  for (int n = 0; n < 4; ++n) {
    const f32x4 css = *reinterpret_cast<const f32x4*>(s_cs + n * 16 + lg4);
    float pv[4];
#pragma unroll
    for (int j = 0; j < 4; ++j) {
      const int s = n * 16 + lg4 + j;
      pv[j] = (s <= tl) ? sc[n][j] * __expf(cst - css[j]) : 0.f;
      o[n][j] *= rsc;
    }
    uint2 wv;
    wv.x = pg8::cvt_pk_bf16(pv[0], pv[1]);
    wv.y = pg8::cvt_pk_bf16(pv[2], pv[3]);
    *reinterpret_cast<uint2*>(sP + tl * LDP + n * 16 + lg4) = wv;
  }
  __syncthreads();
  {
    const bf16x8 pf0 = lds_frag(sP, tl, lq, LDP), pf1 = lds_frag(sP, tl, 32 + lq, LDP);
#pragma unroll
    for (int n = 0; n < 4; ++n) {
      o[n] = __builtin_amdgcn_mfma_f32_16x16x32_bf16(lds_frag(sV, n * 16 + lr, lq, LDP), pf0, o[n], 0, 0, 0);
      o[n] = __builtin_amdgcn_mfma_f32_16x16x32_bf16(lds_frag(sV, n * 16 + lr, 32 + lq, LDP), pf1, o[n], 0, 0, 0);
    }
  }
  float ss = 0.f;
  if (hs < 8) {
#pragma unroll
    for (int n = 0; n < 4; ++n) ss += (o[n][0] * o[n][0] + o[n][1] * o[n][1]) + (o[n][2] * o[n][2] + o[n][3] * o[n][3]);
    ss += __shfl_xor(ss, 16, 64);
    ss += __shfl_xor(ss, 32, 64);
    const float rstd = rsqrtf(ss * (1.f / 64.f) + EPS);
    bfu* yp = ((bfu*)(p.ws + OFF_y)) + (size_t)tok * YW + (hs < 4 ? 256 : 512) + hh * 64 + lg4;
#pragma unroll
    for (int n = 0; n < 4; ++n) {
      const float t0 = __uint_as_float(g4[n].x << 16), t1 = __uint_as_float(g4[n].x & 0xffff0000u);
      const float t2 = __uint_as_float(g4[n].y << 16), t3 = __uint_as_float(g4[n].y & 0xffff0000u);
      uint2 wv;
      wv.x = pg8::cvt_pk_bf16(o[n][0] * rstd * gn[n][0] * siluf_(t0), o[n][1] * rstd * gn[n][1] * siluf_(t1));
      wv.y = pg8::cvt_pk_bf16(o[n][2] * rstd * gn[n][2] * siluf_(t2), o[n][3] * rstd * gn[n][3] * siluf_(t3));
      *reinterpret_cast<uint2*>(yp + n * 16) = wv;
    }
  } else {
    const float dsk = p.in[16][l * 8 + hh];
    bfu* yp = ((bfu*)(p.ws + OFF_y)) + (size_t)tok * YW + 768 + hh * 64 + lg4;
#pragma unroll
    for (int n = 0; n < 4; ++n) {
      const float z0 = __uint_as_float(g4[n].x << 16), z1 = __uint_as_float(g4[n].x & 0xffff0000u);
      const float z2 = __uint_as_float(g4[n].y << 16), z3 = __uint_as_float(g4[n].y & 0xffff0000u);
      const float a0 = __uint_as_float(x4[n].x << 16), a1 = __uint_as_float(x4[n].x & 0xffff0000u);
      const float a2 = __uint_as_float(x4[n].y << 16), a3 = __uint_as_float(x4[n].y & 0xffff0000u);
      const float y0 = (o[n][0] + dsk * a0) * siluf_(z0), y1 = (o[n][1] + dsk * a1) * siluf_(z1);
      const float y2 = (o[n][2] + dsk * a2) * siluf_(z2), y3 = (o[n][3] + dsk * a3) * siluf_(z3);
      ss += (y0 * y0 + y1 * y1) + (y2 * y2 + y3 * y3);
      uint2 wv;
      wv.x = pg8::cvt_pk_bf16(y0, y1);
      wv.y = pg8::cvt_pk_bf16(y2, y3);
      *reinterpret_cast<uint2*>(yp + n * 16) = wv;
    }
    ss += __shfl_xor(ss, 16, 64);
    ss += __shfl_xor(ss, 32, 64);
    if (lg4 == 0) ((float*)(p.ws + OFF_ssq))[tok * 8 + hh] = ss;
  }
  __syncthreads();
}

__device__ void phase_mix(CParams& p_o, int l, bfu* smem, int tid, int half, int cidx, unsigned char* smem_raw) {
  __shared__ int s_item;
  const int total = 512 + NCH * 8;
  while (true) {
    __syncthreads();
    if (threadIdx.x == 0) s_item = (int)atomicAdd(&((unsigned*)(p_o.ws + OFF_ctr))[cidx], 1u);
    __syncthreads();
    const int it = s_item;
    if (it >= total) break;
    CParams* pp_ = &p_o;
    asm volatile("" : "+s"(pp_));
    CParams& p = *pp_;
    if (it < 512) {
      int qb = 127 - (it >> 2), h = it & 3;
      attn_item(p, l, qb, h, smem, tid, half, smem_raw);
    } else {
      int j = (it - 512) * 2 + half;
      chunk_out_item(p, l, j >> 4, j & 15, smem, tid);
    }
  }
}

__device__ void phase_upmerge(CParams& p, bfu* smem, int tid, int vb, int vg, int half, unsigned char* smem_raw) {
  bfu* sA = reinterpret_cast<bfu*>(smem_raw);
  bfu* sB = smem + 2 * 128 * LDP;
  float* s_rs = reinterpret_cast<float*>(smem + 2 * 128 * LDP + 2 * 64 * LDP);
  const int lane = tid & 63, w = tid >> 6, wm = w >> 1, wn = w & 1;
  const int lr = lane & 15, lq = (lane >> 4) * 8, lg4 = (lane >> 4) * 4;
  const int crow = tid >> 3, ccol = (tid & 7) * 8;
  const int t512 = half * 256 + tid, arow = t512 >> 3;
  const int xcd = (vb >> 1) & 7, jl = ((vb >> 4) << 1) | (vb & 1), per = vg >> 3;
  for (int il = jl; il < 16 * 16; il += per) {
    const int mt = xcd * 16 + (il >> 4), nt = il & 15;
    const bfu* Ap = ((bfu*)(p.ws + OFF_y)) + (size_t)(mt * 128 + arow) * YW + ccol;
    const bfu* Bp = ((bfu*)(p.ws + OFF_WupT)) + (size_t)(nt * 64 + crow) * YW + ccol;
    const bfu* Gp = ((bfu*)(p.ws + OFF_u)) + (size_t)(mt * 128 + wm * 64 + lr) * NU + 4096 + nt * 64 + wn * 32 + lg4;
    {
      const int row = tid >> 1, g = tid & 1;
      const float4 q4 = *reinterpret_cast<const float4*>(((float*)(p.ws + OFF_ssq)) + (mt * 128 + row) * 8 + g * 4);
      s_rs[g * 128 + row] = rsqrtf((q4.x + q4.y + q4.z + q4.w) * (1.f / 256.f) + EPS);
    }
    uint4 a0_0, a0_1, b0_0, b0_1, a1_0, a1_1, b1_0, b1_1;
#define U_LOAD(S, KT)                                                                \
  {                                                                                  \
    const int ko_ = (KT) * 64;                                                       \
    a##S##_0 = *reinterpret_cast<const uint4*>(Ap + (size_t)0 * 64 * YW + ko_);      \
    a##S##_1 = *reinterpret_cast<const uint4*>(Ap + (size_t)1 * 64 * YW + ko_);      \
    b##S##_0 = *reinterpret_cast<const uint4*>(Bp + (size_t)0 * 32 * YW + ko_);      \
    b##S##_1 = *reinterpret_cast<const uint4*>(Bp + (size_t)1 * 32 * YW + ko_);      \
  }
#define U_STORE(S, BUF)                                                              \
  {                                                                                  \
    bfu* sAn_ = sA + (BUF) * 128 * LDP + arow * LDP + ccol;                          \
    bfu* sBn_ = sB + (BUF) * 64 * LDP + crow * LDP + ccol;                           \
    *reinterpret_cast<uint4*>(sAn_ + 0 * 64 * LDP) = a##S##_0;                       \
    *reinterpret_cast<uint4*>(sAn_ + 1 * 64 * LDP) = a##S##_1;                       \
    *reinterpret_cast<uint4*>(sBn_ + 0 * 32 * LDP) = b##S##_0;                       \
    *reinterpret_cast<uint4*>(sBn_ + 1 * 32 * LDP) = b##S##_1;                       \
  }
#define U_COMPUTE(BUF)                                                               \
  {                                                                                  \
    const bfu* a_s = sA + (BUF) * 128 * LDP + (wm * 64) * LDP;                       \
    const bfu* b_s = sB + (BUF) * 64 * LDP + (wn * 32) * LDP;                        \
    _Pragma("unroll") for (int ks = 0; ks < 2; ++ks) {                               \
      bf16x8 af0 = lds_frag(a_s, 0 * 16 + lr, ks * 32 + lq, LDP);                    \
      bf16x8 af1 = lds_frag(a_s, 1 * 16 + lr, ks * 32 + lq, LDP);                    \
      bf16x8 af2 = lds_frag(a_s, 2 * 16 + lr, ks * 32 + lq, LDP);                    \
      bf16x8 af3 = lds_frag(a_s, 3 * 16 + lr, ks * 32 + lq, LDP);                    \
      _Pragma("unroll") for (int ni = 0; ni < 2; ++ni) {                             \
        bf16x8 bf_ = lds_frag(b_s, ni * 16 + lr, ks * 32 + lq, LDP);                 \
        acc[0][ni] = __builtin_amdgcn_mfma_f32_16x16x32_bf16(bf_, af0, acc[0][ni], 0, 0, 0); \
        acc[1][ni] = __builtin_amdgcn_mfma_f32_16x16x32_bf16(bf_, af1, acc[1][ni], 0, 0, 0); \
        acc[2][ni] = __builtin_amdgcn_mfma_f32_16x16x32_bf16(bf_, af2, acc[2][ni], 0, 0, 0); \
        acc[3][ni] = __builtin_amdgcn_mfma_f32_16x16x32_bf16(bf_, af3, acc[3][ni], 0, 0, 0); \
      }                                                                              \
    }                                                                                \
  }
    f32x4 acc[4][2], tot[4][2];
    zero_acc<2>(acc);
    zero_acc<2>(tot);
    uint2 gt[4][2];
    U_LOAD(0, 0);
    U_LOAD(1, 1);
    U_STORE(0, 0);
    __syncthreads();
#pragma unroll 1
    for (int kt = 0; kt < 20; kt += 2) {
      if ((kt & 3) == 0) {
        const int br = kt >> 2, gb = br < 3 ? br : 3;
#pragma unroll
        for (int mi = 0; mi < 4; ++mi)
#pragma unroll
          for (int ni = 0; ni < 2; ++ni)
            gt[mi][ni] = *reinterpret_cast<const uint2*>(Gp + (size_t)(mi * 16) * NU + gb * 1024 + ni * 16);
      }
      if (kt + 2 < 20) U_LOAD(0, kt + 2);
      U_COMPUTE(0);
      U_STORE(1, 1);
      __syncthreads();
      if (kt + 3 < 20) U_LOAD(1, kt + 3);
      U_COMPUTE(1);
      if (kt + 2 < 20) U_STORE(0, 0);
      if ((kt & 3) == 2) {
        const int br = kt >> 2;
#pragma unroll
        for (int mi = 0; mi < 4; ++mi) {
          float rsc = 1.f;
          if (br >= 3) rsc = s_rs[(br - 3) * 128 + wm * 64 + mi * 16 + lr];
#pragma unroll
          for (int ni = 0; ni < 2; ++ni) {
            const uint2 g2 = gt[mi][ni];
            tot[mi][ni][0] += acc[mi][ni][0] * (__uint_as_float(g2.x << 16) * rsc);
            tot[mi][ni][1] += acc[mi][ni][1] * (__uint_as_float(g2.x & 0xffff0000u) * rsc);
            tot[mi][ni][2] += acc[mi][ni][2] * (__uint_as_float(g2.y << 16) * rsc);
            tot[mi][ni][3] += acc[mi][ni][3] * (__uint_as_float(g2.y & 0xffff0000u) * rsc);
            acc[mi][ni] = (f32x4){0.f, 0.f, 0.f, 0.f};
          }
        }
      }
      __syncthreads();
    }
#undef U_LOAD
#undef U_STORE
#undef U_COMPUTE
    bfu* Hp = ((bfu*)(p.ws + OFF_h)) + (size_t)(mt * 128 + wm * 64 + lr) * DM + nt * 64 + wn * 32 + lg4;
#pragma unroll
    for (int mi = 0; mi < 4; ++mi)
#pragma unroll
      for (int ni = 0; ni < 2; ++ni) {
        uint2 wv;
        wv.x = pg8::cvt_pk_bf16(tot[mi][ni][0], tot[mi][ni][1]);
        wv.y = pg8::cvt_pk_bf16(tot[mi][ni][2], tot[mi][ni][3]);
        *reinterpret_cast<uint2*>(Hp + (size_t)(mi * 16) * DM + ni * 16) = wv;
      }
  }
}

namespace pg8 {
#define PG8_LAS __attribute__((address_space(3)))
typedef unsigned short bf16_t;
typedef short bf16x8 __attribute__((ext_vector_type(8)));
typedef float f32x4 __attribute__((ext_vector_type(4)));
typedef unsigned u32x4 __attribute__((ext_vector_type(4)));
typedef unsigned u32x2 __attribute__((ext_vector_type(2)));
constexpr int BM = 256, BK = 64, HALF = 128, HTB = HALF * BK * 2, STAGE_BYTES = 8 * HTB, NXCD = 8, WGM = 8;
__device__ __forceinline__ int lds_byte(int r, int c) { const int st = (r >> 4) * 2 + (c >> 5), rr = r & 15, cc = c & 31, ob = rr * 64 + cc * 2; return st * 1024 + (ob ^ (((ob >> 9) & 1) << 5)); }
__device__ __forceinline__ void stage_rc(int b, int& R, int& C) { const int st = b / 1024, sb = b % 1024, swz = sb ^ (((sb >> 9) & 1) << 5); R = (st >> 1) * 16 + swz / 64; C = (st & 1) * 32 + (swz % 64) / 2; }
__device__ __forceinline__ int perm32(int rho) { const int n = rho >> 4, i = rho & 15; return 8 * (i >> 2) + 4 * n + (i & 3); }
struct Unit { int pm, pn; };
struct Gemm { const bf16_t* A; const bf16_t* Bt; int M, N, K; };
struct StaticOrder {
    int nM, nN, nwg, G, c;
    __device__ void init(int M, int N, int G_, int c_) { nM = M / BM; nN = N / BM; nwg = nM * nN; G = G_; c = c_; }
    __device__ bool next(int i, Unit& u) const {
        const long L = (long)i * G + c; if (L >= nwg) return false;
        int wgid = (int)L; { const int q = nwg / NXCD, r = nwg % NXCD, xcd = wgid % NXCD, off = wgid / NXCD; wgid = (xcd < r ? xcd * (q + 1) : r * (q + 1) + (xcd - r) * q) + off; }
        const int nig = WGM * nN, gid = wgid / nig, fm = gid * WGM, gsz = (nM - fm) < WGM ? (nM - fm) : WGM;
        u.pm = fm + ((wgid % nig) % gsz); u.pn = (wgid % nig) / gsz; return true;
    }
    __device__ __forceinline__ void a_ready(const Unit&) const {}
    __device__ __forceinline__ void done(const Unit&) const {}
};
__device__ __forceinline__ unsigned cvt_pk_bf16(float lo, float hi) { unsigned r; asm volatile("v_cvt_pk_bf16_f32 %0, %1, %2" : "=v"(r) : "v"(lo), "v"(hi)); return r; }

template <class Epi, class Sched>
__device__ __forceinline__ void gemm_phase(PG8_LAS unsigned char* lds, const Gemm g, const Sched& S, const Epi& E) {
    const int tid = threadIdx.x, wid = __builtin_amdgcn_readfirstlane(tid >> 6), lane = tid & 63, wr = wid >> 2, wc = wid & 3, fr = lane & 15, fq = lane >> 4;
    const int K = g.K, nt = K / BK;
    unsigned voffA[2], voffB[2];
#pragma unroll
    for (int i = 0; i < 2; ++i) { int R, C; stage_rc(tid * 16 + i * 8192, R, C); const int Rb = Epi::PERM ? ((R & ~31) + perm32(R & 31)) : R;
        voffA[i] = (unsigned)(R * K + C) * 2u; voffB[i] = (unsigned)(Rb * K + C) * 2u; }
    const size_t kstep = (size_t)(BK * 2);
    const size_t hstep = (size_t)HALF * K * 2;
    const size_t tstep = 2 * hstep;
    const unsigned ldsw = (unsigned)wid * 1024u;
    const int aoff = lds_byte(wr * 64 + fr, fq * 8), boff = lds_byte(wc * 32 + fr, fq * 8);
#define PG8_SA(b, h) (((b) * 2 + (h)) * HTB)
#define PG8_SB(b, h) ((4 + (b) * 2 + (h)) * HTB)
#define PG8_STAGE(bufoff, gbase, voff) do { _Pragma("unroll") for (int _i = 0; _i < 2; ++_i) \
        __builtin_amdgcn_global_load_lds((const unsigned*)((const char*)(gbase) + (voff)[_i]), (PG8_LAS unsigned*)(lds + (bufoff) + ldsw + _i * 8192), 16, 0, 0); } while (0)
#define PG8_LDA(dst, b, h) do { _Pragma("unroll") for (int m = 0; m < 4; ++m) _Pragma("unroll") for (int k = 0; k < 2; ++k) dst[m][k] = *(const PG8_LAS bf16x8*)(lds + PG8_SA(b, h) + aoff + m * 2048 + k * 1024); } while (0)
#define PG8_LDB(dst, b, h) do { _Pragma("unroll") for (int n = 0; n < 2; ++n) _Pragma("unroll") for (int k = 0; k < 2; ++k) dst[n][k] = *(const PG8_LAS bf16x8*)(lds + PG8_SB(b, h) + boff + n * 2048 + k * 1024); } while (0)
#define PG8_MMA(ai, bj, At, Bt) do { __builtin_amdgcn_s_setprio(1); _Pragma("unroll") for (int m = 0; m < 4; ++m) _Pragma("unroll") for (int n = 0; n < 2; ++n) _Pragma("unroll") for (int k = 0; k < 2; ++k) \
        acc[ai][bj][m][n] = __builtin_amdgcn_mfma_f32_16x16x32_bf16(Bt[n][k], At[m][k], acc[ai][bj][m][n], 0, 0, 0); __builtin_amdgcn_s_setprio(0); } while (0)
#define PG8_WAIT_V(n) asm volatile("s_waitcnt vmcnt(" #n ")" ::: "memory")
#define PG8_WAIT_L(n) asm volatile("s_waitcnt lgkmcnt(" #n ")" ::: "memory")
#define PG8_BAR __builtin_amdgcn_s_barrier()
#define PG8_SCHED __builtin_amdgcn_sched_barrier(0)
    Unit cur, nxt; int ui = 0;
    if (!S.next(0, cur)) return;
    f32x4 acc[2][2][4][2];
#pragma unroll
    for (int a = 0; a < 2; ++a)
#pragma unroll
        for (int b = 0; b < 2; ++b)
#pragma unroll
            for (int m = 0; m < 4; ++m)
#pragma unroll
                for (int n = 0; n < 2; ++n) acc[a][b][m][n] = (f32x4){0.f, 0.f, 0.f, 0.f};
    bf16x8 At[4][2], B0[2][2], B1[2][2];
    const char* cA = (const char*)g.A + (size_t)cur.pm * tstep; const char* cB = (const char*)g.Bt + (size_t)cur.pn * tstep;
    S.a_ready(cur);
    PG8_STAGE(PG8_SB(0, 0), cB, voffB); PG8_STAGE(PG8_SA(0, 0), cA, voffA); PG8_STAGE(PG8_SB(0, 1), cB + hstep, voffB); PG8_STAGE(PG8_SA(0, 1), cA + hstep, voffA);
    if (wr == 1) PG8_BAR;
    PG8_WAIT_V(4); PG8_BAR;
    PG8_STAGE(PG8_SB(1, 0), cB + kstep, voffB); PG8_STAGE(PG8_SA(1, 0), cA + kstep, voffA); PG8_STAGE(PG8_SB(1, 1), cB + hstep + kstep, voffB);
    PG8_WAIT_V(6); PG8_BAR;
    for (;;) {
        const bool has_next = S.next(ui + 1, nxt);
        const char* nA = has_next ? (const char*)g.A + (size_t)nxt.pm * tstep : cA; const char* nB = has_next ? (const char*)g.Bt + (size_t)nxt.pn * tstep : cB;
        for (int t = 0; t < nt; t += 2) {
            const bool last = (t == nt - 2);
            const char* a1 = cA + (size_t)(t + 1) * kstep;
            const char* a2 = last ? nA : cA + (size_t)(t + 2) * kstep; const char* b2 = last ? nB : cB + (size_t)(t + 2) * kstep;
            const char* a3 = a2 + kstep; const char* b3 = b2 + kstep;
            if (last && has_next) S.a_ready(nxt);
            PG8_LDB(B0, 0, 0); PG8_SCHED; PG8_LDA(At, 0, 0); PG8_STAGE(PG8_SA(1, 1), a1 + hstep, voffA);
            PG8_WAIT_L(8); PG8_BAR; PG8_WAIT_L(0); PG8_MMA(0, 0, At, B0); PG8_BAR; PG8_SCHED;
            PG8_LDB(B1, 0, 1); PG8_STAGE(PG8_SB(0, 0), b2, voffB);
            PG8_BAR; PG8_WAIT_L(0); PG8_MMA(0, 1, At, B1); PG8_BAR;
            PG8_LDA(At, 0, 1); PG8_STAGE(PG8_SA(0, 0), a2, voffA);
            PG8_BAR; PG8_WAIT_L(0); PG8_MMA(1, 0, At, B0); PG8_BAR; PG8_SCHED;
            PG8_STAGE(PG8_SB(0, 1), b2 + hstep, voffB);
            PG8_WAIT_V(6); PG8_BAR; PG8_MMA(1, 1, At, B1); PG8_BAR;
            PG8_LDB(B0, 1, 0); PG8_SCHED; PG8_LDA(At, 1, 0); PG8_STAGE(PG8_SA(0, 1), a2 + hstep, voffA);
            PG8_WAIT_L(8); PG8_BAR; PG8_WAIT_L(0); PG8_MMA(0, 0, At, B0); PG8_BAR; PG8_SCHED;
            PG8_LDB(B1, 1, 1); PG8_STAGE(PG8_SB(1, 0), b3, voffB);
            PG8_BAR; PG8_WAIT_L(0); PG8_MMA(0, 1, At, B1); PG8_BAR;
            PG8_LDA(At, 1, 1); PG8_STAGE(PG8_SA(1, 0), a3, voffA);
            PG8_BAR; PG8_WAIT_L(0); PG8_MMA(1, 0, At, B0); PG8_BAR; PG8_SCHED;
            PG8_STAGE(PG8_SB(1, 1), b3 + hstep, voffB);
            PG8_WAIT_V(6); PG8_BAR; PG8_MMA(1, 1, At, B1); PG8_BAR;
        }
            if constexpr (!Epi::AFTER_DRAIN) { E(acc, cur, wr, wc, fr, fq); S.done(cur); }
            if (!has_next) break;
#pragma unroll
        for (int a = 0; a < 2; ++a)
#pragma unroll
            for (int b = 0; b < 2; ++b)
#pragma unroll
                for (int m = 0; m < 4; ++m)
#pragma unroll
                    for (int n = 0; n < 2; ++n) acc[a][b][m][n] = (f32x4){0.f, 0.f, 0.f, 0.f};
        cur = nxt; cA = nA; cB = nB; ++ui;
    }
    PG8_WAIT_V(0);
    if (wr == 0) PG8_BAR;
    PG8_BAR;
    if constexpr (Epi::AFTER_DRAIN) { E.fused(acc, cur, wr, wc, fr, fq, lds, wid, lane); S.done(cur); }
#undef PG8_SA
#undef PG8_SB
#undef PG8_STAGE
#undef PG8_LDA
#undef PG8_LDB
#undef PG8_MMA
#undef PG8_WAIT_V
#undef PG8_WAIT_L
#undef PG8_BAR
#undef PG8_SCHED
}

}

struct EpiInproj {
  static constexpr bool PERM = true, AFTER_DRAIN = false;
  bfu* u; float* small;
  __device__ __forceinline__ void operator()(const pg8::f32x4 (&acc)[2][2][4][2], const pg8::Unit& un, int wr, int wc, int fr, int fq) const {
    const int row0 = un.pm * 256 + wr * 64 + fr;
    if (un.pn < 32) {
      const bool sig = un.pn >= 16;
      const int col0 = un.pn * 256 + wc * 32 + 8 * fq;
#pragma unroll
      for (int ai = 0; ai < 2; ++ai)
#pragma unroll
        for (int m = 0; m < 4; ++m) {
          bfu* rowp = u + (size_t)(row0 + ai * 128 + m * 16) * NU + col0;
#pragma unroll
          for (int bj = 0; bj < 2; ++bj) {
            pg8::f32x4 v0 = acc[ai][bj][m][0], v1 = acc[ai][bj][m][1];
            if (sig) {
#pragma unroll
              for (int j = 0; j < 4; ++j) { v0[j] = sigmoidf_(v0[j]); v1[j] = sigmoidf_(v1[j]); }
            }
            pg8::u32x4 w;
            w.x = pg8::cvt_pk_bf16(v0[0], v0[1]); w.y = pg8::cvt_pk_bf16(v0[2], v0[3]);
            w.z = pg8::cvt_pk_bf16(v1[0], v1[1]); w.w = pg8::cvt_pk_bf16(v1[2], v1[3]);
            *(pg8::u32x4*)(rowp + bj * 128) = w;
          }
        }
    } else if (wc == 0) {
#pragma unroll
      for (int ai = 0; ai < 2; ++ai)
#pragma unroll
        for (int m = 0; m < 4; ++m) {
          float* sp = small + (size_t)(row0 + ai * 128 + m * 16) * 32 + 8 * fq;
          *(pg8::f32x4*)(sp) = acc[ai][0][m][0];
          *(pg8::f32x4*)(sp + 4) = acc[ai][0][m][1];
        }
    }
  }
};
struct EpiResid {
  static constexpr bool PERM = false, AFTER_DRAIN = false;
  const float* xold; float* out;
  __device__ __forceinline__ void operator()(const pg8::f32x4 (&acc)[2][2][4][2], const pg8::Unit& un, int wr, int wc, int fr, int fq) const {
    const int row0 = un.pm * 256 + wr * 64 + fr, col0 = un.pn * 256 + wc * 32 + 4 * fq;
#pragma unroll
    for (int ai = 0; ai < 2; ++ai)
#pragma unroll
      for (int m = 0; m < 4; ++m) {
        const size_t off = (size_t)(row0 + ai * 128 + m * 16) * DM + col0;
#pragma unroll
        for (int bj = 0; bj < 2; ++bj)
#pragma unroll
          for (int n = 0; n < 2; ++n) {
            const pg8::f32x4 b = *(const pg8::f32x4*)(xold + off + bj * 128 + n * 16);
            *(pg8::f32x4*)(out + off + bj * 128 + n * 16) = b + acc[ai][bj][m][n];
          }
        asm volatile("" ::: "memory");
      }
  }
};
struct EpiSwiglu {
  static constexpr bool PERM = true, AFTER_DRAIN = false;
  bfu* hidden;
  __device__ __forceinline__ void operator()(const pg8::f32x4 (&acc)[2][2][4][2], const pg8::Unit& un, int wr, int wc, int fr, int fq) const {
    const int row0 = un.pm * 256 + wr * 64 + fr;
#pragma unroll
    for (int ai = 0; ai < 2; ++ai)
#pragma unroll
      for (int m = 0; m < 4; ++m) {
        bfu* rowp = hidden + (size_t)(row0 + ai * 128 + m * 16) * FH + (un.pn * 8 + wc) * 16 + 4 * fq;
#pragma unroll
        for (int bj = 0; bj < 2; ++bj) {
          const pg8::f32x4 g = acc[ai][bj][m][0], uu = acc[ai][bj][m][1];
          pg8::u32x2 w;
          w.x = pg8::cvt_pk_bf16(siluf_(g[0]) * uu[0], siluf_(g[1]) * uu[1]);
          w.y = pg8::cvt_pk_bf16(siluf_(g[2]) * uu[2], siluf_(g[3]) * uu[3]);
          *(pg8::u32x2*)(rowp + bj * 64) = w;
        }
      }
  }
};

#define XB_TMO      128
#define XB_XCNT(j)  (256  + 64 * (j))
#define XB_XSUB(j)  (1280 + 64 * (j))
#define XB_XGEN(j)  (2304 + 64 * (j))
#define XB_TOP      3328
#define XB_TOPGEN   3392
#define XCD_BAR_WORDS 3456
#define XB_SPIN_CAP (1u << 18)
#define LAS __attribute__((address_space(3)))

__device__ __forceinline__ unsigned xb_ld(unsigned* p)              { return __hip_atomic_load(p, __ATOMIC_RELAXED, __HIP_MEMORY_SCOPE_AGENT); }
__device__ __forceinline__ unsigned xb_add(unsigned* p, unsigned v) { return __hip_atomic_fetch_add(p, v, __ATOMIC_RELAXED, __HIP_MEMORY_SCOPE_AGENT); }
__device__ __forceinline__ unsigned xb_xcc_id() { return (unsigned)__builtin_amdgcn_s_getreg((3 << 11) | 20) & 0xFu; }
#define XB_SPIN(cond, bar) do { unsigned _sp = 0; while (cond) { __builtin_amdgcn_s_sleep(1); \
    if ((++_sp & 255u) == 0u) { if (xb_ld(&(bar)[XB_TMO])) break; if (_sp > XB_SPIN_CAP) { atomicAdd(&(bar)[XB_TMO], 1u); break; } } } } while (0)

struct XcdBarrier {
    unsigned* bar; unsigned x;
    volatile LAS unsigned* st;
};

__device__ __forceinline__ XcdBarrier xcd_barrier_post(unsigned* bar, volatile LAS unsigned* st) {
    XcdBarrier b; b.bar = bar; b.x = xb_xcc_id(); b.st = st;
    if (threadIdx.x == 0) (void)xb_add(&bar[XB_XCNT(b.x)], 1u);
    return b;
}
__device__ __forceinline__ void xcd_barrier_complete(unsigned* bar, unsigned x, unsigned& nloc, unsigned& nx) {
    const unsigned G = gridDim.x * gridDim.y * gridDim.z;
    unsigned sum, cnt, mine, sp = 0u;
    for (;;) {
        sum = 0u; cnt = 0u; mine = 0u;
#pragma unroll
        for (unsigned j = 0; j < 16; ++j) { const unsigned c = xb_ld(&bar[XB_XCNT(j)]); sum += c; cnt += (c > 0u) ? 1u : 0u; mine = (j == x) ? c : mine; }
        if (sum == G) break;
        __builtin_amdgcn_s_sleep(1);
        if ((++sp & 255u) == 0u) { if (xb_ld(&bar[XB_TMO])) break; if (sp > XB_SPIN_CAP) { atomicAdd(&bar[XB_TMO], 1u); break; } }
    }
    nloc = mine > 0u ? mine : 1u; nx = cnt > 0u ? cnt : 1u;
}

__device__ __forceinline__ void xcd_barrier(const XcdBarrier& b) {
    asm volatile("s_waitcnt vmcnt(0)" ::: "memory");
    __syncthreads();
    if (threadIdx.x == 0) {
        unsigned* bar = b.bar;
        __builtin_amdgcn_s_waitcnt(0);
        unsigned nloc = b.st[0], nx = b.st[1];
        if (nloc == 0u) { xcd_barrier_complete(bar, b.x, nloc, nx); b.st[0] = nloc; b.st[1] = nx; }
        const unsigned old = xb_add(&bar[XB_XSUB(b.x)], 1u);
        const unsigned gen = old / nloc;
        if (old + 1u == (gen + 1u) * nloc) {
            __builtin_amdgcn_fence(__ATOMIC_RELEASE, "agent");
            asm volatile("s_waitcnt vmcnt(0)" ::: "memory");
            const unsigned og = xb_add(&bar[XB_TOP], 1u);
            const unsigned tg = og / nx;
            if (og + 1u == (tg + 1u) * nx) xb_add(&bar[XB_TOPGEN], 1u);
            else XB_SPIN(xb_ld(&bar[XB_TOPGEN]) == tg, bar);
            __builtin_amdgcn_fence(__ATOMIC_ACQUIRE, "agent");
            xb_add(&bar[XB_XGEN(b.x)], 1u);
            asm volatile("s_waitcnt vmcnt(0)" ::: "memory");
        } else {
            XB_SPIN(xb_ld(&bar[XB_XGEN(b.x)]) == gen, bar);
            __builtin_amdgcn_fence(__ATOMIC_ACQUIRE, "agent");
            asm volatile("s_waitcnt vmcnt(0)" ::: "memory");
        }
    }
    __syncthreads();
}


__global__ void __launch_bounds__(NTHREADS, 2) mega(Params p_in, int ph_lo, int ph_hi, int use_cg) {
  extern __shared__ __attribute__((aligned(16))) unsigned char smem_raw[];
  __shared__ uint4 xb_words;
  if (threadIdx.x == 0) xb_words = make_uint4(0u, 0u, 0u, 0u);
  __syncthreads();
  const XcdBarrier xbar = xcd_barrier_post((unsigned*)(p_in.ws + OFF_bar), (volatile LAS unsigned*)&xb_words);
  for (int ph = ph_lo; ph < ph_hi; ++ph) {
#if PROBE_DUP >= 0
    const int l = ph / (PH_PER_LAYER + 1);
    const int ks = ph - l * (PH_PER_LAYER + 1);
    const int k = (ks <= PROBE_DUP) ? ks : ks - 1;
    const int wr = (ks == PROBE_DUP) ? 0 : 1;
#else
    const int wr = 1;
    const int l = ph / PH_PER_LAYER, k = ph - l * PH_PER_LAYER;
#endif
    int t512 = threadIdx.x;
    asm volatile("" : "+v"(t512));
    const int tid = t512 & 255;
    const int half = __builtin_amdgcn_readfirstlane(t512 >> 8);
    const int vb = blockIdx.x * 2 + half, vg = gridDim.x * 2;
    bfu* smem = reinterpret_cast<bfu*>(smem_raw + half * SMEM_HALF);
    CParams* pp = (CParams*)__builtin_amdgcn_kernarg_segment_ptr();
    asm volatile("" : "+s"(pp));
    CParams& p = *pp;
    switch (k) {
      case 0: phase_convert_norm(p, l, smem, tid, vb, vg); break;
      case 1: {
        pg8::Gemm g; g.A = (bfu*)(p.ws + OFF_h); g.Bt = (bfu*)(p.ws + OFF_WinT); g.M = S_LEN; g.N = NINP; g.K = DM;
        pg8::StaticOrder so; so.init(S_LEN, NINP, gridDim.x, blockIdx.x);
        EpiInproj e; e.u = (bfu*)(p.ws + OFF_u); e.small = (float*)(p.ws + OFF_small);
        pg8::gemm_phase<EpiInproj, pg8::StaticOrder>((PG8_LAS unsigned char*)smem_raw, g, so, e);
      } break;
      case 2: phase_prep(p, l, smem, tid, wr, vb, vg); break;
      case 3: phase_scan(p, smem, tid, wr, vb, vg); break;
      case 4: phase_mix(p, l, smem, tid, half, ph, smem_raw); break;
      case 5: phase_upmerge(p, smem, tid, vb, vg, half, smem_raw); break;
      case 6: {
        pg8::Gemm g; g.A = (bfu*)(p.ws + OFF_h); g.Bt = (bfu*)(p.ws + OFF_WoutT); g.M = S_LEN; g.N = DM; g.K = DM;
        pg8::StaticOrder so; so.init(S_LEN, DM, gridDim.x, blockIdx.x);
        EpiResid e; e.xold = (l == 0 ? p.in[0] : p.out); e.out = p.out;
        pg8::gemm_phase<EpiResid, pg8::StaticOrder>((PG8_LAS unsigned char*)smem_raw, g, so, e);
      } break;
      case 7: phase_norm2(p, l, tid, vb, vg); break;
      case 8: {
        pg8::Gemm g; g.A = (bfu*)(p.ws + OFF_h); g.Bt = (bfu*)(p.ws + OFF_WfiT); g.M = S_LEN; g.N = 2 * FH; g.K = DM;
        pg8::StaticOrder so; so.init(S_LEN, 2 * FH, gridDim.x, blockIdx.x);
        EpiSwiglu e; e.hidden = (bfu*)(p.ws + OFF_u);
        pg8::gemm_phase<EpiSwiglu, pg8::StaticOrder>((PG8_LAS unsigned char*)smem_raw, g, so, e);
      } break;
      default: {
        pg8::Gemm g; g.A = (bfu*)(p.ws + OFF_u); g.Bt = (bfu*)(p.ws + OFF_WfoT); g.M = S_LEN; g.N = DM; g.K = FH;
        pg8::StaticOrder so; so.init(S_LEN, DM, gridDim.x, blockIdx.x);
        EpiResid e; e.xold = p.out; e.out = p.out;
        pg8::gemm_phase<EpiResid, pg8::StaticOrder>((PG8_LAS unsigned char*)smem_raw, g, so, e);
      } break;
    }
    if (ph + 1 < ph_hi) {
      if (use_cg) cg::this_grid().sync();
      else xcd_barrier(xbar);
    }
  }
}

#ifndef MK_COOP
#define MK_COOP 1
#endif

extern "C" void kernel_launch(void* const* d_in, const int* in_sizes, int n_in, void* d_out, int out_size, void* d_ws,
                              size_t ws_size, hipStream_t stream) {
  Params p{};
  for (int i = 0; i < 25; ++i) p.in[i] = reinterpret_cast<const float*>(d_in[i]);
  p.out = reinterpret_cast<float*>(d_out);
  p.ws = reinterpret_cast<unsigned char*>(d_ws);
  if (WS_NEED > ws_size) { fprintf(stderr, "workspace too small: need %zu have %zu\n", (size_t)WS_NEED, ws_size); return; }

  static int grid_blocks = 0;
  if (!grid_blocks) {
    (void)hipFuncSetAttribute((const void*)mega, hipFuncAttributeMaxDynamicSharedMemorySize, SMEM_BYTES);
    int dev = 0, cus = 0, per_cu = 0;
    (void)hipGetDevice(&dev);
    (void)hipDeviceGetAttribute(&cus, hipDeviceAttributeMultiprocessorCount, dev);
    (void)hipOccupancyMaxActiveBlocksPerMultiprocessor(&per_cu, mega, NTHREADS, SMEM_BYTES);
    per_cu = 1;
    grid_blocks = cus * per_cu;
  }
  const int nph = 4 * (PH_PER_LAYER + (PROBE_DUP >= 0 ? 1 : 0));
#if MK_COOP
  int lo = 0, hi = nph, use_cg = 0;
  void* args[] = {&p, &lo, &hi, &use_cg};
  (void)hipMemsetAsync(p.ws + OFF_bar, 0, 16384, stream);
  hipError_t e = hipLaunchCooperativeKernel((const void*)mega, dim3(grid_blocks), dim3(NTHREADS), args, SMEM_BYTES, stream);
  if (e != hipSuccess) fprintf(stderr, "cooperative launch failed: %s (grid %d)\n", hipGetErrorString(e), grid_blocks);
#else
  for (int ph = 0; ph < nph; ++ph)
    hipLaunchKernelGGL(mega, dim3(grid_blocks), dim3(NTHREADS), SMEM_BYTES, stream, p, ph, ph + 1, 0);
#endif
}
```

```cpp
#include <hip/hip_runtime.h>
#include <hip/hip_bf16.h>
#include <hip/hip_cooperative_groups.h>
#include <cstdio>
namespace cg = cooperative_groups;

typedef __attribute__((ext_vector_type(8))) short bf16x8;
typedef __attribute__((ext_vector_type(4))) float f32x4;
typedef unsigned short bfu;

#define S_LEN 16384
#define DM 1024
#define NU 8192
#define NINP 8448
#define NSRC 8220
#define FH 2816
#define NCH 256
#define LDP 72
#define YW 1280
#define EPS 1e-6f
#define SMEM_HALF 73728
#define SMEM_BYTES 147456
#define NTHREADS 512
#define PH_PER_LAYER 10
#ifndef PROBE_DUP
#define PROBE_DUP -1
#endif

struct Params {
  const float* in[25];
  float* out;
  unsigned char* ws;
};
typedef const __attribute__((address_space(4))) Params CParams;
constexpr size_t OFF_WinT = 0;
constexpr size_t OFF_WupT = OFF_WinT + (((size_t)NINP*DM*2 + 255) & ~(size_t)255);
constexpr size_t OFF_WoutT = OFF_WupT + (((size_t)DM*YW*2 + 255) & ~(size_t)255);
constexpr size_t OFF_WfiT = OFF_WoutT + (((size_t)DM*DM*2 + 255) & ~(size_t)255);
constexpr size_t OFF_WfoT = OFF_WfiT + (((size_t)2*FH*DM*2 + 255) & ~(size_t)255);
constexpr size_t OFF_u = OFF_WfoT + (((size_t)DM*FH*2 + 255) & ~(size_t)255);
constexpr size_t OFF_small = OFF_u + (((size_t)S_LEN*NU*2 + 255) & ~(size_t)255);
constexpr size_t OFF_h = OFF_small + (((size_t)S_LEN*32*4 + 255) & ~(size_t)255);
constexpr size_t OFF_y = OFF_h + (((size_t)S_LEN*DM*2 + 255) & ~(size_t)255);
constexpr size_t OFF_ssq = OFF_y + (((size_t)S_LEN*YW*2 + 255) & ~(size_t)255);
constexpr size_t OFF_foxq = OFF_ssq + (((size_t)S_LEN*8*4 + 255) & ~(size_t)255);
constexpr size_t OFF_foxk = OFF_foxq + (((size_t)4*S_LEN*64*2 + 255) & ~(size_t)255);
constexpr size_t OFF_foxvT = OFF_foxk + (((size_t)4*S_LEN*64*2 + 255) & ~(size_t)255);
constexpr size_t OFF_foxc = OFF_foxvT + (((size_t)4*S_LEN*64*2 + 255) & ~(size_t)255);
constexpr size_t OFF_foxtot = OFF_foxc + (((size_t)4*S_LEN*4 + 255) & ~(size_t)255);
constexpr size_t OFF_VT = OFF_foxtot + (((size_t)4*NCH*4 + 255) & ~(size_t)255);
constexpr size_t OFF_ST = OFF_VT + (((size_t)16*NCH*4096*2 + 255) & ~(size_t)255);
constexpr size_t OFF_dec = OFF_ST + (((size_t)16*NCH*4096*2 + 255) & ~(size_t)255);
constexpr size_t OFF_csb = OFF_dec + (((size_t)16*NCH*64*4 + 255) & ~(size_t)255);
constexpr size_t OFF_ssdX = OFF_csb + (((size_t)16*S_LEN*4 + 255) & ~(size_t)255);
constexpr size_t OFF_ssdB = OFF_ssdX + (((size_t)S_LEN*512*2 + 255) & ~(size_t)255);
constexpr size_t OFF_ssdC = OFF_ssdB + (((size_t)2*S_LEN*64*2 + 255) & ~(size_t)255);
constexpr size_t OFF_rcos = OFF_ssdC + (((size_t)2*S_LEN*64*2 + 255) & ~(size_t)255);
constexpr size_t OFF_rsin = OFF_rcos + (((size_t)S_LEN*32*4 + 255) & ~(size_t)255);
constexpr size_t OFF_ctr = OFF_rsin + (((size_t)S_LEN*32*4 + 255) & ~(size_t)255);
constexpr size_t OFF_bar = OFF_ctr + (((size_t)256 + 255) & ~(size_t)255);
constexpr size_t WS_NEED = OFF_bar + 16384;

__device__ __forceinline__ bfu f2bf(float f) {
  unsigned u = __float_as_uint(f);
  u += 0x7fffu + ((u >> 16) & 1u);
  return (bfu)(u >> 16);
}
__device__ __forceinline__ float bf2f(bfu b) { return __uint_as_float(((unsigned)b) << 16); }
__device__ __forceinline__ float sigmoidf_(float x) { return 1.f / (1.f + __expf(-x)); }
__device__ __forceinline__ float siluf_(float x) { return x / (1.f + __expf(-x)); }
__device__ __forceinline__ float logsigmoidf_(float z) { return fminf(z, 0.f) - log1pf(expf(-fabsf(z))); }
__device__ __forceinline__ float logsigmoid_fast(float z) { return fminf(z, 0.f) - __logf(1.f + __expf(-fabsf(z))); }
__device__ __forceinline__ float softplus_fast(float z) { return fmaxf(z, 0.f) + __logf(1.f + __expf(-fabsf(z))); }
__device__ __forceinline__ float softplusf_(float z) { return fmaxf(z, 0.f) + log1pf(expf(-fabsf(z))); }

namespace pg8 { __device__ __forceinline__ unsigned cvt_pk_bf16(float lo, float hi); }
__device__ __forceinline__ bf16x8 lds_frag(const bfu* base, int row, int kofs, int stride) {
  return *reinterpret_cast<const bf16x8*>(base + row * stride + kofs);
}

__device__ __forceinline__ void mma16x64(f32x4 (&acc)[4], const bfu* sA, int arow0, const bfu* sB, int lane) {
  const int r = lane & 15, q = (lane >> 4) * 8;
#pragma unroll
  for (int ks = 0; ks < 2; ++ks) {
    bf16x8 a = lds_frag(sA, arow0 + r, ks * 32 + q, LDP);
#pragma unroll
    for (int n = 0; n < 4; ++n) {
      bf16x8 b = lds_frag(sB, n * 16 + r, ks * 32 + q, LDP);
      acc[n] = __builtin_amdgcn_mfma_f32_16x16x32_bf16(a, b, acc[n], 0, 0, 0);
    }
  }
}

__device__ __forceinline__ void load_tile64(bfu* s, const bfu* g, int gs, int tid) {
#pragma unroll
  for (int i = 0; i < 2; ++i) {
    int id = tid + i * 256;
    int r = id >> 3, c = (id & 7) * 8;
    *reinterpret_cast<uint4*>(s + r * LDP + c) = *reinterpret_cast<const uint4*>(g + (size_t)r * gs + c);
  }
}

template <int NI>
__device__ __forceinline__ void gemm_main(f32x4 (&acc)[4][NI], const bfu* __restrict__ A, int lda,
                                          const bfu* __restrict__ Bt, int ldb, int K, bfu* smem, int tid) {
  bfu* sA = smem;
  bfu* sB = smem + 2 * 128 * LDP;
  const int lane = tid & 63, w = tid >> 6, wm = w >> 1, wn = w & 1;
  const int lr = lane & 15, lq = (lane >> 4) * 8;
  const int crow = tid >> 3, ccol = (tid & 7) * 8;
  const bfu* Ap = A + (size_t)crow * lda + ccol;
  const bfu* Bp = Bt + (size_t)crow * ldb + ccol;
  uint4 ra[4], rb[NI];
#pragma unroll
  for (int i = 0; i < 4; ++i) ra[i] = *reinterpret_cast<const uint4*>(Ap + (size_t)i * 32 * lda);
#pragma unroll
  for (int i = 0; i < NI; ++i) rb[i] = *reinterpret_cast<const uint4*>(Bp + (size_t)i * 32 * ldb);
#pragma unroll
  for (int i = 0; i < 4; ++i) *reinterpret_cast<uint4*>(sA + (crow + i * 32) * LDP + ccol) = ra[i];
#pragma unroll
  for (int i = 0; i < NI; ++i) *reinterpret_cast<uint4*>(sB + (crow + i * 32) * LDP + ccol) = rb[i];
  __syncthreads();
  const int nk = K >> 6;
  for (int kt = 0; kt < nk; ++kt) {
    const int cur = kt & 1;
    if (kt + 1 < nk) {
      const int ko = (kt + 1) * 64;
#pragma unroll
      for (int i = 0; i < 4; ++i) ra[i] = *reinterpret_cast<const uint4*>(Ap + (size_t)i * 32 * lda + ko);
#pragma unroll
      for (int i = 0; i < NI; ++i) rb[i] = *reinterpret_cast<const uint4*>(Bp + (size_t)i * 32 * ldb + ko);
    }
    const bfu* a_s = sA + cur * 128 * LDP + (wm * 64) * LDP;
    const bfu* b_s = sB + cur * 128 * LDP + (wn * NI * 16) * LDP;
#pragma unroll
    for (int ks = 0; ks < 2; ++ks) {
      bf16x8 af[4], bfr[NI];
#pragma unroll
      for (int mi = 0; mi < 4; ++mi) af[mi] = lds_frag(a_s, mi * 16 + lr, ks * 32 + lq, LDP);
#pragma unroll
      for (int ni = 0; ni < NI; ++ni) bfr[ni] = lds_frag(b_s, ni * 16 + lr, ks * 32 + lq, LDP);
#pragma unroll
      for (int mi = 0; mi < 4; ++mi)
#pragma unroll
        for (int ni = 0; ni < NI; ++ni)
          acc[mi][ni] = __builtin_amdgcn_mfma_f32_16x16x32_bf16(af[mi], bfr[ni], acc[mi][ni], 0, 0, 0);
    }
    if (kt + 1 < nk) {
      bfu* sAn = sA + (cur ^ 1) * 128 * LDP;
      bfu* sBn = sB + (cur ^ 1) * 128 * LDP;
#pragma unroll
      for (int i = 0; i < 4; ++i) *reinterpret_cast<uint4*>(sAn + (crow + i * 32) * LDP + ccol) = ra[i];
#pragma unroll
      for (int i = 0; i < NI; ++i) *reinterpret_cast<uint4*>(sBn + (crow + i * 32) * LDP + ccol) = rb[i];
    }
    __syncthreads();
  }
}

template <int NI>
__device__ __forceinline__ void zero_acc(f32x4 (&acc)[4][NI]) {
#pragma unroll
  for (int i = 0; i < 4; ++i)
#pragma unroll
    for (int j = 0; j < NI; ++j) acc[i][j] = (f32x4){0.f, 0.f, 0.f, 0.f};
}

__device__ __forceinline__ int win_src(int dc) {
  if (dc < 768) return dc;
  if (dc < 1536) return dc + 4;
  if (dc < 4096) return dc + 20;
  if (dc < 8192) return dc + 28;
  int s = dc - 8192;
  if (s < 4) return 768 + s;
  if (s < 20) return 1540 + (s - 4);
  if (s < 28) return 4116 + (s - 20);
  return -1;
}
__device__ __forceinline__ int ffi_src(int dc) {
  const int G = dc >> 5, w = dc & 31, f = w >> 3, r = w & 7;
  return (r < 4) ? (G * 16 + f * 4 + r) : (FH + G * 16 + f * 4 + (r - 4));
}

__device__ __forceinline__ void convert_tile(const float* __restrict__ W, int ldw, int kt, int ntd, bfu* __restrict__ Wt,
                                             int ldt, int kofs, int mode, const float* __restrict__ rowgain,
                                             bfu* sT, int tid) {
  const int c4 = (tid & 15) * 4, r0 = tid >> 4;
  const int dc = ntd * 64 + c4;
  int sc = dc;
  if (mode == 1) sc = win_src(dc);
  else if (mode == 2) sc = ffi_src(dc);
  float4 v[8];
  float gg[8];
#pragma unroll
  for (int ps = 0; ps < 8; ++ps) {
    const int k = kt * 64 + r0 + ps * 16;
    v[ps] = make_float4(0.f, 0.f, 0.f, 0.f);
    if (sc >= 0) v[ps] = *reinterpret_cast<const float4*>(W + (size_t)k * ldw + sc);
    gg[ps] = rowgain ? rowgain[k] : 1.f;
  }
#pragma unroll
  for (int ps = 0; ps < 8; ++ps) {
    const int kk = r0 + (ps & 3) * 16;
    bfu* sTt = sT + (ps >> 2) * 64 * LDP;
    const float g = gg[ps];
    sTt[(c4 + 0) * LDP + kk] = f2bf(v[ps].x * g);
    sTt[(c4 + 1) * LDP + kk] = f2bf(v[ps].y * g);
    sTt[(c4 + 2) * LDP + kk] = f2bf(v[ps].z * g);
    sTt[(c4 + 3) * LDP + kk] = f2bf(v[ps].w * g);
  }
  __syncthreads();
#pragma unroll
  for (int i = 0; i < 4; ++i) {
    const int id = tid + (i & 1) * 256;
    const int nn = id >> 3, kc = (id & 7) * 8;
    const int tt = i >> 1;
    *reinterpret_cast<uint4*>(Wt + (size_t)(ntd * 64 + nn) * ldt + kofs + (kt + tt) * 64 + kc) =
        *reinterpret_cast<const uint4*>(sT + tt * 64 * LDP + nn * LDP + kc);
  }
  __syncthreads();
}

__device__ __forceinline__ void norm_rows2(const float* __restrict__ x, const float* __restrict__ g, bfu* __restrict__ h,
                                           int row0, int lane) {
  float4 v[2][4];
#pragma unroll
  for (int r = 0; r < 2; ++r)
#pragma unroll
    for (int i = 0; i < 4; ++i) v[r][i] = *reinterpret_cast<const float4*>(x + (size_t)(row0 + r) * DM + i * 256 + lane * 4);
  float4 gg[4];
#pragma unroll
  for (int i = 0; i < 4; ++i) gg[i] = *reinterpret_cast<const float4*>(g + i * 256 + lane * 4);
#pragma unroll
  for (int r = 0; r < 2; ++r) {
    float ss = 0.f;
#pragma unroll
    for (int i = 0; i < 4; ++i)
      ss += v[r][i].x * v[r][i].x + v[r][i].y * v[r][i].y + v[r][i].z * v[r][i].z + v[r][i].w * v[r][i].w;
#pragma unroll
    for (int m = 1; m < 64; m <<= 1) ss += __shfl_xor(ss, m, 64);
    const float rstd = rsqrtf(ss * (1.f / DM) + EPS);
#pragma unroll
    for (int i = 0; i < 4; ++i) {
      uint2 o;
      o.x = pg8::cvt_pk_bf16(v[r][i].x * rstd * gg[i].x, v[r][i].y * rstd * gg[i].y);
      o.y = pg8::cvt_pk_bf16(v[r][i].z * rstd * gg[i].z, v[r][i].w * rstd * gg[i].w);
      *reinterpret_cast<uint2*>(h + (size_t)(row0 + r) * DM + i * 256 + lane * 4) = o;
    }
  }
}

__device__ void phase_convert_norm(CParams& p_o, int l, bfu* smem, int tid, int vb, int vg) {
  const int nconv = 2400, nnorm = 2048;
  const int nrot = (l == 0) ? 64 : 0;
  const int total = nconv + nnorm + nrot;
  if (l == 0 && vb == 0 && tid < 64) ((unsigned*)(p_o.ws + OFF_ctr))[tid] = 0u;
  for (int it = vb; it < total; it += vg) {
    CParams* pp_ = &p_o;
    asm volatile("" : "+s"(pp_));
    CParams& p = *pp_;
    if (it < nconv) {
      if (it < 1056) {
        int kt = (it & 7) * 2, nt = it >> 3;
        convert_tile(p.in[4] + (size_t)l * DM * NSRC, NSRC, kt, nt, ((bfu*)(p.ws + OFF_WinT)), DM, 0, 1, nullptr, smem, tid);
      } else if (it < 1152) {
        int j = it - 1056; int br = j >> 5; j &= 31;
        int kt = (j & 1) * 2, nt = j >> 1;
        const float* W = (br == 0 ? p.in[18] : (br == 1 ? p.in[19] : p.in[20])) + (size_t)l * 256 * DM;
        convert_tile(W, DM, kt, nt, ((bfu*)(p.ws + OFF_WupT)), YW, br * 256, 0, nullptr, smem, tid);
      } else if (it < 1216) {
        int j = it - 1152; int kt = (j & 3) * 2, nt = j >> 2;
        convert_tile(p.in[21] + (size_t)l * 512 * DM, DM, kt, nt, ((bfu*)(p.ws + OFF_WupT)), YW, 768, 0, p.in[17] + l * 512, smem, tid);
      } else if (it < 1344) {
        int j = it - 1216; int kt = (j & 7) * 2, nt = j >> 3;
        convert_tile(p.in[22] + (size_t)l * DM * DM, DM, kt, nt, ((bfu*)(p.ws + OFF_WoutT)), DM, 0, 0, nullptr, smem, tid);
      } else if (it < 2048) {
        int j = it - 1344; int kt = (j & 7) * 2, nt = j >> 3;
        convert_tile(p.in[23] + (size_t)l * DM * 2 * FH, 2 * FH, kt, nt, ((bfu*)(p.ws + OFF_WfiT)), DM, 0, 2, nullptr, smem, tid);
      } else {
        int j = it - 2048; int kt = (j % 22) * 2, nt = j / 22;
        convert_tile(p.in[24] + (size_t)l * FH * DM, DM, kt, nt, ((bfu*)(p.ws + OFF_WfoT)), FH, 0, 0, nullptr, smem, tid);
      }
    } else if (it < nconv + nnorm) {
      norm_rows2((l == 0 ? p.in[0] : p.out), p.in[2] + l * DM, (bfu*)(p.ws + OFF_h), (it - nconv) * 8 + (tid >> 6) * 2, tid & 63);
    } else {
      int base = (it - nconv - nnorm) * 256;
      for (int e = tid; e < 256 * 32; e += 256) {
        int tok = base + (e >> 5), i = e & 31;
        float inv = powf(10000.f, -(float)i / 32.f);
        float ang = (float)((const int*)p.in[1])[tok] * inv;
        double a = (double)ang;
        double kq = rint(a * 0.15915494309189535);
        float r = (float)(a - kq * 6.283185307179586);
        ((float*)(p.ws + OFF_rcos))[tok * 32 + i] = cosf(r);
        ((float*)(p.ws + OFF_rsin))[tok * 32 + i] = sinf(r);
      }
    }
  }
}

__device__ void phase_norm2(CParams& p, int l, int tid, int vb, int vg) {
  for (int it = vb; it < 2048; it += vg)
    norm_rows2(p.out, p.in[3] + l * DM, (bfu*)(p.ws + OFF_h), it * 8 + (tid >> 6) * 2, tid & 63);
}

__device__ __forceinline__ float wave_incl_scan(float v, int lane) {
#pragma unroll
  for (int d = 1; d < 64; d <<= 1) {
    float o = __shfl_up(v, d, 64);
    if (lane >= d) v += o;
  }
  return v;
}

__device__ void phase_prep(CParams& p_o, int l, bfu* smem, int tid, int wr, int vb, int vg) {
  bfu* sK = smem;
  bfu* sV = smem + 64 * LDP;
  float* sF = reinterpret_cast<float*>(smem + 2 * 64 * LDP);
  float* s_glr = sF;
  float* s_seg = sF + 1024;
  float* s_ps = sF + 1280;
  float* s_cs = sF + 1344;
  float* s_dt = sF + 1408;
  const int lane = tid & 63, seg = tid >> 6, col = lane;
  const int total = NCH * 20;
  for (int it = vb; it < total; it += vg) {
    CParams* pp_ = &p_o;
    asm volatile("" : "+s"(pp_));
    CParams& p = *pp_;
    const int c = it / 20, hs = it - c * 20;
    const int tok0 = c * 64;
    bfu kreg[16], vreg[16];
    if (hs < 4) {
      const int h = hs;
      for (int i = tid; i < 1024; i += 256) s_glr[i] = ((float*)(p.ws + OFF_small))[(tok0 + (i >> 4)) * 32 + 4 + (i & 15)];
      float wv[16];
#pragma unroll
      for (int r = 0; r < 16; ++r) wv[r] = p.in[8][(l * 16 + r) * 256 + h * 64 + col];
      const float bias = p.in[9][l * 256 + h * 64 + col];
      bfu qraw[16], kraw[16];
#pragma unroll
      for (int i = 0; i < 16; ++i) {
        const bfu* ur = ((bfu*)(p.ws + OFF_u)) + (size_t)(tok0 + seg * 16 + i) * NU + h * 64 + col;
        qraw[i] = ur[768]; kraw[i] = ur[1024]; vreg[i] = ur[1280];
      }
      __syncthreads();
      float lb[16];
      float run = 0.f;
#pragma unroll
      for (int i = 0; i < 16; ++i) {
        int t = seg * 16 + i;
        float z = bias;
#pragma unroll
        for (int r = 0; r < 16; ++r) z += s_glr[t * 16 + r] * wv[r];
        run += logsigmoid_fast(z) * (1.f / 16.f);
        lb[i] = run;
      }
      s_seg[seg * 64 + col] = run;
      __syncthreads();
      float pre = 0.f, blast = 0.f;
#pragma unroll
      for (int s2 = 0; s2 < 4; ++s2) {
        float v = s_seg[s2 * 64 + col];
        if (s2 < seg) pre += v;
        blast += v;
      }
      if (seg == 0) {
        float e = __expf(blast);
        s_ps[col] = e;
        ((float*)(p.ws + OFF_dec))[(hs * NCH + c) * 64 + col] = e;
        ((float*)(p.ws + OFF_csb))[hs * S_LEN + tok0 + col] = 0.f;
      }
#pragma unroll
      for (int i = 0; i < 16; ++i) {
        int tok = tok0 + seg * 16 + i;
        float b = lb[i] + pre;
        bfu* ur = ((bfu*)(p.ws + OFF_u)) + (size_t)tok * NU + h * 64 + col;
        float q = bf2f(qraw[i]), k = bf2f(kraw[i]);
        bfu qd = f2bf(q * 0.125f * __expf(b));
        bfu ki = f2bf(k * __expf(-b));
        if (wr) { ur[768] = qd; ur[1024] = ki; }
        kreg[i] = ki;
      }
    } else if (hs < 8) {
      const int h = hs - 4;
      const float lg = log1pf(-exp2f(-5.f - (float)h));
      if (seg == 0) {
        s_ps[col] = 1.f;
        ((float*)(p.ws + OFF_dec))[(hs * NCH + c) * 64 + col] = __expf(64.f * lg);
        ((float*)(p.ws + OFF_csb))[hs * S_LEN + tok0 + col] = (float)(col + 1) * lg;
      }
#pragma unroll
      for (int i = 0; i < 16; ++i) {
        int t = seg * 16 + i, tok = tok0 + t;
        float cs = ((float*)(p.ws + OFF_rcos))[tok * 32 + (col & 31)], sn = ((float*)(p.ws + OFF_rsin))[tok * 32 + (col & 31)];
        bfu* ur = ((bfu*)(p.ws + OFF_u)) + (size_t)tok * NU + h * 64;
        float qo = bf2f(ur[1792 + col]), qx = bf2f(ur[1792 + (col ^ 32)]);
        float ko = bf2f(ur[2048 + col]), kx = bf2f(ur[2048 + (col ^ 32)]);
        vreg[i] = ur[2304 + col];
        float qr, kr;
        if (col < 32) { qr = qo * cs - qx * sn; kr = ko * cs - kx * sn; }
        else          { qr = qx * sn + qo * cs; kr = kx * sn + ko * cs; }
        kr *= 0.125f;
        bfu kb = f2bf(kr);
        if (wr) { ur[1792 + col] = f2bf(qr); ur[2048 + col] = kb; }
        kreg[i] = f2bf(bf2f(kb) * __expf(lg * (float)(63 - t)));
      }
    } else if (hs < 16) {
      const int h = hs - 8, g = h >> 2;
      const int chx = h * 64 + col, chb = 512 + g * 64 + col, chc = 640 + g * 64 + col;
      bfu xin[19], bin[19], cin[19];
      {
        const int tb = tok0 + seg * 16 - 3;
        const bfu* ub = ((bfu*)(p.ws + OFF_u)) + 3328;
#pragma unroll
        for (int i = 0; i < 19; ++i) {
          const int tk = tb + i;
          const bool ok = tk >= 0;
          const bfu* ur = ub + (size_t)(ok ? tk : 0) * NU;
          xin[i] = ok ? ur[chx] : (bfu)0;
          bin[i] = ok ? ur[chb] : (bfu)0;
          cin[i] = ok ? ur[chc] : (bfu)0;
        }
      }
      if (seg == 0) {
        float dtv = softplus_fast(((float*)(p.ws + OFF_small))[(tok0 + lane) * 32 + 20 + h] + p.in[14][l * 8 + h]);
        float a = -__expf(p.in[15][l * 8 + h]);
        float cs = wave_incl_scan(dtv * a, lane);
        s_cs[lane] = cs;
        s_dt[lane] = dtv;
        ((float*)(p.ws + OFF_csb))[hs * S_LEN + tok0 + lane] = cs;
        s_ps[lane] = 1.f;
      }
      __syncthreads();
      const float cs_last = s_cs[63];
      if (seg == 0) ((float*)(p.ws + OFF_dec))[(hs * NCH + c) * 64 + col] = __expf(cs_last);
      float wx[4], wb[4], wc[4];
#pragma unroll
      for (int j = 0; j < 4; ++j) {
        wx[j] = p.in[12][(l * 4 + j) * 768 + chx];
        wb[j] = p.in[12][(l * 4 + j) * 768 + chb];
        wc[j] = p.in[12][(l * 4 + j) * 768 + chc];
      }
      const float bx = p.in[13][l * 768 + chx], bb = p.in[13][l * 768 + chb], bc = p.in[13][l * 768 + chc];
#pragma unroll
      for (int i = 0; i < 16; ++i) {
        int t = seg * 16 + i, tok = tok0 + t;
        float xs = siluf_(bx + wx[0] * bf2f(xin[i]) + wx[1] * bf2f(xin[i + 1]) + wx[2] * bf2f(xin[i + 2]) + wx[3] * bf2f(xin[i + 3]));
        float bs = siluf_(bb + wb[0] * bf2f(bin[i]) + wb[1] * bf2f(bin[i + 1]) + wb[2] * bf2f(bin[i + 2]) + wb[3] * bf2f(bin[i + 3]));
        float cv = siluf_(bc + wc[0] * bf2f(cin[i]) + wc[1] * bf2f(cin[i + 1]) + wc[2] * bf2f(cin[i + 2]) + wc[3] * bf2f(cin[i + 3]));
        bfu xb = f2bf(xs);
        ((bfu*)(p.ws + OFF_ssdX))[(size_t)tok * 512 + chx] = xb;
        if ((h & 3) == 0) {
          ((bfu*)(p.ws + OFF_ssdB))[((size_t)g * S_LEN + tok) * 64 + col] = f2bf(bs);
          ((bfu*)(p.ws + OFF_ssdC))[((size_t)g * S_LEN + tok) * 64 + col] = f2bf(cv);
        }
        vreg[i] = f2bf(xs * s_dt[t]);
        kreg[i] = f2bf(bs * __expf(cs_last - s_cs[t]));
      }
    } else {
      const int h = hs - 16;
      if (seg == 0) {
        float lf = logsigmoid_fast(((float*)(p.ws + OFF_small))[(tok0 + lane) * 32 + h] + p.in[5][l * 4 + h]);
        float cs = wave_incl_scan(lf, lane);
        ((float*)(p.ws + OFF_foxc))[h * S_LEN + tok0 + lane] = cs;
        if (lane == 63) ((float*)(p.ws + OFF_foxtot))[h * NCH + c] = cs;
      }
      const float qg = p.in[6][l * 64 + col], kg = p.in[7][l * 64 + col];
#pragma unroll
      for (int i = 0; i < 16; ++i) {
        int tok = tok0 + seg * 16 + i;
        const bfu* ur = ((bfu*)(p.ws + OFF_u)) + (size_t)tok * NU + h * 64 + col;
        float q = bf2f(ur[0]), k = bf2f(ur[256]);
        vreg[i] = ur[512];
        float sq = q * q, sk = k * k;
#pragma unroll
        for (int m = 1; m < 64; m <<= 1) { sq += __shfl_xor(sq, m, 64); sk += __shfl_xor(sk, m, 64); }
        ((bfu*)(p.ws + OFF_foxq))[((size_t)h * S_LEN + tok) * 64 + col] = f2bf(q * rsqrtf(sq * (1.f / 64.f) + EPS) * qg * (0.125f * 1.44269504088896f));
        ((bfu*)(p.ws + OFF_foxk))[((size_t)h * S_LEN + tok) * 64 + col] = f2bf(k * rsqrtf(sk * (1.f / 64.f) + EPS) * kg);
      }
      uint4 v0, v1;
      v0.x = vreg[0] | ((unsigned)vreg[1] << 16); v0.y = vreg[2] | ((unsigned)vreg[3] << 16);
      v0.z = vreg[4] | ((unsigned)vreg[5] << 16); v0.w = vreg[6] | ((unsigned)vreg[7] << 16);
      v1.x = vreg[8] | ((unsigned)vreg[9] << 16); v1.y = vreg[10] | ((unsigned)vreg[11] << 16);
      v1.z = vreg[12] | ((unsigned)vreg[13] << 16); v1.w = vreg[14] | ((unsigned)vreg[15] << 16);
      bfu* dst = ((bfu*)(p.ws + OFF_foxvT)) + ((size_t)h * 64 + col) * S_LEN + tok0 + seg * 16;
      *reinterpret_cast<uint4*>(dst) = v0;
      *reinterpret_cast<uint4*>(dst + 8) = v1;
      continue;
    }
    {
      uint4 k0, k1, v0, v1;
      k0.x = kreg[0] | ((unsigned)kreg[1] << 16); k0.y = kreg[2] | ((unsigned)kreg[3] << 16);
      k0.z = kreg[4] | ((unsigned)kreg[5] << 16); k0.w = kreg[6] | ((unsigned)kreg[7] << 16);
      k1.x = kreg[8] | ((unsigned)kreg[9] << 16); k1.y = kreg[10] | ((unsigned)kreg[11] << 16);
      k1.z = kreg[12] | ((unsigned)kreg[13] << 16); k1.w = kreg[14] | ((unsigned)kreg[15] << 16);
      v0.x = vreg[0] | ((unsigned)vreg[1] << 16); v0.y = vreg[2] | ((unsigned)vreg[3] << 16);
      v0.z = vreg[4] | ((unsigned)vreg[5] << 16); v0.w = vreg[6] | ((unsigned)vreg[7] << 16);
      v1.x = vreg[8] | ((unsigned)vreg[9] << 16); v1.y = vreg[10] | ((unsigned)vreg[11] << 16);
      v1.z = vreg[12] | ((unsigned)vreg[13] << 16); v1.w = vreg[14] | ((unsigned)vreg[15] << 16);
      *reinterpret_cast<uint4*>(sK + col * LDP + seg * 16) = k0;
      *reinterpret_cast<uint4*>(sK + col * LDP + seg * 16 + 8) = k1;
      *reinterpret_cast<uint4*>(sV + col * LDP + seg * 16) = v0;
      *reinterpret_cast<uint4*>(sV + col * LDP + seg * 16 + 8) = v1;
      bfu* dst = ((bfu*)(p.ws + OFF_VT)) + (((size_t)hs * NCH + c) * 64 + col) * 64 + seg * 16;
      *reinterpret_cast<uint4*>(dst) = v0;
      *reinterpret_cast<uint4*>(dst + 8) = v1;
    }
    __syncthreads();
    {
      f32x4 acc[4];
#pragma unroll
      for (int n = 0; n < 4; ++n) acc[n] = (f32x4){0.f, 0.f, 0.f, 0.f};
      {
        const int r = lane & 15, q8 = (lane >> 4) * 8;
#pragma unroll
        for (int ks = 0; ks < 2; ++ks) {
          const bf16x8 vfr = lds_frag(sV, seg * 16 + r, ks * 32 + q8, LDP);
#pragma unroll
          for (int n = 0; n < 4; ++n)
            acc[n] = __builtin_amdgcn_mfma_f32_16x16x32_bf16(lds_frag(sK, n * 16 + r, ks * 32 + q8, LDP), vfr, acc[n], 0, 0, 0);
        }
      }
      bfu* st = ((bfu*)(p.ws + OFF_ST)) + ((size_t)hs * NCH + c) * 4096 + (seg * 16 + (lane & 15)) * 64 + (lane >> 4) * 4;
#pragma unroll
      for (int n = 0; n < 4; ++n) {
        const f32x4 ps = *reinterpret_cast<const f32x4*>(s_ps + n * 16 + (lane >> 4) * 4);
        uint2 wv;
        wv.x = pg8::cvt_pk_bf16(acc[n][0] * ps[0], acc[n][1] * ps[1]);
        wv.y = pg8::cvt_pk_bf16(acc[n][2] * ps[2], acc[n][3] * ps[3]);
        *reinterpret_cast<uint2*>(st + n * 16) = wv;
      }
    }
    __syncthreads();
  }
}

__device__ void phase_scan(CParams& p, bfu* smem, int tid, int wr, int vb, int vg) {
  float* s_x = reinterpret_cast<float*>(smem);
  const int g = tid >> 5, dp = tid & 31;
  for (int it = vb; it < 16 * 64; it += vg) {
    const int hs = it >> 6, e = it & 63;
    unsigned* stp = reinterpret_cast<unsigned*>(((bfu*)(p.ws + OFF_ST)) + ((size_t)hs * NCH + g * 32) * 4096 + e * 64 + dp * 2);
    const float2* dcp = reinterpret_cast<const float2*>(((float*)(p.ws + OFF_dec)) + ((size_t)hs * NCH + g * 32) * 64 + dp * 2);
    unsigned kv[32];
    float2 dc[32];
#pragma unroll
    for (int i = 0; i < 32; ++i) {
      kv[i] = stp[(size_t)i * 2048];
      dc[i] = dcp[i * 32];
    }
    float t0 = 0.f, t1 = 0.f, d0 = 1.f, d1 = 1.f;
#pragma unroll
    for (int i = 0; i < 32; ++i) {
      t0 = t0 * dc[i].x + bf2f((bfu)(kv[i] & 0xffffu));
      t1 = t1 * dc[i].y + bf2f((bfu)(kv[i] >> 16));
      d0 *= dc[i].x;
      d1 *= dc[i].y;
    }
    *reinterpret_cast<float4*>(s_x + (g * 32 + dp) * 4) = make_float4(t0, t1, d0, d1);
    __syncthreads();
    float s0 = 0.f, s1 = 0.f;
    for (int gg = 0; gg < g; ++gg) {
      const float4 x = *reinterpret_cast<const float4*>(s_x + (gg * 32 + dp) * 4);
      s0 = s0 * x.z + x.x;
      s1 = s1 * x.w + x.y;
    }
#pragma unroll
    for (int i = 0; i < 32; ++i) {
      const unsigned o = pg8::cvt_pk_bf16(s0, s1);
      if (wr) stp[(size_t)i * 2048] = o;
      s0 = s0 * dc[i].x + bf2f((bfu)(kv[i] & 0xffffu));
      s1 = s1 * dc[i].y + bf2f((bfu)(kv[i] >> 16));
    }
    __syncthreads();
  }
}

__device__ __forceinline__ void att_compute(const bfu* kS, const bfu* vS, const float* cS, const bfu* sQw,
                                            const float (&ct)[2], float (&l_run)[2], f32x4 (&O)[2][4],
                                            int kt, int qb, int r0, int w, int lr, int lq, int lg4) {
    f32x4 sc[2][4];
#pragma unroll
    for (int mi = 0; mi < 2; ++mi)
#pragma unroll
      for (int n = 0; n < 4; ++n) sc[mi][n] = (f32x4){0.f, 0.f, 0.f, 0.f};
#pragma unroll
    for (int ks = 0; ks < 2; ++ks) {
      bf16x8 aq0 = lds_frag(sQw, lr, ks * 32 + lq, LDP);
      bf16x8 aq1 = lds_frag(sQw, 16 + lr, ks * 32 + lq, LDP);
#pragma unroll
      for (int n = 0; n < 4; ++n) {
        bf16x8 kf = lds_frag(kS, n * 16 + lr, ks * 32 + lq, LDP);
        sc[0][n] = __builtin_amdgcn_mfma_f32_16x16x32_bf16(kf, aq0, sc[0][n], 0, 0, 0);
        sc[1][n] = __builtin_amdgcn_mfma_f32_16x16x32_bf16(kf, aq1, sc[1][n], 0, 0, 0);
      }
    }
    f32x4 csv[4];
#pragma unroll
    for (int n = 0; n < 4; ++n) csv[n] = *reinterpret_cast<const f32x4*>(cS + n * 16 + lg4);
    const bool diag = (kt >= 2 * qb);
    bf16x8 pf[2][2];
#pragma unroll
    for (int mi = 0; mi < 2; ++mi) {
      const int qrow = r0 + w * 32 + mi * 16 + lr;
      float ps = 0.f;
#pragma unroll
      for (int n = 0; n < 4; ++n)
#pragma unroll
        for (int j = 0; j < 4; ++j) {
          float v = (sc[mi][n][j] + ct[mi]) - csv[n][j];
          if (diag && (kt * 64 + n * 16 + lg4 + j > qrow)) v = -INFINITY;
          const float pv = __builtin_amdgcn_exp2f(v);
          sc[mi][n][j] = pv;
          ps += pv;
        }
      l_run[mi] += ps;
#pragma unroll
      for (int ks = 0; ks < 2; ++ks) {
        union { bf16x8 v; unsigned u[4]; } pk;
        pk.u[0] = pg8::cvt_pk_bf16(sc[mi][2 * ks][0], sc[mi][2 * ks][1]);
        pk.u[1] = pg8::cvt_pk_bf16(sc[mi][2 * ks][2], sc[mi][2 * ks][3]);
        pk.u[2] = pg8::cvt_pk_bf16(sc[mi][2 * ks + 1][0], sc[mi][2 * ks + 1][1]);
        pk.u[3] = pg8::cvt_pk_bf16(sc[mi][2 * ks + 1][2], sc[mi][2 * ks + 1][3]);
        pf[mi][ks] = pk.v;
      }
    }
#pragma unroll
    for (int ks = 0; ks < 2; ++ks) {
#pragma unroll
      for (int ef = 0; ef < 4; ++ef) {
        union { bf16x8 v; uint2 h2[2]; } vf;
        vf.h2[0] = *reinterpret_cast<const uint2*>(vS + (ef * 16 + lr) * LDP + ks * 32 + lg4);
        vf.h2[1] = *reinterpret_cast<const uint2*>(vS + (ef * 16 + lr) * LDP + ks * 32 + 16 + lg4);
#pragma unroll
        for (int mi = 0; mi < 2; ++mi)
          O[mi][ef] = __builtin_amdgcn_mfma_f32_16x16x32_bf16(vf.v, pf[mi][ks], O[mi][ef], 0, 0, 0);
      }
    }
}

__device__ void attn_item(CParams& p, int l, int qb, int h, bfu* smem, int tid, int half, unsigned char* smem_raw) {
  bfu* sK = smem;
  bfu* sV = smem + 2 * 64 * LDP;
  float* s_c = reinterpret_cast<float*>(smem + 4 * 64 * LDP);
  float* s_off = s_c + 128;
  const int lane = tid & 63, w = tid >> 6;
  const int lr = lane & 15, lq = (lane >> 4) * 8, lg4 = (lane >> 4) * 4;
  const int r0 = qb * 128;
  const float L2E = 1.44269504088896f;
  s_off[tid] = ((float*)(p.ws + OFF_foxtot))[h * NCH + tid];
  __syncthreads();
  float myoff = 0.f;
  for (int i = 0; i < tid; ++i) myoff += s_off[i];
  __syncthreads();
  s_off[tid] = myoff;
  float* s_misc = reinterpret_cast<float*>(smem + 28416);
  if (tid < 64) {
    float gq = fabsf(p.in[6][l * 64 + tid]), gk = fabsf(p.in[7][l * 64 + tid]);
#pragma unroll
    for (int m = 1; m < 64; m <<= 1) { gq = fmaxf(gq, __shfl_xor(gq, m, 64)); gk = fmaxf(gk, __shfl_xor(gk, m, 64)); }
    if (tid == 0) { s_misc[0] = 40.f + 2.f * 8.f * gq * gk * 1.01f; reinterpret_cast<int*>(s_misc)[1] = 2 * qb; s_misc[2] = 8.f * gq * gk * 1.01f * 1.44269504088896f; }
  }
  __syncthreads();
  {
    const float thr = s_misc[0];
    const float cref = s_off[2 * qb];
    if (tid < 2 * qb && s_off[tid + 1] <= cref + thr) atomicMin(reinterpret_cast<int*>(s_misc) + 1, tid);
  }
  __syncthreads();
  int kt_min = reinterpret_cast<int*>(s_misc)[1];
  const int nkt = 2 * qb + 2;
  if ((nkt - kt_min) & 1) kt_min -= 1;
  const bfu* Qg = ((bfu*)(p.ws + OFF_foxq)) + (size_t)h * S_LEN * 64;
  const bfu* Kg = ((bfu*)(p.ws + OFF_foxk)) + (size_t)h * S_LEN * 64;
  const bfu* Vg = ((bfu*)(p.ws + OFF_foxvT)) + (size_t)h * 64 * S_LEN;
  const float* Cg = ((float*)(p.ws + OFF_foxc)) + (size_t)h * S_LEN;
  bfu* sQ = smem + 4 * 64 * LDP + 768;
  {
#pragma unroll
    for (int i = 0; i < 4; ++i) {
      int id = tid + i * 256;
      int r = id >> 3, c = (id & 7) * 8;
      *reinterpret_cast<uint4*>(sQ + r * LDP + c) = *reinterpret_cast<const uint4*>(Qg + (size_t)(r0 + r) * 64 + c);
    }
  }
  const bfu* sQw = sQ + (w * 32) * LDP;
  float ct[2], l_run[2];
  const float lbound = s_misc[2];
  f32x4 O[2][4];
#pragma unroll
  for (int mi = 0; mi < 2; ++mi) {
    const int qrow = r0 + w * 32 + mi * 16 + lr;
    ct[mi] = (Cg[qrow] + s_off[qrow >> 6]) * L2E - lbound;
    l_run[mi] = 0.f;
#pragma unroll
    for (int n = 0; n < 4; ++n) O[mi][n] = (f32x4){0.f, 0.f, 0.f, 0.f};
  }
  const int nkh = (nkt - kt_min) >> 1;
  const int kt0 = kt_min + half * nkh;
  const int crow0 = tid >> 3, ccol = (tid & 7) * 8;
  uint4 rk0A, rk1A, rv0A, rv1A, rk0B, rk1B, rv0B, rv1B;
  float rcA = 0.f, rcB = 0.f;
  {
    const int k0 = kt0 * 64;
    rk0A = *reinterpret_cast<const uint4*>(Kg + (size_t)(k0 + crow0) * 64 + ccol);
    rk1A = *reinterpret_cast<const uint4*>(Kg + (size_t)(k0 + crow0 + 32) * 64 + ccol);
    rv0A = *reinterpret_cast<const uint4*>(Vg + (size_t)(crow0) * S_LEN + k0 + ccol);
    rv1A = *reinterpret_cast<const uint4*>(Vg + (size_t)(crow0 + 32) * S_LEN + k0 + ccol);
    if (tid < 64) rcA = (Cg[k0 + tid] + s_off[kt0]) * L2E;
  }
  *reinterpret_cast<uint4*>(sK + (crow0) * LDP + ccol) = rk0A;
  *reinterpret_cast<uint4*>(sK + (crow0 + 32) * LDP + ccol) = rk1A;
  *reinterpret_cast<uint4*>(sV + (crow0) * LDP + ccol) = rv0A;
  *reinterpret_cast<uint4*>(sV + (crow0 + 32) * LDP + ccol) = rv1A;
  if (tid < 64) s_c[tid] = rcA;
  rk0B = rk1B = rv0B = rv1B = rk0A;
  __syncthreads();
#define ATT_LOAD(S, KT)                                                                              \
  {                                                                                                  \
    const int k0_ = (KT) * 64;                                                                       \
    rk0##S = *reinterpret_cast<const uint4*>(Kg + (size_t)(k0_ + crow0) * 64 + ccol);                \
    rk1##S = *reinterpret_cast<const uint4*>(Kg + (size_t)(k0_ + crow0 + 32) * 64 + ccol);           \
    rv0##S = *reinterpret_cast<const uint4*>(Vg + (size_t)(crow0) * S_LEN + k0_ + ccol);             \
    rv1##S = *reinterpret_cast<const uint4*>(Vg + (size_t)(crow0 + 32) * S_LEN + k0_ + ccol);        \
    if (tid < 64) rc##S = (Cg[k0_ + tid] + s_off[(KT)]) * L2E;                                       \
  }
#define ATT_STORE(S, BUF)                                                                            \
  {                                                                                                  \
    bfu* kN_ = sK + (BUF) * 64 * LDP;                                                                \
    bfu* vN_ = sV + (BUF) * 64 * LDP;                                                                \
    *reinterpret_cast<uint4*>(kN_ + (crow0) * LDP + ccol) = rk0##S;                                  \
    *reinterpret_cast<uint4*>(kN_ + (crow0 + 32) * LDP + ccol) = rk1##S;                             \
    *reinterpret_cast<uint4*>(vN_ + (crow0) * LDP + ccol) = rv0##S;                                  \
    *reinterpret_cast<uint4*>(vN_ + (crow0 + 32) * LDP + ccol) = rv1##S;                             \
    if (tid < 64) s_c[(BUF) * 64 + tid] = rc##S;                                                     \
  }
  if (nkh > 1) ATT_LOAD(B, kt0 + 1);
  for (int it = 0; it < nkh; it += 2) {
    if (it + 2 < nkh) ATT_LOAD(A, kt0 + it + 2);
    att_compute(sK, sV, s_c, sQw, ct, l_run, O, kt0 + it, qb, r0, w, lr, lq, lg4);
    if (it + 1 < nkh) ATT_STORE(B, 1);
    __syncthreads();
    if (it + 1 >= nkh) break;
    if (it + 3 < nkh) ATT_LOAD(B, kt0 + it + 3);
    att_compute(sK + 64 * LDP, sV + 64 * LDP, s_c + 64, sQw, ct, l_run, O, kt0 + it + 1, qb, r0, w, lr, lq, lg4);
    if (it + 2 < nkh) ATT_STORE(A, 0);
    __syncthreads();
  }
#undef ATT_LOAD
#undef ATT_STORE
  float* xch = reinterpret_cast<float*>(smem_raw + SMEM_HALF);
  if (half == 1) {
#pragma unroll
    for (int mi = 0; mi < 2; ++mi) {
#pragma unroll
      for (int n = 0; n < 4; ++n)
#pragma unroll
        for (int j = 0; j < 4; ++j) xch[((mi * 4 + n) * 4 + j) * 256 + tid] = O[mi][n][j];
      xch[(32 + mi) * 256 + tid] = l_run[mi];
    }
  }
  __syncthreads();
  if (half == 0) {
#pragma unroll
    for (int mi = 0; mi < 2; ++mi) {
      float lsum = l_run[mi] + xch[(32 + mi) * 256 + tid];
      lsum += __shfl_xor(lsum, 16, 64);
      lsum += __shfl_xor(lsum, 32, 64);
      const float inv = 1.f / lsum;
      const int qrow = r0 + w * 32 + mi * 16 + lr;
      bfu* yp = ((bfu*)(p.ws + OFF_y)) + (size_t)qrow * YW + h * 64 + lg4;
#pragma unroll
      for (int n = 0; n < 4; ++n) {
        float o0 = (O[mi][n][0] + xch[((mi * 4 + n) * 4 + 0) * 256 + tid]) * inv;
        float o1 = (O[mi][n][1] + xch[((mi * 4 + n) * 4 + 1) * 256 + tid]) * inv;
        float o2 = (O[mi][n][2] + xch[((mi * 4 + n) * 4 + 2) * 256 + tid]) * inv;
        float o3 = (O[mi][n][3] + xch[((mi * 4 + n) * 4 + 3) * 256 + tid]) * inv;
        uint2 wv;
        wv.x = pg8::cvt_pk_bf16(o0, o1);
        wv.y = pg8::cvt_pk_bf16(o2, o3);
        *reinterpret_cast<uint2*>(yp + n * 16) = wv;
      }
    }
  }
  __syncthreads();
}

__device__ void chunk_out_item(CParams& p, int l, int c, int hs, bfu* smem, int tid) {
  bfu* sQ = smem;
  bfu* sKi = smem + 64 * LDP;
  bfu* sV = smem + 2 * 64 * LDP;
  bfu* sS = smem + 3 * 64 * LDP;
  bfu* sP = smem + 4 * 64 * LDP;
  float* s_cs = reinterpret_cast<float*>(smem + 5 * 64 * LDP);
  const int lane = tid & 63, w = tid >> 6;
  const int lr = lane & 15, lq = (lane >> 4) * 8, lg4 = (lane >> 4) * 4;
  const int tok0 = c * 64;
  const int tl = w * 16 + lr, tok = tok0 + tl;
  const bfu *Qp, *Kp;
  int qs;
  if (hs < 4) { Qp = ((bfu*)(p.ws + OFF_u)) + (size_t)tok0 * NU + 768 + hs * 64; Kp = ((bfu*)(p.ws + OFF_u)) + (size_t)tok0 * NU + 1024 + hs * 64; qs = NU; }
  else if (hs < 8) { Qp = ((bfu*)(p.ws + OFF_u)) + (size_t)tok0 * NU + 1792 + (hs - 4) * 64; Kp = ((bfu*)(p.ws + OFF_u)) + (size_t)tok0 * NU + 2048 + (hs - 4) * 64; qs = NU; }
  else { int g = (hs - 8) >> 2; Qp = ((bfu*)(p.ws + OFF_ssdC)) + ((size_t)g * S_LEN + tok0) * 64; Kp = ((bfu*)(p.ws + OFF_ssdB)) + ((size_t)g * S_LEN + tok0) * 64; qs = 64; }
  uint2 g4[4], x4[4];
  f32x4 gn[4];
  const int hh = (hs < 8) ? (hs & 3) : (hs - 8);
  {
    const int gcol = (hs < 4) ? (1536 + hh * 64) : (hs < 8 ? (2560 + hh * 64) : (2816 + hh * 64));
    const bfu* gp = ((bfu*)(p.ws + OFF_u)) + (size_t)tok * NU + gcol + lg4;
    const bfu* xp = ((bfu*)(p.ws + OFF_ssdX)) + (size_t)tok * 512 + hh * 64 + lg4;
    const float* gnp = (hs < 4 ? p.in[10] : p.in[11]) + l * 64 + lg4;
#pragma unroll
    for (int n = 0; n < 4; ++n) {
      g4[n] = *reinterpret_cast<const uint2*>(gp + n * 16);
      x4[n] = (hs >= 8) ? *reinterpret_cast<const uint2*>(xp + n * 16) : make_uint2(0u, 0u);
      gn[n] = (hs < 8) ? *reinterpret_cast<const f32x4*>(gnp + n * 16) : (f32x4){1.f, 1.f, 1.f, 1.f};
    }
  }
  load_tile64(sQ, Qp, qs, tid);
  load_tile64(sKi, Kp, qs, tid);
  load_tile64(sV, ((bfu*)(p.ws + OFF_VT)) + ((size_t)hs * NCH + c) * 4096, 64, tid);
  load_tile64(sS, ((bfu*)(p.ws + OFF_ST)) + ((size_t)hs * NCH + c) * 4096, 64, tid);
  if (tid < 64) s_cs[tid] = ((float*)(p.ws + OFF_csb))[hs * S_LEN + tok0 + tid];
  __syncthreads();
  const bf16x8 qf0 = lds_frag(sQ, tl, lq, LDP), qf1 = lds_frag(sQ, tl, 32 + lq, LDP);
  f32x4 sc[4], o[4];
#pragma unroll
  for (int n = 0; n < 4; ++n) {
    sc[n] = (f32x4){0.f, 0.f, 0.f, 0.f};
    o[n] = (f32x4){0.f, 0.f, 0.f, 0.f};
  }
#pragma unroll
  for (int n = 0; n < 4; ++n) {
    sc[n] = __builtin_amdgcn_mfma_f32_16x16x32_bf16(lds_frag(sKi, n * 16 + lr, lq, LDP), qf0, sc[n], 0, 0, 0);
    sc[n] = __builtin_amdgcn_mfma_f32_16x16x32_bf16(lds_frag(sKi, n * 16 + lr, 32 + lq, LDP), qf1, sc[n], 0, 0, 0);
    o[n] = __builtin_amdgcn_mfma_f32_16x16x32_bf16(lds_frag(sS, n * 16 + lr, lq, LDP), qf0, o[n], 0, 0, 0);
    o[n] = __builtin_amdgcn_mfma_f32_16x16x32_bf16(lds_frag(sS, n * 16 + lr, 32 + lq, LDP), qf1, o[n], 0, 0, 0);
  }
  const float cst = s_cs[tl];
  const float rsc = __expf(cst);
#pragma unroll
  for (int n = 0; n < 4; ++n) {
    const f32x4 css = *reinterpret_cast<const f32x4*>(s_cs + n * 16 + lg4);
    float pv[4];
#pragma unroll
    for (int j = 0; j < 4; ++j) {
      const int s = n * 16 + lg4 + j;
      pv[j] = (s <= tl) ? sc[n][j] * __expf(cst - css[j]) : 0.f;
      o[n][j] *= rsc;
    }
    uint2 wv;
    wv.x = pg8::cvt_pk_bf16(pv[0], pv[1]);
    wv.y = pg8::cvt_pk_bf16(pv[2], pv[3]);
    *reinterpret_cast<uint2*>(sP + tl * LDP + n * 16 + lg4) = wv;
  }
  __syncthreads();
  {
    const bf16x8 pf0 = lds_frag(sP, tl, lq, LDP), pf1 = lds_frag(sP, tl, 32 + lq, LDP);
#pragma unroll
    for (int n = 0; n < 4; ++n) {
      o[n] = __builtin_amdgcn_mfma_f32_16x16x32_bf16(lds_frag(sV, n * 16 + lr, lq, LDP), pf0, o[n], 0, 0, 0);
      o[n] = __builtin_amdgcn_mfma_f32_16x16x32_bf16(lds_frag(sV, n * 16 + lr, 32 + lq, LDP), pf1, o[n], 0, 0, 0);
    }
  }
  float ss = 0.f;
  if (hs < 8) {
#pragma unroll
    for (int n = 0; n < 4; ++n) ss += (o[n][0] * o[n][0] + o[n][1] * o[n][1]) + (o[n][2] * o[n][2] + o[n][3] * o[n][3]);
    ss += __shfl_xor(ss, 16, 64);
    ss += __shfl_xor(ss, 32, 64);
    const float rstd = rsqrtf(ss * (1.f / 64.f) + EPS);
    bfu* yp = ((bfu*)(p.ws + OFF_y)) + (size_t)tok * YW + (hs < 4 ? 256 : 512) + hh * 64 + lg4;
#pragma unroll
    for (int n = 0; n < 4; ++n) {
      const float t0 = __uint_as_float(g4[n].x << 16), t1 = __uint_as_float(g4[n].x & 0xffff0000u);
      const float t2 = __uint_as_float(g4[n].y << 16), t3 = __uint_as_float(g4[n].y & 0xffff0000u);
      uint2 wv;
      wv.x = pg8::cvt_pk_bf16(o[n][0] * rstd * gn[n][0] * siluf_(t0), o[n][1] * rstd * gn[n][1] * siluf_(t1));
      wv.y = pg8::cvt_pk_bf16(o[n][2] * rstd * gn[n][2] * siluf_(t2), o[n][3] * rstd * gn[n][3] * siluf_(t3));
      *reinterpret_cast<uint2*>(yp + n * 16) = wv;
    }
  } else {
    const float dsk = p.in[16][l * 8 + hh];
    bfu* yp = ((bfu*)(p.ws + OFF_y)) + (size_t)tok * YW + 768 + hh * 64 + lg4;
#pragma unroll
    for (int n = 0; n < 4; ++n) {
      const float z0 = __uint_as_float(g4[n].x << 16), z1 = __uint_as_float(g4[n].x & 0xffff0000u);
      const float z2 = __uint_as_float(g4[n].y << 16), z3 = __uint_as_float(g4[n].y & 0xffff0000u);
      const float a0 = __uint_as_float(x4[n].x << 16), a1 = __uint_as_float(x4[n].x & 0xffff0000u);
      const float a2 = __uint_as_float(x4[n].y << 16), a3 = __uint_as_float(x4[n].y & 0xffff0000u);
      const float y0 = (o[n][0] + dsk * a0) * siluf_(z0), y1 = (o[n][1] + dsk * a1) * siluf_(z1);
      const float y2 = (o[n][2] + dsk * a2) * siluf_(z2), y3 = (o[n][3] + dsk * a3) * siluf_(z3);
      ss += (y0 * y0 + y1 * y1) + (y2 * y2 + y3 * y3);
      uint2 wv;
      wv.x = pg8::cvt_pk_bf16(y0, y1);
      wv.y = pg8::cvt_pk_bf16(y2, y3);
      *reinterpret_cast<uint2*>(yp + n * 16) = wv;
    }
    ss += __shfl_xor(ss, 16, 64);
    ss += __shfl_xor(ss, 32, 64);
    if (lg4 == 0) ((float*)(p.ws + OFF_ssq))[tok * 8 + hh] = ss;
  }
  __syncthreads();
}

__device__ void phase_mix(CParams& p_o, int l, bfu* smem, int tid, int half, int cidx, unsigned char* smem_raw) {
  __shared__ int s_item;
  const int total = 512 + NCH * 8;
  while (true) {
    __syncthreads();
    if (threadIdx.x == 0) s_item = (int)atomicAdd(&((unsigned*)(p_o.ws + OFF_ctr))[cidx], 1u);
    __syncthreads();
    const int it = s_item;
    if (it >= total) break;
    CParams* pp_ = &p_o;
    asm volatile("" : "+s"(pp_));
    CParams& p = *pp_;
    if (it < 512) {
      int qb = 127 - (it >> 2), h = it & 3;
      attn_item(p, l, qb, h, smem, tid, half, smem_raw);
    } else {
      int j = (it - 512) * 2 + half;
      chunk_out_item(p, l, j >> 4, j & 15, smem, tid);
    }
  }
}

__device__ void phase_upmerge(CParams& p, bfu* smem, int tid, int vb, int vg, int half, unsigned char* smem_raw) {
  bfu* sA = reinterpret_cast<bfu*>(smem_raw);
  bfu* sB = smem + 2 * 128 * LDP;
  float* s_rs = reinterpret_cast<float*>(smem + 2 * 128 * LDP + 2 * 64 * LDP);
  const int lane = tid & 63, w = tid >> 6, wm = w >> 1, wn = w & 1;
  const int lr = lane & 15, lq = (lane >> 4) * 8, lg4 = (lane >> 4) * 4;
  const int crow = tid >> 3, ccol = (tid & 7) * 8;
  const int t512 = half * 256 + tid, arow = t512 >> 3;
  const int xcd = (vb >> 1) & 7, jl = ((vb >> 4) << 1) | (vb & 1), per = vg >> 3;
  for (int il = jl; il < 16 * 16; il += per) {
    const int mt = xcd * 16 + (il >> 4), nt = il & 15;
    const bfu* Ap = ((bfu*)(p.ws + OFF_y)) + (size_t)(mt * 128 + arow) * YW + ccol;
    const bfu* Bp = ((bfu*)(p.ws + OFF_WupT)) + (size_t)(nt * 64 + crow) * YW + ccol;
    const bfu* Gp = ((bfu*)(p.ws + OFF_u)) + (size_t)(mt * 128 + wm * 64 + lr) * NU + 4096 + nt * 64 + wn * 32 + lg4;
    {
      const int row = tid >> 1, g = tid & 1;
      const float4 q4 = *reinterpret_cast<const float4*>(((float*)(p.ws + OFF_ssq)) + (mt * 128 + row) * 8 + g * 4);
      s_rs[g * 128 + row] = rsqrtf((q4.x + q4.y + q4.z + q4.w) * (1.f / 256.f) + EPS);
    }
    uint4 a0_0, a0_1, b0_0, b0_1, a1_0, a1_1, b1_0, b1_1;
#define U_LOAD(S, KT)                                                                \
  {                                                                                  \
    const int ko_ = (KT) * 64;                                                       \
    a##S##_0 = *reinterpret_cast<const uint4*>(Ap + (size_t)0 * 64 * YW + ko_);      \
    a##S##_1 = *reinterpret_cast<const uint4*>(Ap + (size_t)1 * 64 * YW + ko_);      \
    b##S##_0 = *reinterpret_cast<const uint4*>(Bp + (size_t)0 * 32 * YW + ko_);      \
    b##S##_1 = *reinterpret_cast<const uint4*>(Bp + (size_t)1 * 32 * YW + ko_);      \
  }
#define U_STORE(S, BUF)                                                              \
  {                                                                                  \
    bfu* sAn_ = sA + (BUF) * 128 * LDP + arow * LDP + ccol;                          \
    bfu* sBn_ = sB + (BUF) * 64 * LDP + crow * LDP + ccol;                           \
    *reinterpret_cast<uint4*>(sAn_ + 0 * 64 * LDP) = a##S##_0;                       \
    *reinterpret_cast<uint4*>(sAn_ + 1 * 64 * LDP) = a##S##_1;                       \
    *reinterpret_cast<uint4*>(sBn_ + 0 * 32 * LDP) = b##S##_0;                       \
    *reinterpret_cast<uint4*>(sBn_ + 1 * 32 * LDP) = b##S##_1;                       \
  }
#define U_COMPUTE(BUF)                                                               \
  {                                                                                  \
    const bfu* a_s = sA + (BUF) * 128 * LDP + (wm * 64) * LDP;                       \
    const bfu* b_s = sB + (BUF) * 64 * LDP + (wn * 32) * LDP;                        \
    _Pragma("unroll") for (int ks = 0; ks < 2; ++ks) {                               \
      bf16x8 af0 = lds_frag(a_s, 0 * 16 + lr, ks * 32 + lq, LDP);                    \
      bf16x8 af1 = lds_frag(a_s, 1 * 16 + lr, ks * 32 + lq, LDP);                    \
      bf16x8 af2 = lds_frag(a_s, 2 * 16 + lr, ks * 32 + lq, LDP);                    \
      bf16x8 af3 = lds_frag(a_s, 3 * 16 + lr, ks * 32 + lq, LDP);                    \
      _Pragma("unroll") for (int ni = 0; ni < 2; ++ni) {                             \
        bf16x8 bf_ = lds_frag(b_s, ni * 16 + lr, ks * 32 + lq, LDP);                 \
        acc[0][ni] = __builtin_amdgcn_mfma_f32_16x16x32_bf16(bf_, af0, acc[0][ni], 0, 0, 0); \
        acc[1][ni] = __builtin_amdgcn_mfma_f32_16x16x32_bf16(bf_, af1, acc[1][ni], 0, 0, 0); \
        acc[2][ni] = __builtin_amdgcn_mfma_f32_16x16x32_bf16(bf_, af2, acc[2][ni], 0, 0, 0); \
        acc[3][ni] = __builtin_amdgcn_mfma_f32_16x16x32_bf16(bf_, af3, acc[3][ni], 0, 0, 0); \
      }                                                                              \
    }                                                                                \
  }
    f32x4 acc[4][2], tot[4][2];
    zero_acc<2>(acc);
    zero_acc<2>(tot);
    uint2 gt[4][2];
    U_LOAD(0, 0);
    U_LOAD(1, 1);
    U_STORE(0, 0);
    __syncthreads();
#pragma unroll 1
    for (int kt = 0; kt < 20; kt += 2) {
      if ((kt & 3) == 0) {
        const int br = kt >> 2, gb = br < 3 ? br : 3;
#pragma unroll
        for (int mi = 0; mi < 4; ++mi)
#pragma unroll
          for (int ni = 0; ni < 2; ++ni)
            gt[mi][ni] = *reinterpret_cast<const uint2*>(Gp + (size_t)(mi * 16) * NU + gb * 1024 + ni * 16);
      }
      if (kt + 2 < 20) U_LOAD(0, kt + 2);
      U_COMPUTE(0);
      U_STORE(1, 1);
      __syncthreads();
      if (kt + 3 < 20) U_LOAD(1, kt + 3);
      U_COMPUTE(1);
      if (kt + 2 < 20) U_STORE(0, 0);
      if ((kt & 3) == 2) {
        const int br = kt >> 2;
#pragma unroll
        for (int mi = 0; mi < 4; ++mi) {
          float rsc = 1.f;
          if (br >= 3) rsc = s_rs[(br - 3) * 128 + wm * 64 + mi * 16 + lr];
#pragma unroll
          for (int ni = 0; ni < 2; ++ni) {
            const uint2 g2 = gt[mi][ni];
            tot[mi][ni][0] += acc[mi][ni][0] * (__uint_as_float(g2.x << 16) * rsc);
            tot[mi][ni][1] += acc[mi][ni][1] * (__uint_as_float(g2.x & 0xffff0000u) * rsc);
            tot[mi][ni][2] += acc[mi][ni][2] * (__uint_as_float(g2.y << 16) * rsc);
            tot[mi][ni][3] += acc[mi][ni][3] * (__uint_as_float(g2.y & 0xffff0000u) * rsc);
            acc[mi][ni] = (f32x4){0.f, 0.f, 0.f, 0.f};
          }
        }
      }
      __syncthreads();
    }
#undef U_LOAD
#undef U_STORE
#undef U_COMPUTE
    bfu* Hp = ((bfu*)(p.ws + OFF_h)) + (size_t)(mt * 128 + wm * 64 + lr) * DM + nt * 64 + wn * 32 + lg4;
#pragma unroll
    for (int mi = 0; mi < 4; ++mi)
#pragma unroll
      for (int ni = 0; ni < 2; ++ni) {
        uint2 wv;
        wv.x = pg8::cvt_pk_bf16(tot[mi][ni][0], tot[mi][ni][1]);
        wv.y = pg8::cvt_pk_bf16(tot[mi][ni][2], tot[mi][ni][3]);
        *reinterpret_cast<uint2*>(Hp + (size_t)(mi * 16) * DM + ni * 16) = wv;
      }
  }
}

namespace pg8 {
#define PG8_LAS __attribute__((address_space(3)))
typedef unsigned short bf16_t;
typedef short bf16x8 __attribute__((ext_vector_type(8)));
typedef float f32x4 __attribute__((ext_vector_type(4)));
typedef unsigned u32x4 __attribute__((ext_vector_type(4)));
typedef unsigned u32x2 __attribute__((ext_vector_type(2)));
constexpr int BM = 256, BK = 64, HALF = 128, HTB = HALF * BK * 2, STAGE_BYTES = 8 * HTB, NXCD = 8, WGM = 16;
__device__ __forceinline__ int lds_byte(int r, int c) { const int st = (r >> 4) * 2 + (c >> 5), rr = r & 15, cc = c & 31, ob = rr * 64 + cc * 2; return st * 1024 + (ob ^ (((ob >> 9) & 1) << 5)); }
__device__ __forceinline__ void stage_rc(int b, int& R, int& C) { const int st = b / 1024, sb = b % 1024, swz = sb ^ (((sb >> 9) & 1) << 5); R = (st >> 1) * 16 + swz / 64; C = (st & 1) * 32 + (swz % 64) / 2; }
__device__ __forceinline__ int perm32(int rho) { const int n = rho >> 4, i = rho & 15; return 8 * (i >> 2) + 4 * n + (i & 3); }
struct Unit { int pm, pn; };
struct Gemm { const bf16_t* A; const bf16_t* Bt; int M, N, K; };
struct StaticOrder {
    int nM, nN, nwg, G, c;
    __device__ void init(int M, int N, int G_, int c_) { nM = M / BM; nN = N / BM; nwg = nM * nN; G = G_; c = c_; }
    __device__ bool next(int i, Unit& u) const {
        const long L = (long)i * G + c; if (L >= nwg) return false;
        int wgid = (int)L; { const int q = nwg / NXCD, r = nwg % NXCD, xcd = wgid % NXCD, off = wgid / NXCD; wgid = (xcd < r ? xcd * (q + 1) : r * (q + 1) + (xcd - r) * q) + off; }
        const int nig = WGM * nN, gid = wgid / nig, fm = gid * WGM, gsz = (nM - fm) < WGM ? (nM - fm) : WGM;
        u.pm = fm + ((wgid % nig) % gsz); u.pn = (wgid % nig) / gsz; return true;
    }
    __device__ __forceinline__ void a_ready(const Unit&) const {}
    __device__ __forceinline__ void done(const Unit&) const {}
};
__device__ __forceinline__ unsigned cvt_pk_bf16(float lo, float hi) { unsigned r; asm volatile("v_cvt_pk_bf16_f32 %0, %1, %2" : "=v"(r) : "v"(lo), "v"(hi)); return r; }

template <class Epi, class Sched>
__device__ __forceinline__ void gemm_phase(PG8_LAS unsigned char* lds, const Gemm g, const Sched& S, const Epi& E) {
    const int tid = threadIdx.x, wid = __builtin_amdgcn_readfirstlane(tid >> 6), lane = tid & 63, wr = wid >> 2, wc = wid & 3, fr = lane & 15, fq = lane >> 4;
    const int K = g.K, nt = K / BK;
    unsigned voffA[2], voffB[2];
#pragma unroll
    for (int i = 0; i < 2; ++i) { int R, C; stage_rc(tid * 16 + i * 8192, R, C); const int Rb = Epi::PERM ? ((R & ~31) + perm32(R & 31)) : R;
        voffA[i] = (unsigned)(R * K + C) * 2u; voffB[i] = (unsigned)(Rb * K + C) * 2u; }
    const size_t kstep = (size_t)(BK * 2);
    const size_t hstep = (size_t)HALF * K * 2;
    const size_t tstep = 2 * hstep;
    const unsigned ldsw = (unsigned)wid * 1024u;
    const int aoff = lds_byte(wr * 64 + fr, fq * 8), boff = lds_byte(wc * 32 + fr, fq * 8);
#define PG8_SA(b, h) (((b) * 2 + (h)) * HTB)
#define PG8_SB(b, h) ((4 + (b) * 2 + (h)) * HTB)
#define PG8_STAGE(bufoff, gbase, voff) do { _Pragma("unroll") for (int _i = 0; _i < 2; ++_i) \
        __builtin_amdgcn_global_load_lds((const unsigned*)((const char*)(gbase) + (voff)[_i]), (PG8_LAS unsigned*)(lds + (bufoff) + ldsw + _i * 8192), 16, 0, 0); } while (0)
#define PG8_LDA(dst, b, h) do { _Pragma("unroll") for (int m = 0; m < 4; ++m) _Pragma("unroll") for (int k = 0; k < 2; ++k) dst[m][k] = *(const PG8_LAS bf16x8*)(lds + PG8_SA(b, h) + aoff + m * 2048 + k * 1024); } while (0)
#define PG8_LDB(dst, b, h) do { _Pragma("unroll") for (int n = 0; n < 2; ++n) _Pragma("unroll") for (int k = 0; k < 2; ++k) dst[n][k] = *(const PG8_LAS bf16x8*)(lds + PG8_SB(b, h) + boff + n * 2048 + k * 1024); } while (0)
#define PG8_MMA(ai, bj, At, Bt) do { __builtin_amdgcn_s_setprio(1); _Pragma("unroll") for (int m = 0; m < 4; ++m) _Pragma("unroll") for (int n = 0; n < 2; ++n) _Pragma("unroll") for (int k = 0; k < 2; ++k) \
        acc[ai][bj][m][n] = __builtin_amdgcn_mfma_f32_16x16x32_bf16(Bt[n][k], At[m][k], acc[ai][bj][m][n], 0, 0, 0); __builtin_amdgcn_s_setprio(0); } while (0)
#define PG8_WAIT_V(n) asm volatile("s_waitcnt vmcnt(" #n ")" ::: "memory")
#define PG8_WAIT_L(n) asm volatile("s_waitcnt lgkmcnt(" #n ")" ::: "memory")
#define PG8_BAR __builtin_amdgcn_s_barrier()
#define PG8_SCHED __builtin_amdgcn_sched_barrier(0)
    Unit cur, nxt; int ui = 0;
    if (!S.next(0, cur)) return;
    f32x4 acc[2][2][4][2];
#pragma unroll
    for (int a = 0; a < 2; ++a)
#pragma unroll
        for (int b = 0; b < 2; ++b)
#pragma unroll
            for (int m = 0; m < 4; ++m)
#pragma unroll
                for (int n = 0; n < 2; ++n) acc[a][b][m][n] = (f32x4){0.f, 0.f, 0.f, 0.f};
    bf16x8 At[4][2], B0[2][2], B1[2][2];
    const char* cA = (const char*)g.A + (size_t)cur.pm * tstep; const char* cB = (const char*)g.Bt + (size_t)cur.pn * tstep;
    S.a_ready(cur);
    PG8_STAGE(PG8_SB(0, 0), cB, voffB); PG8_STAGE(PG8_SA(0, 0), cA, voffA); PG8_STAGE(PG8_SB(0, 1), cB + hstep, voffB); PG8_STAGE(PG8_SA(0, 1), cA + hstep, voffA);
    if (wr == 1) PG8_BAR;
    PG8_WAIT_V(4); PG8_BAR;
    PG8_STAGE(PG8_SB(1, 0), cB + kstep, voffB); PG8_STAGE(PG8_SA(1, 0), cA + kstep, voffA); PG8_STAGE(PG8_SB(1, 1), cB + hstep + kstep, voffB);
    PG8_WAIT_V(6); PG8_BAR;
    for (;;) {
        const bool has_next = S.next(ui + 1, nxt);
        const char* nA = has_next ? (const char*)g.A + (size_t)nxt.pm * tstep : cA; const char* nB = has_next ? (const char*)g.Bt + (size_t)nxt.pn * tstep : cB;
        for (int t = 0; t < nt; t += 2) {
            const bool last = (t == nt - 2);
            const char* a1 = cA + (size_t)(t + 1) * kstep;
            const char* a2 = last ? nA : cA + (size_t)(t + 2) * kstep; const char* b2 = last ? nB : cB + (size_t)(t + 2) * kstep;
            const char* a3 = a2 + kstep; const char* b3 = b2 + kstep;
            if (last && has_next) S.a_ready(nxt);
            PG8_LDB(B0, 0, 0); PG8_SCHED; PG8_LDA(At, 0, 0); PG8_STAGE(PG8_SA(1, 1), a1 + hstep, voffA);
            PG8_WAIT_L(8); PG8_BAR; PG8_WAIT_L(0); PG8_MMA(0, 0, At, B0); PG8_BAR; PG8_SCHED;
            PG8_LDB(B1, 0, 1); PG8_STAGE(PG8_SB(0, 0), b2, voffB);
            PG8_BAR; PG8_WAIT_L(0); PG8_MMA(0, 1, At, B1); PG8_BAR;
            PG8_LDA(At, 0, 1); PG8_STAGE(PG8_SA(0, 0), a2, voffA);
            PG8_BAR; PG8_WAIT_L(0); PG8_MMA(1, 0, At, B0); PG8_BAR; PG8_SCHED;
            PG8_STAGE(PG8_SB(0, 1), b2 + hstep, voffB);
            PG8_WAIT_V(6); PG8_BAR; PG8_MMA(1, 1, At, B1); PG8_BAR;
            PG8_LDB(B0, 1, 0); PG8_SCHED; PG8_LDA(At, 1, 0); PG8_STAGE(PG8_SA(0, 1), a2 + hstep, voffA);
            PG8_WAIT_L(8); PG8_BAR; PG8_WAIT_L(0); PG8_MMA(0, 0, At, B0); PG8_BAR; PG8_SCHED;
            PG8_LDB(B1, 1, 1); PG8_STAGE(PG8_SB(1, 0), b3, voffB);
            PG8_BAR; PG8_WAIT_L(0); PG8_MMA(0, 1, At, B1); PG8_BAR;
            PG8_LDA(At, 1, 1); PG8_STAGE(PG8_SA(1, 0), a3, voffA);
            PG8_BAR; PG8_WAIT_L(0); PG8_MMA(1, 0, At, B0); PG8_BAR; PG8_SCHED;
            PG8_STAGE(PG8_SB(1, 1), b3 + hstep, voffB);
            PG8_WAIT_V(6); PG8_BAR; PG8_MMA(1, 1, At, B1); PG8_BAR;
        }
            if constexpr (!Epi::AFTER_DRAIN) { E(acc, cur, wr, wc, fr, fq); S.done(cur); }
            if (!has_next) break;
#pragma unroll
        for (int a = 0; a < 2; ++a)
#pragma unroll
            for (int b = 0; b < 2; ++b)
#pragma unroll
                for (int m = 0; m < 4; ++m)
#pragma unroll
                    for (int n = 0; n < 2; ++n) acc[a][b][m][n] = (f32x4){0.f, 0.f, 0.f, 0.f};
        cur = nxt; cA = nA; cB = nB; ++ui;
    }
    PG8_WAIT_V(0);
    if (wr == 0) PG8_BAR;
    PG8_BAR;
    if constexpr (Epi::AFTER_DRAIN) { E.fused(acc, cur, wr, wc, fr, fq, lds, wid, lane); S.done(cur); }
#undef PG8_SA
#undef PG8_SB
#undef PG8_STAGE
#undef PG8_LDA
#undef PG8_LDB
#undef PG8_MMA
#undef PG8_WAIT_V
#undef PG8_WAIT_L
#undef PG8_BAR
#undef PG8_SCHED
}

}

struct EpiInproj {
  static constexpr bool PERM = true, AFTER_DRAIN = false;
  bfu* u; float* small;
  __device__ __forceinline__ void operator()(const pg8::f32x4 (&acc)[2][2][4][2], const pg8::Unit& un, int wr, int wc, int fr, int fq) const {
    const int row0 = un.pm * 256 + wr * 64 + fr;
    if (un.pn < 32) {
      const bool sig = un.pn >= 16;
      const int col0 = un.pn * 256 + wc * 32 + 8 * fq;
#pragma unroll
      for (int ai = 0; ai < 2; ++ai)
#pragma unroll
        for (int m = 0; m < 4; ++m) {
          bfu* rowp = u + (size_t)(row0 + ai * 128 + m * 16) * NU + col0;
#pragma unroll
          for (int bj = 0; bj < 2; ++bj) {
            pg8::f32x4 v0 = acc[ai][bj][m][0], v1 = acc[ai][bj][m][1];
            if (sig) {
#pragma unroll
              for (int j = 0; j < 4; ++j) { v0[j] = sigmoidf_(v0[j]); v1[j] = sigmoidf_(v1[j]); }
            }
            pg8::u32x4 w;
            w.x = pg8::cvt_pk_bf16(v0[0], v0[1]); w.y = pg8::cvt_pk_bf16(v0[2], v0[3]);
            w.z = pg8::cvt_pk_bf16(v1[0], v1[1]); w.w = pg8::cvt_pk_bf16(v1[2], v1[3]);
            *(pg8::u32x4*)(rowp + bj * 128) = w;
          }
        }
    } else if (wc == 0) {
#pragma unroll
      for (int ai = 0; ai < 2; ++ai)
#pragma unroll
        for (int m = 0; m < 4; ++m) {
          float* sp = small + (size_t)(row0 + ai * 128 + m * 16) * 32 + 8 * fq;
          *(pg8::f32x4*)(sp) = acc[ai][0][m][0];
          *(pg8::f32x4*)(sp + 4) = acc[ai][0][m][1];
        }
    }
  }
};
struct EpiResid {
  static constexpr bool PERM = false, AFTER_DRAIN = false;
  const float* xold; float* out;
  __device__ __forceinline__ void operator()(const pg8::f32x4 (&acc)[2][2][4][2], const pg8::Unit& un, int wr, int wc, int fr, int fq) const {
    const int row0 = un.pm * 256 + wr * 64 + fr, col0 = un.pn * 256 + wc * 32 + 4 * fq;
#pragma unroll
    for (int ai = 0; ai < 2; ++ai)
#pragma unroll
      for (int m = 0; m < 4; ++m) {
        const size_t off = (size_t)(row0 + ai * 128 + m * 16) * DM + col0;
#pragma unroll
        for (int bj = 0; bj < 2; ++bj)
#pragma unroll
          for (int n = 0; n < 2; ++n) {
            const pg8::f32x4 b = *(const pg8::f32x4*)(xold + off + bj * 128 + n * 16);
            *(pg8::f32x4*)(out + off + bj * 128 + n * 16) = b + acc[ai][bj][m][n];
          }
        asm volatile("" ::: "memory");
      }
  }
};
struct EpiSwiglu {
  static constexpr bool PERM = true, AFTER_DRAIN = false;
  bfu* hidden;
  __device__ __forceinline__ void operator()(const pg8::f32x4 (&acc)[2][2][4][2], const pg8::Unit& un, int wr, int wc, int fr, int fq) const {
    const int row0 = un.pm * 256 + wr * 64 + fr;
#pragma unroll
    for (int ai = 0; ai < 2; ++ai)
#pragma unroll
      for (int m = 0; m < 4; ++m) {
        bfu* rowp = hidden + (size_t)(row0 + ai * 128 + m * 16) * FH + (un.pn * 8 + wc) * 16 + 4 * fq;
#pragma unroll
        for (int bj = 0; bj < 2; ++bj) {
          const pg8::f32x4 g = acc[ai][bj][m][0], uu = acc[ai][bj][m][1];
          pg8::u32x2 w;
          w.x = pg8::cvt_pk_bf16(siluf_(g[0]) * uu[0], siluf_(g[1]) * uu[1]);
          w.y = pg8::cvt_pk_bf16(siluf_(g[2]) * uu[2], siluf_(g[3]) * uu[3]);
          *(pg8::u32x2*)(rowp + bj * 64) = w;
        }
      }
  }
};

#define XB_TMO      128
#define XB_XCNT(j)  (256  + 64 * (j))
#define XB_XSUB(j)  (1280 + 64 * (j))
#define XB_XGEN(j)  (2304 + 64 * (j))
#define XB_TOP      3328
#define XB_TOPGEN   3392
#define XCD_BAR_WORDS 3456
#define XB_SPIN_CAP (1u << 18)
#define LAS __attribute__((address_space(3)))

__device__ __forceinline__ unsigned xb_ld(unsigned* p)              { return __hip_atomic_load(p, __ATOMIC_RELAXED, __HIP_MEMORY_SCOPE_AGENT); }
__device__ __forceinline__ unsigned xb_add(unsigned* p, unsigned v) { return __hip_atomic_fetch_add(p, v, __ATOMIC_RELAXED, __HIP_MEMORY_SCOPE_AGENT); }
__device__ __forceinline__ unsigned xb_xcc_id() { return (unsigned)__builtin_amdgcn_s_getreg((3 << 11) | 20) & 0xFu; }
#define XB_SPIN(cond, bar) do { unsigned _sp = 0; while (cond) { __builtin_amdgcn_s_sleep(1); \
    if ((++_sp & 255u) == 0u) { if (xb_ld(&(bar)[XB_TMO])) break; if (_sp > XB_SPIN_CAP) { atomicAdd(&(bar)[XB_TMO], 1u); break; } } } } while (0)

struct XcdBarrier {
    unsigned* bar; unsigned x;
    volatile LAS unsigned* st;
};

__device__ __forceinline__ XcdBarrier xcd_barrier_post(unsigned* bar, volatile LAS unsigned* st) {
    XcdBarrier b; b.bar = bar; b.x = xb_xcc_id(); b.st = st;
    if (threadIdx.x == 0) (void)xb_add(&bar[XB_XCNT(b.x)], 1u);
    return b;
}
__device__ __forceinline__ void xcd_barrier_complete(unsigned* bar, unsigned x, unsigned& nloc, unsigned& nx) {
    const unsigned G = gridDim.x * gridDim.y * gridDim.z;
    unsigned sum, cnt, mine, sp = 0u;
    for (;;) {
        sum = 0u; cnt = 0u; mine = 0u;
#pragma unroll
        for (unsigned j = 0; j < 16; ++j) { const unsigned c = xb_ld(&bar[XB_XCNT(j)]); sum += c; cnt += (c > 0u) ? 1u : 0u; mine = (j == x) ? c : mine; }
        if (sum == G) break;
        __builtin_amdgcn_s_sleep(1);
        if ((++sp & 255u) == 0u) { if (xb_ld(&bar[XB_TMO])) break; if (sp > XB_SPIN_CAP) { atomicAdd(&bar[XB_TMO], 1u); break; } }
    }
    nloc = mine > 0u ? mine : 1u; nx = cnt > 0u ? cnt : 1u;
}

__device__ __forceinline__ void xcd_barrier(const XcdBarrier& b) {
    asm volatile("s_waitcnt vmcnt(0)" ::: "memory");
    __syncthreads();
    if (threadIdx.x == 0) {
        unsigned* bar = b.bar;
        __builtin_amdgcn_s_waitcnt(0);
        unsigned nloc = b.st[0], nx = b.st[1];
        if (nloc == 0u) { xcd_barrier_complete(bar, b.x, nloc, nx); b.st[0] = nloc; b.st[1] = nx; }
        const unsigned old = xb_add(&bar[XB_XSUB(b.x)], 1u);
        const unsigned gen = old / nloc;
        if (old + 1u == (gen + 1u) * nloc) {
            __builtin_amdgcn_fence(__ATOMIC_RELEASE, "agent");
            asm volatile("s_waitcnt vmcnt(0)" ::: "memory");
            const unsigned og = xb_add(&bar[XB_TOP], 1u);
            const unsigned tg = og / nx;
            if (og + 1u == (tg + 1u) * nx) xb_add(&bar[XB_TOPGEN], 1u);
            else XB_SPIN(xb_ld(&bar[XB_TOPGEN]) == tg, bar);
            __builtin_amdgcn_fence(__ATOMIC_ACQUIRE, "agent");
            xb_add(&bar[XB_XGEN(b.x)], 1u);
            asm volatile("s_waitcnt vmcnt(0)" ::: "memory");
        } else {
            XB_SPIN(xb_ld(&bar[XB_XGEN(b.x)]) == gen, bar);
            __builtin_amdgcn_fence(__ATOMIC_ACQUIRE, "agent");
            asm volatile("s_waitcnt vmcnt(0)" ::: "memory");
        }
    }
    __syncthreads();
}


__global__ void __launch_bounds__(NTHREADS, 2) mega(Params p_in, int ph_lo, int ph_hi, int use_cg) {
  extern __shared__ __attribute__((aligned(16))) unsigned char smem_raw[];
  __shared__ uint4 xb_words;
  if (threadIdx.x == 0) xb_words = make_uint4(0u, 0u, 0u, 0u);
  __syncthreads();
  const XcdBarrier xbar = xcd_barrier_post((unsigned*)(p_in.ws + OFF_bar), (volatile LAS unsigned*)&xb_words);
  for (int ph = ph_lo; ph < ph_hi; ++ph) {
#if PROBE_DUP >= 0
    const int l = ph / (PH_PER_LAYER + 1);
    const int ks = ph - l * (PH_PER_LAYER + 1);
    const int k = (ks <= PROBE_DUP) ? ks : ks - 1;
    const int wr = (ks == PROBE_DUP) ? 0 : 1;
#else
    const int wr = 1;
    const int l = ph / PH_PER_LAYER, k = ph - l * PH_PER_LAYER;
#endif
    int t512 = threadIdx.x;
    asm volatile("" : "+v"(t512));
    const int tid = t512 & 255;
    const int half = __builtin_amdgcn_readfirstlane(t512 >> 8);
    const int vb = blockIdx.x * 2 + half, vg = gridDim.x * 2;
    bfu* smem = reinterpret_cast<bfu*>(smem_raw + half * SMEM_HALF);
    CParams* pp = (CParams*)__builtin_amdgcn_kernarg_segment_ptr();
    asm volatile("" : "+s"(pp));
    CParams& p = *pp;
    switch (k) {
      case 0: phase_convert_norm(p, l, smem, tid, vb, vg); break;
      case 1: {
        pg8::Gemm g; g.A = (bfu*)(p.ws + OFF_h); g.Bt = (bfu*)(p.ws + OFF_WinT); g.M = S_LEN; g.N = NINP; g.K = DM;
        pg8::StaticOrder so; so.init(S_LEN, NINP, gridDim.x, blockIdx.x);
        EpiInproj e; e.u = (bfu*)(p.ws + OFF_u); e.small = (float*)(p.ws + OFF_small);
        pg8::gemm_phase<EpiInproj, pg8::StaticOrder>((PG8_LAS unsigned char*)smem_raw, g, so, e);
      } break;
      case 2: phase_prep(p, l, smem, tid, wr, vb, vg); break;
      case 3: phase_scan(p, smem, tid, wr, vb, vg); break;
      case 4: phase_mix(p, l, smem, tid, half, ph, smem_raw); break;
      case 5: phase_upmerge(p, smem, tid, vb, vg, half, smem_raw); break;
      case 6: {
        pg8::Gemm g; g.A = (bfu*)(p.ws + OFF_h); g.Bt = (bfu*)(p.ws + OFF_WoutT); g.M = S_LEN; g.N = DM; g.K = DM;
        pg8::StaticOrder so; so.init(S_LEN, DM, gridDim.x, blockIdx.x);
        EpiResid e; e.xold = (l == 0 ? p.in[0] : p.out); e.out = p.out;
        pg8::gemm_phase<EpiResid, pg8::StaticOrder>((PG8_LAS unsigned char*)smem_raw, g, so, e);
      } break;
      case 7: phase_norm2(p, l, tid, vb, vg); break;
      case 8: {
        pg8::Gemm g; g.A = (bfu*)(p.ws + OFF_h); g.Bt = (bfu*)(p.ws + OFF_WfiT); g.M = S_LEN; g.N = 2 * FH; g.K = DM;
        pg8::StaticOrder so; so.init(S_LEN, 2 * FH, gridDim.x, blockIdx.x);
        EpiSwiglu e; e.hidden = (bfu*)(p.ws + OFF_u);
        pg8::gemm_phase<EpiSwiglu, pg8::StaticOrder>((PG8_LAS unsigned char*)smem_raw, g, so, e);
      } break;
      default: {
        pg8::Gemm g; g.A = (bfu*)(p.ws + OFF_u); g.Bt = (bfu*)(p.ws + OFF_WfoT); g.M = S_LEN; g.N = DM; g.K = FH;
        pg8::StaticOrder so; so.init(S_LEN, DM, gridDim.x, blockIdx.x);
        EpiResid e; e.xold = p.out; e.out = p.out;
        pg8::gemm_phase<EpiResid, pg8::StaticOrder>((PG8_LAS unsigned char*)smem_raw, g, so, e);
      } break;
    }
    if (ph + 1 < ph_hi) {
      if (use_cg) cg::this_grid().sync();
      else xcd_barrier(xbar);
    }
  }
}

#ifndef MK_COOP
#define MK_COOP 1
#endif

extern "C" void kernel_launch(void* const* d_in, const int* in_sizes, int n_in, void* d_out, int out_size, void* d_ws,
                              size_t ws_size, hipStream_t stream) {
  Params p{};
  for (int i = 0; i < 25; ++i) p.in[i] = reinterpret_cast<const float*>(d_in[i]);
  p.out = reinterpret_cast<float*>(d_out);
  p.ws = reinterpret_cast<unsigned char*>(d_ws);
  if (WS_NEED > ws_size) { fprintf(stderr, "workspace too small: need %zu have %zu\n", (size_t)WS_NEED, ws_size); return; }

  static int grid_blocks = 0;
  if (!grid_blocks) {
    (void)hipFuncSetAttribute((const void*)mega, hipFuncAttributeMaxDynamicSharedMemorySize, SMEM_BYTES);
    int dev = 0, cus = 0, per_cu = 0;
    (void)hipGetDevice(&dev);
    (void)hipDeviceGetAttribute(&cus, hipDeviceAttributeMultiprocessorCount, dev);
    (void)hipOccupancyMaxActiveBlocksPerMultiprocessor(&per_cu, mega, NTHREADS, SMEM_BYTES);
    per_cu = 1;
    grid_blocks = cus * per_cu;
  }
  const int nph = 4 * (PH_PER_LAYER + (PROBE_DUP >= 0 ? 1 : 0));
#if MK_COOP
  int lo = 0, hi = nph, use_cg = 0;
  void* args[] = {&p, &lo, &hi, &use_cg};
  (void)hipMemsetAsync(p.ws + OFF_bar, 0, 16384, stream);
  hipError_t e = hipLaunchCooperativeKernel((const void*)mega, dim3(grid_blocks), dim3(NTHREADS), args, SMEM_BYTES, stream);
  if (e != hipSuccess) fprintf(stderr, "cooperative launch failed: %s (grid %d)\n", hipGetErrorString(e), grid_blocks);
#else
  for (int ph = 0; ph < nph; ++ph)
    hipLaunchKernelGGL(mega, dim3(grid_blocks), dim3(NTHREADS), SMEM_BYTES, stream, p, ph, ph + 1, 0);
#endif
}
```
